# Optimizing an MI355X kernel written in HIP

```python
import math
import jax, jax.numpy as jnp
from jax import lax
import numpy as np

D_MODEL = 1024
BATCH = 32
SEQ = 2048
DEPTH = 2

CHUNK = 64
N_META = 16
ROPE_THETA = 10000.0
EPS = 1e-6
A_HEADS = 4
A_DK = 128
A_DV = 128
A_CONV = 4
B_HEADS = 4
B_DH = 128
IDX_HEADS = 8
IDX_DIM = 64
TOPK_MAX = 256
TOPK_DIV = 4
Q_BLOCK = 64
D_FF = 2816
FFN_CONV = 3

A_WIDTH = A_HEADS * A_DV
B_WIDTH = B_HEADS * B_DH
IN_SPLITS = (A_HEADS * A_DK, A_HEADS * A_DK, A_WIDTH, A_WIDTH, A_HEADS, A_HEADS,
             B_WIDTH, B_DH, B_DH, IDX_HEADS * IDX_DIM, IDX_DIM, IDX_HEADS)
IN_COLS = sum(IN_SPLITS)
SPLIT_POINTS = tuple(int(c) for c in np.cumsum(IN_SPLITS)[:-1])

kernel_name = "hybrid_gdn_dsa_convffn_meta"


def rms_norm(x, g):
    xf = x.astype(jnp.float32)
    y = xf * lax.rsqrt(jnp.mean(xf * xf, axis=-1, keepdims=True) + EPS)
    return (y * g.astype(jnp.float32)).astype(x.dtype)


def l2_norm(x):
    xf = x.astype(jnp.float32)
    return xf * lax.rsqrt(jnp.sum(xf * xf, axis=-1, keepdims=True) + EPS)


def rope_tables(T, dim):
    inv_freq = 1.0 / (ROPE_THETA ** (jnp.arange(0, dim, 2, dtype=jnp.float32) / dim))
    ang = jnp.arange(T, dtype=jnp.float32)[:, None] * inv_freq[None, :]
    return jnp.cos(ang), jnp.sin(ang)


def apply_rope(x, cos, sin):
    xf = x.astype(jnp.float32)
    x1, x2 = jnp.split(xf, 2, axis=-1)
    c, s = cos[:, None, :], sin[:, None, :]
    return jnp.concatenate([x1 * c - x2 * s, x2 * c + x1 * s], axis=-1).astype(x.dtype)


def causal_dwconv(x, w):
    width = w.shape[0]
    T = x.shape[1]
    xp = jnp.pad(x, ((0, 0), (width - 1, 0), (0, 0)))
    out = xp[:, 0:T] * w[0]
    for i in range(1, width):
        out = out + xp[:, i:i + T] * w[i]
    return out


def gated_deltanet(q, k, v, z, a, b, conv_w, a_log, dt_bias, norm_g):
    f32 = jnp.float32
    Bsz, T, _ = q.shape
    qkv = jax.nn.silu(causal_dwconv(jnp.concatenate([q, k, v], axis=-1), conv_w))
    q, k, v = jnp.split(qkv, [A_HEADS * A_DK, 2 * A_HEADS * A_DK], axis=-1)
    q = l2_norm(q.reshape(Bsz, T, A_HEADS, A_DK)) * (A_DK ** -0.5)
    k = l2_norm(k.reshape(Bsz, T, A_HEADS, A_DK))
    v = v.reshape(Bsz, T, A_HEADS, A_DV).astype(f32)
    g = -jnp.exp(a_log.astype(f32)) * jax.nn.softplus(a.astype(f32) + dt_bias.astype(f32))
    beta = jax.nn.sigmoid(b.astype(f32))
    pad = (-T) % CHUNK
    Tp = T + pad
    N = Tp // CHUNK

    def chunks(t):
        t = jnp.pad(t, ((0, 0), (pad, 0)) + ((0, 0),) * (t.ndim - 2))
        t = t.reshape((Bsz, N, CHUNK) + t.shape[2:])
        return jnp.moveaxis(t, 3, 1)

    qc, kc, vc, gch, bc = chunks(q), chunks(k), chunks(v), chunks(g), chunks(beta)
    gcum = jnp.cumsum(gch, axis=-1)
    pos = jnp.arange(CHUNK)
    incl = pos[:, None] >= pos[None, :]
    strict = pos[:, None] > pos[None, :]
    decay = jnp.exp(jnp.where(incl, gcum[..., :, None] - gcum[..., None, :], -jnp.inf))
    kk = jnp.einsum('bhncd,bhnsd->bhncs', kc, kc)
    m = jnp.where(strict, bc[..., None] * kk * decay, 0.0)
    lhs = m + jnp.eye(CHUNK, dtype=f32)
    rhs = jnp.concatenate([vc * bc[..., None], kc * (bc * jnp.exp(gcum))[..., None]], axis=-1)
    sol = lax.linalg.triangular_solve(lhs, rhs, left_side=True, lower=True, unit_diagonal=True)
    u, w = sol[..., :A_DV], sol[..., A_DV:]
    qk = jnp.einsum('bhncd,bhnsd->bhncs', qc, kc) * decay

    def step(S, inp):
        q_c, k_c, u_c, w_c, g_c, qk_c = inp
        v_new = u_c - jnp.einsum('bhcd,bhde->bhce', w_c, S)
        o = (jnp.einsum('bhcd,bhde->bhce', q_c * jnp.exp(g_c)[..., None], S)
             + jnp.einsum('bhcs,bhse->bhce', qk_c, v_new))
        g_last = g_c[..., -1]
        S = (S * jnp.exp(g_last)[..., None, None]
             + jnp.einsum('bhcd,bhce->bhde', k_c * jnp.exp(g_last[..., None] - g_c)[..., None], v_new))
        return S, o

    xs = tuple(jnp.moveaxis(t, 2, 0) for t in (qc, kc, u, w, gcum, qk))
    S0 = jnp.zeros((Bsz, A_HEADS, A_DK, A_DV), f32)
    _, o = lax.scan(step, S0, xs)
    o = jnp.transpose(o, (1, 0, 3, 2, 4)).reshape(Bsz, Tp, A_HEADS, A_DV)[:, pad:]
    o = rms_norm(o, norm_g) * jax.nn.silu(z.reshape(Bsz, T, A_HEADS, A_DV).astype(f32))
    return o.reshape(Bsz, T, A_WIDTH).astype(z.dtype)


def dsa_attention(q, k, v, iq, ik, iw, q_norm, k_norm, kidx_norm, cos_a, sin_a, cos_i, sin_i):
    f32 = jnp.float32
    Bsz, T, _ = q.shape
    S = T - N_META
    topk = min(TOPK_MAX, S // TOPK_DIV)
    q = apply_rope(rms_norm(q.reshape(Bsz, T, B_HEADS, B_DH), q_norm), cos_a, sin_a)
    k = apply_rope(rms_norm(k.reshape(Bsz, T, 1, B_DH), k_norm), cos_a, sin_a)[:, :, 0]
    iq = apply_rope(iq.reshape(Bsz, T, IDX_HEADS, IDX_DIM), cos_i, sin_i)
    ik = apply_rope(rms_norm(ik.reshape(Bsz, T, 1, IDX_DIM), kidx_norm), cos_i, sin_i)[:, :, 0]
    iw = iw * (IDX_HEADS ** -0.5 * IDX_DIM ** -0.5)
    scale = B_DH ** -0.5

    q_m, k_m, v_m = q[:, :N_META], k[:, :N_META], v[:, :N_META]
    s_mm = jnp.einsum('bqhd,bkd->bhqk', q_m, k_m).astype(f32) * scale
    o_meta = jnp.einsum('bhqk,bkd->bqhd', jax.nn.softmax(s_mm, axis=-1).astype(v.dtype), v_m)

    nb = S // Q_BLOCK
    q_r = q[:, N_META:].reshape(Bsz, nb, Q_BLOCK, B_HEADS, B_DH).swapaxes(0, 1)
    iq_r = iq[:, N_META:].reshape(Bsz, nb, Q_BLOCK, IDX_HEADS, IDX_DIM).swapaxes(0, 1)
    iw_r = iw[:, N_META:].reshape(Bsz, nb, Q_BLOCK, IDX_HEADS).swapaxes(0, 1)
    ik_r = ik[:, N_META:]
    kv_r = jnp.concatenate([k[:, N_META:], v[:, N_META:]], axis=-1)
    key_pos = jnp.arange(S)

    def one_block(args):
        j, qb, iqb, iwb = args
        q_pos = j * Q_BLOCK + jnp.arange(Q_BLOCK)
        limit = (q_pos // CHUNK + 1) * CHUNK
        valid = key_pos[None, :] < limit[:, None]
        logit_i = jnp.einsum('bqhd,bsd->bhqs', iqb, ik_r)
        score = jnp.einsum('bhqs,bqh->bqs', jax.nn.relu(logit_i), iwb).astype(f32)
        score = jnp.where(valid[None], score, -jnp.inf)
        _, sel = lax.top_k(score, topk)
        sel_valid = sel < limit[None, :, None]
        kv_sel = jax.vmap(lambda arr, ix: arr[ix])(kv_r, sel)
        k_sel, v_sel = kv_sel[..., :B_DH], kv_sel[..., B_DH:]
        s_meta = jnp.einsum('bqhd,bmd->bhqm', qb, k_m).astype(f32)
        s_sel = jnp.einsum('bqhd,bqkd->bhqk', qb, k_sel).astype(f32)
        s_sel = jnp.where(sel_valid[:, None], s_sel, -jnp.inf)
        p = jax.nn.softmax(jnp.concatenate([s_meta, s_sel], axis=-1) * scale, axis=-1).astype(v.dtype)
        return (jnp.einsum('bhqm,bmd->bqhd', p[..., :N_META], v_m)
                + jnp.einsum('bhqk,bqkd->bqhd', p[..., N_META:], v_sel))

    o_r = lax.map(one_block, (jnp.arange(nb), q_r, iq_r, iw_r))
    o_r = o_r.swapaxes(0, 1).reshape(Bsz, S, B_HEADS, B_DH)
    return jnp.concatenate([o_meta, o_r], axis=1).reshape(Bsz, T, B_WIDTH)


def hybrid_mixer(n, w_in, conv_a, a_log, dt_bias, a_out_norm, q_norm, k_norm, kidx_norm,
                 w_branch_a, w_branch_b, w_gate, b_gate, w_out, cos_a, sin_a, cos_i, sin_i):
    Bsz, T, D = n.shape
    proj = n @ w_in
    aq, ak, av, az, aa, ab, bq, bk, bv, iq, ik, iw = jnp.split(proj, SPLIT_POINTS, axis=-1)
    o_a = gated_deltanet(aq, ak, av, az, aa, ab, conv_a, a_log, dt_bias, a_out_norm)
    o_b = dsa_attention(bq, bk, bv, iq, ik, iw, q_norm, k_norm, kidx_norm, cos_a, sin_a, cos_i, sin_i)
    gates = jax.nn.sigmoid(n @ w_gate + b_gate).reshape(Bsz, T, 2, D)
    y = gates[:, :, 0] * (o_a @ w_branch_a) + gates[:, :, 1] * (o_b @ w_branch_b)
    return y @ w_out


def conv_gated_mlp(n, w_up, conv_w, w_down):
    gate, up = jnp.split(n @ w_up, 2, axis=-1)
    gate = causal_dwconv(gate, conv_w)
    return (jax.nn.silu(gate) * up) @ w_down


def setup_inputs(seed: int = 0) -> dict:
    key = jax.random.key(seed)
    ks = jax.random.split(key, 24)
    L, D = DEPTH, D_MODEL
    f32 = jnp.float32

    def nrm(k, shape, scale):
        return jax.random.normal(k, shape, f32) * scale

    def gain(k, shape):
        return 1.0 + nrm(k, shape, 0.02)

    a_init = jax.random.uniform(ks[5], (L, A_HEADS), f32, 1.0, 16.0)
    dt = jnp.exp(jax.random.uniform(ks[6], (L, A_HEADS), f32, math.log(1e-3), math.log(1e-1)))
    return {
        "x": nrm(ks[0], (BATCH, SEQ, D), 1.0),
        "meta_tokens": nrm(ks[1], (N_META, D), 0.5),
        "norm_mix": gain(ks[2], (L, D)),
        "w_in": nrm(ks[3], (L, D, IN_COLS), D ** -0.5),
        "conv_a": nrm(ks[4], (L, A_CONV, 2 * A_HEADS * A_DK + A_WIDTH), 0.5),
        "a_log": jnp.log(a_init),
        "dt_bias": dt + jnp.log(-jnp.expm1(-dt)),
        "a_out_norm": gain(ks[7], (L, A_DV)),
        "q_norm": gain(ks[8], (L, B_DH)),
        "k_norm": gain(ks[9], (L, B_DH)),
        "kidx_norm": gain(ks[10], (L, IDX_DIM)),
        "w_branch_a": nrm(ks[11], (L, A_WIDTH, D), A_WIDTH ** -0.5),
        "w_branch_b": nrm(ks[12], (L, B_WIDTH, D), B_WIDTH ** -0.5),
        "w_gate": nrm(ks[13], (L, D, 2 * D), D ** -0.5),
        "b_gate": nrm(ks[14], (L, 2 * D), 0.1),
        "w_out": nrm(ks[15], (L, D, D), D ** -0.5),
        "norm_ffn": gain(ks[16], (L, D)),
        "w_up": nrm(ks[17], (L, D, 2 * D_FF), D ** -0.5),
        "conv_ffn": nrm(ks[18], (L, FFN_CONV, D_FF), 0.5),
        "w_down": nrm(ks[19], (L, D_FF, D), D_FF ** -0.5),
    }


def reference(x, meta_tokens, norm_mix, w_in, conv_a, a_log, dt_bias, a_out_norm, q_norm, k_norm,
              kidx_norm, w_branch_a, w_branch_b, w_gate, b_gate, w_out, norm_ffn, w_up, conv_ffn,
              w_down) -> jnp.ndarray:
    Bsz = x.shape[0]
    T = N_META + x.shape[1]
    cos_a, sin_a = rope_tables(T, B_DH)
    cos_i, sin_i = rope_tables(T, IDX_DIM)
    meta = jnp.broadcast_to(meta_tokens.astype(x.dtype)[None], (Bsz, N_META, x.shape[2]))
    h = jnp.concatenate([meta, x], axis=1)
    for l in range(DEPTH):
        n = rms_norm(h, norm_mix[l])
        h = h + hybrid_mixer(n, w_in[l], conv_a[l], a_log[l], dt_bias[l], a_out_norm[l], q_norm[l],
                             k_norm[l], kidx_norm[l], w_branch_a[l], w_branch_b[l], w_gate[l], b_gate[l],
                             w_out[l], cos_a, sin_a, cos_i, sin_i).astype(h.dtype)
        n = rms_norm(h, norm_ffn[l])
        h = h + conv_gated_mlp(n, w_up[l], conv_ffn[l], w_down[l]).astype(h.dtype)
    return h[:, N_META:]
```

```cpp
#include <hip/hip_runtime.h>
#include <cstdio>
#include <cstdint>

#define LAS __attribute__((address_space(3)))
typedef unsigned short bf16_t;
typedef short bf16x8 __attribute__((ext_vector_type(8)));
typedef short s16x4 __attribute__((ext_vector_type(4)));
typedef float f32x4 __attribute__((ext_vector_type(4)));
typedef float f32x16 __attribute__((ext_vector_type(16)));
typedef unsigned u32x4 __attribute__((ext_vector_type(4)));
typedef unsigned u32x2 __attribute__((ext_vector_type(2)));

constexpr int NB = 32, SQ = 2048, RR = NB * SQ, NMETA = 16, TP = 2176, DM = 1024, TPOS = 2064;
constexpr int NIN = 5632, DFF = 2816, NLAYER = 2;
constexpr float EPSF = 1e-6f;

constexpr size_t al256(size_t x) { return (x + 255) / 256 * 256; }
constexpr size_t OFF_CTL = 0, SZ_CTL = 65536;
constexpr size_t OFF_WIN = OFF_CTL + SZ_CTL, SZ_WIN = (size_t)NLAYER * NIN * DM * 2;
constexpr size_t OFF_WBA = OFF_WIN + SZ_WIN, SZ_WB = (size_t)NLAYER * DM * 512 * 2;
constexpr size_t OFF_WBB = OFF_WBA + SZ_WB;
constexpr size_t OFF_WOUT = OFF_WBB + SZ_WB, SZ_WOUT = (size_t)NLAYER * DM * DM * 2;
constexpr size_t OFF_WUP = OFF_WOUT + SZ_WOUT, SZ_WUP = (size_t)NLAYER * NIN * DM * 2;
constexpr size_t OFF_WDN = OFF_WUP + SZ_WUP, SZ_WDN = (size_t)NLAYER * DM * DFF * 2;
constexpr size_t OFF_COSA = OFF_WDN + SZ_WDN, SZ_ROPA = (size_t)TPOS * 64 * 4;
constexpr size_t OFF_SINA = OFF_COSA + SZ_ROPA;
constexpr size_t OFF_COSI = OFF_SINA + SZ_ROPA, SZ_ROPI = (size_t)TPOS * 32 * 4;
constexpr size_t OFF_SINI = OFF_COSI + SZ_ROPI;
constexpr size_t OFF_M = al256(OFF_SINI + SZ_ROPI);
constexpr size_t M_H = OFF_M;
constexpr size_t M_NB = M_H + 16 * 1024 * 4;
constexpr size_t M_RAW = M_NB + 16 * 1024 * 2;
constexpr size_t M_CHUNK = M_RAW + 16 * 1536 * 2;
constexpr size_t M_Z = M_CHUNK + 64 * 1536 * 2;
constexpr size_t M_BQ = M_Z + 16 * 512 * 2;
constexpr size_t M_IQ = M_BQ + 16 * 512 * 2;
constexpr size_t M_K = M_IQ + 16 * 512 * 2;
constexpr size_t M_V = M_K + 16 * 128 * 2;
constexpr size_t M_MISC = M_V + 16 * 128 * 2;
constexpr size_t M_GATES = M_MISC + 16 * 16 * 4;
constexpr size_t M_TQ = M_GATES + 16 * 2048 * 2;
constexpr size_t M_GC = M_TQ + 4 * 2 * 4096 * 2;
constexpr size_t M_BETA = M_GC + 64 * 4 * 4;
constexpr size_t M_OA = M_BETA + 64 * 4 * 4;
constexpr size_t M_OB = M_OA + 16 * 512 * 2;
constexpr size_t M_Y = M_OB + 16 * 512 * 2;
constexpr size_t M_GU = M_Y + 16 * 1024 * 2;
constexpr size_t M_ACT = M_GU + 16 * 5632 * 4;
constexpr size_t M_END = M_ACT + 16 * 2816 * 2;
constexpr size_t OFF_NB = al256(M_END), SZ_NB = (size_t)RR * DM * 2;
constexpr size_t OFF_OA = OFF_NB, OFF_OB = OFF_NB + (size_t)RR * 512 * 2;
constexpr size_t OFF_QKV = OFF_NB + SZ_NB, SZ_QKV = (size_t)RR * 1536 * 2;
constexpr size_t OFF_HALO = OFF_QKV + SZ_QKV, SZ_HALO = (size_t)(RR / 64) * 3 * 1536 * 2;
constexpr size_t OFF_Z = OFF_HALO + SZ_HALO, SZ_512 = (size_t)RR * 512 * 2;
constexpr size_t OFF_BQ = OFF_Z + SZ_512;
constexpr size_t OFF_IQ = OFF_BQ + SZ_512;
constexpr size_t OFF_KB = OFF_IQ + SZ_512, SZ_KB = (size_t)NB * TP * 128 * 2;
constexpr size_t OFF_VB = OFF_KB + SZ_KB;
constexpr size_t OFF_IKB = OFF_VB + SZ_KB, SZ_IKB = (size_t)NB * TP * 64 * 2;
constexpr size_t OFF_MISC = OFF_IKB + SZ_IKB, SZ_MISC = (size_t)RR * 16 * 4;
constexpr size_t OFF_GC = OFF_MISC + SZ_MISC, SZ_GC = (size_t)RR * 4 * 4;
constexpr size_t OFF_BETA = OFF_GC + SZ_GC;
constexpr size_t OFF_GATES = OFF_BETA + SZ_GC, SZ_GATES = (size_t)RR * 2048 * 2;
constexpr size_t OFF_TQ = OFF_GATES + SZ_GATES, SZ_TQ = (size_t)NB * 32 * 4 * 2 * 4096 * 2;
constexpr size_t WS_END = OFF_TQ + SZ_TQ;
constexpr size_t OFF_Y = OFF_QKV;
constexpr size_t OFF_GPRE = OFF_QKV, SZ_FF = (size_t)RR * DFF * 2;
constexpr size_t OFF_UP = OFF_GPRE + SZ_FF;
static_assert(OFF_UP + SZ_FF <= WS_END, "ffn alias region");
static_assert(WS_END <= (size_t)1073741824, "workspace budget");
constexpr int CW_QUEUE = 4096;

constexpr int LDS_BYTES = 163840, LDS_XB = LDS_BYTES - 16;

__device__ __forceinline__ unsigned cvt_pk(float lo, float hi) { unsigned r; asm volatile("v_cvt_pk_bf16_f32 %0, %1, %2" : "=v"(r) : "v"(lo), "v"(hi)); return r; }
__device__ __forceinline__ bf16_t f2bf(float x) { return (bf16_t)(cvt_pk(x, 0.f) & 0xffffu); }
__device__ __forceinline__ float bf2f(bf16_t b) { return __uint_as_float(((unsigned)b) << 16); }
__device__ __forceinline__ float bflo(unsigned w) { return __uint_as_float(w << 16); }
__device__ __forceinline__ float bfhi(unsigned w) { return __uint_as_float(w & 0xffff0000u); }
__device__ __forceinline__ float wave_sum(float v) {
#pragma unroll
    for (int o = 32; o; o >>= 1) v += __shfl_xor(v, o);
    return v; }
__device__ __forceinline__ float half_sum(float v) {
#pragma unroll
    for (int o = 16; o; o >>= 1) v += __shfl_xor(v, o);
    return v; }
__device__ __forceinline__ float sigmoid_f(float x) { return 1.f / (1.f + __expf(-x)); }
__device__ __forceinline__ float silu_f(float x) { return x / (1.f + __expf(-x)); }
__device__ __forceinline__ float softplus_f(float x) { return fmaxf(x, 0.f) + log1pf(__expf(-fabsf(x))); }
__device__ __forceinline__ u32x4 pack8(f32x4 a, f32x4 b) { u32x4 w; w.x = cvt_pk(a[0], a[1]); w.y = cvt_pk(a[2], a[3]); w.z = cvt_pk(b[0], b[1]); w.w = cvt_pk(b[2], b[3]); return w; }
__device__ __forceinline__ bf16x8 as_bf8(u32x4 w) { return __builtin_bit_cast(bf16x8, w); }
__device__ __forceinline__ f32x4 mfma16(bf16x8 a, bf16x8 b, f32x4 c) { return __builtin_amdgcn_mfma_f32_16x16x32_bf16(a, b, c, 0, 0, 0); }

#define XB_TMO      128
#define XB_XCNT(j)  (256  + 64 * (j))
#define XB_XSUB(j)  (1280 + 64 * (j))
#define XB_XGEN(j)  (2304 + 64 * (j))
#define XB_TOP      3328
#define XB_TOPGEN   3392
#define XCD_BAR_WORDS 3456
#define XB_SPIN_CAP (1u << 18)
__device__ __forceinline__ unsigned xb_ld(unsigned* p)              { return __hip_atomic_load(p, __ATOMIC_RELAXED, __HIP_MEMORY_SCOPE_AGENT); }
__device__ __forceinline__ unsigned xb_add(unsigned* p, unsigned v) { return __hip_atomic_fetch_add(p, v, __ATOMIC_RELAXED, __HIP_MEMORY_SCOPE_AGENT); }
__device__ __forceinline__ unsigned xb_xcc_id() { return (unsigned)__builtin_amdgcn_s_getreg((3 << 11) | 20) & 0xFu; }
#define XB_SPIN(cond, bar) do { unsigned _sp = 0; while (cond) { __builtin_amdgcn_s_sleep(1); \
    if ((++_sp & 255u) == 0u) { if (xb_ld(&(bar)[XB_TMO])) break; if (_sp > XB_SPIN_CAP) { atomicAdd(&(bar)[XB_TMO], 1u); break; } } } } while (0)
struct XcdBarrier { unsigned* bar; unsigned x; volatile LAS unsigned* st; };
__device__ __forceinline__ XcdBarrier xcd_barrier_post(unsigned* bar, volatile LAS unsigned* st) {
    XcdBarrier b; b.bar = bar; b.x = xb_xcc_id(); b.st = st;
    if (threadIdx.x == 0) (void)xb_add(&bar[XB_XCNT(b.x)], 1u);
    return b;
}
__device__ __forceinline__ void xcd_barrier_complete(unsigned* bar, unsigned x, unsigned& nloc, unsigned& nx) {
    const unsigned G = gridDim.x * gridDim.y * gridDim.z;
    unsigned sum, cnt, mine, sp = 0u;
    for (;;) {
        sum = 0u; cnt = 0u; mine = 0u;
#pragma unroll
        for (unsigned j = 0; j < 16; ++j) { const unsigned c = xb_ld(&bar[XB_XCNT(j)]); sum += c; cnt += (c > 0u) ? 1u : 0u; mine = (j == x) ? c : mine; }
        if (sum == G) break;
        __builtin_amdgcn_s_sleep(1);
        if ((++sp & 255u) == 0u) { if (xb_ld(&bar[XB_TMO])) break; if (sp > XB_SPIN_CAP) { atomicAdd(&bar[XB_TMO], 1u); break; } }
    }
    nloc = mine > 0u ? mine : 1u; nx = cnt > 0u ? cnt : 1u;
}
__device__ __forceinline__ void xcd_barrier(const XcdBarrier& b) {
    asm volatile("s_waitcnt vmcnt(0)" ::: "memory");
    __syncthreads();
    if (threadIdx.x == 0) {
        unsigned* bar = b.bar;
        __builtin_amdgcn_s_waitcnt(0);
        unsigned nloc = b.st[0], nx = b.st[1];
        if (nloc == 0u) { xcd_barrier_complete(bar, b.x, nloc, nx); b.st[0] = nloc; b.st[1] = nx; }
        const unsigned old = xb_add(&bar[XB_XSUB(b.x)], 1u);
        const unsigned gen = old / nloc;
        if (old + 1u == (gen + 1u) * nloc) {
            __builtin_amdgcn_fence(__ATOMIC_RELEASE, "agent");
            asm volatile("s_waitcnt vmcnt(0)" ::: "memory");
            const unsigned og = xb_add(&bar[XB_TOP], 1u);
            const unsigned tg = og / nx;
            if (og + 1u == (tg + 1u) * nx) xb_add(&bar[XB_TOPGEN], 1u);
            else XB_SPIN(xb_ld(&bar[XB_TOPGEN]) == tg, bar);
            __builtin_amdgcn_fence(__ATOMIC_ACQUIRE, "agent");
            xb_add(&bar[XB_XGEN(b.x)], 1u);
            asm volatile("s_waitcnt vmcnt(0)" ::: "memory");
        } else {
            XB_SPIN(xb_ld(&bar[XB_XGEN(b.x)]) == gen, bar);
            __builtin_amdgcn_fence(__ATOMIC_ACQUIRE, "agent");
            asm volatile("s_waitcnt vmcnt(0)" ::: "memory");
        }
    }
    __syncthreads();
}

namespace pg8 {
#define PG8_LAS __attribute__((address_space(3)))
typedef unsigned short bf16_t;
typedef short bf16x8 __attribute__((ext_vector_type(8)));
typedef float f32x4 __attribute__((ext_vector_type(4)));
typedef unsigned u32x4 __attribute__((ext_vector_type(4)));
constexpr int BM = 256, BK = 64, HALF = 128, HTB = HALF * BK * 2  , STAGE_BYTES = 8 * HTB, NXCD = 8, WGM = 8;

__host__ __device__ __forceinline__ int lds_byte(int r, int c) { const int st = (r >> 4) * 2 + (c >> 5), rr = r & 15, cc = c & 31, ob = rr * 64 + cc * 2; return st * 1024 + (ob ^ (((ob >> 9) & 1) << 5)); }
__host__ __device__ __forceinline__ void stage_rc(int b, int& R, int& C) { const int st = b / 1024, sb = b % 1024, swz = sb ^ (((sb >> 9) & 1) << 5); R = (st >> 1) * 16 + swz / 64; C = (st & 1) * 32 + (swz % 64) / 2; }
__host__ __device__ __forceinline__ int perm32(int rho) { const int n = rho >> 4, i = rho & 15; return 8 * (i >> 2) + 4 * n + (i & 3); }

struct Unit { int pm, pn; };
struct Gemm { const bf16_t* A; const bf16_t* Bt; int M, N, K; };

struct StaticOrder {
    int nM, nN, nwg, G, c;
    __host__ __device__ void init(int M, int N, int G_, int c_) { nM = M / BM; nN = N / BM; nwg = nM * nN; G = G_; c = c_; }
    __host__ __device__ bool next(int i, Unit& u) const {
        const long L = (long)i * G + c; if (L >= nwg) return false;
        int wgid = (int)L; { const int q = nwg / NXCD, r = nwg % NXCD, xcd = wgid % NXCD, off = wgid / NXCD; wgid = (xcd < r ? xcd * (q + 1) : r * (q + 1) + (xcd - r) * q) + off; }
        const int nig = WGM * nN, gid = wgid / nig, fm = gid * WGM, gsz = (nM - fm) < WGM ? (nM - fm) : WGM;
        u.pm = fm + ((wgid % nig) % gsz); u.pn = (wgid % nig) / gsz; return true;
    }
    __device__ __forceinline__ void a_ready(const Unit&) const {}
    __device__ __forceinline__ void done(const Unit&) const {}
};
__device__ __forceinline__ unsigned cvt_pk_bf16(float lo, float hi) { unsigned r; asm volatile("v_cvt_pk_bf16_f32 %0, %1, %2" : "=v"(r) : "v"(lo), "v"(hi)); return r; }
typedef float f32x2 __attribute__((ext_vector_type(2)));
template <class Epi, class Sched, bool STAMP = false>
__device__ __forceinline__ void gemm_phase(PG8_LAS unsigned char* lds, const Gemm g, const Sched& S, const Epi& E, unsigned long long* stamps) {
    int tid_ = threadIdx.x; asm volatile("" : "+v"(tid_));
    const int tid = tid_, wid = __builtin_amdgcn_readfirstlane(tid >> 6), lane = tid & 63, wr = wid >> 2, wc = wid & 3, fr = lane & 15, fq = lane >> 4;
    const int K = g.K, nt = K / BK;
    int ts_lo = 0, ts_hi = 0, nts = 0; const unsigned long long rt_entry = STAMP ? (unsigned long long)wall_clock64() : 0ull;
#define PG8_STAMP() do { if (STAMP && wid == 0 && nts < 64) { const unsigned long long _c = (unsigned long long)clock64(); \
        ts_lo = (lane == nts) ? (int)(unsigned)_c : ts_lo; ts_hi = (lane == nts) ? (int)(unsigned)(_c >> 32) : ts_hi; ++nts; } } while (0)
    PG8_STAMP();
    unsigned voffA[2], voffB[2];
#pragma unroll
    for (int i = 0; i < 2; ++i) { int R, C; stage_rc(tid * 16 + i * 8192, R, C); const int Rb = Epi::PERM ? ((R & ~31) + perm32(R & 31)) : R;
        voffA[i] = (unsigned)(R * K + C) * 2u; voffB[i] = (unsigned)(Rb * K + C) * 2u; }
    const size_t kstep = (size_t)(BK * 2);
    const size_t hstep = (size_t)HALF * K * 2;
    const size_t tstep = 2 * hstep;
    const unsigned ldsw = (unsigned)wid * 1024u;
    const int aoff = lds_byte(wr * 64 + fr, fq * 8), boff = lds_byte(wc * 32 + fr, fq * 8);
#define PG8_SA(b, h) (((b) * 2 + (h)) * HTB)
#define PG8_SB(b, h) ((4 + (b) * 2 + (h)) * HTB)
#define PG8_STAGE(bufoff, gbase, voff) do { _Pragma("unroll") for (int _i = 0; _i < 2; ++_i) \
        __builtin_amdgcn_global_load_lds((const unsigned*)((const char*)(gbase) + (voff)[_i]), (PG8_LAS unsigned*)(lds + (bufoff) + ldsw + _i * 8192), 16, 0, 0); } while (0)
#define PG8_LDA(dst, b, h) do { _Pragma("unroll") for (int m = 0; m < 4; ++m) _Pragma("unroll") for (int k = 0; k < 2; ++k) dst[m][k] = *(const PG8_LAS bf16x8*)(lds + PG8_SA(b, h) + aoff + m * 2048 + k * 1024); } while (0)
#define PG8_LDB(dst, b, h) do { _Pragma("unroll") for (int n = 0; n < 2; ++n) _Pragma("unroll") for (int k = 0; k < 2; ++k) dst[n][k] = *(const PG8_LAS bf16x8*)(lds + PG8_SB(b, h) + boff + n * 2048 + k * 1024); } while (0)
#define PG8_MMA(ai, bj, At, Bt) do { __builtin_amdgcn_s_setprio(1); _Pragma("unroll") for (int m = 0; m < 4; ++m) _Pragma("unroll") for (int n = 0; n < 2; ++n) _Pragma("unroll") for (int k = 0; k < 2; ++k) \
        acc[ai][bj][m][n] = __builtin_amdgcn_mfma_f32_16x16x32_bf16(Bt[n][k], At[m][k], acc[ai][bj][m][n], 0, 0, 0); __builtin_amdgcn_s_setprio(0); } while (0)
#define PG8_WAIT_V(n) asm volatile("s_waitcnt vmcnt(" #n ")" ::: "memory")
#define PG8_WAIT_L(n) asm volatile("s_waitcnt lgkmcnt(" #n ")" ::: "memory")
#define PG8_BAR __builtin_amdgcn_s_barrier()
#define PG8_SCHED __builtin_amdgcn_sched_barrier(0)
    Unit cur, nxt; int ui = 0;
    if (!S.next(0, cur)) return;
    f32x4 acc[2][2][4][2];
#pragma unroll
    for (int a = 0; a < 2; ++a)
#pragma unroll
        for (int b = 0; b < 2; ++b)
#pragma unroll
            for (int m = 0; m < 4; ++m)
#pragma unroll
                for (int n = 0; n < 2; ++n) acc[a][b][m][n] = (f32x4){0.f, 0.f, 0.f, 0.f};
    bf16x8 At[4][2], B0[2][2], B1[2][2];
    const char* cA = (const char*)g.A + (size_t)cur.pm * tstep; const char* cB = (const char*)g.Bt + (size_t)cur.pn * tstep;
    S.a_ready(cur);
    PG8_STAGE(PG8_SB(0, 0), cB, voffB); PG8_STAGE(PG8_SA(0, 0), cA, voffA); PG8_STAGE(PG8_SB(0, 1), cB + hstep, voffB); PG8_STAGE(PG8_SA(0, 1), cA + hstep, voffA);
    if (wr == 1) PG8_BAR;
    PG8_WAIT_V(4); PG8_BAR;
    PG8_STAGE(PG8_SB(1, 0), cB + kstep, voffB); PG8_STAGE(PG8_SA(1, 0), cA + kstep, voffA); PG8_STAGE(PG8_SB(1, 1), cB + hstep + kstep, voffB);
    PG8_WAIT_V(6); PG8_BAR;
    PG8_STAMP();
    for (;;) {
        const bool has_next = S.next(ui + 1, nxt);
        const char* nA = has_next ? (const char*)g.A + (size_t)nxt.pm * tstep : cA; const char* nB = has_next ? (const char*)g.Bt + (size_t)nxt.pn * tstep : cB;
        for (int t = 0; t < nt; t += 2) {
            const bool last = (t == nt - 2);
            const char* a1 = cA + (size_t)(t + 1) * kstep;
            const char* a2 = last ? nA : cA + (size_t)(t + 2) * kstep; const char* b2 = last ? nB : cB + (size_t)(t + 2) * kstep;
            const char* a3 = a2 + kstep; const char* b3 = b2 + kstep;
            if (last && has_next) S.a_ready(nxt);
            PG8_LDB(B0, 0, 0); PG8_SCHED; PG8_LDA(At, 0, 0); PG8_STAGE(PG8_SA(1, 1), a1 + hstep, voffA);
            PG8_WAIT_L(8); PG8_BAR; PG8_WAIT_L(0); PG8_MMA(0, 0, At, B0); PG8_BAR; PG8_SCHED;
            PG8_LDB(B1, 0, 1); PG8_STAGE(PG8_SB(0, 0), b2, voffB);
            PG8_BAR; PG8_WAIT_L(0); PG8_MMA(0, 1, At, B1); PG8_BAR;
            PG8_LDA(At, 0, 1); PG8_STAGE(PG8_SA(0, 0), a2, voffA);
            PG8_BAR; PG8_WAIT_L(0); PG8_MMA(1, 0, At, B0); PG8_BAR; PG8_SCHED;
            PG8_STAGE(PG8_SB(0, 1), b2 + hstep, voffB);
            PG8_WAIT_V(6); PG8_BAR; PG8_MMA(1, 1, At, B1); PG8_BAR;
            PG8_LDB(B0, 1, 0); PG8_SCHED; PG8_LDA(At, 1, 0); PG8_STAGE(PG8_SA(0, 1), a2 + hstep, voffA);
            PG8_WAIT_L(8); PG8_BAR; PG8_WAIT_L(0); PG8_MMA(0, 0, At, B0); PG8_BAR; PG8_SCHED;
            PG8_LDB(B1, 1, 1); PG8_STAGE(PG8_SB(1, 0), b3, voffB);
            PG8_BAR; PG8_WAIT_L(0); PG8_MMA(0, 1, At, B1); PG8_BAR;
            PG8_LDA(At, 1, 1); PG8_STAGE(PG8_SA(1, 0), a3, voffA);
            PG8_BAR; PG8_WAIT_L(0); PG8_MMA(1, 0, At, B0); PG8_BAR; PG8_SCHED;
            PG8_STAGE(PG8_SB(1, 1), b3 + hstep, voffB);
            PG8_WAIT_V(6); PG8_BAR; PG8_MMA(1, 1, At, B1); PG8_BAR;
        }
        PG8_STAMP();
        if constexpr (!Epi::AFTER_DRAIN) { E(acc, cur, wr, wc, fr, fq); S.done(cur); }
        PG8_STAMP();
        if (!has_next) break;
#pragma unroll
        for (int a = 0; a < 2; ++a)
#pragma unroll
            for (int b = 0; b < 2; ++b)
#pragma unroll
                for (int m = 0; m < 4; ++m)
#pragma unroll
                    for (int n = 0; n < 2; ++n) acc[a][b][m][n] = (f32x4){0.f, 0.f, 0.f, 0.f};
        cur = nxt; cA = nA; cB = nB; ++ui;
    }
    PG8_WAIT_V(0);
    if (wr == 0) PG8_BAR;
    PG8_BAR;
    if constexpr (Epi::AFTER_DRAIN) { E.fused(acc, cur, wr, wc, fr, fq, lds, wid, lane); S.done(cur); }
    PG8_STAMP();
    if (STAMP && wid == 0) { stamps[lane] = lane < nts ? (((unsigned long long)(unsigned)ts_hi << 32) | (unsigned)ts_lo) : 0ull;
        if (lane == 62) stamps[62] = rt_entry; if (lane == 63) stamps[63] = (unsigned long long)wall_clock64(); }
#undef PG8_STAMP
#undef PG8_SA
#undef PG8_SB
#undef PG8_STAGE
#undef PG8_LDA
#undef PG8_LDB
#undef PG8_MMA
#undef PG8_WAIT_V
#undef PG8_WAIT_L
#undef PG8_BAR
#undef PG8_SCHED
}
}

struct Args { const float* in[20]; float* out; unsigned char* ws; int ph_lo, ph_hi; };
enum { I_X = 0, I_META, I_NORM_MIX, I_W_IN, I_CONV_A, I_A_LOG, I_DT_BIAS, I_A_OUT_NORM, I_Q_NORM, I_K_NORM, I_KIDX_NORM, I_W_BA, I_W_BB, I_W_GATE, I_B_GATE, I_W_OUT, I_NORM_FFN, I_W_UP, I_CONV_FFN, I_W_DOWN };

#ifndef DBG_NO_DSA
#define DBG_NO_DSA 0
#endif
#ifndef DBG_NO_GDN
#define DBG_NO_GDN 0
#endif
#ifndef DBG_NO_MIX
#define DBG_NO_MIX 0
#endif
#ifndef DBG_NO_FFN
#define DBG_NO_FFN 0
#endif

using pg8::Unit;
struct EpiIn {
    static constexpr bool PERM = true, AFTER_DRAIN = false;
    bf16_t *qkv, *halo, *z, *bq, *iq, *kb, *vb, *ikb; float* misc; bf16_t* gates; const float* bgate;
    __device__ __forceinline__ void operator()(const f32x4 (&acc)[2][2][4][2], const Unit& u, int wr, int wc, int fr, int fq) const {
        const int pn = u.pn, row0 = u.pm * 256 + wr * 64 + fr, cl = wc * 32 + 8 * fq;
        if (pn < 12) {
            bf16_t* base; int ld, cb;
            if (pn < 6) { base = qkv; ld = 1536; cb = pn * 256; } else if (pn < 8) { base = z; ld = 512; cb = (pn - 6) * 256; }
            else if (pn < 10) { base = bq; ld = 512; cb = (pn - 8) * 256; } else { base = iq; ld = 512; cb = (pn - 10) * 256; }
#pragma unroll
            for (int ai = 0; ai < 2; ++ai)
#pragma unroll
                for (int m = 0; m < 4; ++m) {
                    const int row = row0 + ai * 128 + m * 16;
                    bf16_t* p = base + (size_t)row * ld + cb + cl;
                    const u32x4 w0 = pack8(acc[ai][0][m][0], acc[ai][0][m][1]), w1 = pack8(acc[ai][1][m][0], acc[ai][1][m][1]);
                    *(u32x4*)p = w0; *(u32x4*)(p + 128) = w1;
                    if (pn < 6 && (row & 63) >= 61) {
                        bf16_t* hp = halo + ((size_t)(row >> 6) * 3 + ((row & 63) - 61)) * 1536 + cb + cl;
                        *(u32x4*)hp = w0; *(u32x4*)(hp + 128) = w1;
                    }
                }
        } else if (pn == 12) {
#pragma unroll
            for (int ai = 0; ai < 2; ++ai)
#pragma unroll
                for (int m = 0; m < 4; ++m) {
                    const int row = row0 + ai * 128 + m * 16;
                    const size_t prow = (size_t)(row >> 11) * TP + 16 + (row & 2047);
                    *(u32x4*)(kb + prow * 128 + cl) = pack8(acc[ai][0][m][0], acc[ai][0][m][1]);
                    *(u32x4*)(vb + prow * 128 + cl) = pack8(acc[ai][1][m][0], acc[ai][1][m][1]);
                }
        } else if (pn == 13) {
#pragma unroll
            for (int ai = 0; ai < 2; ++ai)
#pragma unroll
                for (int m = 0; m < 4; ++m) {
                    const int row = row0 + ai * 128 + m * 16;
                    if (cl < 64) { const size_t prow = (size_t)(row >> 11) * TP + 16 + (row & 2047); *(u32x4*)(ikb + prow * 64 + cl) = pack8(acc[ai][0][m][0], acc[ai][0][m][1]); }
                    else if (cl < 80) { float* mp = misc + (size_t)row * 16 + (cl - 64); *(f32x4*)mp = acc[ai][0][m][0]; *(f32x4*)(mp + 4) = acc[ai][0][m][1]; }
                }
        } else {
            const int cb = (pn - 14) * 256 + cl;
            f32x4 bv[2][2];
#pragma unroll
            for (int bj = 0; bj < 2; ++bj) { bv[bj][0] = *(const f32x4*)(bgate + cb + bj * 128); bv[bj][1] = *(const f32x4*)(bgate + cb + bj * 128 + 4); }
#pragma unroll
            for (int ai = 0; ai < 2; ++ai)
#pragma unroll
                for (int m = 0; m < 4; ++m) {
                    const int row = row0 + ai * 128 + m * 16;
                    bf16_t* p = gates + (size_t)row * 2048 + cb;
#pragma unroll
                    for (int bj = 0; bj < 2; ++bj) {
                        f32x4 v0 = acc[ai][bj][m][0] + bv[bj][0], v1 = acc[ai][bj][m][1] + bv[bj][1];
#pragma unroll
                        for (int j = 0; j < 4; ++j) { v0[j] = sigmoid_f(v0[j]); v1[j] = sigmoid_f(v1[j]); }
                        *(u32x4*)(p + bj * 128) = pack8(v0, v1);
                    }
                }
        }
    }
};
template <int BR> struct EpiBranch {
    static constexpr bool PERM = true, AFTER_DRAIN = false;
    bf16_t* y; const bf16_t* gates; float sc;
    __device__ __forceinline__ void operator()(const f32x4 (&acc)[2][2][4][2], const Unit& u, int wr, int wc, int fr, int fq) const {
        const int row0 = u.pm * 256 + wr * 64 + fr, c0 = u.pn * 256 + wc * 32 + 8 * fq;
#pragma unroll
        for (int ai = 0; ai < 2; ++ai)
#pragma unroll
            for (int m = 0; m < 4; ++m) {
                const int row = row0 + ai * 128 + m * 16;
#pragma unroll
                for (int bj = 0; bj < 2; ++bj) {
                    const int col = c0 + bj * 128;
                    const u32x4 g = *(const u32x4*)(gates + (size_t)row * 2048 + BR * 1024 + col);
                    f32x4 v0 = acc[ai][bj][m][0] * sc, v1 = acc[ai][bj][m][1] * sc;
                    v0[0] *= bflo(g.x); v0[1] *= bfhi(g.x); v0[2] *= bflo(g.y); v0[3] *= bfhi(g.y);
                    v1[0] *= bflo(g.z); v1[1] *= bfhi(g.z); v1[2] *= bflo(g.w); v1[3] *= bfhi(g.w);
                    bf16_t* yp = y + (size_t)row * 1024 + col;
                    if (BR == 1) {
                        const u32x4 o = *(const u32x4*)yp;
                        v0[0] += bflo(o.x); v0[1] += bfhi(o.x); v0[2] += bflo(o.y); v0[3] += bfhi(o.y);
                        v1[0] += bflo(o.z); v1[1] += bfhi(o.z); v1[2] += bflo(o.w); v1[3] += bfhi(o.w);
                    }
                    *(u32x4*)yp = pack8(v0, v1);
                }
            }
    }
};
struct EpiResid {
    static constexpr bool PERM = false, AFTER_DRAIN = false;
    const float* hin; float* hout; float sc;
    __device__ __forceinline__ void operator()(const f32x4 (&acc)[2][2][4][2], const Unit& u, int wr, int wc, int fr, int fq) const {
        const int row0 = u.pm * 256 + wr * 64 + fr, col0 = u.pn * 256 + wc * 32 + 4 * fq;
#pragma unroll
        for (int ai = 0; ai < 2; ++ai)
#pragma unroll
            for (int m = 0; m < 4; ++m) {
                const size_t ro = (size_t)(row0 + ai * 128 + m * 16) * DM + col0;
#pragma unroll
                for (int bj = 0; bj < 2; ++bj)
#pragma unroll
                    for (int n = 0; n < 2; ++n) { const f32x4 h = *(const f32x4*)(hin + ro + bj * 128 + n * 16); *(f32x4*)(hout + ro + bj * 128 + n * 16) = h + acc[ai][bj][m][n] * sc; }
            }
    }
};
struct EpiUp {
    static constexpr bool PERM = true, AFTER_DRAIN = false;
    bf16_t *gpre, *up;
    __device__ __forceinline__ void operator()(const f32x4 (&acc)[2][2][4][2], const Unit& u, int wr, int wc, int fr, int fq) const {
        const int row0 = u.pm * 256 + wr * 64 + fr, c0 = u.pn * 128 + wc * 32 + 8 * fq;
#pragma unroll
        for (int ai = 0; ai < 2; ++ai)
#pragma unroll
            for (int m = 0; m < 4; ++m) {
                const size_t o = (size_t)(row0 + ai * 128 + m * 16) * DFF + c0;
                *(u32x4*)(gpre + o) = pack8(acc[ai][0][m][0], acc[ai][0][m][1]);
                *(u32x4*)(up + o) = pack8(acc[ai][1][m][0], acc[ai][1][m][1]);
            }
    }
};

template <class F> __device__ __forceinline__ void small_gemm16(const bf16_t* A, const bf16_t* Bt, int N, int K, const F& epi) {
    int tid_ = threadIdx.x; asm volatile("" : "+v"(tid_));
    const int lane = tid_ & 63, wid = tid_ >> 6, r = lane & 15, g = lane >> 4;
    const int gw = blockIdx.x * 8 + wid, nW = gridDim.x * 8;
    for (int ct = gw; ct < N / 16; ct += nW) {
        f32x4 acc = {0.f, 0.f, 0.f, 0.f};
        const bf16_t* ap = A + (size_t)r * K + g * 8; const bf16_t* bp = Bt + (size_t)(ct * 16 + r) * K + g * 8;
#pragma unroll 8
        for (int k = 0; k < K; k += 32) acc = mfma16(*(const bf16x8*)(ap + k), *(const bf16x8*)(bp + k), acc);
#pragma unroll
        for (int rr = 0; rr < 4; ++rr) epi(4 * g + rr, ct * 16 + r, acc[rr]);
    }
}
struct MEpiIn { unsigned char* ws; const float* bgate;
    __device__ __forceinline__ void operator()(int t, int n, float v) const {
        if (n < 1536) ((bf16_t*)(ws + M_RAW))[t * 1536 + n] = f2bf(v);
        else if (n < 2048) ((bf16_t*)(ws + M_Z))[t * 512 + n - 1536] = f2bf(v);
        else if (n < 2560) ((bf16_t*)(ws + M_BQ))[t * 512 + n - 2048] = f2bf(v);
        else if (n < 3072) ((bf16_t*)(ws + M_IQ))[t * 512 + n - 2560] = f2bf(v);
        else if (n < 3200) ((bf16_t*)(ws + M_K))[t * 128 + n - 3072] = f2bf(v);
        else if (n < 3328) ((bf16_t*)(ws + M_V))[t * 128 + n - 3200] = f2bf(v);
        else if (n < 3392) { }
        else if (n < 3408) ((float*)(ws + M_MISC))[t * 16 + n - 3392] = v;
        else if (n < 3584) { }
        else ((bf16_t*)(ws + M_GATES))[t * 2048 + n - 3584] = f2bf(sigmoid_f(v + bgate[n - 3584]));
    } };
template <int BR> struct MEpiBranch { unsigned char* ws; float sc;
    __device__ __forceinline__ void operator()(int t, int n, float v) const {
        bf16_t* y = (bf16_t*)(ws + M_Y) + t * 1024 + n; const float g = bf2f(((const bf16_t*)(ws + M_GATES))[t * 2048 + BR * 1024 + n]);
        float o = g * v * sc; if (BR == 1) o += bf2f(*y); *y = f2bf(o);
    } };
struct MEpiResid { float* h; float sc; __device__ __forceinline__ void operator()(int t, int n, float v) const { h[t * 1024 + n] += v * sc; } };
struct MEpiUp { float* gu; __device__ __forceinline__ void operator()(int t, int n, float v) const { gu[t * 5632 + n] = v; } };

struct MapId { __device__ __forceinline__ int operator()(int n) const { return n; } };
struct MapWin { __device__ __forceinline__ int operator()(int n) const {
    if (n < 2048) return n; if (n < 2560) return n - 2048 + 2056; if (n < 3072) return n - 2560 + 2824; if (n < 3200) return n - 3072 + 2568;
    if (n < 3328) return n - 3200 + 2696; if (n < 3392) return n - 3328 + 3336; if (n < 3400) return n - 3392 + 2048; if (n < 3408) return n; return -1; } };
struct MapWup { __device__ __forceinline__ int operator()(int n) const { const int t = n >> 8, w = n & 255; return w < 128 ? 128 * t + w : 2816 + 128 * t + (w - 128); } };
template <class Map> __device__ __forceinline__ void tr_cvt(const float* __restrict__ src, int ldsrc, int K, bf16_t* __restrict__ dst, int Nd, const Map& map, bf16_t* tile, int& g0) {
    const int G = gridDim.x, tid = threadIdx.x, nnt = Nd / 64, nt = nnt * (K / 64);
    int t = ((int)blockIdx.x - (g0 % G) + G) % G;
    for (; t < nt; t += G) {
        const int n0 = (t % nnt) * 64, k0 = (t / nnt) * 64;
        { const int nn = tid & 63, col = map(n0 + nn);
#pragma unroll
          for (int i = 0; i < 8; ++i) { const int kk = (tid >> 6) + 8 * i; const float v = col >= 0 ? src[(size_t)(k0 + kk) * ldsrc + col] : 0.f; tile[nn * 72 + kk] = f2bf(v); } }
        __syncthreads();
        { const int nn = tid >> 3, part = tid & 7; *(u32x4*)(dst + (size_t)(n0 + nn) * K + k0 + part * 8) = *(const u32x4*)(tile + nn * 72 + part * 8); }
        __syncthreads();
    }
    g0 += nt;
}
__device__ __forceinline__ void p_prologue(const Args& a, char* smem) {
    unsigned char* ws = a.ws; asm volatile("" : "+s"(ws)); bf16_t* tile = (bf16_t*)smem; int g0 = 0;
    for (int l = 0; l < NLAYER; ++l) {
        tr_cvt(a.in[I_W_IN] + (size_t)l * DM * 3408, 3408, DM, (bf16_t*)(ws + OFF_WIN) + (size_t)l * NIN * DM, 3584, MapWin(), tile, g0);
        tr_cvt(a.in[I_W_GATE] + (size_t)l * DM * 2048, 2048, DM, (bf16_t*)(ws + OFF_WIN) + ((size_t)l * NIN + 3584) * DM, 2048, MapId(), tile, g0);
        tr_cvt(a.in[I_W_BA] + (size_t)l * 512 * DM, DM, 512, (bf16_t*)(ws + OFF_WBA) + (size_t)l * DM * 512, DM, MapId(), tile, g0);
        tr_cvt(a.in[I_W_BB] + (size_t)l * 512 * DM, DM, 512, (bf16_t*)(ws + OFF_WBB) + (size_t)l * DM * 512, DM, MapId(), tile, g0);
        tr_cvt(a.in[I_W_OUT] + (size_t)l * DM * DM, DM, DM, (bf16_t*)(ws + OFF_WOUT) + (size_t)l * DM * DM, DM, MapId(), tile, g0);
        tr_cvt(a.in[I_W_UP] + (size_t)l * DM * 5632, 5632, DM, (bf16_t*)(ws + OFF_WUP) + (size_t)l * NIN * DM, NIN, MapWup(), tile, g0);
        tr_cvt(a.in[I_W_DOWN] + (size_t)l * DFF * DM, DM, DFF, (bf16_t*)(ws + OFF_WDN) + (size_t)l * DM * DFF, DM, MapId(), tile, g0);
    }
    const int gt = blockIdx.x * 512 + threadIdx.x, nT = gridDim.x * 512;
    float* cosA = (float*)(ws + OFF_COSA); float* sinA = (float*)(ws + OFF_SINA); float* cosI = (float*)(ws + OFF_COSI); float* sinI = (float*)(ws + OFF_SINI);
    for (int i = gt; i < TPOS * 96; i += nT) {
        const int pos = i / 96, j = i % 96;
        if (j < 64) { const float inv = 1.0f / powf(10000.f, (float)(2 * j) / 128.f), ang = (float)pos * inv; cosA[pos * 64 + j] = cosf(ang); sinA[pos * 64 + j] = sinf(ang); }
        else { const int jj = j - 64; const float inv = 1.0f / powf(10000.f, (float)(2 * jj) / 64.f), ang = (float)pos * inv; cosI[pos * 32 + jj] = cosf(ang); sinI[pos * 32 + jj] = sinf(ang); }
    }
    for (int i = gt; i < 16 * 1024; i += nT) ((float*)(ws + M_H))[i] = a.in[I_META][i];
    for (int i = gt; i < NB * (TP - TPOS) * 16; i += nT) {
        const int b = i / ((TP - TPOS) * 16), r = i % ((TP - TPOS) * 16);
        const size_t o = ((size_t)b * TP + TPOS) * 128 + (size_t)r * 8;
        *(u32x4*)((bf16_t*)(ws + OFF_KB) + o) = (u32x4){0u, 0u, 0u, 0u}; *(u32x4*)((bf16_t*)(ws + OFF_VB) + o) = (u32x4){0u, 0u, 0u, 0u};
    }
}

__device__ __forceinline__ void p_norm(const float* hreal, const float* hmeta, const float* g, bf16_t* nb, bf16_t* nbm, bool with_meta) {
    int tid_ = threadIdx.x; asm volatile("" : "+v"(tid_));
    const int lane = tid_ & 63, gw = blockIdx.x * 8 + (tid_ >> 6), nW = gridDim.x * 8;
    f32x4 gg[4];
#pragma unroll
    for (int i = 0; i < 4; ++i) gg[i] = ((const f32x4*)g)[lane + 64 * i];
    const int nrows = RR + (with_meta ? 16 : 0);
    for (int row = gw; row < nrows; row += nW) {
        const float* src = row < RR ? hreal + (size_t)row * DM : hmeta + (size_t)(row - RR) * DM;
        bf16_t* dst = row < RR ? nb + (size_t)row * DM : nbm + (size_t)(row - RR) * DM;
        f32x4 v[4]; float ss = 0.f;
#pragma unroll
        for (int i = 0; i < 4; ++i) { v[i] = ((const f32x4*)src)[lane + 64 * i]; ss += v[i][0] * v[i][0] + v[i][1] * v[i][1] + v[i][2] * v[i][2] + v[i][3] * v[i][3]; }
        ss = wave_sum(ss);
        const float rstd = rsqrtf(ss * (1.f / DM) + EPSF);
#pragma unroll
        for (int i = 0; i < 4; ++i) { u32x2 w; w.x = cvt_pk(v[i][0] * rstd * gg[i][0], v[i][1] * rstd * gg[i][1]); w.y = cvt_pk(v[i][2] * rstd * gg[i][2], v[i][3] * rstd * gg[i][3]); ((u32x2*)dst)[lane + 64 * i] = w; }
    }
}

namespace mp {
constexpr int RAW_OFF = 0, QS_OFF = 51712, KS_OFF = 70144, MT_OFF = 88576, GC_OFF = 154112, BT_OFF = 155136, RED_OFF = 156160, CNT_OFF = 157184;
}
__device__ __forceinline__ void p_mixprep(const Args& a, int layer, char* smem) {
    using namespace mp;
    unsigned char* ws = a.ws; asm volatile("" : "+s"(ws));
    bf16_t* qkv = (bf16_t*)(ws + OFF_QKV); const bf16_t* halo = (const bf16_t*)(ws + OFF_HALO); const bf16_t* mraw = (const bf16_t*)(ws + M_RAW);
    bf16_t* mchunk = (bf16_t*)(ws + M_CHUNK); bf16_t* TQ = (bf16_t*)(ws + OFF_TQ); bf16_t* mTQ = (bf16_t*)(ws + M_TQ);
    const float* conv_a = a.in[I_CONV_A] + (size_t)layer * 4 * 1536;
    const float* a_log = a.in[I_A_LOG] + layer * 4; const float* dt_bias = a.in[I_DT_BIAS] + layer * 4;
    const float* qn = a.in[I_Q_NORM] + layer * 128; const float* kn = a.in[I_K_NORM] + layer * 128; const float* kin = a.in[I_KIDX_NORM] + layer * 64;
    const float* cosA = (const float*)(ws + OFF_COSA); const float* sinA = (const float*)(ws + OFF_SINA); const float* cosI = (const float*)(ws + OFF_COSI); const float* sinI = (const float*)(ws + OFF_SINI);
    float* GCs = (float*)(smem + GC_OFF); float* BTs = (float*)(smem + BT_OFF); float* RED = (float*)(smem + RED_OFF);
    bf16_t* QS = (bf16_t*)(smem + QS_OFF); bf16_t* KS = (bf16_t*)(smem + KS_OFF); bf16_t* RV = (bf16_t*)(smem + RAW_OFF + 2 * 67 * 256);
    for (int item = blockIdx.x; item < 1025; item += gridDim.x) {
        int tid_ = threadIdx.x; asm volatile("" : "+v"(tid_));
        const int tid = tid_, lane = tid & 63, wid = __builtin_amdgcn_readfirstlane(tid >> 6);
        const bool is_meta = item == 1024; const int b = item >> 5, c = item & 31, row0 = b * 2048 + 64 * c;
        if (tid < 256) { const int t = tid >> 2, h = tid & 3; float g = 0.f, be = 0.f;
            if (!is_meta || t >= 48) { const float* mpp = is_meta ? (const float*)(ws + M_MISC) + (t - 48) * 16 : (const float*)(ws + OFF_MISC) + (size_t)(row0 + t) * 16;
                g = -__expf(a_log[h]) * softplus_f(mpp[h] + dt_bias[h]); be = sigmoid_f(mpp[4 + h]); }
            GCs[tid] = g; BTs[tid] = be; }
        if (tid == 0) *(int*)(smem + CNT_OFF) = 0;
        __syncthreads();
        if (tid < 4) { float s = 0.f; for (int t = 0; t < 64; ++t) { s += GCs[t * 4 + tid]; GCs[t * 4 + tid] = s; } }
        __syncthreads();
        if (tid < 256) { float* gd = is_meta ? (float*)(ws + M_GC) : (float*)(ws + OFF_GC) + (size_t)row0 * 4; float* bd = is_meta ? (float*)(ws + M_BETA) : (float*)(ws + OFF_BETA) + (size_t)row0 * 4;
            gd[tid] = GCs[tid]; bd[tid] = BTs[tid]; }
        for (int h = 0; h < 4; ++h) {
            for (int p = tid; p < 3 * 67 * 16; p += 512) {
                const int tensor = p / (67 * 16), rem = p - tensor * (67 * 16), rr = rem >> 4, cc = (rem & 15) * 8, tt = rr - 3, col = tensor * 512 + h * 128 + cc;
                u32x4 v = {0u, 0u, 0u, 0u};
                if (!is_meta) {
                    const bf16_t* sp;
                    if (tt >= 0) sp = qkv + (size_t)(row0 + tt) * 1536 + col;
                    else if (c > 0) sp = halo + ((size_t)((row0 >> 6) - 1) * 3 + (tt + 3)) * 1536 + col;
                    else sp = mraw + (size_t)(16 + tt) * 1536 + col;
                    v = *(const u32x4*)sp;
                } else if (tt >= 48) v = *(const u32x4*)(mraw + (size_t)(tt - 48) * 1536 + col);
                *(u32x4*)(smem + RAW_OFF + (tensor * 67 + rr) * 256 + cc * 2) = v;
            }
            __syncthreads();
            const int ch = tid & 127, part = tid >> 7;
            float y[3][16];
#pragma unroll
            for (int tensor = 0; tensor < 3; ++tensor) {
                const int wc = tensor * 512 + h * 128 + ch;
                const float w0 = conv_a[wc], w1 = conv_a[1536 + wc], w2 = conv_a[3072 + wc], w3 = conv_a[4608 + wc];
                const bf16_t* rp = (const bf16_t*)(smem + RAW_OFF + tensor * 67 * 256) + ch + part * 16 * 128;
                float x0 = bf2f(rp[0]), x1 = bf2f(rp[128]), x2 = bf2f(rp[256]);
#pragma unroll
                for (int i = 0; i < 16; ++i) { const float x3 = bf2f(rp[(3 + i) * 128]); float v = silu_f(w0 * x0 + w1 * x1 + w2 * x2 + w3 * x3);
                    if (is_meta && part * 16 + i < 48) v = 0.f; y[tensor][i] = v; x0 = x1; x1 = x2; x2 = x3; }
            }
#pragma unroll
            for (int i = 0; i < 16; ++i) { const float sq = wave_sum(y[0][i] * y[0][i]), sk = wave_sum(y[1][i] * y[1][i]);
                if (lane == 0) { const int t = part * 16 + i; RED[t * 2 + (wid & 1)] = sq; RED[(64 + t) * 2 + (wid & 1)] = sk; } }
            __syncthreads();
#pragma unroll
            for (int i = 0; i < 16; ++i) { const int t = part * 16 + i;
                const float rq = rsqrtf(RED[t * 2] + RED[t * 2 + 1] + EPSF) * 0.08838834764831845f, rk = rsqrtf(RED[(64 + t) * 2] + RED[(64 + t) * 2 + 1] + EPSF);
                QS[t * 144 + ch] = f2bf(y[0][i] * rq); KS[t * 144 + ch] = f2bf(y[1][i] * rk); RV[(t + 3) * 128 + ch] = f2bf(y[2][i]); }
            __syncthreads();
            { bf16_t* dbase = is_meta ? mchunk : qkv + (size_t)row0 * 1536;
              for (int p = tid; p < 3072; p += 512) { const int tensor = p >> 10, t = (p & 1023) >> 4, cc = (p & 15) * 8;
                  const bf16_t* sp = tensor == 0 ? QS + t * 144 + cc : (tensor == 1 ? KS + t * 144 + cc : RV + (t + 3) * 128 + cc);
                  *(u32x4*)(dbase + (size_t)t * 1536 + tensor * 512 + h * 128 + cc) = *(const u32x4*)sp; } }
            { const int r = lane & 15, g = lane >> 4, mt = wid >> 1;
              bf16_t* tqd = is_meta ? mTQ + h * 8192 : TQ + (size_t)((row0 >> 6) * 4 + h) * 8192;
              float* MT = (float*)(smem + MT_OFF) + h * 4096;
#pragma unroll
              for (int nti = 0; nti < 2; ++nti) { const int nt = 2 * (wid & 1) + nti;
                  f32x4 akk = {0.f, 0.f, 0.f, 0.f}, aqk = {0.f, 0.f, 0.f, 0.f};
#pragma unroll
                  for (int s = 0; s < 4; ++s) {
                      const bf16x8 fk = *(const bf16x8*)(KS + (16 * mt + r) * 144 + 32 * s + 8 * g);
                      const bf16x8 fq = *(const bf16x8*)(QS + (16 * mt + r) * 144 + 32 * s + 8 * g);
                      const bf16x8 fb = *(const bf16x8*)(KS + (16 * nt + r) * 144 + 32 * s + 8 * g);
                      akk = mfma16(fk, fb, akk); aqk = mfma16(fq, fb, aqk); }
                  const int j = 16 * nt + r; const float gcj = GCs[j * 4 + h];
#pragma unroll
                  for (int rr = 0; rr < 4; ++rr) { const int i = 16 * mt + 4 * g + rr; const float gci = GCs[i * 4 + h], bi = BTs[i * 4 + h];
                      const float dec = (i >= j) ? __expf(gci - gcj) : 0.f;
                      MT[i * 64 + j] = (i > j) ? bi * akk[rr] * dec : 0.f;
                      tqd[4096 + i * 64 + j] = f2bf((i >= j) ? aqk[rr] * dec : 0.f); } } }
            __syncthreads();
        }
        if (wid < 4) {
            float* MT = (float*)(smem + MT_OFF) + wid * 4096;
            MT[lane] = (lane == 0) ? 1.f : 0.f;
            for (int i = 1; i < 64; ++i) {
                float acc0 = (lane == i) ? 1.f : 0.f, acc1 = 0.f;
                int j = 0;
                for (; j + 4 <= i; j += 4) { const f32x4 mv = *(const f32x4*)(MT + i * 64 + j);
                    acc0 -= mv[0] * MT[j * 64 + lane]; acc1 -= mv[1] * MT[(j + 1) * 64 + lane]; acc0 -= mv[2] * MT[(j + 2) * 64 + lane]; acc1 -= mv[3] * MT[(j + 3) * 64 + lane]; }
                for (; j < i; ++j) acc0 -= MT[i * 64 + j] * MT[j * 64 + lane];
                MT[i * 64 + lane] = acc0 + acc1;
            }
            bf16_t* td = is_meta ? mTQ + wid * 8192 : TQ + (size_t)((row0 >> 6) * 4 + wid) * 8192;
            for (int i = 0; i < 64; ++i) td[i * 64 + lane] = f2bf(MT[i * 64 + lane]);
        }
        { const int ntypes = is_meta ? 11 : 10, ntasks = (is_meta ? 16 : 64) * ntypes;
          bf16_t* kb = (bf16_t*)(ws + OFF_KB); bf16_t* vb = (bf16_t*)(ws + OFF_VB); bf16_t* ikb = (bf16_t*)(ws + OFF_IKB);
          for (;;) {
              int task = 0; if (lane == 0) task = atomicAdd((int*)(smem + CNT_OFF), 1);
              task = __builtin_amdgcn_readfirstlane(task);
              if (task >= ntasks) break;
              const int tl = task / ntypes, ty = task - tl * ntypes;
              const int pos = is_meta ? tl : 16 + 64 * c + tl; const size_t row = (size_t)row0 + tl;
              if (ty < 5) {
                  bf16_t* p; const float* w;
                  if (ty < 4) { p = (is_meta ? (bf16_t*)(ws + M_BQ) + tl * 512 : (bf16_t*)(ws + OFF_BQ) + row * 512) + ty * 128; w = qn; }
                  else { p = is_meta ? (bf16_t*)(ws + M_K) + tl * 128 : kb + ((size_t)b * TP + pos) * 128; w = kn; }
                  const float x1 = bf2f(p[lane]), x2 = bf2f(p[lane + 64]);
                  const float ss = wave_sum(x1 * x1 + x2 * x2), rstd = rsqrtf(ss * (1.f / 128.f) + EPSF);
                  const float y1 = x1 * rstd * w[lane], y2 = x2 * rstd * w[lane + 64];
                  const float cs = cosA[pos * 64 + lane], sn = sinA[pos * 64 + lane];
                  const bf16_t o1 = f2bf(y1 * cs - y2 * sn), o2 = f2bf(y2 * cs + y1 * sn);
                  if (ty == 4 && is_meta) { for (int bb = 0; bb < NB; ++bb) { bf16_t* d = kb + ((size_t)bb * TP + tl) * 128; d[lane] = o1; d[lane + 64] = o2; } }
                  else { p[lane] = o1; p[lane + 64] = o2; }
              } else if (ty < 10) {
                  const int half = lane >> 5, l5 = lane & 31;
                  if (ty < 9) {
                      bf16_t* p = (is_meta ? (bf16_t*)(ws + M_IQ) + tl * 512 : (bf16_t*)(ws + OFF_IQ) + row * 512) + (2 * (ty - 5) + half) * 64;
                      const float x1 = bf2f(p[l5]), x2 = bf2f(p[l5 + 32]);
                      const float cs = cosI[pos * 32 + l5], sn = sinI[pos * 32 + l5];
                      p[l5] = f2bf(x1 * cs - x2 * sn); p[l5 + 32] = f2bf(x2 * cs + x1 * sn);
                  } else if (!is_meta) {
                      bf16_t* p = ikb + ((size_t)b * TP + pos) * 64;
                      const float x1 = bf2f(p[l5]), x2 = bf2f(p[l5 + 32]);
                      const float ss = half_sum(x1 * x1 + x2 * x2), rstd = rsqrtf(ss * (1.f / 64.f) + EPSF);
                      const float y1 = x1 * rstd * kin[l5], y2 = x2 * rstd * kin[l5 + 32];
                      const float cs = cosI[pos * 32 + l5], sn = sinI[pos * 32 + l5];
                      const bf16_t o1 = f2bf(y1 * cs - y2 * sn), o2 = f2bf(y2 * cs + y1 * sn);
                      if (half == 0) { p[l5] = o1; p[l5 + 32] = o2; }
                  }
              } else {
                  const bf16_t* sp = (const bf16_t*)(ws + M_V) + tl * 128; const bf16_t v1 = sp[lane], v2 = sp[lane + 64];
                  for (int bb = 0; bb < NB; ++bb) { bf16_t* d = vb + ((size_t)bb * TP + tl) * 128; d[lane] = v1; d[lane + 64] = v2; }
              }
          } }
        __syncthreads();
    }
}

namespace gs { constexpr int KN_OFF = 0, KT_OFF = 17408, QN_OFF = 35840, VT_OFF = 53248, TT_OFF = 71680, QK_OFF = 80896, GC_OFF = 90112, BT_OFF = 90368, OT_OFF = 90624; }
__device__ __forceinline__ bf16x8 frag2(const char* base, int off) {
    const u32x2 lo = *(const u32x2*)(base + off), hi = *(const u32x2*)(base + off + 32);
    u32x4 w; w.x = lo.x; w.y = lo.y; w.z = hi.x; w.w = hi.y; return as_bf8(w); }
__device__ __forceinline__ void gdn_scan_item(const Args& a, int layer, int b, int h, char* smem) {
    using namespace gs;
    unsigned char* ws = a.ws; asm volatile("" : "+s"(ws));
    int tid_ = threadIdx.x; asm volatile("" : "+v"(tid_));
    const int tid = tid_, lane = tid & 63, wid = __builtin_amdgcn_readfirstlane(tid >> 6), r = lane & 15, g = lane >> 4, e0 = 16 * wid;
    const bf16_t* qkv = (const bf16_t*)(ws + OFF_QKV); const bf16_t* mchunk = (const bf16_t*)(ws + M_CHUNK);
    const bf16_t* TQ = (const bf16_t*)(ws + OFF_TQ); const bf16_t* mTQ = (const bf16_t*)(ws + M_TQ);
    const float* ng = a.in[I_A_OUT_NORM] + layer * 128;
    const float ng1 = ng[lane], ng2 = ng[lane + 64];
    f32x4 S[8];
#pragma unroll
    for (int i = 0; i < 8; ++i) S[i] = (f32x4){0.f, 0.f, 0.f, 0.f};
    u32x4 pk[2], pq[2], pv[2], pt, pqk; float psc = 0.f;
#define GS_LOAD(n) do { const int n_ = (n); \
        const bf16_t* qb_ = n_ == 0 ? mchunk : qkv + (size_t)(b * 2048 + 64 * (n_ - 1)) * 1536; \
        const bf16_t* tq_ = n_ == 0 ? mTQ + h * 8192 : TQ + (size_t)((b * 32 + n_ - 1) * 4 + h) * 8192; \
        const float* gc_ = n_ == 0 ? (const float*)(ws + M_GC) : (const float*)(ws + OFF_GC) + (size_t)(b * 2048 + 64 * (n_ - 1)) * 4; \
        const float* bt_ = n_ == 0 ? (const float*)(ws + M_BETA) : (const float*)(ws + OFF_BETA) + (size_t)(b * 2048 + 64 * (n_ - 1)) * 4; \
        _Pragma("unroll") for (int i_ = 0; i_ < 2; ++i_) { const int p_ = tid + 512 * i_, cr_ = p_ >> 4, d0_ = (p_ & 15) * 8; const bf16_t* rp_ = qb_ + (size_t)cr_ * 1536 + h * 128 + d0_; \
            pq[i_] = *(const u32x4*)rp_; pk[i_] = *(const u32x4*)(rp_ + 512); pv[i_] = *(const u32x4*)(rp_ + 1024); } \
        pt = *(const u32x4*)(tq_ + (tid >> 3) * 64 + (tid & 7) * 8); pqk = *(const u32x4*)(tq_ + 4096 + (tid >> 3) * 64 + (tid & 7) * 8); \
        if (tid < 64) psc = gc_[tid * 4 + h]; else if (tid < 128) psc = bt_[(tid - 64) * 4 + h]; } while (0)
    GS_LOAD(0);
    for (int n = 0; n < 33; ++n) {
#pragma unroll
        for (int i = 0; i < 2; ++i) { const int p = tid + 512 * i, cr = p >> 4, d0 = (p & 15) * 8;
            *(u32x4*)(smem + KN_OFF + cr * 272 + d0 * 2) = pk[i]; *(u32x4*)(smem + QN_OFF + cr * 272 + d0 * 2) = pq[i];
            bf16_t* kt = (bf16_t*)(smem + KT_OFF) + d0 * 72 + cr; bf16_t* vt = (bf16_t*)(smem + VT_OFF) + d0 * 72 + cr;
            const unsigned kw[4] = {pk[i].x, pk[i].y, pk[i].z, pk[i].w}, vw[4] = {pv[i].x, pv[i].y, pv[i].z, pv[i].w};
#pragma unroll
            for (int jj = 0; jj < 4; ++jj) { kt[(2 * jj) * 72] = (bf16_t)(kw[jj] & 0xffffu); kt[(2 * jj + 1) * 72] = (bf16_t)(kw[jj] >> 16);
                vt[(2 * jj) * 72] = (bf16_t)(vw[jj] & 0xffffu); vt[(2 * jj + 1) * 72] = (bf16_t)(vw[jj] >> 16); } }
        *(u32x4*)(smem + TT_OFF + (tid >> 3) * 144 + (tid & 7) * 16) = pt; *(u32x4*)(smem + QK_OFF + (tid >> 3) * 144 + (tid & 7) * 16) = pqk;
        if (tid < 64) ((float*)(smem + GC_OFF))[tid] = psc; else if (tid < 128) ((float*)(smem + BT_OFF))[tid - 64] = psc;
        __syncthreads();
        if (n < 32) GS_LOAD(n + 1);
        const float* GC = (const float*)(smem + GC_OFF); const float* BT = (const float*)(smem + BT_OFF);
        bf16x8 Sb[4];
#pragma unroll
        for (int s = 0; s < 4; ++s) Sb[s] = as_bf8(pack8(S[2 * s], S[2 * s + 1]));
        f32x4 X[4], P[4];
#pragma unroll
        for (int mt = 0; mt < 4; ++mt) { X[mt] = (f32x4){0.f, 0.f, 0.f, 0.f}; P[mt] = (f32x4){0.f, 0.f, 0.f, 0.f};
#pragma unroll
            for (int s = 0; s < 4; ++s) { const int off = (16 * mt + r) * 272 + (32 * s + 4 * g) * 2;
                X[mt] = mfma16(frag2(smem + KN_OFF, off), Sb[s], X[mt]); P[mt] = mfma16(frag2(smem + QN_OFF, off), Sb[s], P[mt]); } }
        f32x4 Rr[4], eg[4], gcv[4];
#pragma unroll
        for (int mt = 0; mt < 4; ++mt) { const int c0 = 16 * mt + 4 * g; gcv[mt] = *(const f32x4*)(GC + c0); const f32x4 bt4 = *(const f32x4*)(BT + c0);
            const u32x2 vt = *(const u32x2*)(smem + VT_OFF + (e0 + r) * 144 + c0 * 2);
            const float vv[4] = {bflo(vt.x), bfhi(vt.x), bflo(vt.y), bfhi(vt.y)};
#pragma unroll
            for (int rr = 0; rr < 4; ++rr) { eg[mt][rr] = __expf(gcv[mt][rr]); Rr[mt][rr] = bt4[rr] * (vv[rr] - eg[mt][rr] * X[mt][rr]); } }
        bf16x8 Rb[2] = {as_bf8(pack8(Rr[0], Rr[1])), as_bf8(pack8(Rr[2], Rr[3]))};
        f32x4 Vn[4];
#pragma unroll
        for (int mt = 0; mt < 4; ++mt) { Vn[mt] = (f32x4){0.f, 0.f, 0.f, 0.f};
#pragma unroll
            for (int s = 0; s < 2; ++s) Vn[mt] = mfma16(frag2(smem + TT_OFF, (16 * mt + r) * 144 + (32 * s + 4 * g) * 2), Rb[s], Vn[mt]); }
        bf16x8 Vnb[2] = {as_bf8(pack8(Vn[0], Vn[1])), as_bf8(pack8(Vn[2], Vn[3]))};
        const float glast = GC[63];
        f32x4 O[4], Vp[4];
#pragma unroll
        for (int mt = 0; mt < 4; ++mt) {
#pragma unroll
            for (int rr = 0; rr < 4; ++rr) { O[mt][rr] = P[mt][rr] * eg[mt][rr]; Vp[mt][rr] = Vn[mt][rr] * __expf(glast - gcv[mt][rr]); }
#pragma unroll
            for (int s = 0; s < 2; ++s) O[mt] = mfma16(frag2(smem + QK_OFF, (16 * mt + r) * 144 + (32 * s + 4 * g) * 2), Vnb[s], O[mt]); }
        bf16x8 Vpb[2] = {as_bf8(pack8(Vp[0], Vp[1])), as_bf8(pack8(Vp[2], Vp[3]))};
        const float egl = __expf(glast);
#pragma unroll
        for (int dt = 0; dt < 8; ++dt) { S[dt] = S[dt] * egl;
#pragma unroll
            for (int s = 0; s < 2; ++s) S[dt] = mfma16(frag2(smem + KT_OFF, (16 * dt + r) * 144 + (32 * s + 4 * g) * 2), Vpb[s], S[dt]); }
        float* OT = (float*)(smem + OT_OFF);
#pragma unroll
        for (int mt = 0; mt < 4; ++mt)
#pragma unroll
            for (int rr = 0; rr < 4; ++rr) OT[(16 * mt + 4 * g + rr) * 132 + e0 + r] = O[mt][rr];
        __syncthreads();
#pragma unroll
        for (int i = 0; i < 8; ++i) { const int c = 8 * wid + i;
            const float o1 = OT[c * 132 + lane], o2 = OT[c * 132 + lane + 64];
            const float ss = wave_sum(o1 * o1 + o2 * o2), rstd = rsqrtf(ss * (1.f / 128.f) + EPSF);
            const bf16_t* zp; bf16_t* op; bool wrt;
            if (n == 0) { wrt = (b == 0 && c >= 48); zp = (const bf16_t*)(ws + M_Z) + (c - 48) * 512 + h * 128; op = (bf16_t*)(ws + M_OA) + (c - 48) * 512 + h * 128; }
            else { const size_t row = (size_t)b * 2048 + 64 * (n - 1) + c; zp = (const bf16_t*)(ws + OFF_Z) + row * 512 + h * 128; op = (bf16_t*)(ws + OFF_OA) + row * 512 + h * 128; wrt = true; }
            if (wrt) { op[lane] = f2bf(o1 * rstd * ng1 * silu_f(bf2f(zp[lane]))); op[lane + 64] = f2bf(o2 * rstd * ng2 * silu_f(bf2f(zp[lane + 64]))); } }
    }
#undef GS_LOAD
    __syncthreads();
}

#ifndef DSASEL
#define DSASEL 3
#endif
namespace da {
constexpr int SC_PITCH = 2112, SC_OFF = 0, MASK_OFF = 16 * SC_PITCH * 4, IWL_OFF = MASK_OFF + 64 * 34 * 8, END_OFF = IWL_OFF + 64 * 8 * 4;
constexpr int KSEL = 272;
static_assert(END_OFF <= LDS_XB, "dsa lds");
constexpr float SCALE = 0.088388347648318440f, THR = 8.f;
constexpr int SHM_V = 64 * 128 * 2, SHM_K = 64 * 128 * 2;
#define KSWZ(row, colB) ((row) * 256 + ((colB) ^ (((row) & 7) << 4)))
#define SBAR() __builtin_amdgcn_sched_barrier(0)
__device__ __forceinline__ int crow(int r, int hi) { return (r & 3) + 8 * (r >> 2) + 4 * hi; }
__device__ __forceinline__ void partialSM(f32x16& p0, f32x16& p1, float& m_reg, float& mn, float& alpha) {
  constexpr float C = SCALE * 1.4426950408889634f;
  float pmax = p0[0]; for (int r = 1; r < 16; ++r) pmax = fmaxf(pmax, p0[r]); for (int r = 0; r < 16; ++r) pmax = fmaxf(pmax, p1[r]);
  { auto rr = __builtin_amdgcn_permlane32_swap(__float_as_uint(pmax), __float_as_uint(pmax), false, false);
    pmax = fmaxf(__uint_as_float(rr[0]), __uint_as_float(rr[1])); }
  if (__builtin_expect(__all(pmax - m_reg <= THR / SCALE), 1)) { mn = m_reg; alpha = 1.f; }
  else { mn = fmaxf(m_reg, pmax); alpha = __builtin_amdgcn_exp2f((m_reg - mn) * C); m_reg = mn; }
  float mnC = -mn * C;
  for (int r = 0; r < 16; ++r) p0[r] = fmaf(p0[r], C, mnC); for (int r = 0; r < 16; ++r) p1[r] = fmaf(p1[r], C, mnC);
  for (int r = 0; r < 16; ++r) p0[r] = __builtin_amdgcn_exp2f(p0[r]);
}
__device__ __forceinline__ void finishSM(f32x16& p0, f32x16& p1, float alpha, float& l_reg, bf16x8& pa0, bf16x8& pa1, bf16x8& pa2, bf16x8& pa3) {
  for (int r = 0; r < 16; ++r) p1[r] = __builtin_amdgcn_exp2f(p1[r]);
  float ps = 0; for (int r = 0; r < 16; ++r) ps += p0[r]; for (int r = 0; r < 16; ++r) ps += p1[r];
  { auto rr = __builtin_amdgcn_permlane32_swap(__float_as_uint(ps), __float_as_uint(ps), false, false);
    ps = __uint_as_float(rr[0]) + __uint_as_float(rr[1]); }
  l_reg = l_reg * alpha + ps;
#define PK4(P, BASE, OUT) do { unsigned a0 = cvt_pk(P[BASE + 0], P[BASE + 1]), a1 = cvt_pk(P[BASE + 2], P[BASE + 3]);   \
    unsigned b0 = cvt_pk(P[BASE + 4], P[BASE + 5]), b1 = cvt_pk(P[BASE + 6], P[BASE + 7]);                              \
    auto r0 = __builtin_amdgcn_permlane32_swap(a0, b0, false, false); auto r1 = __builtin_amdgcn_permlane32_swap(a1, b1, false, false); \
    u32x4 w = {r0[0], r1[0], r0[1], r1[1]}; OUT = as_bf8(w); } while (0)
  PK4(p0, 0, pa0); PK4(p0, 8, pa1); PK4(p1, 0, pa2); PK4(p1, 8, pa3);
#undef PK4
}
__device__ __forceinline__ void qkt(f32x16& p0, f32x16& p1, const char* Ks, const bf16x8* qr, int r32, int hi) {
  p0 = f32x16{}; p1 = f32x16{};
  for (int d0 = 0; d0 < 8; ++d0) { int cb = (d0 * 16 + hi * 8) * 2;
    bf16x8 b0 = *reinterpret_cast<const bf16x8*>(Ks + KSWZ(r32, cb));
    bf16x8 b1 = *reinterpret_cast<const bf16x8*>(Ks + KSWZ(32 + r32, cb));
    p0 = __builtin_amdgcn_mfma_f32_32x32x16_bf16(b0, qr[d0], p0, 0, 0, 0);
    p1 = __builtin_amdgcn_mfma_f32_32x32x16_bf16(b1, qr[d0], p1, 0, 0, 0); }
}
__device__ __forceinline__ void maskp(f32x16& p0, f32x16& p1, const char* mrow, int tile, int hi) {
  const u32x2 mw = *(const u32x2*)(mrow + tile * 8); const unsigned w0 = mw.x >> (4 * hi), w1 = mw.y >> (4 * hi);
#pragma unroll
  for (int r = 0; r < 16; ++r) { const int bit = (r & 3) + 8 * (r >> 2);
    p0[r] = ((w0 >> bit) & 1u) ? p0[r] : -1e30f; p1[r] = ((w1 >> bit) & 1u) ? p1[r] : -1e30f; }
}
__device__ __forceinline__ int v_st(int k, int c) { const int kk = (k & ~0xC) | ((k & 4) << 1) | ((k & 8) >> 1); return ((kk >> 3) * 4 + (c >> 5)) * 512 + ((kk & 7) * 32 + (c & 31)) * 2; }
__device__ __forceinline__ int v_rd_base(int lane) { return ((lane & 3) << 3) | (((lane >> 2) & 3) << 6) | (((lane >> 4) & 1) << 5) | (((lane >> 5) & 1) << 8); }
constexpr int v_rd_off(int d0, int ks, int half) { return d0 * 512 + ks * 4096 + half * 2048; }
template <int OFF> __device__ __forceinline__ s16x4 tr_read(int vb) {
  s16x4 r; asm volatile("ds_read_b64_tr_b16 %0, %1 offset:%2" : "=&v"(r) : "v"(vb), "i"(OFF) : "memory"); return r;
}
template <int D0> __device__ __forceinline__ void pv_one(f32x16& od, int vb, bf16x8 pa0, bf16x8 pa1, bf16x8 pa2, bf16x8 pa3) {
  const s16x4 l0 = tr_read<v_rd_off(D0, 0, 0)>(vb), h0 = tr_read<v_rd_off(D0, 0, 1)>(vb), l1 = tr_read<v_rd_off(D0, 1, 0)>(vb), h1 = tr_read<v_rd_off(D0, 1, 1)>(vb);
  const s16x4 l2 = tr_read<v_rd_off(D0, 2, 0)>(vb), h2 = tr_read<v_rd_off(D0, 2, 1)>(vb), l3 = tr_read<v_rd_off(D0, 3, 0)>(vb), h3 = tr_read<v_rd_off(D0, 3, 1)>(vb);
  asm volatile("s_waitcnt lgkmcnt(0)" ::: "memory"); SBAR();
#define PK(L, H) (bf16x8){L[0], L[1], L[2], L[3], H[0], H[1], H[2], H[3]}
  od = __builtin_amdgcn_mfma_f32_32x32x16_bf16(pa0, PK(l0, h0), od, 0, 0, 0);
  od = __builtin_amdgcn_mfma_f32_32x32x16_bf16(pa1, PK(l1, h1), od, 0, 0, 0);
  od = __builtin_amdgcn_mfma_f32_32x32x16_bf16(pa2, PK(l2, h2), od, 0, 0, 0);
  od = __builtin_amdgcn_mfma_f32_32x32x16_bf16(pa3, PK(l3, h3), od, 0, 0, 0);
#undef PK
}
__device__ __forceinline__ void pv_d0(f32x16* o, int vb, bf16x8 pa0, bf16x8 pa1, bf16x8 pa2, bf16x8 pa3) {
  pv_one<0>(o[0], vb, pa0, pa1, pa2, pa3); pv_one<1>(o[1], vb, pa0, pa1, pa2, pa3); pv_one<2>(o[2], vb, pa0, pa1, pa2, pa3); pv_one<3>(o[3], vb, pa0, pa1, pa2, pa3);
}
__device__ __forceinline__ void attn_body(const bf16_t* Qb, const bf16_t* Kh, const bf16_t* Vh, bf16_t* Ob, int NT, const char* maskbase, char* lds) {
  int tid_ = threadIdx.x; asm volatile("" : "+v"(tid_));
  const int tid = tid_, wid = tid >> 6, lane = tid & 63, r32 = lane & 31, hi = lane >> 5;
  char* V_lds = lds; char* K_lds = lds + 2 * SHM_V;
  float* wsf = (float*)(lds + 2 * SHM_V + 2 * SHM_K) + wid * 64; float* li_l = wsf; float* al_l = wsf + 32;
  float m_reg = -1e30f, l_reg = 0; f32x16 o[4] = {}; bf16x8 qr[8];
  const int head = wid >> 1, qloc0 = (wid & 1) * 32;
  const char* mrow = maskbase + (qloc0 + r32) * (34 * 8);
  const bf16_t* Qw = Qb + (size_t)(qloc0 + r32) * 512 + head * 128 + hi * 8;
#pragma unroll
  for (int d0 = 0; d0 < 8; ++d0) qr[d0] = *(const bf16x8*)(Qw + d0 * 16);
  const int sr = tid >> 4, sc = (tid & 15) * 8, vst0 = v_st(sr, sc), vst1 = v_st(32 + sr, sc);
  const int vb0 = (int)(uintptr_t)V_lds + v_rd_base(lane);
  struct { bf16x8 vs0, vs1, ks0, ks1; } sr_[2];
#define SLOAD(i, k0) do { sr_[i].vs0 = *(const bf16x8*)(&Vh[(long)((k0) + sr) * 128 + sc]); sr_[i].vs1 = *(const bf16x8*)(&Vh[(long)((k0) + 32 + sr) * 128 + sc]); \
    sr_[i].ks0 = *(const bf16x8*)(&Kh[(long)((k0) + sr) * 128 + sc]); sr_[i].ks1 = *(const bf16x8*)(&Kh[(long)((k0) + 32 + sr) * 128 + sc]); } while (0)
#define SWRITE(b, i) do { *(bf16x8*)(V_lds + (b) * SHM_V + vst0) = sr_[i].vs0;          \
    *(bf16x8*)(V_lds + (b) * SHM_V + vst1) = sr_[i].vs1; int kc = sc * 2;               \
    *(bf16x8*)(K_lds + (b) * SHM_K + KSWZ(sr, kc)) = sr_[i].ks0;                       \
    *(bf16x8*)(K_lds + (b) * SHM_K + KSWZ(32 + sr, kc)) = sr_[i].ks1; } while (0)
#define SWAIT() asm volatile("s_waitcnt vmcnt(4)" ::: "memory")
#define RESC(a) do { if (__any((a) < 1.f)) { if (hi == 0) al_l[r32] = (a); asm volatile("s_waitcnt lgkmcnt(0)" ::: "memory"); \
    for (int d = 0; d < 4; ++d) for (int r = 0; r < 16; ++r) o[d][r] *= al_l[crow(r, hi)]; } } while (0)
  f32x16 pA0, pA1, pB0, pB1; float mnA, mnB, alA, alB; bf16x8 pa0, pa1, pa2, pa3;
  constexpr int SE = 0, SO = 1;
  SLOAD(SE, 0); asm volatile("s_waitcnt vmcnt(0)" ::: "memory"); SWRITE(0, SE); __syncthreads();
  qkt(pA0, pA1, K_lds, qr, r32, hi); maskp(pA0, pA1, mrow, 0, hi); partialSM(pA0, pA1, m_reg, mnA, alA);
  SLOAD(SO, 64); if (2 < NT) SLOAD(SE, 2 * 64);
  SWAIT(); SWRITE(1, SO); __syncthreads();
  for (int j = 1; j + 1 < NT; j += 2) {
    SBAR(); qkt(pB0, pB1, K_lds + SHM_K, qr, r32, hi); maskp(pB0, pB1, mrow, j, hi);
    finishSM(pA0, pA1, alA, l_reg, pa0, pa1, pa2, pa3); SBAR();
    SLOAD(SO, (j + 2) * 64); SBAR();
    pv_d0(o, vb0, pa0, pa1, pa2, pa3); partialSM(pB0, pB1, m_reg, mnB, alB);
    __syncthreads(); SWAIT(); SWRITE(0, SE);
    RESC(alB); __syncthreads();
    SBAR(); qkt(pA0, pA1, K_lds, qr, r32, hi); maskp(pA0, pA1, mrow, j + 1, hi);
    finishSM(pB0, pB1, alB, l_reg, pa0, pa1, pa2, pa3); SBAR();
    if (j + 3 < NT) SLOAD(SE, (j + 3) * 64); SBAR();
    pv_d0(o, vb0 + SHM_V, pa0, pa1, pa2, pa3); partialSM(pA0, pA1, m_reg, mnA, alA);
    __syncthreads(); SWAIT(); SWRITE(1, SO);
    RESC(alA); __syncthreads();
  }
  SBAR(); qkt(pB0, pB1, K_lds + SHM_K, qr, r32, hi); maskp(pB0, pB1, mrow, NT - 1, hi);
  finishSM(pA0, pA1, alA, l_reg, pa0, pa1, pa2, pa3); SBAR();
  pv_d0(o, vb0, pa0, pa1, pa2, pa3); partialSM(pB0, pB1, m_reg, mnB, alB);
  __syncthreads(); RESC(alB);
  finishSM(pB0, pB1, alB, l_reg, pa0, pa1, pa2, pa3); SBAR();
  pv_d0(o, vb0 + SHM_V, pa0, pa1, pa2, pa3);
  if (hi == 0) li_l[r32] = l_reg; asm volatile("s_waitcnt lgkmcnt(0)" ::: "memory");
  float rli[16];
#pragma unroll
  for (int r = 0; r < 16; ++r) rli[r] = __builtin_amdgcn_rcpf(li_l[crow(r, hi)]);
#pragma unroll
  for (int r = 0; r < 16; ++r) { bf16_t* orow = Ob + (size_t)(qloc0 + crow(r, hi)) * 512 + head * 128 + r32;
#pragma unroll
    for (int d0 = 0; d0 < 4; ++d0) orow[d0 * 32] = f2bf(o[d0][r] * rli[r]); }
  asm volatile("s_waitcnt vmcnt(0)" ::: "memory");
#undef SLOAD
#undef SWRITE
#undef SWAIT
#undef RESC
}
__device__ __forceinline__ void select_query(const float* sc, unsigned long long* mrow, int NT, int NTe, int NP, int lane) {
    if (NP <= KSEL) {
        for (int i = 0; i < NTe; ++i) { const int lo = 64 * i; const unsigned long long w = (lo + 64 <= NP) ? ~0ull : (lo >= NP ? 0ull : ((1ull << (NP - lo)) - 1ull)); if (lane == 0) mrow[i] = w; }
        return;
    }
    unsigned u[33];
#pragma unroll
    for (int i = 0; i < 33; ++i) { unsigned v = 0u; if (i < NT) { const unsigned bits = __float_as_uint(sc[64 * i + lane]); v = (bits & 0x80000000u) ? ~bits : (bits | 0x80000000u); } u[i] = v; }
    unsigned t = 0u;
    for (int bit = 31; bit >= 0; --bit) { const unsigned cand = t | (1u << bit); int cnt = 0;
#pragma unroll
        for (int i = 0; i < 33; ++i) if (i < NT) cnt += __popcll(__ballot(u[i] >= cand));
        if (cnt >= KSEL) t = cand; }
    int gt = 0;
#pragma unroll
    for (int i = 0; i < 33; ++i) if (i < NT) gt += __popcll(__ballot(u[i] > t));
    int need = KSEL - gt;
#pragma unroll
    for (int i = 0; i < 34; ++i) if (i < NTe) {
        unsigned long long w = 0ull;
        if (i < 33) { if (i < NT) { w = __ballot(u[i < 33 ? i : 0] > t); unsigned long long e = __ballot(u[i < 33 ? i : 0] == t);
            if (need > 0 && e) { const int pe = __popcll(e); if (pe <= need) { w |= e; need -= pe; } else { while (need > 0) { const unsigned long long low = e & (~e + 1ull); w |= low; e ^= low; --need; } } } } }
        if (lane == 0) mrow[i] = w; }
}
__device__ __forceinline__ void dsa_item(const Args& a, int b, int j, char* smem) {
    unsigned char* ws = a.ws; asm volatile("" : "+s"(ws));
    int tid_ = threadIdx.x; asm volatile("" : "+v"(tid_));
    const int tid = tid_, lane = tid & 63, wid = __builtin_amdgcn_readfirstlane(tid >> 6), hi = lane >> 5;
    const int limit = 64 * (j + 1), NP = 16 + limit, NT = j + 2, NTe = (NT + 1) & ~1, row0 = b * 2048 + 64 * j;
    const bf16_t* iq = (const bf16_t*)(ws + OFF_IQ); const bf16_t* ikb = (const bf16_t*)(ws + OFF_IKB); const float* misc = (const float*)(ws + OFF_MISC);
    float* SC = (float*)(smem + SC_OFF); float* IWL = (float*)(smem + IWL_OFF); unsigned long long* MASK = (unsigned long long*)(smem + MASK_OFF);
    { const int q = tid >> 3, hh = tid & 7; IWL[tid] = misc[(size_t)(row0 + q) * 16 + 8 + hh] * 0.044194173824159216f; }
    if (DSASEL & 1) for (int sub = 0; sub < 4; ++sub) {
        for (int p = tid; p < 16 * 16; p += 512) SC[(p >> 4) * SC_PITCH + (p & 15)] = __builtin_inff();
        for (int p = tid; p < 16 * 48; p += 512) { const int q = p / 48, x = p - q * 48; SC[q * SC_PITCH + NP + x] = -__builtin_inff(); }
        __syncthreads();
        bf16x8 af[4][4];
        { const int rho = lane & 31, qq = 2 * ((rho >> 2) & 1) + (rho >> 4), hh = 4 * ((rho >> 3) & 1) + (rho & 3);
#pragma unroll
          for (int mt = 0; mt < 4; ++mt)
#pragma unroll
              for (int ks = 0; ks < 4; ++ks) af[mt][ks] = *(const bf16x8*)(iq + (size_t)(row0 + sub * 16 + 4 * mt + qq) * 512 + hh * 64 + 16 * ks + 8 * hi); }
        for (int kt = wid; kt < 2 * (j + 1); kt += 8) {
            bf16x8 bfr[4];
#pragma unroll
            for (int ks = 0; ks < 4; ++ks) bfr[ks] = *(const bf16x8*)(ikb + ((size_t)b * TP + 16 + 32 * kt + (lane & 31)) * 64 + 16 * ks + 8 * hi);
#pragma unroll
            for (int mt = 0; mt < 4; ++mt) {
                f32x16 acc = {};
#pragma unroll
                for (int ks = 0; ks < 4; ++ks) acc = __builtin_amdgcn_mfma_f32_32x32x16_bf16(af[mt][ks], bfr[ks], acc, 0, 0, 0);
                const float* iw0 = IWL + (sub * 16 + 4 * mt + 2 * hi) * 8;
                float s0 = 0.f, s1 = 0.f;
#pragma unroll
                for (int rg = 0; rg < 8; ++rg) { s0 += fmaxf(acc[rg], 0.f) * iw0[rg]; s1 += fmaxf(acc[8 + rg], 0.f) * iw0[8 + rg]; }
                if (s0 == 0.f) s0 = 0.f; if (s1 == 0.f) s1 = 0.f;
                float* sp = SC + (4 * mt + 2 * hi) * SC_PITCH + 16 + 32 * kt + (lane & 31);
                sp[0] = s0; sp[SC_PITCH] = s1;
            }
        }
        __syncthreads();
#pragma unroll 1
        for (int qi = 0; qi < 2; ++qi) { const int ql = 2 * wid + qi; select_query(SC + ql * SC_PITCH, MASK + (sub * 16 + ql) * 34, NT, NTe, NP, lane); }
        __syncthreads();
    }
    if (DSASEL & 2) attn_body((const bf16_t*)(ws + OFF_BQ) + (size_t)row0 * 512, (const bf16_t*)(ws + OFF_KB) + (size_t)b * TP * 128, (const bf16_t*)(ws + OFF_VB) + (size_t)b * TP * 128,
              (bf16_t*)(ws + OFF_OB) + (size_t)row0 * 512, NTe, smem + MASK_OFF, smem);
    __syncthreads();
}
__device__ __forceinline__ void dsa_meta_item(const Args& a) {
    unsigned char* ws = a.ws; asm volatile("" : "+s"(ws));
    if (threadIdx.x >= 64) return;
    const int lane = threadIdx.x, q = lane >> 2, h = lane & 3;
    const bf16_t* qp = (const bf16_t*)(ws + M_BQ) + q * 512 + h * 128; const bf16_t* kb = (const bf16_t*)(ws + OFF_KB); const bf16_t* vb = (const bf16_t*)(ws + OFF_VB);
    float s[16]; float mx = -1e30f;
#pragma unroll
    for (int k = 0; k < 16; ++k) { float acc = 0.f; for (int d = 0; d < 128; ++d) acc += bf2f(qp[d]) * bf2f(kb[k * 128 + d]); s[k] = acc * SCALE; mx = fmaxf(mx, s[k]); }
    float l = 0.f;
#pragma unroll
    for (int k = 0; k < 16; ++k) { s[k] = __expf(s[k] - mx); l += s[k]; }
    const float rl = 1.f / l;
    bf16_t* op = (bf16_t*)(ws + M_OB) + q * 512 + h * 128;
    for (int d = 0; d < 128; ++d) { float acc = 0.f;
#pragma unroll
        for (int k = 0; k < 16; ++k) acc += s[k] * bf2f(vb[k * 128 + d]); op[d] = f2bf(acc * rl); }
}
}

__device__ __forceinline__ void p_mixers(const Args& a, int layer, char* smem) {
    unsigned* ctr = (unsigned*)(a.ws + OFF_CTL) + CW_QUEUE + 64 * layer;
    int* slot = (int*)(smem + LDS_XB - 16);
    constexpr int NSCAN = NB * 4, NDSA = NB * 32, NITEM = NSCAN + NDSA + 1;
    for (;;) {
        __syncthreads();
        if (threadIdx.x == 0) *slot = (int)__hip_atomic_fetch_add(ctr, 1u, __ATOMIC_RELAXED, __HIP_MEMORY_SCOPE_AGENT);
        __syncthreads();
        const int it = *slot;
        if (it >= NITEM) break;
#ifndef MIXSEL
#define MIXSEL 7
#endif
        if (it < NSCAN) { if (MIXSEL & 1) gdn_scan_item(a, layer, it >> 2, it & 3, smem); }
        else if (it < NSCAN + NDSA) { const int k = it - NSCAN, j = 31 - (k >> 5), b = k & 31; if (MIXSEL & 2) da::dsa_item(a, b, j, smem); }
        else if (MIXSEL & 4) da::dsa_meta_item(a);
    }
}

__device__ __forceinline__ void p_ffnconv(const Args& a, int layer, bool with_meta) {
    unsigned char* ws = a.ws; asm volatile("" : "+s"(ws));
    const float* cw = a.in[I_CONV_FFN] + (size_t)layer * 3 * DFF;
    const bf16_t* gp = (const bf16_t*)(ws + OFF_GPRE); bf16_t* up = (bf16_t*)(ws + OFF_UP); const float* mgu = (const float*)(ws + M_GU);
    int tid_ = threadIdx.x; asm volatile("" : "+v"(tid_));
    const int gt = blockIdx.x * 512 + tid_, nT = gridDim.x * 512;
    for (int id = gt; id < NB * 32 * 352; id += nT) {
        const int cg = id % 352, blk = id / 352, c0 = cg * 8; const size_t row0 = (size_t)blk * 64;
        float w0[8], w1[8], w2[8], g0[8], g1[8];
#pragma unroll
        for (int k = 0; k < 8; ++k) { w0[k] = cw[c0 + k]; w1[k] = cw[DFF + c0 + k]; w2[k] = cw[2 * DFF + c0 + k]; }
        if ((blk & 31) == 0) {
#pragma unroll
            for (int k = 0; k < 8; ++k) { const int c = c0 + k, gi = (c >> 7) * 256 + (c & 127); g0[k] = mgu[14 * 5632 + gi]; g1[k] = mgu[15 * 5632 + gi]; }
        } else {
            const u32x4 a0 = *(const u32x4*)(gp + (row0 - 2) * DFF + c0), a1 = *(const u32x4*)(gp + (row0 - 1) * DFF + c0);
            g0[0] = bflo(a0.x); g0[1] = bfhi(a0.x); g0[2] = bflo(a0.y); g0[3] = bfhi(a0.y); g0[4] = bflo(a0.z); g0[5] = bfhi(a0.z); g0[6] = bflo(a0.w); g0[7] = bfhi(a0.w);
            g1[0] = bflo(a1.x); g1[1] = bfhi(a1.x); g1[2] = bflo(a1.y); g1[3] = bfhi(a1.y); g1[4] = bflo(a1.z); g1[5] = bfhi(a1.z); g1[6] = bflo(a1.w); g1[7] = bfhi(a1.w);
        }
#pragma unroll 4
        for (int t = 0; t < 64; ++t) {
            const u32x4 gv = *(const u32x4*)(gp + (row0 + t) * DFF + c0), uv = *(const u32x4*)(up + (row0 + t) * DFF + c0);
            const float g2[8] = {bflo(gv.x), bfhi(gv.x), bflo(gv.y), bfhi(gv.y), bflo(gv.z), bfhi(gv.z), bflo(gv.w), bfhi(gv.w)};
            const float uu[8] = {bflo(uv.x), bfhi(uv.x), bflo(uv.y), bfhi(uv.y), bflo(uv.z), bfhi(uv.z), bflo(uv.w), bfhi(uv.w)};
            float o[8];
#pragma unroll
            for (int k = 0; k < 8; ++k) { o[k] = silu_f(w0[k] * g0[k] + w1[k] * g1[k] + w2[k] * g2[k]) * uu[k]; g0[k] = g1[k]; g1[k] = g2[k]; }
            u32x4 w; w.x = cvt_pk(o[0], o[1]); w.y = cvt_pk(o[2], o[3]); w.z = cvt_pk(o[4], o[5]); w.w = cvt_pk(o[6], o[7]);
            *(u32x4*)(up + (row0 + t) * DFF + c0) = w;
        }
    }
    if (with_meta) {
        bf16_t* mact = (bf16_t*)(ws + M_ACT);
        for (int c = gt; c < DFF; c += nT) { const int gi = (c >> 7) * 256 + (c & 127); const float w0 = cw[c], w1 = cw[DFF + c], w2 = cw[2 * DFF + c]; float g0 = 0.f, g1 = 0.f;
            for (int t = 0; t < 16; ++t) { const float g2 = mgu[t * 5632 + gi], uu = mgu[t * 5632 + gi + 128]; mact[t * DFF + c] = f2bf(silu_f(w0 * g0 + w1 * g1 + w2 * g2) * uu); g0 = g1; g1 = g2; } }
    }
}

constexpr int NPH = 1 + 10 * NLAYER;
#ifndef ONE_LAUNCH
#define ONE_LAUNCH 0
#endif
template <int L> __device__ __forceinline__ void layer_phases(const Args& a, char* smem, const XcdBarrier& bar, const int lo, const int hi) {
    constexpr int l = L;
    unsigned char* ws0 = a.ws;
    PG8_LAS unsigned char* glds = (PG8_LAS unsigned char*)smem;
    const int G = gridDim.x, bx = blockIdx.x;
#define IN(k) (lo <= (k) && (k) < hi)
#define SEAM(k) do { if (IN(k) && IN((k) + 1)) xcd_barrier(bar); } while (0)
#define OPQ_WS() unsigned char* ws = ws0; asm volatile("" : "+s"(ws))
#ifndef EN_MASK
#define EN_MASK 0xFFFF
#endif
        const int pb = 1 + 10 * l;
        const float* hin = l == 0 ? a.in[I_X] : a.out;
        if ((EN_MASK & 2) && IN(pb + 0)) { OPQ_WS(); p_norm(hin, (float*)(ws + M_H), a.in[I_NORM_MIX] + l * DM, (bf16_t*)(ws + OFF_NB), (bf16_t*)(ws + M_NB), true); }
        SEAM(pb + 0);
        if ((EN_MASK & 4) && IN(pb + 1)) { OPQ_WS();
            const bf16_t* WinT = (const bf16_t*)(ws + OFF_WIN) + (size_t)l * NIN * DM; bf16_t* nb = (bf16_t*)(ws + OFF_NB); bf16_t* nbm = (bf16_t*)(ws + M_NB);
            small_gemm16(nbm, WinT, NIN, DM, MEpiIn{ws, a.in[I_B_GATE] + l * 2048});
            pg8::Gemm g{nb, WinT, RR, NIN, DM}; pg8::StaticOrder S; S.init(RR, NIN, G, bx);
            EpiIn E{(bf16_t*)(ws + OFF_QKV), (bf16_t*)(ws + OFF_HALO), (bf16_t*)(ws + OFF_Z), (bf16_t*)(ws + OFF_BQ), (bf16_t*)(ws + OFF_IQ), (bf16_t*)(ws + OFF_KB), (bf16_t*)(ws + OFF_VB),
                    (bf16_t*)(ws + OFF_IKB), (float*)(ws + OFF_MISC), (bf16_t*)(ws + OFF_GATES), a.in[I_B_GATE] + l * 2048};
            pg8::gemm_phase<EpiIn, pg8::StaticOrder>(glds, g, S, E, nullptr);
        }
        SEAM(pb + 1);
        if ((EN_MASK & 8) && IN(pb + 2)) p_mixprep(a, l, smem);
        SEAM(pb + 2);
        if ((EN_MASK & 16) && IN(pb + 3)) p_mixers(a, l, smem);
        SEAM(pb + 3);
        if ((EN_MASK & 32) && IN(pb + 4)) { OPQ_WS();
            const bf16_t* WbaT = (const bf16_t*)(ws + OFF_WBA) + (size_t)l * DM * 512; const bf16_t* WbbT = (const bf16_t*)(ws + OFF_WBB) + (size_t)l * DM * 512;
            small_gemm16((const bf16_t*)(ws + M_OA), WbaT, DM, 512, MEpiBranch<0>{ws, DBG_NO_GDN ? 0.f : 1.f});
            asm volatile("s_waitcnt vmcnt(0)" ::: "memory"); __syncthreads();
            small_gemm16((const bf16_t*)(ws + M_OB), WbbT, DM, 512, MEpiBranch<1>{ws, DBG_NO_DSA ? 0.f : 1.f});
            { pg8::Gemm g{(const bf16_t*)(ws + OFF_OA), WbaT, RR, DM, 512}; pg8::StaticOrder S; S.init(RR, DM, G, bx);
              EpiBranch<0> E{(bf16_t*)(ws + OFF_Y), (const bf16_t*)(ws + OFF_GATES), DBG_NO_GDN ? 0.f : 1.f};
              pg8::gemm_phase<EpiBranch<0>, pg8::StaticOrder>(glds, g, S, E, nullptr); }
            { pg8::Gemm g{(const bf16_t*)(ws + OFF_OB), WbbT, RR, DM, 512}; pg8::StaticOrder S; S.init(RR, DM, G, bx);
              EpiBranch<1> E{(bf16_t*)(ws + OFF_Y), (const bf16_t*)(ws + OFF_GATES), DBG_NO_DSA ? 0.f : 1.f};
              pg8::gemm_phase<EpiBranch<1>, pg8::StaticOrder>(glds, g, S, E, nullptr); }
        }
        SEAM(pb + 4);
        if ((EN_MASK & 64) && IN(pb + 5)) { OPQ_WS(); float* hmeta = (float*)(ws + M_H);
            const bf16_t* WoutT = (const bf16_t*)(ws + OFF_WOUT) + (size_t)l * DM * DM;
            small_gemm16((const bf16_t*)(ws + M_Y), WoutT, DM, DM, MEpiResid{hmeta, DBG_NO_MIX ? 0.f : 1.f});
            pg8::Gemm g{(const bf16_t*)(ws + OFF_Y), WoutT, RR, DM, DM}; pg8::StaticOrder S; S.init(RR, DM, G, bx);
            EpiResid E{hin, a.out, DBG_NO_MIX ? 0.f : 1.f};
            pg8::gemm_phase<EpiResid, pg8::StaticOrder>(glds, g, S, E, nullptr);
        }
        SEAM(pb + 5);
        if ((EN_MASK & 2) && IN(pb + 6)) { OPQ_WS(); p_norm(a.out, (float*)(ws + M_H), a.in[I_NORM_FFN] + l * DM, (bf16_t*)(ws + OFF_NB), (bf16_t*)(ws + M_NB), true); }
        SEAM(pb + 6);
        if ((EN_MASK & 128) && IN(pb + 7)) { OPQ_WS(); bf16_t* nb = (bf16_t*)(ws + OFF_NB); bf16_t* nbm = (bf16_t*)(ws + M_NB);
            const bf16_t* WupT = (const bf16_t*)(ws + OFF_WUP) + (size_t)l * NIN * DM;
            small_gemm16(nbm, WupT, NIN, DM, MEpiUp{(float*)(ws + M_GU)});
            pg8::Gemm g{nb, WupT, RR, NIN, DM}; pg8::StaticOrder S; S.init(RR, NIN, G, bx);
            EpiUp E{(bf16_t*)(ws + OFF_GPRE), (bf16_t*)(ws + OFF_UP)};
            pg8::gemm_phase<EpiUp, pg8::StaticOrder>(glds, g, S, E, nullptr);
        }
        SEAM(pb + 7);
        if ((EN_MASK & 256) && IN(pb + 8)) p_ffnconv(a, l, true);
        SEAM(pb + 8);
        if ((EN_MASK & 64) && IN(pb + 9)) { OPQ_WS(); float* hmeta = (float*)(ws + M_H);
            const bf16_t* WdnT = (const bf16_t*)(ws + OFF_WDN) + (size_t)l * DM * DFF;
            small_gemm16((const bf16_t*)(ws + M_ACT), WdnT, DM, DFF, MEpiResid{hmeta, DBG_NO_FFN ? 0.f : 1.f});
            pg8::Gemm g{(const bf16_t*)(ws + OFF_UP), WdnT, RR, DM, DFF}; pg8::StaticOrder S; S.init(RR, DM, G, bx);
            EpiResid E{a.out, a.out, DBG_NO_FFN ? 0.f : 1.f};
            pg8::gemm_phase<EpiResid, pg8::StaticOrder>(glds, g, S, E, nullptr);
        }
        SEAM(pb + 9);
    #undef IN
#undef SEAM
#undef OPQ_WS
}
__global__ void __launch_bounds__(512, 2) fwd(Args a) {
    extern __shared__ __attribute__((aligned(16))) char smem[];
    unsigned char* ws = a.ws;
    const int lo = a.ph_lo, hi = a.ph_hi;
    const bool fused = (hi - lo) > 1;
    if (threadIdx.x == 0) *(u32x4*)(smem + LDS_XB) = (u32x4){0u, 0u, 0u, 0u};
    __syncthreads();
    XcdBarrier bar; bar.bar = (unsigned*)(ws + OFF_CTL); bar.x = 0; bar.st = (volatile LAS unsigned*)(smem + LDS_XB);
    if (fused) bar = xcd_barrier_post((unsigned*)(ws + OFF_CTL), (volatile LAS unsigned*)(smem + LDS_XB));
    if ((EN_MASK & 1) && lo <= 0 && 0 < hi) p_prologue(a, smem);
    if (lo <= 0 && 1 < hi) xcd_barrier(bar);
    layer_phases<0>(a, smem, bar, lo, hi);
    layer_phases<1>(a, smem, bar, lo, hi);
}


extern "C" void kernel_launch(void* const* d_in, const int* in_sizes, int n_in, void* d_out, int out_size, void* d_ws, size_t ws_size, hipStream_t stream) {
    static int grid = 0;
    if (grid == 0) {
        if (n_in != 20 || in_sizes[0] != RR * DM || out_size != RR * DM || ws_size < WS_END) {
            fprintf(stderr, "kernel_launch: shape mismatch: n_in %d in0 %d out %d ws %zu (need %zu)\n", n_in, n_in > 0 ? in_sizes[0] : -1, out_size, ws_size, (size_t)WS_END); grid = -1; return; }
        int dev = 0, cus = 0, per_cu = 0;
        if (hipGetDevice(&dev) != hipSuccess || hipDeviceGetAttribute(&cus, hipDeviceAttributeMultiprocessorCount, dev) != hipSuccess) { fprintf(stderr, "kernel_launch: device query failed\n"); grid = -1; return; }
        if (hipFuncSetAttribute((const void*)fwd, hipFuncAttributeMaxDynamicSharedMemorySize, LDS_BYTES) != hipSuccess) { fprintf(stderr, "kernel_launch: hipFuncSetAttribute failed\n"); grid = -1; return; }
        if (hipOccupancyMaxActiveBlocksPerMultiprocessor(&per_cu, (const void*)fwd, 512, LDS_BYTES) != hipSuccess || per_cu < 1)
            fprintf(stderr, "kernel_launch: note: occupancy query reports %d workgroups per CU\n", per_cu);
        (void)hipGetLastError();
        grid = cus;
    }
    if (grid < 0) return;
    if (hipMemsetAsync((char*)d_ws + OFF_CTL, 0, SZ_CTL, stream) != hipSuccess) { fprintf(stderr, "kernel_launch: memset failed\n"); return; }
    Args a{};
    for (int i = 0; i < 20; ++i) a.in[i] = (const float*)d_in[i];
    a.out = (float*)d_out; a.ws = (unsigned char*)d_ws;
#if ONE_LAUNCH
    a.ph_lo = 0; a.ph_hi = NPH;
    hipLaunchKernelGGL(fwd, dim3(grid), dim3(512), LDS_BYTES, stream, a);
#else
    for (int p = 0; p < NPH; ++p) { a.ph_lo = p; a.ph_hi = p + 1; hipLaunchKernelGGL(fwd, dim3(grid), dim3(512), LDS_BYTES, stream, a); }
#endif
    const hipError_t le = hipPeekAtLastError();
    if (le != hipSuccess) fprintf(stderr, "kernel_launch: launch failed: %s\n", hipGetErrorName(le));
}
```

```cpp
#define ONE_LAUNCH 1
#include <hip/hip_runtime.h>
#include <cstdio>
#include <cstdint>

#define LAS __attribute__((address_space(3)))
typedef unsigned short bf16_t;
typedef short bf16x8 __attribute__((ext_vector_type(8)));
typedef short s16x4 __attribute__((ext_vector_type(4)));
typedef float f32x4 __attribute__((ext_vector_type(4)));
typedef float f32x16 __attribute__((ext_vector_type(16)));
typedef unsigned u32x4 __attribute__((ext_vector_type(4)));
typedef unsigned u32x2 __attribute__((ext_vector_type(2)));

constexpr int NB = 32, SQ = 2048, RR = NB * SQ, NMETA = 16, TP = 2176, DM = 1024, TPOS = 2064;
constexpr int NIN = 5632, DFF = 2816, NLAYER = 2;
constexpr float EPSF = 1e-6f;

constexpr size_t al256(size_t x) { return (x + 255) / 256 * 256; }
constexpr size_t OFF_CTL = 0, SZ_CTL = 65536;
constexpr size_t OFF_WIN = OFF_CTL + SZ_CTL, SZ_WIN = (size_t)NLAYER * NIN * DM * 2;
constexpr size_t OFF_WBR = OFF_WIN + SZ_WIN, SZ_WBR = (size_t)NLAYER * 2048 * DM * 2;
constexpr size_t OFF_WOUT = OFF_WBR + SZ_WBR, SZ_WOUT = (size_t)NLAYER * DM * DM * 2;
constexpr size_t OFF_WUP = OFF_WOUT + SZ_WOUT, SZ_WUP = (size_t)NLAYER * NIN * DM * 2;
constexpr size_t OFF_WDN = OFF_WUP + SZ_WUP, SZ_WDN = (size_t)NLAYER * DM * DFF * 2;
constexpr size_t OFF_COSA = OFF_WDN + SZ_WDN, SZ_ROPA = (size_t)TPOS * 64 * 4;
constexpr size_t OFF_SINA = OFF_COSA + SZ_ROPA;
constexpr size_t OFF_COSI = OFF_SINA + SZ_ROPA, SZ_ROPI = (size_t)TPOS * 32 * 4;
constexpr size_t OFF_SINI = OFF_COSI + SZ_ROPI;
constexpr size_t OFF_M = al256(OFF_SINI + SZ_ROPI);
constexpr size_t M_H = OFF_M;
constexpr size_t M_RAW = M_H + 16 * 1024 * 4;
constexpr size_t M_CHUNK = M_RAW + 16 * 1536 * 2;
constexpr size_t M_Z = M_CHUNK + 64 * 1536 * 2;
constexpr size_t M_BQ = M_Z + 16 * 512 * 2;
constexpr size_t M_IQ = M_BQ + 16 * 512 * 2;
constexpr size_t M_K = M_IQ + 16 * 512 * 2;
constexpr size_t M_V = M_K + 16 * 128 * 2;
constexpr size_t M_MISC = M_V + 16 * 128 * 2;
constexpr size_t M_GATES = M_MISC + 16 * 16 * 4;
constexpr size_t M_TQ = M_GATES + 16 * 2048 * 2;
constexpr size_t M_GC = M_TQ + 4 * 2 * 4096 * 2;
constexpr size_t M_BETA = M_GC + 64 * 4 * 4;
constexpr size_t M_OAB = M_BETA + 64 * 4 * 4;
constexpr size_t M_Y = M_OAB + 16 * 1024 * 2;
constexpr size_t M_GU = M_Y + 16 * 1024 * 2;
constexpr size_t M_ACT = M_GU + 16 * 5632 * 4;
constexpr size_t M_END = M_ACT + 16 * 2816 * 2;
constexpr size_t OFF_HB = al256(M_END), SZ_HB = (size_t)RR * DM * 2;
constexpr size_t OFF_SSQ = OFF_HB + SZ_HB, SZ_SSQ = (size_t)4 * RR * 8;
constexpr size_t OFF_QKV = OFF_SSQ + SZ_SSQ, SZ_QKV = (size_t)RR * 1536 * 2;
constexpr size_t OFF_HALO = OFF_QKV + SZ_QKV, SZ_HALO = (size_t)(RR / 64) * 3 * 1536 * 2;
constexpr size_t OFF_Z = OFF_HALO + SZ_HALO, SZ_512 = (size_t)RR * 512 * 2;
constexpr size_t OFF_BQ = OFF_Z + SZ_512;
constexpr size_t OFF_IQ = OFF_BQ + SZ_512;
constexpr size_t OFF_KB = OFF_IQ + SZ_512, SZ_KB = (size_t)NB * TP * 128 * 2;
constexpr size_t OFF_VB = OFF_KB + SZ_KB;
constexpr size_t OFF_IKB = OFF_VB + SZ_KB, SZ_IKB = (size_t)NB * TP * 64 * 2;
constexpr size_t OFF_MISC = OFF_IKB + SZ_IKB, SZ_MISC = (size_t)RR * 16 * 4;
constexpr size_t OFF_GC = OFF_MISC + SZ_MISC, SZ_GC = (size_t)RR * 4 * 4;
constexpr size_t OFF_BETA = OFF_GC + SZ_GC;
constexpr size_t OFF_TQ = OFF_BETA + SZ_GC, SZ_TQ = (size_t)NB * 32 * 4 * 2 * 4096 * 2;
constexpr size_t OFF_OAB = OFF_TQ + SZ_TQ, SZ_OAB = (size_t)RR * DM * 2;
constexpr size_t OFF_HG = OFF_OAB + SZ_OAB, SZ_HG = (size_t)256 * 2 * DFF * 4;
constexpr size_t WS_END = OFF_HG + SZ_HG;
constexpr size_t OFF_Y = OFF_QKV;
constexpr size_t OFF_ACT = OFF_QKV, SZ_FF = (size_t)RR * DFF * 2;
static_assert(OFF_ACT + SZ_FF <= OFF_OAB, "ffn alias region");
static_assert(WS_END <= (size_t)1073741824, "workspace budget");
constexpr int CW_QUEUE = 4096;

constexpr int LDS_BYTES = 163840, LDS_XB = LDS_BYTES - 16;

#define AS_GLOBAL(p) ((unsigned char*)(__attribute__((address_space(1))) unsigned char*)(p))
typedef __bf16 bf16x2_t __attribute__((ext_vector_type(2)));
__device__ __forceinline__ unsigned cvt_pk(float lo, float hi) { bf16x2_t v; v[0] = (__bf16)lo; v[1] = (__bf16)hi; return __builtin_bit_cast(unsigned, v); }
__device__ __forceinline__ bf16_t f2bf(float x) { return (bf16_t)(cvt_pk(x, 0.f) & 0xffffu); }
__device__ __forceinline__ float bf2f(bf16_t b) { return __uint_as_float(((unsigned)b) << 16); }
__device__ __forceinline__ float bflo(unsigned w) { return __uint_as_float(w << 16); }
__device__ __forceinline__ float bfhi(unsigned w) { return __uint_as_float(w & 0xffff0000u); }
__device__ __forceinline__ float wave_sum(float v) {
#pragma unroll
    for (int o = 32; o; o >>= 1) v += __shfl_xor(v, o);
    return v; }
__device__ __forceinline__ float half_sum(float v) {
#pragma unroll
    for (int o = 16; o; o >>= 1) v += __shfl_xor(v, o);
    return v; }
typedef unsigned long long u64_t;
constexpr float SSQ_SCALE = 1048576.f, SSQ_INV = 1.f / 1048576.f;
__device__ __forceinline__ float rstd_of(const u64_t* ssq, int row) { return rsqrtf((float)ssq[row] * (SSQ_INV / DM) + EPSF); }
#ifndef FAST_SIG
#define FAST_SIG 1
#endif
#ifndef FAST_SILU
#define FAST_SILU 1
#endif
__device__ __forceinline__ float sigmoid_f(float x) { return FAST_SIG ? __builtin_amdgcn_rcpf(1.f + __expf(-x)) : 1.f / (1.f + __expf(-x)); }
__device__ __forceinline__ float sigmoid_slow(float x) { return 1.f / (1.f + __expf(-x)); }
__device__ __forceinline__ float sigmoid_fast(float x) { return __builtin_amdgcn_rcpf(1.f + __expf(-x)); }
__device__ __forceinline__ float silu_f(float x) { return FAST_SILU ? x * __builtin_amdgcn_rcpf(1.f + __expf(-x)) : x / (1.f + __expf(-x)); }
__device__ __forceinline__ float softplus_f(float x) { return fmaxf(x, 0.f) + log1pf(__expf(-fabsf(x))); }
__device__ __forceinline__ u32x4 pack8(f32x4 a, f32x4 b) { u32x4 w; w.x = cvt_pk(a[0], a[1]); w.y = cvt_pk(a[2], a[3]); w.z = cvt_pk(b[0], b[1]); w.w = cvt_pk(b[2], b[3]); return w; }
__device__ __forceinline__ bf16x8 as_bf8(u32x4 w) { return __builtin_bit_cast(bf16x8, w); }
__device__ __forceinline__ f32x4 mfma16(bf16x8 a, bf16x8 b, f32x4 c) { return __builtin_amdgcn_mfma_f32_16x16x32_bf16(a, b, c, 0, 0, 0); }

#define XB_TMO      128
#define XB_XCNT(j)  (256  + 64 * (j))
#define XB_XSUB(j)  (1280 + 64 * (j))
#define XB_XGEN(j)  (2304 + 64 * (j))
#define XB_TOP      3328
#define XB_TOPGEN   3392
#define XCD_BAR_WORDS 3456
#define XB_SPIN_CAP (1u << 18)
__device__ __forceinline__ unsigned xb_ld(unsigned* p)              { return __hip_atomic_load(p, __ATOMIC_RELAXED, __HIP_MEMORY_SCOPE_AGENT); }
__device__ __forceinline__ unsigned xb_add(unsigned* p, unsigned v) { return __hip_atomic_fetch_add(p, v, __ATOMIC_RELAXED, __HIP_MEMORY_SCOPE_AGENT); }
__device__ __forceinline__ unsigned xb_xcc_id() { return (unsigned)__builtin_amdgcn_s_getreg((3 << 11) | 20) & 0xFu; }
#define XB_SPIN(cond, bar) do { unsigned _sp = 0; while (cond) { __builtin_amdgcn_s_sleep(1); \
    if ((++_sp & 255u) == 0u) { if (xb_ld(&(bar)[XB_TMO])) break; if (_sp > XB_SPIN_CAP) { atomicAdd(&(bar)[XB_TMO], 1u); break; } } } } while (0)
struct XcdBarrier { unsigned* bar; unsigned x; volatile LAS unsigned* st; };
__device__ __forceinline__ XcdBarrier xcd_barrier_post(unsigned* bar, volatile LAS unsigned* st) {
    XcdBarrier b; b.bar = bar; b.x = xb_xcc_id(); b.st = st;
    if (threadIdx.x == 0) (void)xb_add(&bar[XB_XCNT(b.x)], 1u);
    return b;
}
__device__ __forceinline__ void xcd_barrier_complete(unsigned* bar, unsigned x, unsigned& nloc, unsigned& nx) {
    const unsigned G = gridDim.x * gridDim.y * gridDim.z;
    unsigned sum, cnt, mine, sp = 0u;
    for (;;) {
        sum = 0u; cnt = 0u; mine = 0u;
#pragma unroll
        for (unsigned j = 0; j < 16; ++j) { const unsigned c = xb_ld(&bar[XB_XCNT(j)]); sum += c; cnt += (c > 0u) ? 1u : 0u; mine = (j == x) ? c : mine; }
        if (sum == G) break;
        __builtin_amdgcn_s_sleep(1);
        if ((++sp & 255u) == 0u) { if (xb_ld(&bar[XB_TMO])) break; if (sp > XB_SPIN_CAP) { atomicAdd(&bar[XB_TMO], 1u); break; } }
    }
    nloc = mine > 0u ? mine : 1u; nx = cnt > 0u ? cnt : 1u;
}
__device__ __forceinline__ void xcd_barrier(const XcdBarrier& b) {
    asm volatile("s_waitcnt vmcnt(0)" ::: "memory");
    __syncthreads();
    if (threadIdx.x == 0) {
        unsigned* bar = b.bar;
        __builtin_amdgcn_s_waitcnt(0);
        unsigned nloc = b.st[0], nx = b.st[1];
        if (nloc == 0u) { xcd_barrier_complete(bar, b.x, nloc, nx); b.st[0] = nloc; b.st[1] = nx; }
        const unsigned old = xb_add(&bar[XB_XSUB(b.x)], 1u);
        const unsigned gen = old / nloc;
        if (old + 1u == (gen + 1u) * nloc) {
            __builtin_amdgcn_fence(__ATOMIC_RELEASE, "agent");
            asm volatile("s_waitcnt vmcnt(0)" ::: "memory");
            const unsigned og = xb_add(&bar[XB_TOP], 1u);
            const unsigned tg = og / nx;
            if (og + 1u == (tg + 1u) * nx) xb_add(&bar[XB_TOPGEN], 1u);
            else XB_SPIN(xb_ld(&bar[XB_TOPGEN]) == tg, bar);
            __builtin_amdgcn_fence(__ATOMIC_ACQUIRE, "agent");
            xb_add(&bar[XB_XGEN(b.x)], 1u);
            asm volatile("s_waitcnt vmcnt(0)" ::: "memory");
        } else {
            XB_SPIN(xb_ld(&bar[XB_XGEN(b.x)]) == gen, bar);
            __builtin_amdgcn_fence(__ATOMIC_ACQUIRE, "agent");
            asm volatile("s_waitcnt vmcnt(0)" ::: "memory");
        }
    }
    __syncthreads();
}

namespace pg8 {
#define PG8_LAS __attribute__((address_space(3)))
typedef unsigned short bf16_t;
typedef short bf16x8 __attribute__((ext_vector_type(8)));
typedef float f32x4 __attribute__((ext_vector_type(4)));
typedef unsigned u32x4 __attribute__((ext_vector_type(4)));
constexpr int BM = 256, BK = 64, HALF = 128, HTB = HALF * BK * 2  , STAGE_BYTES = 8 * HTB, NXCD = 8, WGM = 8;

__host__ __device__ __forceinline__ int lds_byte(int r, int c) { const int st = (r >> 4) * 2 + (c >> 5), rr = r & 15, cc = c & 31, ob = rr * 64 + cc * 2; return st * 1024 + (ob ^ (((ob >> 9) & 1) << 5)); }
__host__ __device__ __forceinline__ void stage_rc(int b, int& R, int& C) { const int st = b / 1024, sb = b % 1024, swz = sb ^ (((sb >> 9) & 1) << 5); R = (st >> 1) * 16 + swz / 64; C = (st & 1) * 32 + (swz % 64) / 2; }
__host__ __device__ __forceinline__ int perm32(int rho) { const int n = rho >> 4, i = rho & 15; return 8 * (i >> 2) + 4 * n + (i & 3); }

struct Unit { int pm, pn; };
struct Gemm { const bf16_t* A; const bf16_t* Bt; int M, N, K; };

struct StaticOrder {
    int nM, nN, nwg, G, c;
    __host__ __device__ void init(int M, int N, int G_, int c_) { nM = M / BM; nN = N / BM; nwg = nM * nN; G = G_; c = c_; }
    __host__ __device__ bool next(int i, Unit& u) const {
        const long L = (long)i * G + c; if (L >= nwg) return false;
        int wgid = (int)L; { const int q = nwg / NXCD, r = nwg % NXCD, xcd = wgid % NXCD, off = wgid / NXCD; wgid = (xcd < r ? xcd * (q + 1) : r * (q + 1) + (xcd - r) * q) + off; }
        const int nig = WGM * nN, gid = wgid / nig, fm = gid * WGM, gsz = (nM - fm) < WGM ? (nM - fm) : WGM;
        u.pm = fm + ((wgid % nig) % gsz); u.pn = (wgid % nig) / gsz; return true;
    }
    __device__ __forceinline__ void a_ready(const Unit&) const {}
    __device__ __forceinline__ void done(const Unit&) const {}
};
__device__ __forceinline__ unsigned cvt_pk_bf16(float lo, float hi) { unsigned r; asm volatile("v_cvt_pk_bf16_f32 %0, %1, %2" : "=v"(r) : "v"(lo), "v"(hi)); return r; }
typedef float f32x2 __attribute__((ext_vector_type(2)));
template <class Epi, class Sched, bool STAMP = false>
__device__ __forceinline__ void gemm_phase(PG8_LAS unsigned char* lds, const Gemm g, const Sched& S, const Epi& E, unsigned long long* stamps) {
    int tid_ = threadIdx.x; asm volatile("" : "+v"(tid_));
    const int tid = tid_, wid = __builtin_amdgcn_readfirstlane(tid >> 6), lane = tid & 63, wr = wid >> 2, wc = wid & 3, fr = lane & 15, fq = lane >> 4;
    const int K = g.K, nt = K / BK;
    int ts_lo = 0, ts_hi = 0, nts = 0; const unsigned long long rt_entry = STAMP ? (unsigned long long)wall_clock64() : 0ull;
#define PG8_STAMP() do { if (STAMP && wid == 0 && nts < 64) { const unsigned long long _c = (unsigned long long)clock64(); \
        ts_lo = (lane == nts) ? (int)(unsigned)_c : ts_lo; ts_hi = (lane == nts) ? (int)(unsigned)(_c >> 32) : ts_hi; ++nts; } } while (0)
    PG8_STAMP();
    unsigned voffA[2], voffB[2];
#pragma unroll
    for (int i = 0; i < 2; ++i) { int R, C; stage_rc(tid * 16 + i * 8192, R, C); const int Rb = Epi::PERM ? ((R & ~31) + perm32(R & 31)) : R;
        const int Ra = Epi::APERM ? (8 * (16 * (R >> 6) + (R & 15)) + ((R >> 4) & 3)) : R;
        voffA[i] = (unsigned)(Ra * K + C) * 2u; voffB[i] = (unsigned)(Rb * K + C) * 2u; }
    const size_t kstep = (size_t)(BK * 2);
    const size_t hstep = (size_t)HALF * K * 2;
    const size_t tstep = 2 * hstep;
    const size_t hstepA = Epi::APERM ? (size_t)4 * K * 2 : hstep;
    const unsigned ldsw = (unsigned)wid * 1024u;
    const int aoff = lds_byte(wr * 64 + fr, fq * 8), boff = lds_byte(wc * 32 + fr, fq * 8);
#define PG8_SA(b, h) (((b) * 2 + (h)) * HTB)
#define PG8_SB(b, h) ((4 + (b) * 2 + (h)) * HTB)
#define PG8_STAGE(bufoff, gbase, voff) do { _Pragma("unroll") for (int _i = 0; _i < 2; ++_i) \
        __builtin_amdgcn_global_load_lds((const unsigned*)((const char*)(gbase) + (voff)[_i]), (PG8_LAS unsigned*)(lds + (bufoff) + ldsw + _i * 8192), 16, 0, 0); } while (0)
#define PG8_LDA(dst, b, h) do { _Pragma("unroll") for (int m = 0; m < 4; ++m) _Pragma("unroll") for (int k = 0; k < 2; ++k) dst[m][k] = *(const PG8_LAS bf16x8*)(lds + PG8_SA(b, h) + aoff + m * 2048 + k * 1024); } while (0)
#define PG8_LDB(dst, b, h) do { _Pragma("unroll") for (int n = 0; n < 2; ++n) _Pragma("unroll") for (int k = 0; k < 2; ++k) dst[n][k] = *(const PG8_LAS bf16x8*)(lds + PG8_SB(b, h) + boff + n * 2048 + k * 1024); } while (0)
#define PG8_MMA(ai, bj, At, Bt) do { __builtin_amdgcn_s_setprio(1); _Pragma("unroll") for (int m = 0; m < 4; ++m) _Pragma("unroll") for (int n = 0; n < 2; ++n) _Pragma("unroll") for (int k = 0; k < 2; ++k) \
        acc[ai][bj][m][n] = __builtin_amdgcn_mfma_f32_16x16x32_bf16(Bt[n][k], At[m][k], acc[ai][bj][m][n], 0, 0, 0); __builtin_amdgcn_s_setprio(0); } while (0)
#define PG8_WAIT_V(n) asm volatile("s_waitcnt vmcnt(" #n ")" ::: "memory")
#define PG8_WAIT_L(n) asm volatile("s_waitcnt lgkmcnt(" #n ")" ::: "memory")
#define PG8_BAR __builtin_amdgcn_s_barrier()
#define PG8_SCHED __builtin_amdgcn_sched_barrier(0)
    Unit cur, nxt; int ui = 0;
    if (!S.next(0, cur)) return;
    f32x4 acc[2][2][4][2];
#pragma unroll
    for (int a = 0; a < 2; ++a)
#pragma unroll
        for (int b = 0; b < 2; ++b)
#pragma unroll
            for (int m = 0; m < 4; ++m)
#pragma unroll
                for (int n = 0; n < 2; ++n) acc[a][b][m][n] = (f32x4){0.f, 0.f, 0.f, 0.f};
    bf16x8 At[4][2], B0[2][2], B1[2][2];
    const char* cA = (const char*)g.A + (size_t)cur.pm * tstep; const char* cB = (const char*)g.Bt + (size_t)cur.pn * tstep;
    S.a_ready(cur);
    PG8_STAGE(PG8_SB(0, 0), cB, voffB); PG8_STAGE(PG8_SA(0, 0), cA, voffA); PG8_STAGE(PG8_SB(0, 1), cB + hstep, voffB); PG8_STAGE(PG8_SA(0, 1), cA + hstepA, voffA);
    if (wr == 1) PG8_BAR;
    PG8_WAIT_V(4); PG8_BAR;
    PG8_STAGE(PG8_SB(1, 0), cB + kstep, voffB); PG8_STAGE(PG8_SA(1, 0), cA + kstep, voffA); PG8_STAGE(PG8_SB(1, 1), cB + hstep + kstep, voffB);
    PG8_WAIT_V(6); PG8_BAR;
    PG8_STAMP();
    for (;;) {
        const bool has_next = S.next(ui + 1, nxt);
        const char* nA = has_next ? (const char*)g.A + (size_t)nxt.pm * tstep : cA; const char* nB = has_next ? (const char*)g.Bt + (size_t)nxt.pn * tstep : cB;
        for (int t = 0; t < nt; t += 2) {
            const bool last = (t == nt - 2);
            const bool bd_lo = !Epi::BD || (t * BK * 2 < K), bd_hi = !Epi::BD || !(t * BK * 2 < K);
            const char* a1 = cA + (size_t)(t + 1) * kstep;
            const char* a2 = last ? nA : cA + (size_t)(t + 2) * kstep; const char* b2 = last ? nB : cB + (size_t)(t + 2) * kstep;
            const char* a3 = a2 + kstep; const char* b3 = b2 + kstep;
            if (last && has_next) S.a_ready(nxt);
            PG8_LDB(B0, 0, 0); PG8_SCHED; PG8_LDA(At, 0, 0); PG8_STAGE(PG8_SA(1, 1), a1 + hstepA, voffA);
            PG8_WAIT_L(8); PG8_BAR; PG8_WAIT_L(0); if (bd_lo) PG8_MMA(0, 0, At, B0); PG8_BAR; PG8_SCHED;
            PG8_LDB(B1, 0, 1); PG8_STAGE(PG8_SB(0, 0), b2, voffB);
            PG8_BAR; PG8_WAIT_L(0); if (bd_hi) PG8_MMA(0, 1, At, B1); PG8_BAR;
            PG8_LDA(At, 0, 1); PG8_STAGE(PG8_SA(0, 0), a2, voffA);
            PG8_BAR; PG8_WAIT_L(0); if (bd_lo) PG8_MMA(1, 0, At, B0); PG8_BAR; PG8_SCHED;
            PG8_STAGE(PG8_SB(0, 1), b2 + hstep, voffB);
            PG8_WAIT_V(6); PG8_BAR; if (bd_hi) PG8_MMA(1, 1, At, B1); PG8_BAR;
            PG8_LDB(B0, 1, 0); PG8_SCHED; PG8_LDA(At, 1, 0); PG8_STAGE(PG8_SA(0, 1), a2 + hstepA, voffA);
            PG8_WAIT_L(8); PG8_BAR; PG8_WAIT_L(0); if (bd_lo) PG8_MMA(0, 0, At, B0); PG8_BAR; PG8_SCHED;
            PG8_LDB(B1, 1, 1); PG8_STAGE(PG8_SB(1, 0), b3, voffB);
            PG8_BAR; PG8_WAIT_L(0); if (bd_hi) PG8_MMA(0, 1, At, B1); PG8_BAR;
            PG8_LDA(At, 1, 1); PG8_STAGE(PG8_SA(1, 0), a3, voffA);
            PG8_BAR; PG8_WAIT_L(0); if (bd_lo) PG8_MMA(1, 0, At, B0); PG8_BAR; PG8_SCHED;
            PG8_STAGE(PG8_SB(1, 1), b3 + hstep, voffB);
            PG8_WAIT_V(6); PG8_BAR; if (bd_hi) PG8_MMA(1, 1, At, B1); PG8_BAR;
        }
        PG8_STAMP();
        if constexpr (!Epi::AFTER_DRAIN) { E(acc, cur, wr, wc, fr, fq); S.done(cur); }
        PG8_STAMP();
        if (!has_next) break;
#pragma unroll
        for (int a = 0; a < 2; ++a)
#pragma unroll
            for (int b = 0; b < 2; ++b)
#pragma unroll
                for (int m = 0; m < 4; ++m)
#pragma unroll
                    for (int n = 0; n < 2; ++n) acc[a][b][m][n] = (f32x4){0.f, 0.f, 0.f, 0.f};
        cur = nxt; cA = nA; cB = nB; ++ui;
    }
    PG8_WAIT_V(0);
    if (wr == 0) PG8_BAR;
    PG8_BAR;
    if constexpr (Epi::AFTER_DRAIN) { E.fused(acc, cur, wr, wc, fr, fq, lds, wid, lane); S.done(cur); }
    PG8_STAMP();
    if (STAMP && wid == 0) { stamps[lane] = lane < nts ? (((unsigned long long)(unsigned)ts_hi << 32) | (unsigned)ts_lo) : 0ull;
        if (lane == 62) stamps[62] = rt_entry; if (lane == 63) stamps[63] = (unsigned long long)wall_clock64(); }
#undef PG8_STAMP
#undef PG8_SA
#undef PG8_SB
#undef PG8_STAGE
#undef PG8_LDA
#undef PG8_LDB
#undef PG8_MMA
#undef PG8_WAIT_V
#undef PG8_WAIT_L
#undef PG8_BAR
#undef PG8_SCHED
}
}

struct Args { const float* in[20]; float* out; unsigned char* ws; int ph_lo, ph_hi; };
enum { I_X = 0, I_META, I_NORM_MIX, I_W_IN, I_CONV_A, I_A_LOG, I_DT_BIAS, I_A_OUT_NORM, I_Q_NORM, I_K_NORM, I_KIDX_NORM, I_W_BA, I_W_BB, I_W_GATE, I_B_GATE, I_W_OUT, I_NORM_FFN, I_W_UP, I_CONV_FFN, I_W_DOWN };

#ifndef DBG_NO_DSA
#define DBG_NO_DSA 0
#endif
#ifndef DBG_NO_GDN
#define DBG_NO_GDN 0
#endif
#ifndef DBG_NO_MIX
#define DBG_NO_MIX 0
#endif
#ifndef DBG_NO_FFN
#define DBG_NO_FFN 0
#endif

#ifndef SIG_EPI
#define SIG_EPI sigmoid_fast
#endif
#ifndef SIG_META
#define SIG_META sigmoid_fast
#endif
#ifndef SIG_BETA
#define SIG_BETA sigmoid_fast
#endif
#ifndef GATE_ROT
#define GATE_ROT 0
#endif
#define GATE_COL(row, col) (GATE_ROT ? (((col) + 128 * ((row) & 15)) & 2047) : (col))
#ifndef NT_STORE
#define NT_STORE 0
#endif
#define ST16(ptr, val) do { if (NT_STORE) __builtin_nontemporal_store((val), (u32x4*)(ptr)); else *(u32x4*)(ptr) = (val); } while (0)
using pg8::Unit;
struct EpiIn {
    static constexpr bool PERM = true, AFTER_DRAIN = false, APERM = false, BD = false;
    bf16_t *qkv, *halo, *z, *bq, *iq, *kb, *vb, *ikb; float* misc; bf16_t* gates; const float* bgate; const u64_t* ssq;
    __device__ __forceinline__ void operator()(const f32x4 (&acc)[2][2][4][2], const Unit& u, int wr, int wc, int fr, int fq) const {
        const int pn = u.pn, row0 = u.pm * 256 + wr * 64 + fr, cl = wc * 32 + 8 * fq;
        float rs[2][4];
        { u64_t sv[2][4];
#pragma unroll
          for (int ai = 0; ai < 2; ++ai)
#pragma unroll
              for (int m = 0; m < 4; ++m) sv[ai][m] = ssq[row0 + ai * 128 + m * 16];
#pragma unroll
          for (int ai = 0; ai < 2; ++ai)
#pragma unroll
              for (int m = 0; m < 4; ++m) rs[ai][m] = rsqrtf((float)sv[ai][m] * (SSQ_INV / DM) + EPSF); }
        if (pn < 12) {
            bf16_t* base; int ld, cb;
            if (pn < 6) { base = qkv; ld = 1536; cb = pn * 256; } else if (pn < 8) { base = z; ld = 512; cb = (pn - 6) * 256; }
            else if (pn < 10) { base = bq; ld = 512; cb = (pn - 8) * 256; } else { base = iq; ld = 512; cb = (pn - 10) * 256; }
#pragma unroll
            for (int ai = 0; ai < 2; ++ai)
#pragma unroll
                for (int m = 0; m < 4; ++m) {
                    const int row = row0 + ai * 128 + m * 16; const float r = rs[ai][m];
                    bf16_t* p = base + (size_t)row * ld + cb + cl;
                    const u32x4 w0 = pack8(acc[ai][0][m][0] * r, acc[ai][0][m][1] * r), w1 = pack8(acc[ai][1][m][0] * r, acc[ai][1][m][1] * r);
                    ST16(p, w0); ST16(p + 128, w1);
                    if (pn < 6 && (row & 63) >= 61) {
                        bf16_t* hp = halo + ((size_t)(row >> 6) * 3 + ((row & 63) - 61)) * 1536 + cb + cl;
                        *(u32x4*)hp = w0; *(u32x4*)(hp + 128) = w1;
                    }
                }
        } else if (pn == 12) {
#pragma unroll
            for (int ai = 0; ai < 2; ++ai)
#pragma unroll
                for (int m = 0; m < 4; ++m) {
                    const int row = row0 + ai * 128 + m * 16; const float r = rs[ai][m];
                    const size_t prow = (size_t)(row >> 11) * TP + 16 + (row & 2047);
                    *(u32x4*)(kb + prow * 128 + cl) = pack8(acc[ai][0][m][0] * r, acc[ai][0][m][1] * r);
                    *(u32x4*)(vb + prow * 128 + cl) = pack8(acc[ai][1][m][0] * r, acc[ai][1][m][1] * r);
                }
        } else if (pn == 13) {
#pragma unroll
            for (int ai = 0; ai < 2; ++ai)
#pragma unroll
                for (int m = 0; m < 4; ++m) {
                    const int row = row0 + ai * 128 + m * 16; const float r = rs[ai][m];
                    if (cl < 64) { const size_t prow = (size_t)(row >> 11) * TP + 16 + (row & 2047); *(u32x4*)(ikb + prow * 64 + cl) = pack8(acc[ai][0][m][0] * r, acc[ai][0][m][1] * r); }
                    else if (cl < 80) { float* mp = misc + (size_t)row * 16 + (cl - 64); *(f32x4*)mp = acc[ai][0][m][0] * r; *(f32x4*)(mp + 4) = acc[ai][0][m][1] * r; }
                }
        } else {
            const int cb = (pn - 14) * 256 + cl;
            f32x4 bv[2][2];
#pragma unroll
            for (int bj = 0; bj < 2; ++bj) { bv[bj][0] = *(const f32x4*)(bgate + cb + bj * 128); bv[bj][1] = *(const f32x4*)(bgate + cb + bj * 128 + 4); }
#pragma unroll
            for (int ai = 0; ai < 2; ++ai)
#pragma unroll
                for (int m = 0; m < 4; ++m) {
                    const int row = row0 + ai * 128 + m * 16; const float r = rs[ai][m];
                    bf16_t* p = gates + (size_t)row * 2048;
#pragma unroll
                    for (int bj = 0; bj < 2; ++bj) {
                        f32x4 v0 = acc[ai][bj][m][0] * r + bv[bj][0], v1 = acc[ai][bj][m][1] * r + bv[bj][1];
#pragma unroll
                        for (int j = 0; j < 4; ++j) { v0[j] = SIG_EPI(v0[j]); v1[j] = SIG_EPI(v1[j]); }
                        ST16(p + GATE_COL(row, cb + bj * 128), pack8(v0, v1));
                    }
                }
        }
    }
};
struct EpiBr {
    static constexpr bool PERM = true, AFTER_DRAIN = false, APERM = false, BD = true;
    bf16_t* y; const bf16_t* gates; float sca, scb;
    __device__ __forceinline__ u32x4 comb(const f32x4 (&acc)[2][2][4][2], int ai, int m, u32x4 ga, u32x4 gb) const {
        f32x4 a0 = acc[ai][0][m][0] * sca, a1 = acc[ai][0][m][1] * sca, b0 = acc[ai][1][m][0] * scb, b1 = acc[ai][1][m][1] * scb, v0, v1;
        v0[0] = bflo(ga.x) * a0[0] + bflo(gb.x) * b0[0]; v0[1] = bfhi(ga.x) * a0[1] + bfhi(gb.x) * b0[1]; v0[2] = bflo(ga.y) * a0[2] + bflo(gb.y) * b0[2]; v0[3] = bfhi(ga.y) * a0[3] + bfhi(gb.y) * b0[3];
        v1[0] = bflo(ga.z) * a1[0] + bflo(gb.z) * b1[0]; v1[1] = bfhi(ga.z) * a1[1] + bfhi(gb.z) * b1[1]; v1[2] = bflo(ga.w) * a1[2] + bflo(gb.w) * b1[2]; v1[3] = bfhi(ga.w) * a1[3] + bfhi(gb.w) * b1[3];
        return pack8(v0, v1); }
    __device__ __forceinline__ void operator()(const f32x4 (&acc)[2][2][4][2], const Unit& u, int wr, int wc, int fr, int fq) const {
        const int row0 = u.pm * 256 + wr * 64 + fr, c0 = u.pn * 128 + wc * 32 + 8 * fq;
        u32x4 ga[4], gb[4], w0[4];
#pragma unroll
        for (int m = 0; m < 4; ++m) { const int rw = row0 + m * 16; const size_t go = (size_t)rw * 2048; ga[m] = *(const u32x4*)(gates + go + GATE_COL(rw, c0)); gb[m] = *(const u32x4*)(gates + go + GATE_COL(rw, 1024 + c0)); }
#pragma unroll
        for (int m = 0; m < 4; ++m) w0[m] = comb(acc, 0, m, ga[m], gb[m]);
#pragma unroll
        for (int m = 0; m < 4; ++m) { const int rw = row0 + 128 + m * 16; const size_t go = (size_t)rw * 2048; ga[m] = *(const u32x4*)(gates + go + GATE_COL(rw, c0)); gb[m] = *(const u32x4*)(gates + go + GATE_COL(rw, 1024 + c0)); }
#pragma unroll
        for (int m = 0; m < 4; ++m) *(u32x4*)(y + (size_t)(row0 + m * 16) * 1024 + c0) = w0[m];
#pragma unroll
        for (int m = 0; m < 4; ++m) *(u32x4*)(y + (size_t)(row0 + 128 + m * 16) * 1024 + c0) = comb(acc, 1, m, ga[m], gb[m]);
    }
};
struct EpiResidB {
    static constexpr bool PERM = true, AFTER_DRAIN = false, APERM = false, BD = false;
    bf16_t* hb; u64_t* ssq; float sc;
    __device__ __forceinline__ u32x4 upd(const f32x4 (&acc)[2][2][4][2], int ai, int bj, int m, u32x4 ov, float& part) const {
        f32x4 v0 = acc[ai][bj][m][0] * sc, v1 = acc[ai][bj][m][1] * sc;
        v0[0] += bflo(ov.x); v0[1] += bfhi(ov.x); v0[2] += bflo(ov.y); v0[3] += bfhi(ov.y); v1[0] += bflo(ov.z); v1[1] += bfhi(ov.z); v1[2] += bflo(ov.w); v1[3] += bfhi(ov.w);
        const u32x4 w = pack8(v0, v1);
        part += bflo(w.x) * bflo(w.x) + bfhi(w.x) * bfhi(w.x) + bflo(w.y) * bflo(w.y) + bfhi(w.y) * bfhi(w.y) + bflo(w.z) * bflo(w.z) + bfhi(w.z) * bfhi(w.z) + bflo(w.w) * bflo(w.w) + bfhi(w.w) * bfhi(w.w);
        return w; }
    __device__ __forceinline__ void operator()(const f32x4 (&acc)[2][2][4][2], const Unit& u, int wr, int wc, int fr, int fq) const {
        const int row0 = u.pm * 256 + wr * 64 + fr, c0 = u.pn * 256 + wc * 32 + 8 * fq;
        u32x4 o[4][2], w0[4][2]; float p0[4], p1[4];
#pragma unroll
        for (int m = 0; m < 4; ++m)
#pragma unroll
            for (int bj = 0; bj < 2; ++bj) o[m][bj] = *(const u32x4*)(hb + (size_t)(row0 + m * 16) * DM + c0 + bj * 128);
#pragma unroll
        for (int m = 0; m < 4; ++m) { p0[m] = 0.f; w0[m][0] = upd(acc, 0, 0, m, o[m][0], p0[m]); w0[m][1] = upd(acc, 0, 1, m, o[m][1], p0[m]); }
#pragma unroll
        for (int m = 0; m < 4; ++m)
#pragma unroll
            for (int bj = 0; bj < 2; ++bj) o[m][bj] = *(const u32x4*)(hb + (size_t)(row0 + 128 + m * 16) * DM + c0 + bj * 128);
#pragma unroll
        for (int m = 0; m < 4; ++m)
#pragma unroll
            for (int bj = 0; bj < 2; ++bj) *(u32x4*)(hb + (size_t)(row0 + m * 16) * DM + c0 + bj * 128) = w0[m][bj];
#pragma unroll
        for (int m = 0; m < 4; ++m) { p1[m] = 0.f;
#pragma unroll
            for (int bj = 0; bj < 2; ++bj) *(u32x4*)(hb + (size_t)(row0 + 128 + m * 16) * DM + c0 + bj * 128) = upd(acc, 1, bj, m, o[m][bj], p1[m]); }
#pragma unroll
        for (int m = 0; m < 4; ++m) {
            float a = p0[m], b = p1[m];
            a += __shfl_xor(a, 16); a += __shfl_xor(a, 32); b += __shfl_xor(b, 16); b += __shfl_xor(b, 32);
            if (ssq != nullptr && fq == 0) { atomicAdd(ssq + row0 + m * 16, (u64_t)(unsigned)(a * SSQ_SCALE + 0.5f)); atomicAdd(ssq + row0 + 128 + m * 16, (u64_t)(unsigned)(b * SSQ_SCALE + 0.5f)); }
        }
    }
};
struct EpiFinal {
    static constexpr bool PERM = true, AFTER_DRAIN = false, APERM = false, BD = false;
    const bf16_t* hb; float* out; float sc;
    __device__ __forceinline__ void operator()(const f32x4 (&acc)[2][2][4][2], const Unit& u, int wr, int wc, int fr, int fq) const {
        const int row0 = u.pm * 256 + wr * 64 + fr, c0 = u.pn * 256 + wc * 32 + 8 * fq;
        u32x4 o[2][4][2];
#pragma unroll
        for (int ai = 0; ai < 2; ++ai)
#pragma unroll
            for (int m = 0; m < 4; ++m)
#pragma unroll
                for (int bj = 0; bj < 2; ++bj) o[ai][m][bj] = *(const u32x4*)(hb + (size_t)(row0 + ai * 128 + m * 16) * DM + c0 + bj * 128);
#pragma unroll
        for (int ai = 0; ai < 2; ++ai)
#pragma unroll
            for (int m = 0; m < 4; ++m) {
                const size_t ro = (size_t)(row0 + ai * 128 + m * 16) * DM + c0;
#pragma unroll
                for (int bj = 0; bj < 2; ++bj) { const u32x4 ov = o[ai][m][bj]; f32x4 v0 = acc[ai][bj][m][0] * sc, v1 = acc[ai][bj][m][1] * sc;
                    v0[0] += bflo(ov.x); v0[1] += bfhi(ov.x); v0[2] += bflo(ov.y); v0[3] += bfhi(ov.y); v1[0] += bflo(ov.z); v1[1] += bfhi(ov.z); v1[2] += bflo(ov.w); v1[3] += bfhi(ov.w);
                    *(f32x4*)(out + ro + bj * 128) = v0; *(f32x4*)(out + ro + bj * 128 + 4) = v1; }
            }
    }
};
struct EpiNull {
    static constexpr bool PERM = true, AFTER_DRAIN = false, APERM = false, BD = false;
    __device__ __forceinline__ void operator()(const f32x4 (&acc)[2][2][4][2], const Unit& u, int wr, int wc, int fr, int fq) const {
#pragma unroll
        for (int ai = 0; ai < 2; ++ai)
#pragma unroll
            for (int bj = 0; bj < 2; ++bj)
#pragma unroll
                for (int m = 0; m < 4; ++m)
#pragma unroll
                    for (int n = 0; n < 2; ++n) asm volatile("" :: "v"(acc[ai][bj][m][n]));
    }
};
struct EpiUp {
    static constexpr bool PERM = true, AFTER_DRAIN = false, APERM = false, BD = false;
    bf16_t *gpre, *up; const u64_t* ssq;
    __device__ __forceinline__ void operator()(const f32x4 (&acc)[2][2][4][2], const Unit& u, int wr, int wc, int fr, int fq) const {
        const int row0 = u.pm * 256 + wr * 64 + fr, c0 = u.pn * 128 + wc * 32 + 8 * fq;
        u64_t sv[2][4];
#pragma unroll
        for (int ai = 0; ai < 2; ++ai)
#pragma unroll
            for (int m = 0; m < 4; ++m) sv[ai][m] = ssq[row0 + ai * 128 + m * 16];
#pragma unroll
        for (int ai = 0; ai < 2; ++ai)
#pragma unroll
            for (int m = 0; m < 4; ++m) {
                const int row = row0 + ai * 128 + m * 16; const float r = rsqrtf((float)sv[ai][m] * (SSQ_INV / DM) + EPSF);
                const size_t o = (size_t)row * DFF + c0;
                *(u32x4*)(gpre + o) = pack8(acc[ai][0][m][0] * r, acc[ai][0][m][1] * r);
                *(u32x4*)(up + o) = pack8(acc[ai][1][m][0] * r, acc[ai][1][m][1] * r);
            }
    }
};

template <int MODE> struct EpiUpConvT {
    static constexpr bool PERM = true, AFTER_DRAIN = false, APERM = true, BD = false;
    bf16_t* act; const u64_t* ssq; const float* cw; const float* hg; const float* mgu; char* xlds; int rt;
    __device__ __forceinline__ void operator()(const f32x4 (&acc)[2][2][4][2], const Unit& u, int wr, int wc, int fr, int fq) const {
        const int pm = u.pm, pn = u.pn, cl = wc * 32 + 8 * fq, ch0 = pn * 128 + cl, t0 = pm * 256 + 8 * (16 * wr + fr);
        u64_t sv[8];
#pragma unroll
        for (int j = 0; j < 8; ++j) sv[j] = (MODE == 2) ? (u64_t)(1000000 + j + rt) : ssq[t0 + j];
        float w0[8], w1[8], w2[8], b1[8], b2[8];
        { const f32x4 a0 = *(const f32x4*)(cw + ch0), a1 = *(const f32x4*)(cw + ch0 + 4), c0 = *(const f32x4*)(cw + DFF + ch0), c1 = *(const f32x4*)(cw + DFF + ch0 + 4),
                      e0 = *(const f32x4*)(cw + 2 * DFF + ch0), e1 = *(const f32x4*)(cw + 2 * DFF + ch0 + 4);
          const float* h2 = ((pm & 7) == 0) ? mgu + 14 * 5632 + pn * 256 + cl : hg + (size_t)(pm * 2) * DFF + ch0;
          const float* h1 = ((pm & 7) == 0) ? mgu + 15 * 5632 + pn * 256 + cl : hg + (size_t)(pm * 2 + 1) * DFF + ch0;
          const f32x4 p20 = *(const f32x4*)h2, p21 = *(const f32x4*)(h2 + 4), p10 = *(const f32x4*)h1, p11 = *(const f32x4*)(h1 + 4);
#pragma unroll
          for (int c = 0; c < 4; ++c) { w0[c] = a0[c]; w0[4 + c] = a1[c]; w1[c] = c0[c]; w1[4 + c] = c1[c]; w2[c] = e0[c]; w2[4 + c] = e1[c]; b2[c] = p20[c]; b2[4 + c] = p21[c]; b1[c] = p10[c]; b1[4 + c] = p11[c]; } }
        float rs[8];
#pragma unroll
        for (int j = 0; j < 8; ++j) rs[j] = rsqrtf((float)sv[j] * (SSQ_INV / DM) + EPSF);
        float g6[8], g7[8];
#pragma unroll
        for (int c = 0; c < 8; ++c) { g6[c] = acc[1][0][2][c >> 2][c & 3] * rs[6]; g7[c] = acc[1][0][3][c >> 2][c & 3] * rs[7]; }
        float* xw = (float*)(xlds + ((wc * 4 + fq) * 16) * 4);
        if (wr == 0 && fr == 15) { *(f32x4*)xw = (f32x4){g6[0], g6[1], g6[2], g6[3]}; *(f32x4*)(xw + 4) = (f32x4){g6[4], g6[5], g6[6], g6[7]};
                                   *(f32x4*)(xw + 8) = (f32x4){g7[0], g7[1], g7[2], g7[3]}; *(f32x4*)(xw + 12) = (f32x4){g7[4], g7[5], g7[6], g7[7]}; }
        asm volatile("s_waitcnt lgkmcnt(0)" ::: "memory");
        __builtin_amdgcn_s_barrier();
        asm volatile("" ::: "memory");
        if (wr == 1) { const f32x4 q0 = *(const f32x4*)xw, q1 = *(const f32x4*)(xw + 4), q2 = *(const f32x4*)(xw + 8), q3 = *(const f32x4*)(xw + 12);
#pragma unroll
            for (int c = 0; c < 4; ++c) { b2[c] = q0[c]; b2[4 + c] = q1[c]; b1[c] = q2[c]; b1[4 + c] = q3[c]; } }
        float gm1[8], gm2[8];
#pragma unroll
        for (int c = 0; c < 8; ++c) {
            gm1[c] = __int_as_float(__builtin_amdgcn_update_dpp(__float_as_int(b1[c]), __float_as_int(g7[c]), 0x111, 0xf, 0xf, false));
            gm2[c] = __int_as_float(__builtin_amdgcn_update_dpp(__float_as_int(b2[c]), __float_as_int(g6[c]), 0x111, 0xf, 0xf, false)); }
#pragma unroll
        for (int j = 0; j < 8; ++j) { const int ai = j >> 2, m = j & 3; float o[8];
#pragma unroll
            for (int c = 0; c < 8; ++c) { const float g = acc[ai][0][m][c >> 2][c & 3] * rs[j], up = acc[ai][1][m][c >> 2][c & 3] * rs[j];
                o[c] = silu_f(w0[c] * gm2[c] + w1[c] * gm1[c] + w2[c] * g) * up; gm2[c] = gm1[c]; gm1[c] = g; }
            u32x4 w; w.x = cvt_pk(o[0], o[1]); w.y = cvt_pk(o[2], o[3]); w.z = cvt_pk(o[4], o[5]); w.w = cvt_pk(o[6], o[7]);
            if (MODE != 1 || rt == 12345) ST16(act + (size_t)(t0 + j) * DFF + ch0, w); }
    }
};
typedef EpiUpConvT<0> EpiUpConv;

constexpr int MN_PITCH = 2064;
template <bool ALDS, class F> __device__ __forceinline__ void small_gemm16(const void* Ain, const bf16_t* Bt, int N, int K, const F& epi, char* red) {
    int tid_ = threadIdx.x; asm volatile("" : "+v"(tid_));
    const int lane = tid_ & 63, wid = tid_ >> 6, r = lane & 15, g = lane >> 4;
    const int kw = K >> 3, kb0 = wid * kw;
    for (int ct = blockIdx.x; ct < N / 16; ct += gridDim.x) {
        f32x4 acc = {0.f, 0.f, 0.f, 0.f};
        const bf16_t* bp = Bt + (size_t)(ct * 16 + r) * K + kb0 + g * 8;
        if (ALDS) { const char* ap = (const char*)Ain + r * MN_PITCH + (kb0 + g * 8) * 2;
#pragma unroll 4
            for (int k = 0; k < kw; k += 32) acc = mfma16(*(const bf16x8*)(ap + k * 2), *(const bf16x8*)(bp + k), acc);
        } else { const bf16_t* ap = (const bf16_t*)Ain + (size_t)r * K + kb0 + g * 8;
#pragma unroll 4
            for (int k = 0; k < kw; k += 32) acc = mfma16(*(const bf16x8*)(ap + k), *(const bf16x8*)(bp + k), acc); }
        *(f32x4*)(red + (wid * 64 + lane) * 16) = acc;
        __syncthreads();
        if (wid == 0) { f32x4 s = *(const f32x4*)(red + lane * 16);
#pragma unroll
            for (int w = 1; w < 8; ++w) s += *(const f32x4*)(red + (w * 64 + lane) * 16);
#pragma unroll
            for (int rr = 0; rr < 4; ++rr) epi(4 * g + rr, ct * 16 + r, s[rr]); }
        __syncthreads();
    }
}
__device__ __forceinline__ void meta_norm_lds(const float* hmeta, char* img) {
    int tid_ = threadIdx.x; asm volatile("" : "+v"(tid_));
    const int lane = tid_ & 63, wid = tid_ >> 6;
#pragma unroll
    for (int rr = 0; rr < 2; ++rr) { const int row = 2 * wid + rr; const float* src = hmeta + row * DM;
        f32x4 v[4]; float ss = 0.f;
#pragma unroll
        for (int i = 0; i < 4; ++i) { v[i] = ((const f32x4*)src)[lane + 64 * i]; ss += v[i][0] * v[i][0] + v[i][1] * v[i][1] + v[i][2] * v[i][2] + v[i][3] * v[i][3]; }
        ss = wave_sum(ss); const float rstd = rsqrtf(ss * (1.f / DM) + EPSF);
#pragma unroll
        for (int i = 0; i < 4; ++i) { u32x2 w; w.x = cvt_pk(v[i][0] * rstd, v[i][1] * rstd); w.y = cvt_pk(v[i][2] * rstd, v[i][3] * rstd); *(u32x2*)(img + row * MN_PITCH + (lane + 64 * i) * 8) = w; } }
    __syncthreads();
}
struct MEpiIn { unsigned char* ws; const float* bgate;
    __device__ __forceinline__ void operator()(int t, int n, float v) const {
        if (n < 1536) ((bf16_t*)(ws + M_RAW))[t * 1536 + n] = f2bf(v);
        else if (n < 2048) ((bf16_t*)(ws + M_Z))[t * 512 + n - 1536] = f2bf(v);
        else if (n < 2560) ((bf16_t*)(ws + M_BQ))[t * 512 + n - 2048] = f2bf(v);
        else if (n < 3072) ((bf16_t*)(ws + M_IQ))[t * 512 + n - 2560] = f2bf(v);
        else if (n < 3200) ((bf16_t*)(ws + M_K))[t * 128 + n - 3072] = f2bf(v);
        else if (n < 3328) ((bf16_t*)(ws + M_V))[t * 128 + n - 3200] = f2bf(v);
        else if (n < 3392) { }
        else if (n < 3408) ((float*)(ws + M_MISC))[t * 16 + n - 3392] = v;
        else if (n < 3584) { }
        else ((bf16_t*)(ws + M_GATES))[t * 2048 + n - 3584] = f2bf(SIG_META(v + bgate[n - 3584]));
    } };
struct MEpiBr { unsigned char* ws; float sca, scb;
    __device__ __forceinline__ void operator()(int t, int n, float v) const {
        const int ch = 128 * (n >> 8) + (n & 127), br = (n >> 7) & 1;
        const float g = bf2f(((const bf16_t*)(ws + M_GATES))[t * 2048 + br * 1024 + ch]);
        ((float*)(ws + M_GU))[t * 5632 + n] = g * v * (br ? scb : sca);
    } };
struct MEpiResid { float* h; float sc; __device__ __forceinline__ void operator()(int t, int n, float v) const { h[t * 1024 + n] += v * sc; } };
struct MEpiUp { float* gu; __device__ __forceinline__ void operator()(int t, int n, float v) const { gu[t * 5632 + n] = v; } };

struct MapId { __device__ __forceinline__ int operator()(int n) const { return n; } };
struct MapWin { __device__ __forceinline__ int operator()(int n) const {
    if (n < 2048) return n; if (n < 2560) return n - 2048 + 2056; if (n < 3072) return n - 2560 + 2824; if (n < 3200) return n - 3072 + 2568;
    if (n < 3328) return n - 3200 + 2696; if (n < 3392) return n - 3328 + 3336; if (n < 3400) return n - 3392 + 2048; if (n < 3408) return n; return -1; } };
struct MapWup { __device__ __forceinline__ int operator()(int n) const { const int t = n >> 8, w = n & 255; return w < 128 ? 128 * t + w : 2816 + 128 * t + (w - 128); } };
struct MapBrA { __device__ __forceinline__ int operator()(int n) const { return (n & 255) < 128 ? 128 * (n >> 8) + (n & 127) : -1; } };
struct MapBrB { __device__ __forceinline__ int operator()(int n) const { return (n & 255) >= 128 ? 128 * (n >> 8) + (n & 127) : -1; } };
template <class Map> __device__ __forceinline__ void tr_cvt(const float* __restrict__ src, int ldsrc, int K, bf16_t* __restrict__ dst, int ldd, int koff, int Nd, const Map& map, const float* gain, float* tile, int& g0) {
    const int G = gridDim.x, tid = threadIdx.x, nnt = Nd / 64, nt = nnt * (K / 128);
    int t = ((int)blockIdx.x - (g0 % G) + G) % G;
    for (; t < nt; t += G) {
        const int n0 = (t % nnt) * 64, k0 = (t / nnt) * 128;
        { const int nn = tid & 63, col = map(n0 + nn); float v[16];
#pragma unroll
          for (int i = 0; i < 16; ++i) { const int kk = (tid >> 6) + 8 * i; v[i] = col >= 0 ? src[(size_t)(k0 + kk) * ldsrc + col] : 0.f; }
#pragma unroll
          for (int i = 0; i < 16; ++i) { const int kk = (tid >> 6) + 8 * i; tile[kk * 65 + nn] = v[i]; } }
        __syncthreads();
#pragma unroll
        for (int hh = 0; hh < 2; ++hh) { const int nn = tid >> 3, part = (tid & 7) + 8 * hh; float v[8];
#pragma unroll
          for (int jj = 0; jj < 8; ++jj) { const int kk = part * 8 + jj; v[jj] = tile[kk * 65 + nn] * (gain ? gain[k0 + kk] : 1.f); }
          u32x4 w; w.x = cvt_pk(v[0], v[1]); w.y = cvt_pk(v[2], v[3]); w.z = cvt_pk(v[4], v[5]); w.w = cvt_pk(v[6], v[7]);
          *(u32x4*)(dst + (size_t)(n0 + nn) * ldd + koff + k0 + part * 8) = w; }
        __syncthreads();
    }
    g0 += nt;
}
__device__ __forceinline__ void p_prologue(const Args& a, char* smem) {
    unsigned char* ws = a.ws; { size_t z_ = 0; asm volatile("" : "+s"(z_)); ws += z_; } float* tile = (float*)smem; int g0 = 0;
    for (int l = 0; l < NLAYER; ++l) {
        const float* gmix = a.in[I_NORM_MIX] + l * DM; const float* gffn = a.in[I_NORM_FFN] + l * DM;
        tr_cvt(a.in[I_W_IN] + (size_t)l * DM * 3408, 3408, DM, (bf16_t*)(ws + OFF_WIN) + (size_t)l * NIN * DM, DM, 0, 3584, MapWin(), gmix, tile, g0);
        tr_cvt(a.in[I_W_GATE] + (size_t)l * DM * 2048, 2048, DM, (bf16_t*)(ws + OFF_WIN) + ((size_t)l * NIN + 3584) * DM, DM, 0, 2048, MapId(), gmix, tile, g0);
        tr_cvt(a.in[I_W_BA] + (size_t)l * 512 * DM, DM, 512, (bf16_t*)(ws + OFF_WBR) + (size_t)l * 2048 * DM, DM, 0, 2048, MapBrA(), nullptr, tile, g0);
        tr_cvt(a.in[I_W_BB] + (size_t)l * 512 * DM, DM, 512, (bf16_t*)(ws + OFF_WBR) + (size_t)l * 2048 * DM, DM, 512, 2048, MapBrB(), nullptr, tile, g0);
        tr_cvt(a.in[I_W_OUT] + (size_t)l * DM * DM, DM, DM, (bf16_t*)(ws + OFF_WOUT) + (size_t)l * DM * DM, DM, 0, DM, MapId(), nullptr, tile, g0);
        tr_cvt(a.in[I_W_UP] + (size_t)l * DM * 5632, 5632, DM, (bf16_t*)(ws + OFF_WUP) + (size_t)l * NIN * DM, DM, 0, NIN, MapWup(), gffn, tile, g0);
        tr_cvt(a.in[I_W_DOWN] + (size_t)l * DFF * DM, DM, DFF, (bf16_t*)(ws + OFF_WDN) + (size_t)l * DM * DFF, DFF, 0, DM, MapId(), nullptr, tile, g0);
    }
    const int gt = blockIdx.x * 512 + threadIdx.x, nT = gridDim.x * 512;
    { const int lane = threadIdx.x & 63, gw = blockIdx.x * 8 + (threadIdx.x >> 6), nW = gridDim.x * 8;
      bf16_t* hb = (bf16_t*)(ws + OFF_HB); u64_t* ssq = (u64_t*)(ws + OFF_SSQ);
      for (int row = 2 * gw; row < RR; row += 2 * nW) { const float* src = a.in[I_X] + (size_t)row * DM; float ss0 = 0.f, ss1 = 0.f; f32x4 v[8];
#pragma unroll
          for (int i = 0; i < 8; ++i) v[i] = ((const f32x4*)src)[lane + 64 * i];
#pragma unroll
          for (int i = 0; i < 8; ++i) { u32x2 w; w.x = cvt_pk(v[i][0], v[i][1]); w.y = cvt_pk(v[i][2], v[i][3]);
              const float q = bflo(w.x) * bflo(w.x) + bfhi(w.x) * bfhi(w.x) + bflo(w.y) * bflo(w.y) + bfhi(w.y) * bfhi(w.y); if (i < 4) ss0 += q; else ss1 += q;
              ((u32x2*)(hb + (size_t)row * DM))[lane + 64 * i] = w; }
          ss0 = wave_sum(ss0); ss1 = wave_sum(ss1); if (lane == 0) { ssq[row] = (u64_t)(ss0 * SSQ_SCALE + 0.5f); ssq[row + 1] = (u64_t)(ss1 * SSQ_SCALE + 0.5f); } }
      for (int i = gt; i < 3 * RR; i += nT) ssq[RR + i] = 0ull; }
    float* cosA = (float*)(ws + OFF_COSA); float* sinA = (float*)(ws + OFF_SINA); float* cosI = (float*)(ws + OFF_COSI); float* sinI = (float*)(ws + OFF_SINI);
    for (int i = gt; i < TPOS * 96; i += nT) {
        const int pos = i / 96, j = i % 96;
        if (j < 64) { const float inv = 1.0f / powf(10000.f, (float)(2 * j) / 128.f), ang = (float)pos * inv; cosA[pos * 64 + j] = cosf(ang); sinA[pos * 64 + j] = sinf(ang); }
        else { const int jj = j - 64; const float inv = 1.0f / powf(10000.f, (float)(2 * jj) / 64.f), ang = (float)pos * inv; cosI[pos * 32 + jj] = cosf(ang); sinI[pos * 32 + jj] = sinf(ang); }
    }
    for (int i = gt; i < 16 * 1024; i += nT) ((float*)(ws + M_H))[i] = a.in[I_META][i];
    for (int i = gt; i < NB * (TP - TPOS) * 16; i += nT) {
        const int b = i / ((TP - TPOS) * 16), r = i % ((TP - TPOS) * 16);
        const size_t o = ((size_t)b * TP + TPOS) * 128 + (size_t)r * 8;
        *(u32x4*)((bf16_t*)(ws + OFF_KB) + o) = (u32x4){0u, 0u, 0u, 0u}; *(u32x4*)((bf16_t*)(ws + OFF_VB) + o) = (u32x4){0u, 0u, 0u, 0u};
    }
}

template <int GL, bool NORM> __device__ __forceinline__ u32x4 rope8(u32x4 raw, int lig, const float* w, const float* cs, const float* sn) {
    float x[8] = {bflo(raw.x), bfhi(raw.x), bflo(raw.y), bfhi(raw.y), bflo(raw.z), bfhi(raw.z), bflo(raw.w), bfhi(raw.w)};
    if (NORM) { float ss = 0.f;
#pragma unroll
        for (int j = 0; j < 8; ++j) ss += x[j] * x[j];
#pragma unroll
        for (int o = 1; o < GL; o <<= 1) ss += __shfl_xor(ss, o);
        const float rstd = rsqrtf(ss * (1.f / (8 * GL)) + EPSF);
        const f32x4 w0 = *(const f32x4*)(w + 8 * lig), w1 = *(const f32x4*)(w + 8 * lig + 4);
#pragma unroll
        for (int j = 0; j < 4; ++j) { x[j] *= rstd * w0[j]; x[4 + j] *= rstd * w1[j]; } }
    const int ih = lig & (GL / 2 - 1); const bool second = lig >= GL / 2;
    const f32x4 c0 = *(const f32x4*)(cs + 8 * ih), c1 = *(const f32x4*)(cs + 8 * ih + 4), s0 = *(const f32x4*)(sn + 8 * ih), s1 = *(const f32x4*)(sn + 8 * ih + 4);
    float o[8];
#pragma unroll
    for (int j = 0; j < 8; ++j) { const float other = __shfl_xor(x[j], GL / 2), cc = j < 4 ? c0[j] : c1[j - 4], ss_ = j < 4 ? s0[j] : s1[j - 4];
        o[j] = x[j] * cc + (second ? other * ss_ : -other * ss_); }
    u32x4 r; r.x = cvt_pk(o[0], o[1]); r.y = cvt_pk(o[2], o[3]); r.z = cvt_pk(o[4], o[5]); r.w = cvt_pk(o[6], o[7]); return r;
}
namespace mp {
constexpr int RAW_OFF = 0, QS_OFF = 51712, KS_OFF = 70144, MT_OFF = 88576, GC_OFF = 154112, BT_OFF = 155136, RED_OFF = 156160, CNT_OFF = 157184;
}
__device__ __forceinline__ void p_mixprep(const Args& a, int layer, char* smem, bool do_store, int skip = 0) {
    using namespace mp;
    unsigned char* ws = a.ws; { size_t z_ = 0; asm volatile("" : "+s"(z_)); ws += z_; }
    bf16_t* qkv = (bf16_t*)(ws + OFF_QKV); const bf16_t* halo = (const bf16_t*)(ws + OFF_HALO); const bf16_t* mraw = (const bf16_t*)(ws + M_RAW);
    bf16_t* mchunk = (bf16_t*)(ws + M_CHUNK); bf16_t* TQ = (bf16_t*)(ws + OFF_TQ); bf16_t* mTQ = (bf16_t*)(ws + M_TQ);
    const float* conv_a = a.in[I_CONV_A] + (size_t)layer * 4 * 1536;
    const float* a_log = a.in[I_A_LOG] + layer * 4; const float* dt_bias = a.in[I_DT_BIAS] + layer * 4;
    const float* qn = a.in[I_Q_NORM] + layer * 128; const float* kn = a.in[I_K_NORM] + layer * 128; const float* kin = a.in[I_KIDX_NORM] + layer * 64;
    const float* cosA = (const float*)(ws + OFF_COSA); const float* sinA = (const float*)(ws + OFF_SINA); const float* cosI = (const float*)(ws + OFF_COSI); const float* sinI = (const float*)(ws + OFF_SINI);
    float* GCs = (float*)(smem + GC_OFF); float* BTs = (float*)(smem + BT_OFF); float* RED = (float*)(smem + RED_OFF);
    bf16_t* QS = (bf16_t*)(smem + QS_OFF); bf16_t* KS = (bf16_t*)(smem + KS_OFF); bf16_t* RV = (bf16_t*)(smem + RAW_OFF + 2 * 67 * 256);
    for (int item = blockIdx.x; item < 1028; item += gridDim.x) {
        int tid_ = threadIdx.x; asm volatile("" : "+v"(tid_));
        const int tid = tid_, lane = tid & 63, wid = __builtin_amdgcn_readfirstlane(tid >> 6);
        const bool is_meta = item >= 1024; const int b = item >> 5, c = item & 31, row0 = b * 2048 + 64 * c;
        const int h_lo = is_meta ? item - 1024 : 0, h_hi = is_meta ? h_lo + 1 : 4;
        { float g = 0.f, be = 0.f; const int t = tid >> 2, h = tid & 3;
          if (tid < 256 && (!is_meta || t >= 48)) { const float* mpp = is_meta ? (const float*)(ws + M_MISC) + (t - 48) * 16 : (const float*)(ws + OFF_MISC) + (size_t)(row0 + t) * 16;
              g = -__expf(a_log[h]) * softplus_f(mpp[h] + dt_bias[h]); be = SIG_BETA(mpp[4 + h]); }
          float s = g;
#pragma unroll
          for (int o = 4; o < 64; o <<= 1) { const float v = __shfl_up(s, o); if (lane >= o) s += v; }
          if (tid < 256 && lane >= 60) RED[wid * 4 + (lane & 3)] = s;
          __syncthreads();
          if (tid < 256) { for (int w = 0; w < wid; ++w) s += RED[w * 4 + h]; GCs[tid] = s; BTs[tid] = be; } }
        __syncthreads();
        if (do_store && tid < 256 && item <= 1024) { float* gd = is_meta ? (float*)(ws + M_GC) : (float*)(ws + OFF_GC) + (size_t)row0 * 4; float* bd = is_meta ? (float*)(ws + M_BETA) : (float*)(ws + OFF_BETA) + (size_t)row0 * 4;
            gd[tid] = GCs[tid]; bd[tid] = BTs[tid]; }
        const bf16_t* zsrc = (const bf16_t*)(ws + OFF_KB) + (size_t)TPOS * 128;
#define MP_DMA(hh, plo, phi) do { int td_ = tid; asm volatile("" : "+v"(td_)); _Pragma("unroll 1") for (int it = 0; it < 7; ++it) { const int p = td_ + 512 * it; \
            if (p >= (plo) && p < (phi)) { const int tensor = p / (67 * 16), rem = p - tensor * (67 * 16), rr = rem >> 4, cc = (rem & 15) * 8, tt = rr - 3, col = tensor * 512 + (hh) * 128 + cc; \
                const bf16_t* sp = zsrc; \
                if (!is_meta) { if (tt >= 0) sp = qkv + (size_t)(row0 + tt) * 1536 + col; else if (c > 0) sp = halo + ((size_t)((row0 >> 6) - 1) * 3 + (tt + 3)) * 1536 + col; \
                    else sp = mraw + (size_t)(16 + tt) * 1536 + col; } \
                else if (tt >= 48) sp = mraw + (size_t)(tt - 48) * 1536 + col; \
                __builtin_amdgcn_global_load_lds((const unsigned*)sp, (LAS unsigned*)(smem + RAW_OFF + (wid * 64 + 512 * it) * 16), 16, 0, 0); } } } while (0)
        MP_DMA(h_lo, 0, 3 * 67 * 16);
        for (int h = h_lo; h < ((skip & 8) ? h_lo : h_hi); ++h) {
            asm volatile("s_waitcnt vmcnt(0)" ::: "memory");
            __syncthreads();
            const int ch = tid & 127, part = tid >> 7;
            float y[3][16];
            if (is_meta && part < 3) {
#pragma unroll
                for (int tensor = 0; tensor < 3; ++tensor)
#pragma unroll
                    for (int i = 0; i < 16; ++i) y[tensor][i] = 0.f;
            } else
#pragma unroll
            for (int tensor = 0; tensor < 3; ++tensor) {
                const int wc = tensor * 512 + h * 128 + ch;
                const float w0 = conv_a[wc], w1 = conv_a[1536 + wc], w2 = conv_a[3072 + wc], w3 = conv_a[4608 + wc];
                const bf16_t* rp = (const bf16_t*)(smem + RAW_OFF + tensor * 67 * 256) + ch + part * 16 * 128;
                float x0 = bf2f(rp[0]), x1 = bf2f(rp[128]), x2 = bf2f(rp[256]);
#pragma unroll
                for (int i = 0; i < 16; ++i) { const float x3 = bf2f(rp[(3 + i) * 128]); float v = (skip & 32) ? x3 : silu_f(w0 * x0 + w1 * x1 + w2 * x2 + w3 * x3);
                    if (is_meta && part * 16 + i < 48) v = 0.f; y[tensor][i] = v; x0 = x1; x1 = x2; x2 = x3; }
            }
#pragma unroll
            for (int i = 0; i < 16; ++i) { const float sq = (skip & 1) ? y[0][i] : wave_sum(y[0][i] * y[0][i]), sk = (skip & 1) ? y[1][i] : wave_sum(y[1][i] * y[1][i]);
                if (lane == 0) { const int t = part * 16 + i; RED[t * 2 + (wid & 1)] = sq; RED[(64 + t) * 2 + (wid & 1)] = sk; } }
            __syncthreads();
            if (h + 1 < h_hi) MP_DMA(h + 1, 0, 2 * 67 * 16);
#pragma unroll
            for (int i = 0; i < 16; ++i) { const int t = part * 16 + i;
                const float rq = rsqrtf(RED[t * 2] + RED[t * 2 + 1] + EPSF) * 0.08838834764831845f, rk = rsqrtf(RED[(64 + t) * 2] + RED[(64 + t) * 2 + 1] + EPSF);
                QS[t * 144 + ch] = f2bf(y[0][i] * rq); KS[t * 144 + ch] = f2bf(y[1][i] * rk); RV[(t + 3) * 128 + ch] = f2bf(y[2][i]); }
            __syncthreads();
            if (!(skip & 128)) { bf16_t* dbase = is_meta ? mchunk : qkv + (size_t)row0 * 1536;
              for (int p = tid; p < 3072; p += 512) { const int tensor = p >> 10, t = (p & 1023) >> 4, cc = (p & 15) * 8;
                  const bf16_t* sp = tensor == 0 ? QS + t * 144 + cc : (tensor == 1 ? KS + t * 144 + cc : RV + (t + 3) * 128 + cc);
                  if (do_store) *(u32x4*)(dbase + (size_t)t * 1536 + tensor * 512 + h * 128 + cc) = *(const u32x4*)sp; } }
            if (!(skip & 256)) { const int r = lane & 15, g = lane >> 4, mt = wid >> 1;
              bf16_t* tqd = is_meta ? mTQ + h * 8192 : TQ + (size_t)((row0 >> 6) * 4 + h) * 8192;
              float* MT = (float*)(smem + MT_OFF) + h * 4096;
#pragma unroll
              for (int nti = 0; nti < 2; ++nti) { const int nt = 2 * (wid & 1) + nti;
                  f32x4 akk = {0.f, 0.f, 0.f, 0.f}, aqk = {0.f, 0.f, 0.f, 0.f};
#pragma unroll
                  for (int s = 0; s < 4; ++s) {
                      const bf16x8 fk = *(const bf16x8*)(KS + (16 * mt + r) * 144 + 32 * s + 8 * g);
                      const bf16x8 fq = *(const bf16x8*)(QS + (16 * mt + r) * 144 + 32 * s + 8 * g);
                      const bf16x8 fb = *(const bf16x8*)(KS + (16 * nt + r) * 144 + 32 * s + 8 * g);
                      akk = mfma16(fk, fb, akk); aqk = mfma16(fq, fb, aqk); }
                  const int j = 16 * nt + r; const float gcj = GCs[j * 4 + h];
#pragma unroll
                  for (int rr = 0; rr < 4; ++rr) { const int i = 16 * mt + 4 * g + rr; const float gci = GCs[i * 4 + h], bi = BTs[i * 4 + h];
                      const float dec = (i >= j) ? __expf(gci - gcj) : 0.f;
                      MT[i * 64 + j] = (i > j) ? bi * akk[rr] * dec : 0.f;
                      if (do_store) tqd[4096 + i * 64 + j] = f2bf((i >= j) ? aqk[rr] * dec : 0.f); } } }
            __syncthreads();
            if (h + 1 < h_hi) MP_DMA(h + 1, 2 * 67 * 16, 3 * 67 * 16);
        }
#undef MP_DMA
        if (!(skip & 2) && wid < 4 && wid >= h_lo && wid < h_hi) { const int hh = wid;
            float* MT = (float*)(smem + MT_OFF) + hh * 4096;
            const int ib = is_meta ? 48 : 0;
            if (is_meta) for (int i = 0; i < 48; ++i) MT[i * 64 + lane] = (lane == i) ? 1.f : 0.f;
            for (int i0 = ib; i0 < 64; i0 += 4) {
                float a0 = (lane == i0) ? 1.f : 0.f, a1 = (lane == i0 + 1) ? 1.f : 0.f, a2 = (lane == i0 + 2) ? 1.f : 0.f, a3 = (lane == i0 + 3) ? 1.f : 0.f;
#pragma unroll 2
                for (int j = ib; j < i0; j += 4) {
                    const f32x4 m0 = *(const f32x4*)(MT + (i0 + 0) * 64 + j), m1 = *(const f32x4*)(MT + (i0 + 1) * 64 + j), m2 = *(const f32x4*)(MT + (i0 + 2) * 64 + j), m3 = *(const f32x4*)(MT + (i0 + 3) * 64 + j);
                    const float t0 = MT[(j + 0) * 64 + lane], t1 = MT[(j + 1) * 64 + lane], t2 = MT[(j + 2) * 64 + lane], t3 = MT[(j + 3) * 64 + lane];
                    a0 -= m0[0] * t0 + m0[1] * t1 + m0[2] * t2 + m0[3] * t3; a1 -= m1[0] * t0 + m1[1] * t1 + m1[2] * t2 + m1[3] * t3;
                    a2 -= m2[0] * t0 + m2[1] * t1 + m2[2] * t2 + m2[3] * t3; a3 -= m3[0] * t0 + m3[1] * t1 + m3[2] * t2 + m3[3] * t3; }
                const f32x4 d1 = *(const f32x4*)(MT + (i0 + 1) * 64 + i0), d2 = *(const f32x4*)(MT + (i0 + 2) * 64 + i0), d3 = *(const f32x4*)(MT + (i0 + 3) * 64 + i0);
                a1 -= d1[0] * a0; a2 -= d2[0] * a0 + d2[1] * a1; a3 -= d3[0] * a0 + d3[1] * a1 + d3[2] * a2;
                MT[(i0 + 0) * 64 + lane] = a0; MT[(i0 + 1) * 64 + lane] = a1; MT[(i0 + 2) * 64 + lane] = a2; MT[(i0 + 3) * 64 + lane] = a3;
            }
            bf16_t* td = is_meta ? mTQ + hh * 8192 : TQ + (size_t)((row0 >> 6) * 4 + hh) * 8192;
            if (do_store) for (int i = 0; i < 64; ++i) td[i * 64 + lane] = f2bf(MT[i * 64 + lane]);
        }
        if (!(skip & 4) && item <= 1024 && (wid >= 4 || !is_meta)) {
            bf16_t* kb = (bf16_t*)(ws + OFF_KB); bf16_t* vb = (bf16_t*)(ws + OFF_VB); bf16_t* ikb = (bf16_t*)(ws + OFF_IKB);
            const int ntok = is_meta ? 4 : (wid >= 4 ? 12 : 4), tbase = is_meta ? (wid - 4) * 4 : (wid >= 4 ? (wid - 4) * 12 : 48 + wid * 4);
            for (int t0 = 0; t0 < ntok; t0 += 4) {
                u32x4 rq[4], ri[4], rm[4];
#pragma unroll
                for (int u = 0; u < 4; ++u) { const int tl = tbase + t0 + u; const size_t row = (size_t)row0 + tl; const int pos = is_meta ? tl : 16 + 64 * c + tl;
                    const bf16_t* qp = is_meta ? (const bf16_t*)(ws + M_BQ) + tl * 512 : (const bf16_t*)(ws + OFF_BQ) + row * 512;
                    const bf16_t* ip = is_meta ? (const bf16_t*)(ws + M_IQ) + tl * 512 : (const bf16_t*)(ws + OFF_IQ) + row * 512;
                    rq[u] = *(const u32x4*)(qp + lane * 8); ri[u] = *(const u32x4*)(ip + lane * 8);
                    const bf16_t* mp = is_meta ? (const bf16_t*)(ws + M_K) + tl * 128 + (lane & 15) * 8
                                               : (lane < 16 ? kb + ((size_t)b * TP + pos) * 128 + lane * 8 : ikb + ((size_t)b * TP + pos) * 64 + (lane & 7) * 8);
                    rm[u] = *(const u32x4*)mp; }
#pragma unroll
                for (int u = 0; u < 4; ++u) { const int tl = tbase + t0 + u; const size_t row = (size_t)row0 + tl; const int pos = is_meta ? tl : 16 + 64 * c + tl;
                    const u32x4 oq = rope8<16, true>(rq[u], lane & 15, qn, cosA + pos * 64, sinA + pos * 64);
                    const u32x4 oi = rope8<8, false>(ri[u], lane & 7, nullptr, cosI + pos * 32, sinI + pos * 32);
                    const u32x4 ok = rope8<16, true>(rm[u], lane & 15, kn, cosA + pos * 64, sinA + pos * 64);
                    const u32x4 oik = rope8<8, true>(rm[u], lane & 7, kin, cosI + pos * 32, sinI + pos * 32);
                    bf16_t* qp = is_meta ? (bf16_t*)(ws + M_BQ) + tl * 512 : (bf16_t*)(ws + OFF_BQ) + row * 512;
                    bf16_t* ip = is_meta ? (bf16_t*)(ws + M_IQ) + tl * 512 : (bf16_t*)(ws + OFF_IQ) + row * 512;
                    if (do_store) { *(u32x4*)(qp + lane * 8) = oq; *(u32x4*)(ip + lane * 8) = oi; }
                    if (!do_store) { } else if (!is_meta) { if (lane < 16) *(u32x4*)(kb + ((size_t)b * TP + pos) * 128 + lane * 8) = ok; else if (lane < 24) *(u32x4*)(ikb + ((size_t)b * TP + pos) * 64 + (lane & 7) * 8) = oik; }
                    else {
                        const u32x4 vv = *(const u32x4*)((const bf16_t*)(ws + M_V) + tl * 128 + (lane & 15) * 8);
                        if (lane < 16) for (int bb = 0; bb < NB; ++bb) { *(u32x4*)(kb + ((size_t)bb * TP + tl) * 128 + lane * 8) = ok; *(u32x4*)(vb + ((size_t)bb * TP + tl) * 128 + lane * 8) = vv; } }
                }
            }
        }
        __syncthreads();
    }
}

namespace gs { constexpr int KN_OFF = 0, KT_OFF = 17408, QN_OFF = 35840, VT_OFF = 53248, TT_OFF = 71680, QK_OFF = 80896, GC_OFF = 90112, BT_OFF = 90368, OT_OFF = 90624; }
__device__ __forceinline__ bf16x8 frag2(const char* base, int off) { return *(const bf16x8*)(base + off); }
__device__ __forceinline__ void gdn_scan_item(const Args& a, int layer, int b, int h, char* smem) {
    using namespace gs;
    unsigned char* ws = a.ws; { size_t z_ = 0; asm volatile("" : "+s"(z_)); ws += z_; }
    int tid_ = threadIdx.x; asm volatile("" : "+v"(tid_));
    const int tid = tid_, lane = tid & 63, wid = __builtin_amdgcn_readfirstlane(tid >> 6), r = lane & 15, g = lane >> 4, e0 = 16 * wid;
    const bf16_t* qkv = (const bf16_t*)(ws + OFF_QKV); const bf16_t* mchunk = (const bf16_t*)(ws + M_CHUNK);
    const bf16_t* TQ = (const bf16_t*)(ws + OFF_TQ); const bf16_t* mTQ = (const bf16_t*)(ws + M_TQ);
    const float* ng = a.in[I_A_OUT_NORM] + layer * 128;
    const float ng1 = ng[lane], ng2 = ng[lane + 64];
    f32x4 S[8];
#pragma unroll
    for (int i = 0; i < 8; ++i) S[i] = (f32x4){0.f, 0.f, 0.f, 0.f};
    u32x4 pk[2], pq[2], pv[2], pt, pqk; float psc = 0.f;
#define GS_LOAD(n) do { const int n_ = (n); \
        const bf16_t* qb_ = n_ == 0 ? mchunk : qkv + (size_t)(b * 2048 + 64 * (n_ - 1)) * 1536; \
        const bf16_t* tq_ = n_ == 0 ? mTQ + h * 8192 : TQ + (size_t)((b * 32 + n_ - 1) * 4 + h) * 8192; \
        const float* gc_ = n_ == 0 ? (const float*)(ws + M_GC) : (const float*)(ws + OFF_GC) + (size_t)(b * 2048 + 64 * (n_ - 1)) * 4; \
        const float* bt_ = n_ == 0 ? (const float*)(ws + M_BETA) : (const float*)(ws + OFF_BETA) + (size_t)(b * 2048 + 64 * (n_ - 1)) * 4; \
        _Pragma("unroll") for (int i_ = 0; i_ < 2; ++i_) { const int p_ = tid + 512 * i_, cr_ = p_ >> 4, d0_ = (p_ & 15) * 8; const bf16_t* rp_ = qb_ + (size_t)cr_ * 1536 + h * 128 + d0_; \
            pq[i_] = *(const u32x4*)rp_; pk[i_] = *(const u32x4*)(rp_ + 512); pv[i_] = *(const u32x4*)(rp_ + 1024); } \
        pt = *(const u32x4*)(tq_ + (tid >> 3) * 64 + (tid & 7) * 8); pqk = *(const u32x4*)(tq_ + 4096 + (tid >> 3) * 64 + (tid & 7) * 8); \
        if (tid < 64) psc = gc_[tid * 4 + h]; else if (tid < 128) psc = bt_[(tid - 64) * 4 + h]; } while (0)
    GS_LOAD(0);
    for (int n = 0; n < 33; ++n) {
#pragma unroll
        for (int i = 0; i < 2; ++i) { const int p = tid + 512 * i, cr = p >> 4, d0 = (p & 15) * 8;
            { const int u = (d0 >> 3) & 3, pa = (d0 & ~31) + 16 * (u & 1) + 4 * (u >> 1);
              *(u32x2*)(smem + KN_OFF + cr * 272 + pa * 2) = (u32x2){pk[i].x, pk[i].y}; *(u32x2*)(smem + KN_OFF + cr * 272 + (pa + 8) * 2) = (u32x2){pk[i].z, pk[i].w};
              *(u32x2*)(smem + QN_OFF + cr * 272 + pa * 2) = (u32x2){pq[i].x, pq[i].y}; *(u32x2*)(smem + QN_OFF + cr * 272 + (pa + 8) * 2) = (u32x2){pq[i].z, pq[i].w}; }
            const int cp = (cr & ~31) + 8 * ((cr >> 2) & 3) + 4 * ((cr >> 4) & 1) + (cr & 3);
            bf16_t* kt = (bf16_t*)(smem + KT_OFF) + d0 * 72 + cp; bf16_t* vt = (bf16_t*)(smem + VT_OFF) + d0 * 72 + cp;
            const unsigned kw[4] = {pk[i].x, pk[i].y, pk[i].z, pk[i].w}, vw[4] = {pv[i].x, pv[i].y, pv[i].z, pv[i].w};
#pragma unroll
            for (int jj = 0; jj < 4; ++jj) { kt[(2 * jj) * 72] = (bf16_t)(kw[jj] & 0xffffu); kt[(2 * jj + 1) * 72] = (bf16_t)(kw[jj] >> 16);
                vt[(2 * jj) * 72] = (bf16_t)(vw[jj] & 0xffffu); vt[(2 * jj + 1) * 72] = (bf16_t)(vw[jj] >> 16); } }
        { const int c0 = (tid & 7) * 8, u = (c0 >> 3) & 3, pa = (c0 & ~31) + 16 * (u & 1) + 4 * (u >> 1), ro = (tid >> 3) * 144;
          *(u32x2*)(smem + TT_OFF + ro + pa * 2) = (u32x2){pt.x, pt.y}; *(u32x2*)(smem + TT_OFF + ro + (pa + 8) * 2) = (u32x2){pt.z, pt.w};
          *(u32x2*)(smem + QK_OFF + ro + pa * 2) = (u32x2){pqk.x, pqk.y}; *(u32x2*)(smem + QK_OFF + ro + (pa + 8) * 2) = (u32x2){pqk.z, pqk.w}; }
        if (tid < 64) ((float*)(smem + GC_OFF))[tid] = psc; else if (tid < 128) ((float*)(smem + BT_OFF))[tid - 64] = psc;
        __syncthreads();
        if (n < 32) GS_LOAD(n + 1);
        bf16_t zz1[8], zz2[8];
#pragma unroll
        for (int i = 0; i < 8; ++i) { const int c = 8 * wid + i; const bf16_t* zp;
            if (n == 0) zp = (const bf16_t*)(ws + M_Z) + (c >= 48 ? c - 48 : 0) * 512 + h * 128;
            else zp = (const bf16_t*)(ws + OFF_Z) + ((size_t)b * 2048 + 64 * (n - 1) + c) * 512 + h * 128;
            zz1[i] = zp[lane]; zz2[i] = zp[lane + 64]; }
        const float* GC = (const float*)(smem + GC_OFF); const float* BT = (const float*)(smem + BT_OFF);
        bf16x8 Sb[4];
#pragma unroll
        for (int s = 0; s < 4; ++s) Sb[s] = as_bf8(pack8(S[2 * s], S[2 * s + 1]));
        f32x4 X[4], P[4];
#pragma unroll
        for (int mt = 0; mt < 4; ++mt) { X[mt] = (f32x4){0.f, 0.f, 0.f, 0.f}; P[mt] = (f32x4){0.f, 0.f, 0.f, 0.f};
#pragma unroll
            for (int s = 0; s < 4; ++s) { const int off = (16 * mt + r) * 272 + (32 * s + 8 * g) * 2;
                X[mt] = mfma16(frag2(smem + KN_OFF, off), Sb[s], X[mt]); P[mt] = mfma16(frag2(smem + QN_OFF, off), Sb[s], P[mt]); } }
        f32x4 Rr[4], eg[4], gcv[4];
#pragma unroll
        for (int mt = 0; mt < 4; ++mt) { const int c0 = 16 * mt + 4 * g; gcv[mt] = *(const f32x4*)(GC + c0); const f32x4 bt4 = *(const f32x4*)(BT + c0);
            const u32x2 vt = *(const u32x2*)(smem + VT_OFF + (e0 + r) * 144 + (32 * (mt >> 1) + 8 * g + 4 * (mt & 1)) * 2);
            const float vv[4] = {bflo(vt.x), bfhi(vt.x), bflo(vt.y), bfhi(vt.y)};
#pragma unroll
            for (int rr = 0; rr < 4; ++rr) { eg[mt][rr] = __expf(gcv[mt][rr]); Rr[mt][rr] = bt4[rr] * (vv[rr] - eg[mt][rr] * X[mt][rr]); } }
        bf16x8 Rb[2] = {as_bf8(pack8(Rr[0], Rr[1])), as_bf8(pack8(Rr[2], Rr[3]))};
        f32x4 Vn[4];
#pragma unroll
        for (int mt = 0; mt < 4; ++mt) { Vn[mt] = (f32x4){0.f, 0.f, 0.f, 0.f};
#pragma unroll
            for (int s = 0; s < 2; ++s) Vn[mt] = mfma16(frag2(smem + TT_OFF, (16 * mt + r) * 144 + (32 * s + 8 * g) * 2), Rb[s], Vn[mt]); }
        bf16x8 Vnb[2] = {as_bf8(pack8(Vn[0], Vn[1])), as_bf8(pack8(Vn[2], Vn[3]))};
        const float glast = GC[63];
        f32x4 O[4], Vp[4];
#pragma unroll
        for (int mt = 0; mt < 4; ++mt) {
#pragma unroll
            for (int rr = 0; rr < 4; ++rr) { O[mt][rr] = P[mt][rr] * eg[mt][rr]; Vp[mt][rr] = Vn[mt][rr] * __expf(glast - gcv[mt][rr]); }
#pragma unroll
            for (int s = 0; s < 2; ++s) O[mt] = mfma16(frag2(smem + QK_OFF, (16 * mt + r) * 144 + (32 * s + 8 * g) * 2), Vnb[s], O[mt]); }
        bf16x8 Vpb[2] = {as_bf8(pack8(Vp[0], Vp[1])), as_bf8(pack8(Vp[2], Vp[3]))};
        const float egl = __expf(glast);
#pragma unroll
        for (int dt = 0; dt < 8; ++dt) { S[dt] = S[dt] * egl;
#pragma unroll
            for (int s = 0; s < 2; ++s) S[dt] = mfma16(frag2(smem + KT_OFF, (16 * dt + r) * 144 + (32 * s + 8 * g) * 2), Vpb[s], S[dt]); }
        float* OT = (float*)(smem + OT_OFF);
#pragma unroll
        for (int mt = 0; mt < 4; ++mt)
#pragma unroll
            for (int rr = 0; rr < 4; ++rr) OT[(16 * mt + 4 * g + rr) * 132 + e0 + r] = O[mt][rr];
        __syncthreads();
#pragma unroll
        for (int i = 0; i < 8; ++i) { const int c = 8 * wid + i;
            const float o1 = OT[c * 132 + lane], o2 = OT[c * 132 + lane + 64];
            const float ss = wave_sum(o1 * o1 + o2 * o2), rstd = rsqrtf(ss * (1.f / 128.f) + EPSF);
            bf16_t* op; bool wrt;
            if (n == 0) { wrt = (b == 0 && c >= 48); op = (bf16_t*)(ws + M_OAB) + (c - 48) * 1024 + h * 128; }
            else { const size_t row = (size_t)b * 2048 + 64 * (n - 1) + c; op = (bf16_t*)(ws + OFF_OAB) + row * 1024 + h * 128; wrt = true; }
            if (wrt) { op[lane] = f2bf(o1 * rstd * ng1 * silu_f(bf2f(zz1[i]))); op[lane + 64] = f2bf(o2 * rstd * ng2 * silu_f(bf2f(zz2[i]))); } }
    }
#undef GS_LOAD
    __syncthreads();
}

#ifndef DSASEL
#define DSASEL 3
#endif
#ifndef DSA_REP
#define DSA_REP 0
#endif
namespace da {
constexpr int SC_PITCH = 2112, SC_OFF = 0, MASK_OFF = 16 * SC_PITCH * 4, IWL_OFF = MASK_OFF + 64 * 34 * 8, END_OFF = IWL_OFF + 64 * 8 * 4;
constexpr int KSEL = 272;
static_assert(END_OFF + 8 * 128 * 4 <= LDS_XB - 16, "dsa lds");
constexpr float SCALE = 0.088388347648318440f, THR = 8.f;
constexpr int SHM_V = 64 * 128 * 2, SHM_K = 64 * 128 * 2;
#define KSWZ(row, colB) ((row) * 256 + ((colB) ^ (((row) & 7) << 4)))
#define SBAR() __builtin_amdgcn_sched_barrier(0)
__device__ __forceinline__ int crow(int r, int hi) { return (r & 3) + 8 * (r >> 2) + 4 * hi; }
__device__ __forceinline__ void partialSM(f32x16& p0, f32x16& p1, float& m_reg, float& mn, float& alpha) {
  constexpr float C = SCALE * 1.4426950408889634f;
  float pmax = p0[0]; for (int r = 1; r < 16; ++r) pmax = fmaxf(pmax, p0[r]); for (int r = 0; r < 16; ++r) pmax = fmaxf(pmax, p1[r]);
  { auto rr = __builtin_amdgcn_permlane32_swap(__float_as_uint(pmax), __float_as_uint(pmax), false, false);
    pmax = fmaxf(__uint_as_float(rr[0]), __uint_as_float(rr[1])); }
  if (__builtin_expect(__all(pmax - m_reg <= THR / SCALE), 1)) { mn = m_reg; alpha = 1.f; }
  else { mn = fmaxf(m_reg, pmax); alpha = __builtin_amdgcn_exp2f((m_reg - mn) * C); m_reg = mn; }
  float mnC = -mn * C;
  for (int r = 0; r < 16; ++r) p0[r] = fmaf(p0[r], C, mnC); for (int r = 0; r < 16; ++r) p1[r] = fmaf(p1[r], C, mnC);
  for (int r = 0; r < 16; ++r) p0[r] = __builtin_amdgcn_exp2f(p0[r]);
}
__device__ __forceinline__ void finishSM(f32x16& p0, f32x16& p1, float alpha, float& l_reg, bf16x8& pa0, bf16x8& pa1, bf16x8& pa2, bf16x8& pa3) {
  for (int r = 0; r < 16; ++r) p1[r] = __builtin_amdgcn_exp2f(p1[r]);
  float ps = 0; for (int r = 0; r < 16; ++r) ps += p0[r]; for (int r = 0; r < 16; ++r) ps += p1[r];
  { auto rr = __builtin_amdgcn_permlane32_swap(__float_as_uint(ps), __float_as_uint(ps), false, false);
    ps = __uint_as_float(rr[0]) + __uint_as_float(rr[1]); }
  l_reg = l_reg * alpha + ps;
#define PK4(P, BASE, OUT) do { unsigned a0 = cvt_pk(P[BASE + 0], P[BASE + 1]), a1 = cvt_pk(P[BASE + 2], P[BASE + 3]);   \
    unsigned b0 = cvt_pk(P[BASE + 4], P[BASE + 5]), b1 = cvt_pk(P[BASE + 6], P[BASE + 7]);                              \
    auto r0 = __builtin_amdgcn_permlane32_swap(a0, b0, false, false); auto r1 = __builtin_amdgcn_permlane32_swap(a1, b1, false, false); \
    u32x4 w = {r0[0], r1[0], r0[1], r1[1]}; OUT = as_bf8(w); } while (0)
  PK4(p0, 0, pa0); PK4(p0, 8, pa1); PK4(p1, 0, pa2); PK4(p1, 8, pa3);
#undef PK4
}
__device__ __forceinline__ void qkt(f32x16& p0, f32x16& p1, const char* Ks, const bf16x8* qr, int r32, int hi) {
  p0 = f32x16{}; p1 = f32x16{};
  for (int d0 = 0; d0 < 8; ++d0) { int cb = (d0 * 16 + hi * 8) * 2;
    bf16x8 b0 = *reinterpret_cast<const bf16x8*>(Ks + KSWZ(r32, cb));
    bf16x8 b1 = *reinterpret_cast<const bf16x8*>(Ks + KSWZ(32 + r32, cb));
    p0 = __builtin_amdgcn_mfma_f32_32x32x16_bf16(b0, qr[d0], p0, 0, 0, 0);
    p1 = __builtin_amdgcn_mfma_f32_32x32x16_bf16(b1, qr[d0], p1, 0, 0, 0); }
}
__device__ __forceinline__ void maskp(f32x16& p0, f32x16& p1, const char* mrow, int tile, int hi) {
  const u32x2 mw = *(const u32x2*)(mrow + tile * 8); const unsigned w0 = mw.x >> (4 * hi), w1 = mw.y >> (4 * hi);
#pragma unroll
  for (int r = 0; r < 16; ++r) { const int bit = (r & 3) + 8 * (r >> 2);
    p0[r] = ((w0 >> bit) & 1u) ? p0[r] : -1e30f; p1[r] = ((w1 >> bit) & 1u) ? p1[r] : -1e30f; }
}
__device__ __forceinline__ int v_st(int k, int c) { const int kk = (k & ~0xC) | ((k & 4) << 1) | ((k & 8) >> 1); return ((kk >> 3) * 4 + (c >> 5)) * 512 + ((kk & 7) * 32 + (c & 31)) * 2; }
__device__ __forceinline__ int v_rd_base(int lane) { return ((lane & 3) << 3) | (((lane >> 2) & 3) << 6) | (((lane >> 4) & 1) << 5) | (((lane >> 5) & 1) << 8); }
constexpr int v_rd_off(int d0, int ks, int half) { return d0 * 512 + ks * 4096 + half * 2048; }
template <int OFF> __device__ __forceinline__ s16x4 tr_read(int vb) {
  s16x4 r; asm volatile("ds_read_b64_tr_b16 %0, %1 offset:%2" : "=&v"(r) : "v"(vb), "i"(OFF) : "memory"); return r;
}
template <int D0> __device__ __forceinline__ void pv_one(f32x16& od, int vb, bf16x8 pa0, bf16x8 pa1, bf16x8 pa2, bf16x8 pa3) {
  const s16x4 l0 = tr_read<v_rd_off(D0, 0, 0)>(vb), h0 = tr_read<v_rd_off(D0, 0, 1)>(vb), l1 = tr_read<v_rd_off(D0, 1, 0)>(vb), h1 = tr_read<v_rd_off(D0, 1, 1)>(vb);
  const s16x4 l2 = tr_read<v_rd_off(D0, 2, 0)>(vb), h2 = tr_read<v_rd_off(D0, 2, 1)>(vb), l3 = tr_read<v_rd_off(D0, 3, 0)>(vb), h3 = tr_read<v_rd_off(D0, 3, 1)>(vb);
  asm volatile("s_waitcnt lgkmcnt(0)" ::: "memory"); SBAR();
#define PK(L, H) (bf16x8){L[0], L[1], L[2], L[3], H[0], H[1], H[2], H[3]}
  od = __builtin_amdgcn_mfma_f32_32x32x16_bf16(pa0, PK(l0, h0), od, 0, 0, 0);
  od = __builtin_amdgcn_mfma_f32_32x32x16_bf16(pa1, PK(l1, h1), od, 0, 0, 0);
  od = __builtin_amdgcn_mfma_f32_32x32x16_bf16(pa2, PK(l2, h2), od, 0, 0, 0);
  od = __builtin_amdgcn_mfma_f32_32x32x16_bf16(pa3, PK(l3, h3), od, 0, 0, 0);
#undef PK
}
__device__ __forceinline__ void pv_d0(f32x16* o, int vb, bf16x8 pa0, bf16x8 pa1, bf16x8 pa2, bf16x8 pa3) {
  pv_one<0>(o[0], vb, pa0, pa1, pa2, pa3); pv_one<1>(o[1], vb, pa0, pa1, pa2, pa3); pv_one<2>(o[2], vb, pa0, pa1, pa2, pa3); pv_one<3>(o[3], vb, pa0, pa1, pa2, pa3);
}
__device__ __forceinline__ void attn_body(const bf16_t* Qb, const bf16_t* Kh, const bf16_t* Vh, bf16_t* Ob, int NT, const char* maskbase, char* lds) {
  int tid_ = threadIdx.x; asm volatile("" : "+v"(tid_));
  const int tid = tid_, wid = tid >> 6, lane = tid & 63, r32 = lane & 31, hi = lane >> 5;
  char* V_lds = lds; char* K_lds = lds + 2 * SHM_V;
  float* wsf = (float*)(lds + 2 * SHM_V + 2 * SHM_K) + wid * 64; float* li_l = wsf; float* al_l = wsf + 32;
  float m_reg = -1e30f, l_reg = 0; f32x16 o[4] = {}; bf16x8 qr[8];
  const int head = wid >> 1, qloc0 = (wid & 1) * 32;
  const char* mrow = maskbase + (qloc0 + r32) * (34 * 8);
  const bf16_t* Qw = Qb + (size_t)(qloc0 + r32) * 512 + head * 128 + hi * 8;
#pragma unroll
  for (int d0 = 0; d0 < 8; ++d0) qr[d0] = *(const bf16x8*)(Qw + d0 * 16);
  const int sr = tid >> 4, sc = (tid & 15) * 8;
  const int vb0 = (int)(uintptr_t)V_lds + v_rd_base(lane);
  struct { bf16x8 vs0, vs1, ks0, ks1; } sr_[2];
#define SLOAD(i, k0) do { sr_[i].vs0 = *(const bf16x8*)(&Vh[(long)((k0) + sr) * 128 + sc]); sr_[i].vs1 = *(const bf16x8*)(&Vh[(long)((k0) + 32 + sr) * 128 + sc]); \
    sr_[i].ks0 = *(const bf16x8*)(&Kh[(long)((k0) + sr) * 128 + sc]); sr_[i].ks1 = *(const bf16x8*)(&Kh[(long)((k0) + 32 + sr) * 128 + sc]); } while (0)
#define SWRITE(b, i) do { int t_ = tid; asm volatile("" : "+v"(t_)); const int sr_w = t_ >> 4, sc_w = (t_ & 15) * 8;     \
    *(bf16x8*)(V_lds + (b) * SHM_V + v_st(sr_w, sc_w)) = sr_[i].vs0;          \
    *(bf16x8*)(V_lds + (b) * SHM_V + v_st(32 + sr_w, sc_w)) = sr_[i].vs1; int kc = sc_w * 2;               \
    *(bf16x8*)(K_lds + (b) * SHM_K + KSWZ(sr_w, kc)) = sr_[i].ks0;                       \
    *(bf16x8*)(K_lds + (b) * SHM_K + KSWZ(32 + sr_w, kc)) = sr_[i].ks1; } while (0)
#define SWAIT() asm volatile("s_waitcnt vmcnt(4)" ::: "memory")
#define RESC(a) do { if (__any((a) < 1.f)) { if (hi == 0) al_l[r32] = (a); asm volatile("s_waitcnt lgkmcnt(0)" ::: "memory"); \
    for (int d = 0; d < 4; ++d) for (int r = 0; r < 16; ++r) o[d][r] *= al_l[crow(r, hi)]; } } while (0)
  f32x16 pA0, pA1, pB0, pB1; float mnA, mnB, alA, alB; bf16x8 pa0, pa1, pa2, pa3;
  constexpr int SE = 0, SO = 1;
  SLOAD(SE, 0); asm volatile("s_waitcnt vmcnt(0)" ::: "memory"); SWRITE(0, SE); __syncthreads();
  qkt(pA0, pA1, K_lds, qr, r32, hi); maskp(pA0, pA1, mrow, 0, hi); partialSM(pA0, pA1, m_reg, mnA, alA);
  SLOAD(SO, 64); if (2 < NT) SLOAD(SE, 2 * 64);
  SWAIT(); SWRITE(1, SO); __syncthreads();
  for (int j = 1; j + 1 < NT; j += 2) {
    SBAR(); qkt(pB0, pB1, K_lds + SHM_K, qr, r32, hi); maskp(pB0, pB1, mrow, j, hi);
    finishSM(pA0, pA1, alA, l_reg, pa0, pa1, pa2, pa3); SBAR();
    SLOAD(SO, (j + 2) * 64); SBAR();
    pv_d0(o, vb0, pa0, pa1, pa2, pa3); partialSM(pB0, pB1, m_reg, mnB, alB);
    __syncthreads(); SWAIT(); SWRITE(0, SE);
    RESC(alB); __syncthreads();
    SBAR(); qkt(pA0, pA1, K_lds, qr, r32, hi); maskp(pA0, pA1, mrow, j + 1, hi);
    finishSM(pB0, pB1, alB, l_reg, pa0, pa1, pa2, pa3); SBAR();
    if (j + 3 < NT) SLOAD(SE, (j + 3) * 64); SBAR();
    pv_d0(o, vb0 + SHM_V, pa0, pa1, pa2, pa3); partialSM(pA0, pA1, m_reg, mnA, alA);
    __syncthreads(); SWAIT(); SWRITE(1, SO);
    RESC(alA); __syncthreads();
  }
  SBAR(); qkt(pB0, pB1, K_lds + SHM_K, qr, r32, hi); maskp(pB0, pB1, mrow, NT - 1, hi);
  finishSM(pA0, pA1, alA, l_reg, pa0, pa1, pa2, pa3); SBAR();
  pv_d0(o, vb0, pa0, pa1, pa2, pa3); partialSM(pB0, pB1, m_reg, mnB, alB);
  __syncthreads(); RESC(alB);
  finishSM(pB0, pB1, alB, l_reg, pa0, pa1, pa2, pa3); SBAR();
  pv_d0(o, vb0 + SHM_V, pa0, pa1, pa2, pa3);
  if (hi == 0) li_l[r32] = l_reg; asm volatile("s_waitcnt lgkmcnt(0)" ::: "memory");
  float rli[16];
#pragma unroll
  for (int r = 0; r < 16; ++r) rli[r] = __builtin_amdgcn_rcpf(li_l[crow(r, hi)]);
#pragma unroll
  for (int r = 0; r < 16; ++r) { bf16_t* orow = Ob + (size_t)(qloc0 + crow(r, hi)) * 1024 + head * 128 + r32;
#pragma unroll
    for (int d0 = 0; d0 < 4; ++d0) orow[d0 * 32] = f2bf(o[d0][r] * rli[r]); }
  asm volatile("s_waitcnt vmcnt(0)" ::: "memory");
#undef SLOAD
#undef SWRITE
#undef SWAIT
#undef RESC
}
__device__ __forceinline__ int wave_total(int x) {
    x += __builtin_amdgcn_update_dpp(0, x, 0x128, 0xf, 0xf, false);
    x += __builtin_amdgcn_update_dpp(0, x, 0x124, 0xf, 0xf, false);
    x += __builtin_amdgcn_update_dpp(0, x, 0x122, 0xf, 0xf, false);
    x += __builtin_amdgcn_update_dpp(0, x, 0x121, 0xf, 0xf, false);
    return __builtin_amdgcn_readlane(x, 0) + __builtin_amdgcn_readlane(x, 16) + __builtin_amdgcn_readlane(x, 32) + __builtin_amdgcn_readlane(x, 48);
}
__device__ __forceinline__ unsigned ordkey(float x) { const unsigned b = __float_as_uint(x); return (b & 0x80000000u) ? ~b : (b | 0x80000000u); }
typedef unsigned short us2_t __attribute__((ext_vector_type(2)));
template <int NTW> __device__ __forceinline__ void select2_t(const float* scA, const float* scB, unsigned long long* mrowA, unsigned long long* mrowB, int NT, int NTe, int lane, unsigned* cand) {
    constexpr int NP2 = (NTW + 1) / 2;
    unsigned ua[NTW], ub[NTW];
#pragma unroll
    for (int i = 0; i < NTW; ++i) { ua[i] = (i < NT) ? ordkey(scA[64 * i + lane]) : 0u; ub[i] = (i < NT) ? ordkey(scB[64 * i + lane]) : 0u; }
    unsigned pa[NP2], pb[NP2];
#pragma unroll
    for (int p = 0; p < NP2; ++p) { const unsigned a0 = ua[2 * p] >> 17, a1 = (2 * p + 1 < NTW) ? (ua[2 * p + 1 < NTW ? 2 * p + 1 : 0] >> 17) : 0u, b0 = ub[2 * p] >> 17, b1 = (2 * p + 1 < NTW) ? (ub[2 * p + 1 < NTW ? 2 * p + 1 : 0] >> 17) : 0u;
        pa[p] = (a0 | 0x8000u) | ((a1 | 0x8000u) << 16); pb[p] = (b0 | 0x8000u) | ((b1 | 0x8000u) << 16); }
    unsigned ta = 0u, tb = 0u; int gea = 64 * NTW, geb = 64 * NTW;
#pragma unroll 1
    for (int bit = 14; bit >= 0; --bit) { const unsigned ca = ta | (1u << bit), cb = tb | (1u << bit); const unsigned ca2 = ca | (ca << 16), cb2 = cb | (cb << 16);
        unsigned sa = 0u, sb = 0u; int na = 0, nb = 0;
#pragma unroll
        for (int p = 0; p < NP2; ++p) {
            const unsigned da = __builtin_bit_cast(unsigned, __builtin_bit_cast(us2_t, pa[p]) - __builtin_bit_cast(us2_t, ca2)), db = __builtin_bit_cast(unsigned, __builtin_bit_cast(us2_t, pb[p]) - __builtin_bit_cast(us2_t, cb2));
            sa = (sa >> 1) | (da & 0x80008000u); sb = (sb >> 1) | (db & 0x80008000u);
            if ((p & 15) == 15) { na += __popc(sa); nb += __popc(sb); sa = 0u; sb = 0u; } }
        na = wave_total(na + __popc(sa)); nb = wave_total(nb + __popc(sb));
        if (na >= KSEL) { ta = ca; gea = na; } if (nb >= KSEL) { tb = cb; geb = nb; } }
#pragma unroll 1
    for (int q = 0; q < 2; ++q) {
        unsigned long long* mrow = q ? mrowB : mrowA; const unsigned t15 = q ? tb : ta;
        unsigned u[NTW];
#pragma unroll
        for (int i = 0; i < NTW; ++i) u[i] = q ? ub[i] : ua[i];
        int ncand = 0;
#pragma unroll
        for (int i = 0; i < NTW; ++i) { const unsigned long long mc = __ballot((u[i] >> 17) == t15);
            if (mc) { const int idx = ncand + (int)__builtin_amdgcn_mbcnt_hi((unsigned)(mc >> 32), __builtin_amdgcn_mbcnt_lo((unsigned)mc, 0u));
                if (((u[i] >> 17) == t15) && idx < 128) cand[idx] = (u[i] & 0x1FFFFu) + 1u; }
            ncand += __popcll(mc); }
        const int ngt = (q ? geb : gea) - ncand;
        const int kk = KSEL - ngt;
        unsigned t;
#ifndef CAND_CAP
#define CAND_CAP 128
#endif
        if (ncand <= CAND_CAP) {
            asm volatile("s_waitcnt lgkmcnt(0)" ::: "memory");
            const unsigned c0 = lane < ncand ? cand[lane] : 0u, c1 = lane + 64 < ncand ? cand[lane + 64] : 0u;
            unsigned tl = 0u;
            for (int bit = 17; bit >= 0; --bit) { const unsigned cc = tl | (1u << bit); const int n = __popcll(__ballot(c0 >= cc)) + __popcll(__ballot(c1 >= cc)); if (n >= kk) tl = cc; }
            t = (t15 << 17) | (tl - 1u);
        } else {
            int tt = (int)(t15 << 16);
            for (int bit = 15; bit >= 0; --bit) { const int cc = tt | (1 << bit); int n = 0;
#pragma unroll
                for (int i = 0; i < NTW; ++i) n += __popcll(__ballot((int)(u[i] >> 1) >= cc));
                if (n >= KSEL) tt = cc; }
            t = ((unsigned)tt << 1) | 1u; int n1 = 0;
#pragma unroll
            for (int i = 0; i < NTW; ++i) n1 += __popcll(__ballot(u[i] >= t));
            if (n1 < KSEL) t -= 1u;
        }
        int tot = 0;
#pragma unroll
        for (int i = 0; i < NTW; ++i) { const unsigned long long w = __ballot(u[i] >= t); tot += __popcll(w); if (i < NT && lane == 0) mrow[i] = w; }
        if (tot > KSEL) {
            int need = KSEL;
#pragma unroll
            for (int i = 0; i < NTW; ++i) need -= __popcll(__ballot(u[i] > t));
#pragma unroll
            for (int i = 0; i < NTW; ++i) {
                unsigned long long w = __ballot(u[i] > t); unsigned long long e = __ballot(u[i] == t);
                if (need > 0 && e) { const int pe = __popcll(e); if (pe <= need) { w |= e; need -= pe; } else { while (need > 0) { const unsigned long long low = e & (~e + 1ull); w |= low; e ^= low; --need; } } }
                if (i < NT && lane == 0) mrow[i] = w; } }
        if (NTe > NT && lane == 0) mrow[NT] = 0ull;
    }
}
__device__ __forceinline__ void select2(const float* scA, const float* scB, unsigned long long* mrowA, unsigned long long* mrowB, int NT, int NTe, int NP, int lane, unsigned* cand) {
    if (NP <= KSEL) {
        for (int i = 0; i < NTe; ++i) { const int lo = 64 * i; const unsigned long long w = (lo + 64 <= NP) ? ~0ull : (lo >= NP ? 0ull : ((1ull << (NP - lo)) - 1ull)); if (lane == 0) { mrowA[i] = w; mrowB[i] = w; } }
        return;
    }
    if (NT <= 9) select2_t<9>(scA, scB, mrowA, mrowB, NT, NTe, lane, cand);
    else if (NT <= 17) select2_t<17>(scA, scB, mrowA, mrowB, NT, NTe, lane, cand);
    else if (NT <= 25) select2_t<25>(scA, scB, mrowA, mrowB, NT, NTe, lane, cand);
    else select2_t<33>(scA, scB, mrowA, mrowB, NT, NTe, lane, cand);
}
__device__ __forceinline__ void dsa_item(const Args& a, int b, int j, char* smem, int dry = 0) {
    unsigned char* ws = a.ws; { size_t z_ = 0; asm volatile("" : "+s"(z_)); ws += z_; }
    int tid_ = threadIdx.x; asm volatile("" : "+v"(tid_));
    const int tid = tid_, lane = tid & 63, wid = __builtin_amdgcn_readfirstlane(tid >> 6), hi = lane >> 5;
    const int limit = 64 * (j + 1), NP = 16 + limit, NT = j + 2, NTe = (NT + 1) & ~1, row0 = b * 2048 + 64 * j;
    const bf16_t* iq = (const bf16_t*)(ws + OFF_IQ); const bf16_t* ikb = (const bf16_t*)(ws + OFF_IKB); const float* misc = (const float*)(ws + OFF_MISC);
    float* SC = (float*)(smem + SC_OFF); float* IWL = (float*)(smem + IWL_OFF); unsigned long long* MASK = (unsigned long long*)(smem + MASK_OFF);
    { const int q = tid >> 3, hh = tid & 7; IWL[tid] = misc[(size_t)(row0 + q) * 16 + 8 + hh] * 0.044194173824159216f; }
    bf16x8 af[4][4];
#define DSA_AF_LOAD(sb) do { const int rho = lane & 31, qq = 2 * ((rho >> 2) & 1) + (rho >> 4), hh = 4 * ((rho >> 3) & 1) + (rho & 3); \
        _Pragma("unroll") for (int mt = 0; mt < 4; ++mt) _Pragma("unroll") for (int ks = 0; ks < 4; ++ks) \
            af[mt][ks] = *(const bf16x8*)(iq + (size_t)(row0 + (sb) * 16 + 4 * mt + qq) * 512 + hh * 64 + 16 * ks + 8 * hi); } while (0)
    DSA_AF_LOAD(0);
    if ((DSASEL & 1) && !(dry & 1)) for (int sub = 0; sub < 4; ++sub) {
        for (int p = tid; p < 16 * 16; p += 512) SC[(p >> 4) * SC_PITCH + (p & 15)] = __builtin_inff();
        for (int p = tid; p < 16 * 48; p += 512) { const int q = p / 48, x = p - q * 48; SC[q * SC_PITCH + NP + x] = -__builtin_inff(); }
        __syncthreads();
        for (int rep_i = 0; rep_i < 1 + (DSA_REP & 1); ++rep_i) {
        const bf16_t* ikp = ikb + ((size_t)b * TP + 16 + (lane & 31)) * 64 + 8 * hi;
        bf16x8 bnx[4];
        { const int kt0 = wid < 2 * (j + 1) ? wid : 0;
#pragma unroll
          for (int ks = 0; ks < 4; ++ks) bnx[ks] = *(const bf16x8*)(ikp + (size_t)(32 * kt0) * 64 + 16 * ks); }
        for (int kt = wid; kt < 2 * (j + 1); kt += 8) {
            bf16x8 bfr[4];
#pragma unroll
            for (int ks = 0; ks < 4; ++ks) bfr[ks] = bnx[ks];
            { const int ktn = (kt + 8 < 2 * (j + 1)) ? kt + 8 : kt;
#pragma unroll
              for (int ks = 0; ks < 4; ++ks) bnx[ks] = *(const bf16x8*)(ikp + (size_t)(32 * ktn) * 64 + 16 * ks); }
#pragma unroll
            for (int mt = 0; mt < 4; ++mt) {
                f32x16 acc = {};
#pragma unroll
                for (int ks = 0; ks < 4; ++ks) acc = __builtin_amdgcn_mfma_f32_32x32x16_bf16(af[mt][ks], bfr[ks], acc, 0, 0, 0);
                const float* iw0 = IWL + (sub * 16 + 4 * mt + 2 * hi) * 8;
                float s0 = 0.f, s1 = 0.f;
#pragma unroll
                for (int rg = 0; rg < 8; ++rg) { s0 += fmaxf(acc[rg], 0.f) * iw0[rg]; s1 += fmaxf(acc[8 + rg], 0.f) * iw0[8 + rg]; }
                if (s0 == 0.f) s0 = 0.f; if (s1 == 0.f) s1 = 0.f;
                float* sp = SC + (4 * mt + 2 * hi) * SC_PITCH + 16 + 32 * kt + (lane & 31);
                sp[0] = s0; sp[SC_PITCH] = s1;
            }
        }
        }
        if (sub < 3) DSA_AF_LOAD(sub + 1);
        __syncthreads();
#pragma unroll 1
        for (int rep_s = 0; rep_s < 1 + ((DSA_REP >> 1) & 1); ++rep_s)
        { const int ql = 2 * wid; select2(SC + ql * SC_PITCH, SC + (ql + 1) * SC_PITCH, MASK + (sub * 16 + ql) * 34, MASK + (sub * 16 + ql + 1) * 34, NT, NTe, NP, lane, (unsigned*)(smem + END_OFF) + wid * 128); }
        __syncthreads();
    }
#pragma unroll 1
    for (int rep_a = 0; rep_a < 1 + ((DSA_REP >> 2) & 1); ++rep_a)
    if ((DSASEL & 2) && !(dry & 2)) attn_body((const bf16_t*)(ws + OFF_BQ) + (size_t)row0 * 512, (const bf16_t*)(ws + OFF_KB) + (size_t)b * TP * 128, (const bf16_t*)(ws + OFF_VB) + (size_t)b * TP * 128,
              (bf16_t*)(ws + OFF_OAB) + (size_t)row0 * 1024 + 512, NTe, smem + MASK_OFF, smem);
    __syncthreads();
}
__device__ __forceinline__ void dsa_meta_item(const Args& a) {
    unsigned char* ws = a.ws; { size_t z_ = 0; asm volatile("" : "+s"(z_)); ws += z_; }
    int tid_ = threadIdx.x; asm volatile("" : "+v"(tid_));
    if (tid_ >= 64) return;
    const int lane = tid_, q = lane >> 2, h = lane & 3;
    const bf16_t* qp = (const bf16_t*)(ws + M_BQ) + q * 512 + h * 128; const bf16_t* kb = (const bf16_t*)(ws + OFF_KB); const bf16_t* vb = (const bf16_t*)(ws + OFF_VB);
    float s[16]; float mx = -1e30f;
#pragma unroll
    for (int k = 0; k < 16; ++k) { float acc = 0.f; for (int d = 0; d < 128; ++d) acc += bf2f(qp[d]) * bf2f(kb[k * 128 + d]); s[k] = acc * SCALE; mx = fmaxf(mx, s[k]); }
    float l = 0.f;
#pragma unroll
    for (int k = 0; k < 16; ++k) { s[k] = __expf(s[k] - mx); l += s[k]; }
    const float rl = 1.f / l;
    bf16_t* op = (bf16_t*)(ws + M_OAB) + q * 1024 + 512 + h * 128;
    for (int d = 0; d < 128; ++d) { float acc = 0.f;
#pragma unroll
        for (int k = 0; k < 16; ++k) acc += s[k] * bf2f(vb[k * 128 + d]); op[d] = f2bf(acc * rl); }
}
}

__device__ __forceinline__ void p_mixers(const Args& a, int layer_rep, char* smem, int dry = 0) {
    const int layer = layer_rep & 1;
    unsigned* ctr = (unsigned*)(a.ws + OFF_CTL) + CW_QUEUE + 64 * layer_rep;
    int* slot = (int*)(smem + LDS_XB - 16);
    constexpr int NSCAN = NB * 4, NDSA = NB * 32, NITEM = NSCAN + NDSA + 1;
    for (;;) {
        __syncthreads();
        if (threadIdx.x == 0) *slot = (int)__hip_atomic_fetch_add(ctr, 1u, __ATOMIC_RELAXED, __HIP_MEMORY_SCOPE_AGENT);
        __syncthreads();
        const int it = *slot;
        if (it >= NITEM) break;
#ifndef MIXSEL
#define MIXSEL 7
#endif
        if (it == 0) { if ((MIXSEL & 4) && !dry) da::dsa_meta_item(a); }
        else if (it <= NSCAN) { const int si = it - 1; for (int rep_g = 0; rep_g < 1 + ((DSA_REP >> 3) & 1); ++rep_g) if ((MIXSEL & 1) && !(dry & 4)) gdn_scan_item(a, layer, si >> 2, si & 3, smem); }
        else { const int k = it - 1 - NSCAN, j = 31 - (k >> 5), b = k & 31; if (MIXSEL & 2) da::dsa_item(a, b, j, smem, dry); }
    }
}

__device__ __forceinline__ void p_halo(const Args& a, int layer) {
    unsigned char* ws = a.ws; { size_t z_ = 0; asm volatile("" : "+s"(z_)); ws += z_; }
    int tid_ = threadIdx.x; asm volatile("" : "+v"(tid_));
    const int lane = tid_ & 63, wid = tid_ >> 6, r = lane & 15, g = lane >> 4, gw = blockIdx.x * 8 + wid, nW = gridDim.x * 8;
    const bf16_t* hb = (const bf16_t*)(ws + OFF_HB); const bf16_t* WupT = (const bf16_t*)(ws + OFF_WUP) + (size_t)layer * NIN * DM;
    const u64_t* ssq = (const u64_t*)(ws + OFF_SSQ) + (size_t)(2 * layer + 1) * RR; float* hg = (float*)(ws + OFF_HG);
    for (int job = gw; job < 32 * 176; job += nW) {
        const int rt = job & 31, ct = job >> 5;
        const int rowA = ((r >> 1) == 0) ? 0 : 256 * (8 * rt + (r >> 1)) - 2 + (r & 1);
        const bf16_t* ap = hb + (size_t)rowA * DM + g * 8; const bf16_t* bp = WupT + (size_t)(256 * (ct >> 3) + 16 * (ct & 7) + r) * DM + g * 8;
        f32x4 acc = {0.f, 0.f, 0.f, 0.f};
#pragma unroll 8
        for (int k = 0; k < DM; k += 32) acc = mfma16(*(const bf16x8*)(ap + k), *(const bf16x8*)(bp + k), acc);
#pragma unroll
        for (int rr = 0; rr < 4; ++rr) { const int ri = 4 * g + rr;
            if ((ri >> 1) != 0) { const int pmD = 8 * rt + (ri >> 1), rowD = 256 * pmD - 2 + (ri & 1);
                hg[(size_t)(pmD * 2 + (ri & 1)) * DFF + 128 * (ct >> 3) + 16 * (ct & 7) + r] = acc[rr] * rstd_of(ssq, rowD); } }
    }
}
__device__ __forceinline__ void meta_act(const Args& a, int layer) {
    unsigned char* ws = a.ws; { size_t z_ = 0; asm volatile("" : "+s"(z_)); ws += z_; }
    int tid_ = threadIdx.x; asm volatile("" : "+v"(tid_));
    const float* cw = a.in[I_CONV_FFN] + (size_t)layer * 3 * DFF; const float* mgu = (const float*)(ws + M_GU); bf16_t* mact = (bf16_t*)(ws + M_ACT);
    for (int c = blockIdx.x * 512 + tid_; c < DFF; c += gridDim.x * 512) { const int gi = (c >> 7) * 256 + (c & 127); const float w0 = cw[c], w1 = cw[DFF + c], w2 = cw[2 * DFF + c]; float g0 = 0.f, g1 = 0.f;
        for (int t = 0; t < 16; ++t) { const float g2 = mgu[t * 5632 + gi], uu = mgu[t * 5632 + gi + 128]; mact[t * DFF + c] = f2bf(silu_f(w0 * g0 + w1 * g1 + w2 * g2) * uu); g0 = g1; g1 = g2; } }
}

constexpr int NPH = 1 + 8 * NLAYER;
#ifndef ONE_LAUNCH
#define ONE_LAUNCH 0
#endif
#ifndef STAGGER_US
#define STAGGER_US 0
#endif
__device__ __forceinline__ void stagger_delay(int us) {
    if (us > 0 && (blockIdx.x & 1)) { const unsigned long long t0 = __builtin_amdgcn_s_memrealtime(); while (__builtin_amdgcn_s_memrealtime() - t0 < (unsigned long long)us * 100ull) __builtin_amdgcn_s_sleep(8); }
}
__device__ __forceinline__ void meta_y_lds(const unsigned char* ws, char* img) {
    const float* P = (const float*)(ws + M_GU);
    for (int i = threadIdx.x; i < 16 * 1024; i += 512) { const int t = i >> 10, ch = i & 1023, n = 256 * (ch >> 7) + (ch & 127);
        *(bf16_t*)(img + t * MN_PITCH + ch * 2) = f2bf(P[t * 5632 + n] + P[t * 5632 + n + 128]); }
    __syncthreads();
}
template <int L> __device__ __forceinline__ void layer_phases(const Args& a, char* smem, const XcdBarrier& bar, const int lo, const int hi) {
    constexpr int l = L;
    unsigned char* ws0 = a.ws;
    PG8_LAS unsigned char* glds = (PG8_LAS unsigned char*)smem;
    const int G = gridDim.x, bx = blockIdx.x;
#define IN(k) (lo <= (k) && (k) < hi)
#define SEAM(k) do { if (IN(k) && IN((k) + 1)) xcd_barrier(bar); } while (0)
#define OPQ_WS() unsigned char* ws = ws0; { size_t z_ = 0; asm volatile("" : "+s"(z_)); ws += z_; }
#ifndef EN_MASK
#define EN_MASK 0xFFFF
#endif
#ifndef REP_MASK
#define REP_MASK 0
#endif
#define NREP(k) (1 + ((REP_MASK >> (k)) & 1))
    constexpr int pb = 1 + 8 * l;
    for (int rep = 0; rep < NREP(0); ++rep) if (IN(pb + 0)) { OPQ_WS();
        const bf16_t* WinT = (const bf16_t*)(ws + OFF_WIN) + (size_t)l * NIN * DM;
        meta_norm_lds((const float*)(ws + M_H), smem);
        small_gemm16<true>(smem, WinT, NIN, DM, MEpiIn{ws, a.in[I_B_GATE] + l * 2048}, smem + 40960);
        __syncthreads();
        pg8::Gemm g{(const bf16_t*)(ws + OFF_HB), WinT, RR, NIN, DM}; pg8::StaticOrder S; S.init(RR, NIN, G, bx);
        EpiIn E{(bf16_t*)(ws + OFF_QKV), (bf16_t*)(ws + OFF_HALO), (bf16_t*)(ws + OFF_Z), (bf16_t*)(ws + OFF_BQ), (bf16_t*)(ws + OFF_IQ), (bf16_t*)(ws + OFF_KB), (bf16_t*)(ws + OFF_VB),
                (bf16_t*)(ws + OFF_IKB), (float*)(ws + OFF_MISC), (bf16_t*)a.out, a.in[I_B_GATE] + l * 2048, (const u64_t*)(ws + OFF_SSQ) + (size_t)(2 * l) * RR};
        stagger_delay(STAGGER_US);
        pg8::gemm_phase<EpiIn, pg8::StaticOrder>(glds, g, S, E, nullptr);
#if defined(PROBE_DUP_IN)
        pg8::gemm_phase<EpiIn, pg8::StaticOrder>(glds, g, S, E, nullptr);
#endif
    }
    SEAM(pb + 0);
#if defined(PROBE_DRY_PREP)
    if (IN(pb + 1)) p_mixprep(a, l, smem, a.ph_hi == 12345, PROBE_DRY_PREP);
#endif
    if (IN(pb + 1)) p_mixprep(a, l, smem, true);
    SEAM(pb + 1);
#if defined(PROBE_DRYMIX)
    if (IN(pb + 2)) p_mixers(a, l + 2, smem, PROBE_DRYMIX);
#endif
    for (int rep = 0; rep < NREP(2); ++rep) if (IN(pb + 2)) p_mixers(a, l + 2 * rep, smem);
    SEAM(pb + 2);
    for (int rep = 0; rep < NREP(3); ++rep) if (IN(pb + 3)) { OPQ_WS();
        const bf16_t* WbrT = (const bf16_t*)(ws + OFF_WBR) + (size_t)l * 2048 * DM;
        small_gemm16<false>((const bf16_t*)(ws + M_OAB), WbrT, 2048, DM, MEpiBr{ws, DBG_NO_GDN ? 0.f : 1.f, DBG_NO_DSA ? 0.f : 1.f}, smem + 40960);
        pg8::Gemm g{(const bf16_t*)(ws + OFF_OAB), WbrT, RR, 2048, DM}; pg8::StaticOrder S; S.init(RR, 2048, G, bx);
        EpiBr E{(bf16_t*)(ws + OFF_Y), (const bf16_t*)a.out, DBG_NO_GDN ? 0.f : 1.f, DBG_NO_DSA ? 0.f : 1.f};
        pg8::gemm_phase<EpiBr, pg8::StaticOrder>(glds, g, S, E, nullptr);
    }
    SEAM(pb + 3);
    for (int rep = 0; rep < NREP(4); ++rep) if (IN(pb + 4)) { OPQ_WS();
        const bf16_t* WoutT = (const bf16_t*)(ws + OFF_WOUT) + (size_t)l * DM * DM;
        meta_y_lds(ws, smem);
        small_gemm16<true>(smem, WoutT, DM, DM, MEpiResid{(float*)(ws + M_H), (DBG_NO_MIX || rep) ? 0.f : 1.f}, smem + 40960);
        __syncthreads();
        pg8::Gemm g{(const bf16_t*)(ws + OFF_Y), WoutT, RR, DM, DM}; pg8::StaticOrder S; S.init(RR, DM, G, bx);
        EpiResidB E{(bf16_t*)(ws + OFF_HB), rep ? nullptr : (u64_t*)(ws + OFF_SSQ) + (size_t)(2 * l + 1) * RR, (DBG_NO_MIX || rep) ? 0.f : 1.f};
        pg8::gemm_phase<EpiResidB, pg8::StaticOrder>(glds, g, S, E, nullptr);
    }
    SEAM(pb + 4);
    if (IN(pb + 5)) { OPQ_WS();
        const bf16_t* WupT = (const bf16_t*)(ws + OFF_WUP) + (size_t)l * NIN * DM;
        meta_norm_lds((const float*)(ws + M_H), smem);
        small_gemm16<true>(smem, WupT, NIN, DM, MEpiUp{(float*)(ws + M_GU)}, smem + 40960);
        p_halo(a, l);
    }
    SEAM(pb + 5);
    for (int rep = 0; rep < NREP(6); ++rep) if (IN(pb + 6)) { OPQ_WS();
        const bf16_t* WupT = (const bf16_t*)(ws + OFF_WUP) + (size_t)l * NIN * DM;
        if constexpr (L + 1 < NLAYER) meta_act(a, l);
        pg8::Gemm g{(const bf16_t*)(ws + OFF_HB), WupT, RR, NIN, DM}; pg8::StaticOrder S; S.init(RR, NIN, G, bx);
        EpiUpConv E{(bf16_t*)(ws + OFF_ACT), (const u64_t*)(ws + OFF_SSQ) + (size_t)(2 * l + 1) * RR, a.in[I_CONV_FFN] + (size_t)l * 3 * DFF, (const float*)(ws + OFF_HG), (const float*)(ws + M_GU), smem + 131072, a.ph_hi};
        pg8::gemm_phase<EpiUpConv, pg8::StaticOrder>(glds, g, S, E, nullptr);
#if defined(PROBE_UPMODE)
        { EpiUpConvT<PROBE_UPMODE> E2{(bf16_t*)(ws + OFF_ACT), (const u64_t*)(ws + OFF_SSQ) + (size_t)(2 * l + 1) * RR, a.in[I_CONV_FFN] + (size_t)l * 3 * DFF, (const float*)(ws + OFF_HG), (const float*)(ws + M_GU), smem + 131072, a.ph_hi};
          pg8::gemm_phase<EpiUpConvT<PROBE_UPMODE>, pg8::StaticOrder>(glds, g, S, E2, nullptr); }
#endif
#if defined(PROBE_NULLM)
        { EpiNull EN; pg8::Gemm g2{(const bf16_t*)(ws + OFF_OAB), (const bf16_t*)(ws + OFF_WUP) + (size_t)(1 - l) * NIN * DM, PROBE_NULLM, NIN, DM}; pg8::StaticOrder S2; S2.init(PROBE_NULLM, NIN, G, bx);
          pg8::gemm_phase<EpiNull, pg8::StaticOrder>(glds, g2, S2, EN, nullptr); }
#endif
    }
    SEAM(pb + 6);
    for (int rep = 0; rep < NREP(7); ++rep) if (IN(pb + 7)) { OPQ_WS();
        const bf16_t* WdnT = (const bf16_t*)(ws + OFF_WDN) + (size_t)l * DM * DFF;
        if constexpr (L + 1 < NLAYER) small_gemm16<false>((const bf16_t*)(ws + M_ACT), WdnT, DM, DFF, MEpiResid{(float*)(ws + M_H), (DBG_NO_FFN || rep) ? 0.f : 1.f}, smem + 40960);
        pg8::Gemm g{(const bf16_t*)(ws + OFF_ACT), WdnT, RR, DM, DFF}; pg8::StaticOrder S; S.init(RR, DM, G, bx);
#if defined(PROBE_NULLDOWN)
        { EpiNull EN; pg8::gemm_phase<EpiNull, pg8::StaticOrder>(glds, g, S, EN, nullptr); }
#endif
        if constexpr (L + 1 < NLAYER) {
            EpiResidB E{(bf16_t*)(ws + OFF_HB), rep ? nullptr : (u64_t*)(ws + OFF_SSQ) + (size_t)(2 * l + 2) * RR, (DBG_NO_FFN || rep) ? 0.f : 1.f};
            pg8::gemm_phase<EpiResidB, pg8::StaticOrder>(glds, g, S, E, nullptr);
        } else {
            EpiFinal E{(const bf16_t*)(ws + OFF_HB), a.out, DBG_NO_FFN ? 0.f : 1.f};
            pg8::gemm_phase<EpiFinal, pg8::StaticOrder>(glds, g, S, E, nullptr);
        }
    }
    SEAM(pb + 7);
#undef IN
#undef SEAM
#undef OPQ_WS
}
__global__ void __launch_bounds__(512, 2) fwd(Args a) {
    extern __shared__ __attribute__((aligned(16))) char smem[];
    unsigned char* ws = a.ws;
    const int lo = a.ph_lo, hi = a.ph_hi;
    const bool fused = (hi - lo) > 1;
    if (threadIdx.x == 0) *(u32x4*)(smem + LDS_XB) = (u32x4){0u, 0u, 0u, 0u};
    __syncthreads();
    XcdBarrier bar; bar.bar = (unsigned*)(ws + OFF_CTL); bar.x = 0; bar.st = (volatile LAS unsigned*)(smem + LDS_XB);
    if (fused) bar = xcd_barrier_post((unsigned*)(ws + OFF_CTL), (volatile LAS unsigned*)(smem + LDS_XB));
    for (int rep = 0; rep < 1 + ((REP_MASK >> 15) & 1); ++rep) if ((EN_MASK & 1) && lo <= 0 && 0 < hi) p_prologue(a, smem);
    if (lo <= 0 && 1 < hi) xcd_barrier(bar);
    layer_phases<0>(a, smem, bar, lo, hi);
    layer_phases<1>(a, smem, bar, lo, hi);
}


extern "C" void kernel_launch(void* const* d_in, const int* in_sizes, int n_in, void* d_out, int out_size, void* d_ws, size_t ws_size, hipStream_t stream) {
    static int grid = 0;
    if (grid == 0) {
        if (n_in != 20 || in_sizes[0] != RR * DM || out_size != RR * DM || ws_size < WS_END) {
            fprintf(stderr, "kernel_launch: shape mismatch: n_in %d in0 %d out %d ws %zu (need %zu)\n", n_in, n_in > 0 ? in_sizes[0] : -1, out_size, ws_size, (size_t)WS_END); grid = -1; return; }
        int dev = 0, cus = 0, per_cu = 0;
        if (hipGetDevice(&dev) != hipSuccess || hipDeviceGetAttribute(&cus, hipDeviceAttributeMultiprocessorCount, dev) != hipSuccess) { fprintf(stderr, "kernel_launch: device query failed\n"); grid = -1; return; }
        if (hipFuncSetAttribute((const void*)fwd, hipFuncAttributeMaxDynamicSharedMemorySize, LDS_BYTES) != hipSuccess) { fprintf(stderr, "kernel_launch: hipFuncSetAttribute failed\n"); grid = -1; return; }
        if (hipOccupancyMaxActiveBlocksPerMultiprocessor(&per_cu, (const void*)fwd, 512, LDS_BYTES) != hipSuccess || per_cu < 1)
            fprintf(stderr, "kernel_launch: note: occupancy query reports %d workgroups per CU\n", per_cu);
        (void)hipGetLastError();
        grid = cus;
    }
    if (grid < 0) return;
    if (hipMemsetAsync((char*)d_ws + OFF_CTL, 0, SZ_CTL, stream) != hipSuccess) { fprintf(stderr, "kernel_launch: memset failed\n"); return; }
    Args a{};
    for (int i = 0; i < 20; ++i) a.in[i] = (const float*)d_in[i];
    a.out = (float*)d_out; a.ws = (unsigned char*)d_ws;
#if ONE_LAUNCH
    a.ph_lo = 0; a.ph_hi = NPH;
    hipLaunchKernelGGL(fwd, dim3(grid), dim3(512), LDS_BYTES, stream, a);
#else
    for (int p = 0; p < NPH; ++p) { a.ph_lo = p; a.ph_hi = p + 1; hipLaunchKernelGGL(fwd, dim3(grid), dim3(512), LDS_BYTES, stream, a); }
#endif
    const hipError_t le = hipPeekAtLastError();
    if (le != hipSuccess) fprintf(stderr, "kernel_launch: launch failed: %s\n", hipGetErrorName(le));
}
```

```cpp
#define ONE_LAUNCH 1
#include <hip/hip_runtime.h>
#include <cstdio>
#include <cstdint>

#define LAS __attribute__((address_space(3)))
typedef unsigned short bf16_t;
typedef short bf16x8 __attribute__((ext_vector_type(8)));
typedef short s16x4 __attribute__((ext_vector_type(4)));
typedef float f32x4 __attribute__((ext_vector_type(4)));
typedef float f32x16 __attribute__((ext_vector_type(16)));
typedef unsigned u32x4 __attribute__((ext_vector_type(4)));
typedef unsigned u32x2 __attribute__((ext_vector_type(2)));

constexpr int NB = 32, SQ = 2048, RR = NB * SQ, NMETA = 16, TP = 2176, DM = 1024, TPOS = 2064;
constexpr int NIN = 5632, DFF = 2816, NLAYER = 2;
constexpr float EPSF = 1e-6f;

constexpr size_t al256(size_t x) { return (x + 255) / 256 * 256; }
constexpr size_t OFF_CTL = 0, SZ_CTL = 65536;
constexpr size_t OFF_WIN = OFF_CTL + SZ_CTL, SZ_WIN = (size_t)NLAYER * NIN * DM * 2;
constexpr size_t OFF_WBR = OFF_WIN + SZ_WIN, SZ_WBR = (size_t)NLAYER * 2048 * DM * 2;
constexpr size_t OFF_WOUT = OFF_WBR + SZ_WBR, SZ_WOUT = (size_t)NLAYER * DM * DM * 2;
constexpr size_t OFF_WUP = OFF_WOUT + SZ_WOUT, SZ_WUP = (size_t)NLAYER * NIN * DM * 2;
constexpr size_t OFF_WDN = OFF_WUP + SZ_WUP, SZ_WDN = (size_t)NLAYER * DM * DFF * 2;
constexpr size_t OFF_COSA = OFF_WDN + SZ_WDN, SZ_ROPA = (size_t)TPOS * 64 * 4;
constexpr size_t OFF_SINA = OFF_COSA + SZ_ROPA;
constexpr size_t OFF_COSI = OFF_SINA + SZ_ROPA, SZ_ROPI = (size_t)TPOS * 32 * 4;
constexpr size_t OFF_SINI = OFF_COSI + SZ_ROPI;
constexpr size_t OFF_M = al256(OFF_SINI + SZ_ROPI);
constexpr size_t M_H = OFF_M;
constexpr size_t M_RAW = M_H + 16 * 1024 * 4;
constexpr size_t M_CHUNK = M_RAW + 16 * 1536 * 2;
constexpr size_t M_Z = M_CHUNK + 64 * 1536 * 2;
constexpr size_t M_BQ = M_Z + 16 * 512 * 2;
constexpr size_t M_IQ = M_BQ + 16 * 512 * 2;
constexpr size_t M_K = M_IQ + 16 * 512 * 2;
constexpr size_t M_V = M_K + 16 * 128 * 2;
constexpr size_t M_MISC = M_V + 16 * 128 * 2;
constexpr size_t M_GATES = M_MISC + 16 * 16 * 4;
constexpr size_t M_TQ = M_GATES + 16 * 2048 * 2;
constexpr size_t M_GC = M_TQ + 4 * 2 * 4096 * 2;
constexpr size_t M_BETA = M_GC + 64 * 4 * 4;
constexpr size_t M_OAB = M_BETA + 64 * 4 * 4;
constexpr size_t M_Y = M_OAB + 16 * 1024 * 2;
constexpr size_t M_GU = M_Y + 16 * 1024 * 2;
constexpr size_t M_ACT = M_GU + 16 * 5632 * 4;
constexpr size_t M_END = M_ACT + 16 * 2816 * 2;
constexpr size_t OFF_HB = al256(M_END), SZ_HB = (size_t)RR * DM * 2;
constexpr size_t OFF_SSQ = OFF_HB + SZ_HB, SZ_SSQ = (size_t)4 * RR * 8;
constexpr size_t OFF_QKV = OFF_SSQ + SZ_SSQ, SZ_QKV = (size_t)RR * 1536 * 2;
constexpr size_t OFF_HALO = OFF_QKV + SZ_QKV, SZ_HALO = (size_t)(RR / 64) * 3 * 1536 * 2;
constexpr size_t OFF_Z = OFF_HALO + SZ_HALO, SZ_512 = (size_t)RR * 512 * 2;
constexpr size_t OFF_BQ = OFF_Z + SZ_512;
constexpr size_t OFF_IQ = OFF_BQ + SZ_512;
constexpr size_t OFF_KB = OFF_IQ + SZ_512, SZ_KB = (size_t)NB * TP * 128 * 2;
constexpr size_t OFF_VB = OFF_KB + SZ_KB;
constexpr size_t OFF_IKB = OFF_VB + SZ_KB, SZ_IKB = (size_t)NB * TP * 64 * 2;
constexpr size_t OFF_MISC = OFF_IKB + SZ_IKB, SZ_MISC = (size_t)RR * 16 * 4;
constexpr size_t OFF_GC = OFF_MISC + SZ_MISC, SZ_GC = (size_t)RR * 4 * 4;
constexpr size_t OFF_BETA = OFF_GC + SZ_GC;
constexpr size_t OFF_TQ = OFF_BETA + SZ_GC, SZ_TQ = (size_t)NB * 32 * 4 * 2 * 4096 * 2;
constexpr size_t OFF_OAB = OFF_TQ + SZ_TQ, SZ_OAB = (size_t)RR * DM * 2;
constexpr size_t OFF_HG = OFF_OAB + SZ_OAB, SZ_HG = (size_t)256 * 2 * DFF * 4;
constexpr size_t WS_END = OFF_HG + SZ_HG;
constexpr size_t OFF_Y = OFF_QKV;
constexpr size_t OFF_ACT = OFF_QKV, SZ_FF = (size_t)RR * DFF * 2;
static_assert(OFF_ACT + SZ_FF <= OFF_OAB, "ffn alias region");
static_assert(WS_END <= (size_t)1073741824, "workspace budget");
constexpr int CW_QUEUE = 4096;

constexpr int LDS_BYTES = 163840, LDS_XB = LDS_BYTES - 16;

#define AS_GLOBAL(p) ((unsigned char*)(__attribute__((address_space(1))) unsigned char*)(p))
typedef __bf16 bf16x2_t __attribute__((ext_vector_type(2)));
__device__ __forceinline__ unsigned cvt_pk(float lo, float hi) { bf16x2_t v; v[0] = (__bf16)lo; v[1] = (__bf16)hi; return __builtin_bit_cast(unsigned, v); }
__device__ __forceinline__ bf16_t f2bf(float x) { return (bf16_t)(cvt_pk(x, 0.f) & 0xffffu); }
__device__ __forceinline__ float bf2f(bf16_t b) { return __uint_as_float(((unsigned)b) << 16); }
__device__ __forceinline__ float bflo(unsigned w) { return __uint_as_float(w << 16); }
__device__ __forceinline__ float bfhi(unsigned w) { return __uint_as_float(w & 0xffff0000u); }
template <int CTRL, int RM = 0xf> __device__ __forceinline__ float dpp_mov(float v) {
    return __builtin_bit_cast(float, __builtin_amdgcn_update_dpp(0, __builtin_bit_cast(int, v), CTRL, RM, 0xf, false)); }
__device__ __forceinline__ float row_sum16(float v) {
    v += dpp_mov<0xB1>(v); v += dpp_mov<0x4E>(v); v += dpp_mov<0x141>(v); v += dpp_mov<0x140>(v); return v; }
__device__ __forceinline__ float wave_sum_hi(float v) {
    v = row_sum16(v); v += dpp_mov<0x142, 0xa>(v); v += dpp_mov<0x143, 0xc>(v); return v; }
__device__ __forceinline__ float wave_sum(float v) { return __builtin_bit_cast(float, __builtin_amdgcn_readlane(__builtin_bit_cast(int, wave_sum_hi(v)), 63)); }
__device__ __forceinline__ float half_sum(float v) {
#pragma unroll
    for (int o = 16; o; o >>= 1) v += __shfl_xor(v, o);
    return v; }
typedef unsigned long long u64_t;
constexpr float SSQ_SCALE = 1048576.f, SSQ_INV = 1.f / 1048576.f;
__device__ __forceinline__ float rstd_of(const u64_t* ssq, int row) { return rsqrtf((float)ssq[row] * (SSQ_INV / DM) + EPSF); }
#ifndef FAST_SIG
#define FAST_SIG 1
#endif
#ifndef FAST_SILU
#define FAST_SILU 1
#endif
__device__ __forceinline__ float sigmoid_f(float x) { return FAST_SIG ? __builtin_amdgcn_rcpf(1.f + __expf(-x)) : 1.f / (1.f + __expf(-x)); }
__device__ __forceinline__ float sigmoid_slow(float x) { return 1.f / (1.f + __expf(-x)); }
__device__ __forceinline__ float sigmoid_fast(float x) { return __builtin_amdgcn_rcpf(1.f + __expf(-x)); }
__device__ __forceinline__ float silu_f(float x) { return FAST_SILU ? x * __builtin_amdgcn_rcpf(1.f + __expf(-x)) : x / (1.f + __expf(-x)); }
__device__ __forceinline__ float softplus_f(float x) { return fmaxf(x, 0.f) + log1pf(__expf(-fabsf(x))); }
__device__ __forceinline__ u32x4 pack8(f32x4 a, f32x4 b) { u32x4 w; w.x = cvt_pk(a[0], a[1]); w.y = cvt_pk(a[2], a[3]); w.z = cvt_pk(b[0], b[1]); w.w = cvt_pk(b[2], b[3]); return w; }
__device__ __forceinline__ bf16x8 as_bf8(u32x4 w) { return __builtin_bit_cast(bf16x8, w); }
__device__ __forceinline__ f32x4 mfma16(bf16x8 a, bf16x8 b, f32x4 c) { return __builtin_amdgcn_mfma_f32_16x16x32_bf16(a, b, c, 0, 0, 0); }

#define XB_TMO      128
#define XB_XCNT(j)  (256  + 64 * (j))
#define XB_XSUB(j)  (1280 + 64 * (j))
#define XB_XGEN(j)  (2304 + 64 * (j))
#define XB_TOP      3328
#define XB_TOPGEN   3392
#define XCD_BAR_WORDS 3456
#define XB_SPIN_CAP (1u << 18)
__device__ __forceinline__ unsigned xb_ld(unsigned* p)              { return __hip_atomic_load(p, __ATOMIC_RELAXED, __HIP_MEMORY_SCOPE_AGENT); }
__device__ __forceinline__ unsigned xb_add(unsigned* p, unsigned v) { return __hip_atomic_fetch_add(p, v, __ATOMIC_RELAXED, __HIP_MEMORY_SCOPE_AGENT); }
__device__ __forceinline__ unsigned xb_xcc_id() { return (unsigned)__builtin_amdgcn_s_getreg((3 << 11) | 20) & 0xFu; }
#define XB_SPIN(cond, bar) do { unsigned _sp = 0; while (cond) { __builtin_amdgcn_s_sleep(1); \
    if ((++_sp & 255u) == 0u) { if (xb_ld(&(bar)[XB_TMO])) break; if (_sp > XB_SPIN_CAP) { atomicAdd(&(bar)[XB_TMO], 1u); break; } } } } while (0)
struct XcdBarrier { unsigned* bar; unsigned x; volatile LAS unsigned* st; };
__device__ __forceinline__ XcdBarrier xcd_barrier_post(unsigned* bar, volatile LAS unsigned* st) {
    XcdBarrier b; b.bar = bar; b.x = xb_xcc_id(); b.st = st;
    if (threadIdx.x == 0) (void)xb_add(&bar[XB_XCNT(b.x)], 1u);
    return b;
}
__device__ __forceinline__ void xcd_barrier_complete(unsigned* bar, unsigned x, unsigned& nloc, unsigned& nx) {
    const unsigned G = gridDim.x * gridDim.y * gridDim.z;
    unsigned sum, cnt, mine, sp = 0u;
    for (;;) {
        sum = 0u; cnt = 0u; mine = 0u;
#pragma unroll
        for (unsigned j = 0; j < 16; ++j) { const unsigned c = xb_ld(&bar[XB_XCNT(j)]); sum += c; cnt += (c > 0u) ? 1u : 0u; mine = (j == x) ? c : mine; }
        if (sum == G) break;
        __builtin_amdgcn_s_sleep(1);
        if ((++sp & 255u) == 0u) { if (xb_ld(&bar[XB_TMO])) break; if (sp > XB_SPIN_CAP) { atomicAdd(&bar[XB_TMO], 1u); break; } }
    }
    nloc = mine > 0u ? mine : 1u; nx = cnt > 0u ? cnt : 1u;
}
__device__ __forceinline__ void xcd_barrier(const XcdBarrier& b) {
    asm volatile("s_waitcnt vmcnt(0)" ::: "memory");
    __syncthreads();
    if (threadIdx.x == 0) {
        unsigned* bar = b.bar;
        __builtin_amdgcn_s_waitcnt(0);
        unsigned nloc = b.st[0], nx = b.st[1];
        if (nloc == 0u) { xcd_barrier_complete(bar, b.x, nloc, nx); b.st[0] = nloc; b.st[1] = nx; }
        const unsigned old = xb_add(&bar[XB_XSUB(b.x)], 1u);
        const unsigned gen = old / nloc;
        if (old + 1u == (gen + 1u) * nloc) {
            __builtin_amdgcn_fence(__ATOMIC_RELEASE, "agent");
            asm volatile("s_waitcnt vmcnt(0)" ::: "memory");
            const unsigned og = xb_add(&bar[XB_TOP], 1u);
            const unsigned tg = og / nx;
            if (og + 1u == (tg + 1u) * nx) xb_add(&bar[XB_TOPGEN], 1u);
            else XB_SPIN(xb_ld(&bar[XB_TOPGEN]) == tg, bar);
            __builtin_amdgcn_fence(__ATOMIC_ACQUIRE, "agent");
            xb_add(&bar[XB_XGEN(b.x)], 1u);
            asm volatile("s_waitcnt vmcnt(0)" ::: "memory");
        } else {
            XB_SPIN(xb_ld(&bar[XB_XGEN(b.x)]) == gen, bar);
            __builtin_amdgcn_fence(__ATOMIC_ACQUIRE, "agent");
            asm volatile("s_waitcnt vmcnt(0)" ::: "memory");
        }
    }
    __syncthreads();
}

namespace pg8 {
#define PG8_LAS __attribute__((address_space(3)))
typedef unsigned short bf16_t;
typedef short bf16x8 __attribute__((ext_vector_type(8)));
typedef float f32x4 __attribute__((ext_vector_type(4)));
typedef unsigned u32x4 __attribute__((ext_vector_type(4)));
constexpr int BM = 256, BK = 64, HALF = 128, HTB = HALF * BK * 2  , STAGE_BYTES = 8 * HTB, NXCD = 8, WGM = 8;

__host__ __device__ __forceinline__ int lds_byte(int r, int c) { const int st = (r >> 4) * 2 + (c >> 5), rr = r & 15, cc = c & 31, ob = rr * 64 + cc * 2; return st * 1024 + (ob ^ (((ob >> 9) & 1) << 5)); }
__host__ __device__ __forceinline__ void stage_rc(int b, int& R, int& C) { const int st = b / 1024, sb = b % 1024, swz = sb ^ (((sb >> 9) & 1) << 5); R = (st >> 1) * 16 + swz / 64; C = (st & 1) * 32 + (swz % 64) / 2; }
__host__ __device__ __forceinline__ int perm32(int rho) { const int n = rho >> 4, i = rho & 15; return 8 * (i >> 2) + 4 * n + (i & 3); }

struct Unit { int pm, pn; };
struct Gemm { const bf16_t* A; const bf16_t* Bt; int M, N, K; };

struct StaticOrder {
    int nM, nN, nwg, G, c;
    __host__ __device__ void init(int M, int N, int G_, int c_) { nM = M / BM; nN = N / BM; nwg = nM * nN; G = G_; c = c_; }
    __host__ __device__ bool next(int i, Unit& u) const {
        const long L = (long)i * G + c; if (L >= nwg) return false;
        int wgid = (int)L; { const int q = nwg / NXCD, r = nwg % NXCD, xcd = wgid % NXCD, off = wgid / NXCD; wgid = (xcd < r ? xcd * (q + 1) : r * (q + 1) + (xcd - r) * q) + off; }
        const int nig = WGM * nN, gid = wgid / nig, fm = gid * WGM, gsz = (nM - fm) < WGM ? (nM - fm) : WGM;
        u.pm = fm + ((wgid % nig) % gsz); u.pn = (wgid % nig) / gsz; return true;
    }
    __device__ __forceinline__ void a_ready(const Unit&) const {}
    __device__ __forceinline__ void done(const Unit&) const {}
};
__device__ __forceinline__ unsigned cvt_pk_bf16(float lo, float hi) { unsigned r; asm volatile("v_cvt_pk_bf16_f32 %0, %1, %2" : "=v"(r) : "v"(lo), "v"(hi)); return r; }
typedef float f32x2 __attribute__((ext_vector_type(2)));
template <class Epi, class Sched, bool STAMP = false>
__device__ __forceinline__ void gemm_phase(PG8_LAS unsigned char* lds, const Gemm g, const Sched& S, const Epi& E, unsigned long long* stamps) {
    int tid_ = threadIdx.x; asm volatile("" : "+v"(tid_));
    const int tid = tid_, wid = __builtin_amdgcn_readfirstlane(tid >> 6), lane = tid & 63, wr = wid >> 2, wc = wid & 3, fr = lane & 15, fq = lane >> 4;
    const int K = g.K, nt = K / BK;
    int ts_lo = 0, ts_hi = 0, nts = 0; const unsigned long long rt_entry = STAMP ? (unsigned long long)wall_clock64() : 0ull;
#define PG8_STAMP() do { if (STAMP && wid == 0 && nts < 64) { const unsigned long long _c = (unsigned long long)clock64(); \
        ts_lo = (lane == nts) ? (int)(unsigned)_c : ts_lo; ts_hi = (lane == nts) ? (int)(unsigned)(_c >> 32) : ts_hi; ++nts; } } while (0)
    PG8_STAMP();
    unsigned voffA[2], voffB[2];
#pragma unroll
    for (int i = 0; i < 2; ++i) { int R, C; stage_rc(tid * 16 + i * 8192, R, C); const int Rb = Epi::PERM ? ((R & ~31) + perm32(R & 31)) : R;
        const int Ra = Epi::APERM ? (8 * (16 * (R >> 6) + (R & 15)) + ((R >> 4) & 3)) : R;
        voffA[i] = (unsigned)(Ra * K + C) * 2u; voffB[i] = (unsigned)(Rb * K + C) * 2u; }
    const size_t kstep = (size_t)(BK * 2);
    const size_t hstep = (size_t)HALF * K * 2;
    const size_t tstep = 2 * hstep;
    const size_t hstepA = Epi::APERM ? (size_t)4 * K * 2 : hstep;
    const unsigned ldsw = (unsigned)wid * 1024u;
    const int aoff = lds_byte(wr * 64 + fr, fq * 8), boff = lds_byte(wc * 32 + fr, fq * 8);
#define PG8_SA(b, h) (((b) * 2 + (h)) * HTB)
#define PG8_SB(b, h) ((4 + (b) * 2 + (h)) * HTB)
#define PG8_STAGE(bufoff, gbase, voff) do { _Pragma("unroll") for (int _i = 0; _i < 2; ++_i) \
        __builtin_amdgcn_global_load_lds((const unsigned*)((const char*)(gbase) + (voff)[_i]), (PG8_LAS unsigned*)(lds + (bufoff) + ldsw + _i * 8192), 16, 0, 0); } while (0)
#define PG8_LDA(dst, b, h) do { _Pragma("unroll") for (int m = 0; m < 4; ++m) _Pragma("unroll") for (int k = 0; k < 2; ++k) dst[m][k] = *(const PG8_LAS bf16x8*)(lds + PG8_SA(b, h) + aoff + m * 2048 + k * 1024); } while (0)
#define PG8_LDB(dst, b, h) do { _Pragma("unroll") for (int n = 0; n < 2; ++n) _Pragma("unroll") for (int k = 0; k < 2; ++k) dst[n][k] = *(const PG8_LAS bf16x8*)(lds + PG8_SB(b, h) + boff + n * 2048 + k * 1024); } while (0)
#define PG8_MMA(ai, bj, At, Bt) do { __builtin_amdgcn_s_setprio(1); _Pragma("unroll") for (int m = 0; m < 4; ++m) _Pragma("unroll") for (int n = 0; n < 2; ++n) _Pragma("unroll") for (int k = 0; k < 2; ++k) \
        acc[ai][bj][m][n] = __builtin_amdgcn_mfma_f32_16x16x32_bf16(Bt[n][k], At[m][k], acc[ai][bj][m][n], 0, 0, 0); __builtin_amdgcn_s_setprio(0); } while (0)
#define PG8_WAIT_V(n) asm volatile("s_waitcnt vmcnt(" #n ")" ::: "memory")
#define PG8_WAIT_L(n) asm volatile("s_waitcnt lgkmcnt(" #n ")" ::: "memory")
#define PG8_BAR __builtin_amdgcn_s_barrier()
#define PG8_SCHED __builtin_amdgcn_sched_barrier(0)
    Unit cur, nxt; int ui = 0;
    if (!S.next(0, cur)) return;
    f32x4 acc[2][2][4][2];
#pragma unroll
    for (int a = 0; a < 2; ++a)
#pragma unroll
        for (int b = 0; b < 2; ++b)
#pragma unroll
            for (int m = 0; m < 4; ++m)
#pragma unroll
                for (int n = 0; n < 2; ++n) acc[a][b][m][n] = (f32x4){0.f, 0.f, 0.f, 0.f};
    bf16x8 At[4][2], B0[2][2], B1[2][2];
    const char* cA = (const char*)g.A + (size_t)cur.pm * tstep; const char* cB = (const char*)g.Bt + (size_t)cur.pn * tstep;
    S.a_ready(cur);
    PG8_STAGE(PG8_SB(0, 0), cB, voffB); PG8_STAGE(PG8_SA(0, 0), cA, voffA); PG8_STAGE(PG8_SB(0, 1), cB + hstep, voffB); PG8_STAGE(PG8_SA(0, 1), cA + hstepA, voffA);
    if (wr == 1) PG8_BAR;
    PG8_WAIT_V(4); PG8_BAR;
    PG8_STAGE(PG8_SB(1, 0), cB + kstep, voffB); PG8_STAGE(PG8_SA(1, 0), cA + kstep, voffA); PG8_STAGE(PG8_SB(1, 1), cB + hstep + kstep, voffB);
    PG8_WAIT_V(6); PG8_BAR;
    PG8_STAMP();
    for (;;) {
        const bool has_next = S.next(ui + 1, nxt);
        const char* nA = has_next ? (const char*)g.A + (size_t)nxt.pm * tstep : cA; const char* nB = has_next ? (const char*)g.Bt + (size_t)nxt.pn * tstep : cB;
        for (int t = 0; t < nt; t += 2) {
            const bool last = (t == nt - 2);
            const bool bd_lo = !Epi::BD || (t * BK * 2 < K), bd_hi = !Epi::BD || !(t * BK * 2 < K);
            const char* a1 = cA + (size_t)(t + 1) * kstep;
            const char* a2 = last ? nA : cA + (size_t)(t + 2) * kstep; const char* b2 = last ? nB : cB + (size_t)(t + 2) * kstep;
            const char* a3 = a2 + kstep; const char* b3 = b2 + kstep;
            if (last && has_next) S.a_ready(nxt);
            PG8_LDB(B0, 0, 0); PG8_SCHED; PG8_LDA(At, 0, 0); PG8_STAGE(PG8_SA(1, 1), a1 + hstepA, voffA);
            PG8_WAIT_L(8); PG8_BAR; PG8_WAIT_L(0); if (bd_lo) PG8_MMA(0, 0, At, B0); PG8_BAR; PG8_SCHED;
            PG8_LDB(B1, 0, 1); PG8_STAGE(PG8_SB(0, 0), b2, voffB);
            PG8_BAR; PG8_WAIT_L(0); if (bd_hi) PG8_MMA(0, 1, At, B1); PG8_BAR;
            PG8_LDA(At, 0, 1); PG8_STAGE(PG8_SA(0, 0), a2, voffA);
            PG8_BAR; PG8_WAIT_L(0); if (bd_lo) PG8_MMA(1, 0, At, B0); PG8_BAR; PG8_SCHED;
            PG8_STAGE(PG8_SB(0, 1), b2 + hstep, voffB);
            PG8_WAIT_V(6); PG8_BAR; if (bd_hi) PG8_MMA(1, 1, At, B1); PG8_BAR;
            PG8_LDB(B0, 1, 0); PG8_SCHED; PG8_LDA(At, 1, 0); PG8_STAGE(PG8_SA(0, 1), a2 + hstepA, voffA);
            PG8_WAIT_L(8); PG8_BAR; PG8_WAIT_L(0); if (bd_lo) PG8_MMA(0, 0, At, B0); PG8_BAR; PG8_SCHED;
            PG8_LDB(B1, 1, 1); PG8_STAGE(PG8_SB(1, 0), b3, voffB);
            PG8_BAR; PG8_WAIT_L(0); if (bd_hi) PG8_MMA(0, 1, At, B1); PG8_BAR;
            PG8_LDA(At, 1, 1); PG8_STAGE(PG8_SA(1, 0), a3, voffA);
            PG8_BAR; PG8_WAIT_L(0); if (bd_lo) PG8_MMA(1, 0, At, B0); PG8_BAR; PG8_SCHED;
            PG8_STAGE(PG8_SB(1, 1), b3 + hstep, voffB);
            PG8_WAIT_V(6); PG8_BAR; if (bd_hi) PG8_MMA(1, 1, At, B1); PG8_BAR;
        }
        PG8_STAMP();
        if constexpr (!Epi::AFTER_DRAIN) { E(acc, cur, wr, wc, fr, fq); S.done(cur); }
        PG8_STAMP();
        if (!has_next) break;
#pragma unroll
        for (int a = 0; a < 2; ++a)
#pragma unroll
            for (int b = 0; b < 2; ++b)
#pragma unroll
                for (int m = 0; m < 4; ++m)
#pragma unroll
                    for (int n = 0; n < 2; ++n) acc[a][b][m][n] = (f32x4){0.f, 0.f, 0.f, 0.f};
        cur = nxt; cA = nA; cB = nB; ++ui;
    }
    PG8_WAIT_V(0);
    if (wr == 0) PG8_BAR;
    PG8_BAR;
    if constexpr (Epi::AFTER_DRAIN) { E.fused(acc, cur, wr, wc, fr, fq, lds, wid, lane); S.done(cur); }
    PG8_STAMP();
    if (STAMP && wid == 0) { stamps[lane] = lane < nts ? (((unsigned long long)(unsigned)ts_hi << 32) | (unsigned)ts_lo) : 0ull;
        if (lane == 62) stamps[62] = rt_entry; if (lane == 63) stamps[63] = (unsigned long long)wall_clock64(); }
#undef PG8_STAMP
#undef PG8_SA
#undef PG8_SB
#undef PG8_STAGE
#undef PG8_LDA
#undef PG8_LDB
#undef PG8_MMA
#undef PG8_WAIT_V
#undef PG8_WAIT_L
#undef PG8_BAR
#undef PG8_SCHED
}
}

struct Args { const float* in[20]; float* out; unsigned char* ws; int ph_lo, ph_hi; };
enum { I_X = 0, I_META, I_NORM_MIX, I_W_IN, I_CONV_A, I_A_LOG, I_DT_BIAS, I_A_OUT_NORM, I_Q_NORM, I_K_NORM, I_KIDX_NORM, I_W_BA, I_W_BB, I_W_GATE, I_B_GATE, I_W_OUT, I_NORM_FFN, I_W_UP, I_CONV_FFN, I_W_DOWN };

#ifndef DBG_NO_DSA
#define DBG_NO_DSA 0
#endif
#ifndef DBG_NO_GDN
#define DBG_NO_GDN 0
#endif
#ifndef DBG_NO_MIX
#define DBG_NO_MIX 0
#endif
#ifndef DBG_NO_FFN
#define DBG_NO_FFN 0
#endif

#ifndef SIG_EPI
#define SIG_EPI sigmoid_fast
#endif
#ifndef SIG_META
#define SIG_META sigmoid_fast
#endif
#ifndef SIG_BETA
#define SIG_BETA sigmoid_fast
#endif
#ifndef GATE_ROT
#define GATE_ROT 0
#endif
#define GATE_COL(row, col) (GATE_ROT ? (((col) + 128 * ((row) & 15)) & 2047) : (col))
#ifndef NT_STORE
#define NT_STORE 0
#endif
#define ST16(ptr, val) do { if (NT_STORE) __builtin_nontemporal_store((val), (u32x4*)(ptr)); else *(u32x4*)(ptr) = (val); } while (0)
struct PanelOrder : pg8::StaticOrder {
    __host__ __device__ bool next(int i, pg8::Unit& u) const { if (i >= nN || c >= nM) return false; u.pm = c; u.pn = i; return true; }
};
using pg8::Unit;
struct EpiIn {
    static constexpr bool PERM = true, AFTER_DRAIN = false, APERM = false, BD = false;
    bf16_t *qkv, *halo, *z, *bq, *iq, *kb, *vb, *ikb; float* misc; bf16_t* gates; const float* bgate; const u64_t* ssq;
    __device__ __forceinline__ void operator()(const f32x4 (&acc)[2][2][4][2], const Unit& u, int wr, int wc, int fr, int fq) const {
        const int pn = u.pn, row0 = u.pm * 256 + wr * 64 + fr, cl = wc * 32 + 8 * fq;
        float rs[2][4];
        { u64_t sv[2][4];
#pragma unroll
          for (int ai = 0; ai < 2; ++ai)
#pragma unroll
              for (int m = 0; m < 4; ++m) sv[ai][m] = ssq[row0 + ai * 128 + m * 16];
#pragma unroll
          for (int ai = 0; ai < 2; ++ai)
#pragma unroll
              for (int m = 0; m < 4; ++m) rs[ai][m] = rsqrtf((float)sv[ai][m] * (SSQ_INV / DM) + EPSF); }
        if (pn < 12) {
            bf16_t* base; int ld, cb;
            if (pn < 6) { base = qkv; ld = 1536; cb = pn * 256; } else if (pn < 8) { base = z; ld = 512; cb = (pn - 6) * 256; }
            else if (pn < 10) { base = bq; ld = 512; cb = (pn - 8) * 256; } else { base = iq; ld = 512; cb = (pn - 10) * 256; }
#pragma unroll
            for (int ai = 0; ai < 2; ++ai)
#pragma unroll
                for (int m = 0; m < 4; ++m) {
                    const int row = row0 + ai * 128 + m * 16; const float r = rs[ai][m];
                    bf16_t* p = base + (size_t)row * ld + cb + cl;
                    const u32x4 w0 = pack8(acc[ai][0][m][0] * r, acc[ai][0][m][1] * r), w1 = pack8(acc[ai][1][m][0] * r, acc[ai][1][m][1] * r);
                    ST16(p, w0); ST16(p + 128, w1);
                    if (pn < 6 && (row & 63) >= 61) {
                        bf16_t* hp = halo + ((size_t)(row >> 6) * 3 + ((row & 63) - 61)) * 1536 + cb + cl;
                        *(u32x4*)hp = w0; *(u32x4*)(hp + 128) = w1;
                    }
                }
        } else if (pn == 12) {
#pragma unroll
            for (int ai = 0; ai < 2; ++ai)
#pragma unroll
                for (int m = 0; m < 4; ++m) {
                    const int row = row0 + ai * 128 + m * 16; const float r = rs[ai][m];
                    const size_t prow = (size_t)(row >> 11) * TP + 16 + (row & 2047);
                    *(u32x4*)(kb + prow * 128 + cl) = pack8(acc[ai][0][m][0] * r, acc[ai][0][m][1] * r);
                    *(u32x4*)(vb + prow * 128 + cl) = pack8(acc[ai][1][m][0] * r, acc[ai][1][m][1] * r);
                }
        } else if (pn == 13) {
#pragma unroll
            for (int ai = 0; ai < 2; ++ai)
#pragma unroll
                for (int m = 0; m < 4; ++m) {
                    const int row = row0 + ai * 128 + m * 16; const float r = rs[ai][m];
                    if (cl < 64) { const size_t prow = (size_t)(row >> 11) * TP + 16 + (row & 2047); *(u32x4*)(ikb + prow * 64 + cl) = pack8(acc[ai][0][m][0] * r, acc[ai][0][m][1] * r); }
                    else if (cl < 80) { float* mp = misc + (size_t)row * 16 + (cl - 64); *(f32x4*)mp = acc[ai][0][m][0] * r; *(f32x4*)(mp + 4) = acc[ai][0][m][1] * r; }
                }
        } else {
            const int cb = (pn - 14) * 256 + cl;
            f32x4 bv[2][2];
#pragma unroll
            for (int bj = 0; bj < 2; ++bj) { bv[bj][0] = *(const f32x4*)(bgate + cb + bj * 128); bv[bj][1] = *(const f32x4*)(bgate + cb + bj * 128 + 4); }
#pragma unroll
            for (int ai = 0; ai < 2; ++ai)
#pragma unroll
                for (int m = 0; m < 4; ++m) {
                    const int row = row0 + ai * 128 + m * 16; const float r = rs[ai][m];
                    bf16_t* p = gates + (size_t)row * 2048;
#pragma unroll
                    for (int bj = 0; bj < 2; ++bj) {
                        f32x4 v0 = acc[ai][bj][m][0] * r + bv[bj][0], v1 = acc[ai][bj][m][1] * r + bv[bj][1];
#pragma unroll
                        for (int j = 0; j < 4; ++j) { v0[j] = SIG_EPI(v0[j]); v1[j] = SIG_EPI(v1[j]); }
                        ST16(p + GATE_COL(row, cb + bj * 128), pack8(v0, v1));
                    }
                }
        }
    }
};
struct EpiBr {
    static constexpr bool PERM = true, AFTER_DRAIN = false, APERM = false, BD = true;
    bf16_t* y; const bf16_t* gates; float sca, scb;
    __device__ __forceinline__ u32x4 comb(const f32x4 (&acc)[2][2][4][2], int ai, int m, u32x4 ga, u32x4 gb) const {
        f32x4 a0 = acc[ai][0][m][0] * sca, a1 = acc[ai][0][m][1] * sca, b0 = acc[ai][1][m][0] * scb, b1 = acc[ai][1][m][1] * scb, v0, v1;
        v0[0] = bflo(ga.x) * a0[0] + bflo(gb.x) * b0[0]; v0[1] = bfhi(ga.x) * a0[1] + bfhi(gb.x) * b0[1]; v0[2] = bflo(ga.y) * a0[2] + bflo(gb.y) * b0[2]; v0[3] = bfhi(ga.y) * a0[3] + bfhi(gb.y) * b0[3];
        v1[0] = bflo(ga.z) * a1[0] + bflo(gb.z) * b1[0]; v1[1] = bfhi(ga.z) * a1[1] + bfhi(gb.z) * b1[1]; v1[2] = bflo(ga.w) * a1[2] + bflo(gb.w) * b1[2]; v1[3] = bfhi(ga.w) * a1[3] + bfhi(gb.w) * b1[3];
        return pack8(v0, v1); }
    __device__ __forceinline__ void operator()(const f32x4 (&acc)[2][2][4][2], const Unit& u, int wr, int wc, int fr, int fq) const {
        const int row0 = u.pm * 256 + wr * 64 + fr, c0 = u.pn * 128 + wc * 32 + 8 * fq;
        u32x4 ga[4], gb[4], w0[4];
#pragma unroll
        for (int m = 0; m < 4; ++m) { const int rw = row0 + m * 16; const size_t go = (size_t)rw * 2048; ga[m] = *(const u32x4*)(gates + go + GATE_COL(rw, c0)); gb[m] = *(const u32x4*)(gates + go + GATE_COL(rw, 1024 + c0)); }
#pragma unroll
        for (int m = 0; m < 4; ++m) w0[m] = comb(acc, 0, m, ga[m], gb[m]);
#pragma unroll
        for (int m = 0; m < 4; ++m) { const int rw = row0 + 128 + m * 16; const size_t go = (size_t)rw * 2048; ga[m] = *(const u32x4*)(gates + go + GATE_COL(rw, c0)); gb[m] = *(const u32x4*)(gates + go + GATE_COL(rw, 1024 + c0)); }
#pragma unroll
        for (int m = 0; m < 4; ++m) *(u32x4*)(y + (size_t)(row0 + m * 16) * 1024 + c0) = w0[m];
#pragma unroll
        for (int m = 0; m < 4; ++m) *(u32x4*)(y + (size_t)(row0 + 128 + m * 16) * 1024 + c0) = comb(acc, 1, m, ga[m], gb[m]);
    }
};
struct EpiResidB {
    static constexpr bool PERM = true, AFTER_DRAIN = false, APERM = false, BD = false;
    bf16_t* hb; u64_t* ssq; float sc;
    __device__ __forceinline__ u32x4 upd(const f32x4 (&acc)[2][2][4][2], int ai, int bj, int m, u32x4 ov, float& part) const {
        f32x4 v0 = acc[ai][bj][m][0] * sc, v1 = acc[ai][bj][m][1] * sc;
        v0[0] += bflo(ov.x); v0[1] += bfhi(ov.x); v0[2] += bflo(ov.y); v0[3] += bfhi(ov.y); v1[0] += bflo(ov.z); v1[1] += bfhi(ov.z); v1[2] += bflo(ov.w); v1[3] += bfhi(ov.w);
        const u32x4 w = pack8(v0, v1);
        part += bflo(w.x) * bflo(w.x) + bfhi(w.x) * bfhi(w.x) + bflo(w.y) * bflo(w.y) + bfhi(w.y) * bfhi(w.y) + bflo(w.z) * bflo(w.z) + bfhi(w.z) * bfhi(w.z) + bflo(w.w) * bflo(w.w) + bfhi(w.w) * bfhi(w.w);
        return w; }
    __device__ __forceinline__ void operator()(const f32x4 (&acc)[2][2][4][2], const Unit& u, int wr, int wc, int fr, int fq) const {
        const int row0 = u.pm * 256 + wr * 64 + fr, c0 = u.pn * 256 + wc * 32 + 8 * fq;
        u32x4 o[4][2], w0[4][2]; float p0[4], p1[4];
#pragma unroll
        for (int m = 0; m < 4; ++m)
#pragma unroll
            for (int bj = 0; bj < 2; ++bj) o[m][bj] = *(const u32x4*)(hb + (size_t)(row0 + m * 16) * DM + c0 + bj * 128);
#pragma unroll
        for (int m = 0; m < 4; ++m) { p0[m] = 0.f; w0[m][0] = upd(acc, 0, 0, m, o[m][0], p0[m]); w0[m][1] = upd(acc, 0, 1, m, o[m][1], p0[m]); }
#pragma unroll
        for (int m = 0; m < 4; ++m)
#pragma unroll
            for (int bj = 0; bj < 2; ++bj) o[m][bj] = *(const u32x4*)(hb + (size_t)(row0 + 128 + m * 16) * DM + c0 + bj * 128);
#pragma unroll
        for (int m = 0; m < 4; ++m)
#pragma unroll
            for (int bj = 0; bj < 2; ++bj) *(u32x4*)(hb + (size_t)(row0 + m * 16) * DM + c0 + bj * 128) = w0[m][bj];
#pragma unroll
        for (int m = 0; m < 4; ++m) { p1[m] = 0.f;
#pragma unroll
            for (int bj = 0; bj < 2; ++bj) *(u32x4*)(hb + (size_t)(row0 + 128 + m * 16) * DM + c0 + bj * 128) = upd(acc, 1, bj, m, o[m][bj], p1[m]); }
#pragma unroll
        for (int m = 0; m < 4; ++m) {
            float a = p0[m], b = p1[m];
            a += __shfl_xor(a, 16); a += __shfl_xor(a, 32); b += __shfl_xor(b, 16); b += __shfl_xor(b, 32);
            if (ssq != nullptr && fq == 0) { atomicAdd(ssq + row0 + m * 16, (u64_t)(unsigned)(a * SSQ_SCALE + 0.5f)); atomicAdd(ssq + row0 + 128 + m * 16, (u64_t)(unsigned)(b * SSQ_SCALE + 0.5f)); }
        }
    }
};
struct EpiFinal {
    static constexpr bool PERM = true, AFTER_DRAIN = false, APERM = false, BD = false;
    const bf16_t* hb; float* out; float sc;
    __device__ __forceinline__ void operator()(const f32x4 (&acc)[2][2][4][2], const Unit& u, int wr, int wc, int fr, int fq) const {
        const int row0 = u.pm * 256 + wr * 64 + fr, c0 = u.pn * 256 + wc * 32 + 8 * fq;
        u32x4 o[2][4][2];
#pragma unroll
        for (int ai = 0; ai < 2; ++ai)
#pragma unroll
            for (int m = 0; m < 4; ++m)
#pragma unroll
                for (int bj = 0; bj < 2; ++bj) o[ai][m][bj] = *(const u32x4*)(hb + (size_t)(row0 + ai * 128 + m * 16) * DM + c0 + bj * 128);
#pragma unroll
        for (int ai = 0; ai < 2; ++ai)
#pragma unroll
            for (int m = 0; m < 4; ++m) {
                const size_t ro = (size_t)(row0 + ai * 128 + m * 16) * DM + c0;
#pragma unroll
                for (int bj = 0; bj < 2; ++bj) { const u32x4 ov = o[ai][m][bj]; f32x4 v0 = acc[ai][bj][m][0] * sc, v1 = acc[ai][bj][m][1] * sc;
                    v0[0] += bflo(ov.x); v0[1] += bfhi(ov.x); v0[2] += bflo(ov.y); v0[3] += bfhi(ov.y); v1[0] += bflo(ov.z); v1[1] += bfhi(ov.z); v1[2] += bflo(ov.w); v1[3] += bfhi(ov.w);
                    *(f32x4*)(out + ro + bj * 128) = v0; *(f32x4*)(out + ro + bj * 128 + 4) = v1; }
            }
    }
};
struct EpiNull {
    static constexpr bool PERM = true, AFTER_DRAIN = false, APERM = false, BD = false;
    __device__ __forceinline__ void operator()(const f32x4 (&acc)[2][2][4][2], const Unit& u, int wr, int wc, int fr, int fq) const {
#pragma unroll
        for (int ai = 0; ai < 2; ++ai)
#pragma unroll
            for (int bj = 0; bj < 2; ++bj)
#pragma unroll
                for (int m = 0; m < 4; ++m)
#pragma unroll
                    for (int n = 0; n < 2; ++n) asm volatile("" :: "v"(acc[ai][bj][m][n]));
    }
};
struct EpiUp {
    static constexpr bool PERM = true, AFTER_DRAIN = false, APERM = false, BD = false;
    bf16_t *gpre, *up; const u64_t* ssq;
    __device__ __forceinline__ void operator()(const f32x4 (&acc)[2][2][4][2], const Unit& u, int wr, int wc, int fr, int fq) const {
        const int row0 = u.pm * 256 + wr * 64 + fr, c0 = u.pn * 128 + wc * 32 + 8 * fq;
        u64_t sv[2][4];
#pragma unroll
        for (int ai = 0; ai < 2; ++ai)
#pragma unroll
            for (int m = 0; m < 4; ++m) sv[ai][m] = ssq[row0 + ai * 128 + m * 16];
#pragma unroll
        for (int ai = 0; ai < 2; ++ai)
#pragma unroll
            for (int m = 0; m < 4; ++m) {
                const int row = row0 + ai * 128 + m * 16; const float r = rsqrtf((float)sv[ai][m] * (SSQ_INV / DM) + EPSF);
                const size_t o = (size_t)row * DFF + c0;
                *(u32x4*)(gpre + o) = pack8(acc[ai][0][m][0] * r, acc[ai][0][m][1] * r);
                *(u32x4*)(up + o) = pack8(acc[ai][1][m][0] * r, acc[ai][1][m][1] * r);
            }
    }
};

template <int MODE> struct EpiUpConvT {
    static constexpr bool PERM = true, AFTER_DRAIN = false, APERM = true, BD = false;
    bf16_t* act; const u64_t* ssq; const float* cw; const float* hg; const float* mgu; char* xlds; int rt;
    __device__ __forceinline__ void operator()(const f32x4 (&acc)[2][2][4][2], const Unit& u, int wr, int wc, int fr, int fq) const {
        const int pm = u.pm, pn = u.pn, cl = wc * 32 + 8 * fq, ch0 = pn * 128 + cl, t0 = pm * 256 + 8 * (16 * wr + fr);
        u64_t sv[8];
#pragma unroll
        for (int j = 0; j < 8; ++j) sv[j] = (MODE == 2) ? (u64_t)(1000000 + j + rt) : ssq[t0 + j];
        float w0[8], w1[8], w2[8], b1[8], b2[8];
        { const f32x4 a0 = *(const f32x4*)(cw + ch0), a1 = *(const f32x4*)(cw + ch0 + 4), c0 = *(const f32x4*)(cw + DFF + ch0), c1 = *(const f32x4*)(cw + DFF + ch0 + 4),
                      e0 = *(const f32x4*)(cw + 2 * DFF + ch0), e1 = *(const f32x4*)(cw + 2 * DFF + ch0 + 4);
          const float* h2 = ((pm & 7) == 0) ? mgu + 14 * 5632 + pn * 256 + cl : hg + (size_t)(pm * 2) * DFF + ch0;
          const float* h1 = ((pm & 7) == 0) ? mgu + 15 * 5632 + pn * 256 + cl : hg + (size_t)(pm * 2 + 1) * DFF + ch0;
          const f32x4 p20 = *(const f32x4*)h2, p21 = *(const f32x4*)(h2 + 4), p10 = *(const f32x4*)h1, p11 = *(const f32x4*)(h1 + 4);
#pragma unroll
          for (int c = 0; c < 4; ++c) { w0[c] = a0[c]; w0[4 + c] = a1[c]; w1[c] = c0[c]; w1[4 + c] = c1[c]; w2[c] = e0[c]; w2[4 + c] = e1[c]; b2[c] = p20[c]; b2[4 + c] = p21[c]; b1[c] = p10[c]; b1[4 + c] = p11[c]; } }
        float rs[8];
#pragma unroll
        for (int j = 0; j < 8; ++j) rs[j] = rsqrtf((float)sv[j] * (SSQ_INV / DM) + EPSF);
        float g6[8], g7[8];
#pragma unroll
        for (int c = 0; c < 8; ++c) { g6[c] = acc[1][0][2][c >> 2][c & 3] * rs[6]; g7[c] = acc[1][0][3][c >> 2][c & 3] * rs[7]; }
        float* xw = (float*)(xlds + ((wc * 4 + fq) * 16) * 4);
        if (wr == 0 && fr == 15) { *(f32x4*)xw = (f32x4){g6[0], g6[1], g6[2], g6[3]}; *(f32x4*)(xw + 4) = (f32x4){g6[4], g6[5], g6[6], g6[7]};
                                   *(f32x4*)(xw + 8) = (f32x4){g7[0], g7[1], g7[2], g7[3]}; *(f32x4*)(xw + 12) = (f32x4){g7[4], g7[5], g7[6], g7[7]}; }
        asm volatile("s_waitcnt lgkmcnt(0)" ::: "memory");
        __builtin_amdgcn_s_barrier();
        asm volatile("" ::: "memory");
        if (wr == 1) { const f32x4 q0 = *(const f32x4*)xw, q1 = *(const f32x4*)(xw + 4), q2 = *(const f32x4*)(xw + 8), q3 = *(const f32x4*)(xw + 12);
#pragma unroll
            for (int c = 0; c < 4; ++c) { b2[c] = q0[c]; b2[4 + c] = q1[c]; b1[c] = q2[c]; b1[4 + c] = q3[c]; } }
        float gm1[8], gm2[8];
#pragma unroll
        for (int c = 0; c < 8; ++c) {
            gm1[c] = __int_as_float(__builtin_amdgcn_update_dpp(__float_as_int(b1[c]), __float_as_int(g7[c]), 0x111, 0xf, 0xf, false));
            gm2[c] = __int_as_float(__builtin_amdgcn_update_dpp(__float_as_int(b2[c]), __float_as_int(g6[c]), 0x111, 0xf, 0xf, false)); }
#pragma unroll
        for (int j = 0; j < 8; ++j) { const int ai = j >> 2, m = j & 3; float o[8];
#pragma unroll
            for (int c = 0; c < 8; ++c) { const float g = acc[ai][0][m][c >> 2][c & 3] * rs[j], up = acc[ai][1][m][c >> 2][c & 3] * rs[j];
                o[c] = silu_f(w0[c] * gm2[c] + w1[c] * gm1[c] + w2[c] * g) * up; gm2[c] = gm1[c]; gm1[c] = g; }
            u32x4 w; w.x = cvt_pk(o[0], o[1]); w.y = cvt_pk(o[2], o[3]); w.z = cvt_pk(o[4], o[5]); w.w = cvt_pk(o[6], o[7]);
            if (MODE != 1 || rt == 12345) ST16(act + (size_t)(t0 + j) * DFF + ch0, w); }
    }
};
typedef EpiUpConvT<0> EpiUpConv;

constexpr int MN_PITCH = 2064;
template <bool ALDS, class F> __device__ __forceinline__ void small_gemm16(const void* Ain, const bf16_t* Bt, int N, int K, const F& epi, char* red) {
    int tid_ = threadIdx.x; asm volatile("" : "+v"(tid_));
    const int lane = tid_ & 63, wid = tid_ >> 6, r = lane & 15, g = lane >> 4;
    const int kw = K >> 3, kb0 = wid * kw;
    for (int ct = blockIdx.x; ct < N / 16; ct += gridDim.x) {
        f32x4 acc = {0.f, 0.f, 0.f, 0.f};
        const bf16_t* bp = Bt + (size_t)(ct * 16 + r) * K + kb0 + g * 8;
        if (ALDS) { const char* ap = (const char*)Ain + r * MN_PITCH + (kb0 + g * 8) * 2;
#pragma unroll 4
            for (int k = 0; k < kw; k += 32) acc = mfma16(*(const bf16x8*)(ap + k * 2), *(const bf16x8*)(bp + k), acc);
        } else { const bf16_t* ap = (const bf16_t*)Ain + (size_t)r * K + kb0 + g * 8;
#pragma unroll 4
            for (int k = 0; k < kw; k += 32) acc = mfma16(*(const bf16x8*)(ap + k), *(const bf16x8*)(bp + k), acc); }
        *(f32x4*)(red + (wid * 64 + lane) * 16) = acc;
        __syncthreads();
        if (wid == 0) { f32x4 s = *(const f32x4*)(red + lane * 16);
#pragma unroll
            for (int w = 1; w < 8; ++w) s += *(const f32x4*)(red + (w * 64 + lane) * 16);
#pragma unroll
            for (int rr = 0; rr < 4; ++rr) epi(4 * g + rr, ct * 16 + r, s[rr]); }
        __syncthreads();
    }
}
__device__ __forceinline__ void meta_norm_lds(const float* hmeta, char* img) {
    int tid_ = threadIdx.x; asm volatile("" : "+v"(tid_));
    const int lane = tid_ & 63, wid = tid_ >> 6;
#pragma unroll
    for (int rr = 0; rr < 2; ++rr) { const int row = 2 * wid + rr; const float* src = hmeta + row * DM;
        f32x4 v[4]; float ss = 0.f;
#pragma unroll
        for (int i = 0; i < 4; ++i) { v[i] = ((const f32x4*)src)[lane + 64 * i]; ss += v[i][0] * v[i][0] + v[i][1] * v[i][1] + v[i][2] * v[i][2] + v[i][3] * v[i][3]; }
        ss = wave_sum(ss); const float rstd = rsqrtf(ss * (1.f / DM) + EPSF);
#pragma unroll
        for (int i = 0; i < 4; ++i) { u32x2 w; w.x = cvt_pk(v[i][0] * rstd, v[i][1] * rstd); w.y = cvt_pk(v[i][2] * rstd, v[i][3] * rstd); *(u32x2*)(img + row * MN_PITCH + (lane + 64 * i) * 8) = w; } }
    __syncthreads();
}
struct MEpiIn { unsigned char* ws; const float* bgate;
    __device__ __forceinline__ void operator()(int t, int n, float v) const {
        if (n < 1536) ((bf16_t*)(ws + M_RAW))[t * 1536 + n] = f2bf(v);
        else if (n < 2048) ((bf16_t*)(ws + M_Z))[t * 512 + n - 1536] = f2bf(v);
        else if (n < 2560) ((bf16_t*)(ws + M_BQ))[t * 512 + n - 2048] = f2bf(v);
        else if (n < 3072) ((bf16_t*)(ws + M_IQ))[t * 512 + n - 2560] = f2bf(v);
        else if (n < 3200) ((bf16_t*)(ws + M_K))[t * 128 + n - 3072] = f2bf(v);
        else if (n < 3328) ((bf16_t*)(ws + M_V))[t * 128 + n - 3200] = f2bf(v);
        else if (n < 3392) { }
        else if (n < 3408) ((float*)(ws + M_MISC))[t * 16 + n - 3392] = v;
        else if (n < 3584) { }
        else ((bf16_t*)(ws + M_GATES))[t * 2048 + n - 3584] = f2bf(SIG_META(v + bgate[n - 3584]));
    } };
struct MEpiBr { unsigned char* ws; float sca, scb;
    __device__ __forceinline__ void operator()(int t, int n, float v) const {
        const int ch = 128 * (n >> 8) + (n & 127), br = (n >> 7) & 1;
        const float g = bf2f(((const bf16_t*)(ws + M_GATES))[t * 2048 + br * 1024 + ch]);
        ((float*)(ws + M_GU))[t * 5632 + n] = g * v * (br ? scb : sca);
    } };
struct MEpiResid { float* h; float sc; __device__ __forceinline__ void operator()(int t, int n, float v) const { h[t * 1024 + n] += v * sc; } };
struct MEpiUp { float* gu; __device__ __forceinline__ void operator()(int t, int n, float v) const { gu[t * 5632 + n] = v; } };

struct MapId { __device__ __forceinline__ int operator()(int n) const { return n; } };
struct MapWin { __device__ __forceinline__ int operator()(int n) const {
    if (n < 2048) return n; if (n < 2560) return n - 2048 + 2056; if (n < 3072) return n - 2560 + 2824; if (n < 3200) return n - 3072 + 2568;
    if (n < 3328) return n - 3200 + 2696; if (n < 3392) return n - 3328 + 3336; if (n < 3400) return n - 3392 + 2048; if (n < 3408) return n; return -1; } };
struct MapWup { __device__ __forceinline__ int operator()(int n) const { const int t = n >> 8, w = n & 255; return w < 128 ? 128 * t + w : 2816 + 128 * t + (w - 128); } };
struct MapBrA { __device__ __forceinline__ int operator()(int n) const { return (n & 255) < 128 ? 128 * (n >> 8) + (n & 127) : -1; } };
struct MapBrB { __device__ __forceinline__ int operator()(int n) const { return (n & 255) >= 128 ? 128 * (n >> 8) + (n & 127) : -1; } };
template <class Map> __device__ __forceinline__ void tr_cvt(const float* __restrict__ src, int ldsrc, int K, bf16_t* __restrict__ dst, int ldd, int koff, int Nd, const Map& map, const float* gain, float* tile, int& g0) {
    const int G = gridDim.x, tid = threadIdx.x, nnt = Nd / 64, nt = nnt * (K / 128);
    int t = ((int)blockIdx.x - (g0 % G) + G) % G;
    for (; t < nt; t += G) {
        const int n0 = (t % nnt) * 64, k0 = (t / nnt) * 128;
        { const int nn = tid & 63, col = map(n0 + nn); float v[16];
#pragma unroll
          for (int i = 0; i < 16; ++i) { const int kk = (tid >> 6) + 8 * i; v[i] = col >= 0 ? src[(size_t)(k0 + kk) * ldsrc + col] : 0.f; }
#pragma unroll
          for (int i = 0; i < 16; ++i) { const int kk = (tid >> 6) + 8 * i; tile[kk * 65 + nn] = v[i]; } }
        __syncthreads();
#pragma unroll
        for (int hh = 0; hh < 2; ++hh) { const int nn = tid >> 3, part = (tid & 7) + 8 * hh; float v[8];
#pragma unroll
          for (int jj = 0; jj < 8; ++jj) { const int kk = part * 8 + jj; v[jj] = tile[kk * 65 + nn] * (gain ? gain[k0 + kk] : 1.f); }
          u32x4 w; w.x = cvt_pk(v[0], v[1]); w.y = cvt_pk(v[2], v[3]); w.z = cvt_pk(v[4], v[5]); w.w = cvt_pk(v[6], v[7]);
          *(u32x4*)(dst + (size_t)(n0 + nn) * ldd + koff + k0 + part * 8) = w; }
        __syncthreads();
    }
    g0 += nt;
}
__device__ __forceinline__ void p_prologue(const Args& a, char* smem) {
    unsigned char* ws = a.ws; { size_t z_ = 0; asm volatile("" : "+s"(z_)); ws += z_; } float* tile = (float*)smem; int g0 = 0;
    for (int l = 0; l < NLAYER; ++l) {
        const float* gmix = a.in[I_NORM_MIX] + l * DM; const float* gffn = a.in[I_NORM_FFN] + l * DM;
        tr_cvt(a.in[I_W_IN] + (size_t)l * DM * 3408, 3408, DM, (bf16_t*)(ws + OFF_WIN) + (size_t)l * NIN * DM, DM, 0, 3584, MapWin(), gmix, tile, g0);
        tr_cvt(a.in[I_W_GATE] + (size_t)l * DM * 2048, 2048, DM, (bf16_t*)(ws + OFF_WIN) + ((size_t)l * NIN + 3584) * DM, DM, 0, 2048, MapId(), gmix, tile, g0);
        tr_cvt(a.in[I_W_BA] + (size_t)l * 512 * DM, DM, 512, (bf16_t*)(ws + OFF_WBR) + (size_t)l * 2048 * DM, DM, 0, 2048, MapBrA(), nullptr, tile, g0);
        tr_cvt(a.in[I_W_BB] + (size_t)l * 512 * DM, DM, 512, (bf16_t*)(ws + OFF_WBR) + (size_t)l * 2048 * DM, DM, 512, 2048, MapBrB(), nullptr, tile, g0);
        tr_cvt(a.in[I_W_OUT] + (size_t)l * DM * DM, DM, DM, (bf16_t*)(ws + OFF_WOUT) + (size_t)l * DM * DM, DM, 0, DM, MapId(), nullptr, tile, g0);
        tr_cvt(a.in[I_W_UP] + (size_t)l * DM * 5632, 5632, DM, (bf16_t*)(ws + OFF_WUP) + (size_t)l * NIN * DM, DM, 0, NIN, MapWup(), gffn, tile, g0);
        tr_cvt(a.in[I_W_DOWN] + (size_t)l * DFF * DM, DM, DFF, (bf16_t*)(ws + OFF_WDN) + (size_t)l * DM * DFF, DFF, 0, DM, MapId(), nullptr, tile, g0);
    }
    const int gt = blockIdx.x * 512 + threadIdx.x, nT = gridDim.x * 512;
    { const int lane = threadIdx.x & 63, gw = blockIdx.x * 8 + (threadIdx.x >> 6), nW = gridDim.x * 8;
      bf16_t* hb = (bf16_t*)(ws + OFF_HB); u64_t* ssq = (u64_t*)(ws + OFF_SSQ);
      for (int row = 2 * gw; row < RR; row += 2 * nW) { const float* src = a.in[I_X] + (size_t)row * DM; float ss0 = 0.f, ss1 = 0.f; f32x4 v[8];
#pragma unroll
          for (int i = 0; i < 8; ++i) v[i] = ((const f32x4*)src)[lane + 64 * i];
#pragma unroll
          for (int i = 0; i < 8; ++i) { u32x2 w; w.x = cvt_pk(v[i][0], v[i][1]); w.y = cvt_pk(v[i][2], v[i][3]);
              const float q = bflo(w.x) * bflo(w.x) + bfhi(w.x) * bfhi(w.x) + bflo(w.y) * bflo(w.y) + bfhi(w.y) * bfhi(w.y); if (i < 4) ss0 += q; else ss1 += q;
              ((u32x2*)(hb + (size_t)row * DM))[lane + 64 * i] = w; }
          ss0 = wave_sum(ss0); ss1 = wave_sum(ss1); if (lane == 0) { ssq[row] = (u64_t)(ss0 * SSQ_SCALE + 0.5f); ssq[row + 1] = (u64_t)(ss1 * SSQ_SCALE + 0.5f); } }
      for (int i = gt; i < 3 * RR; i += nT) ssq[RR + i] = 0ull; }
    float* cosA = (float*)(ws + OFF_COSA); float* sinA = (float*)(ws + OFF_SINA); float* cosI = (float*)(ws + OFF_COSI); float* sinI = (float*)(ws + OFF_SINI);
    for (int i = gt; i < TPOS * 96; i += nT) {
        const int pos = i / 96, j = i % 96;
        if (j < 64) { const float inv = 1.0f / powf(10000.f, (float)(2 * j) / 128.f), ang = (float)pos * inv; cosA[pos * 64 + j] = cosf(ang); sinA[pos * 64 + j] = sinf(ang); }
        else { const int jj = j - 64; const float inv = 1.0f / powf(10000.f, (float)(2 * jj) / 64.f), ang = (float)pos * inv; cosI[pos * 32 + jj] = cosf(ang); sinI[pos * 32 + jj] = sinf(ang); }
    }
    for (int i = gt; i < 16 * 1024; i += nT) ((float*)(ws + M_H))[i] = a.in[I_META][i];
    for (int i = gt; i < NB * (TP - TPOS) * 16; i += nT) {
        const int b = i / ((TP - TPOS) * 16), r = i % ((TP - TPOS) * 16);
        const size_t o = ((size_t)b * TP + TPOS) * 128 + (size_t)r * 8;
        *(u32x4*)((bf16_t*)(ws + OFF_KB) + o) = (u32x4){0u, 0u, 0u, 0u}; *(u32x4*)((bf16_t*)(ws + OFF_VB) + o) = (u32x4){0u, 0u, 0u, 0u};
    }
}

template <int GL, bool NORM> __device__ __forceinline__ u32x4 rope8(u32x4 raw, int lig, const float* w, const float* cs, const float* sn) {
    float x[8] = {bflo(raw.x), bfhi(raw.x), bflo(raw.y), bfhi(raw.y), bflo(raw.z), bfhi(raw.z), bflo(raw.w), bfhi(raw.w)};
    if (NORM) { float ss = 0.f;
#pragma unroll
        for (int j = 0; j < 8; ++j) ss += x[j] * x[j];
        ss += dpp_mov<0xB1>(ss); ss += dpp_mov<0x4E>(ss); ss += dpp_mov<0x141>(ss); if (GL == 16) ss += dpp_mov<0x140>(ss);
        const float rstd = rsqrtf(ss * (1.f / (8 * GL)) + EPSF);
        const f32x4 w0 = *(const f32x4*)(w + 8 * lig), w1 = *(const f32x4*)(w + 8 * lig + 4);
#pragma unroll
        for (int j = 0; j < 4; ++j) { x[j] *= rstd * w0[j]; x[4 + j] *= rstd * w1[j]; } }
    const int ih = lig & (GL / 2 - 1); const bool second = lig >= GL / 2;
    const f32x4 c0 = *(const f32x4*)(cs + 8 * ih), c1 = *(const f32x4*)(cs + 8 * ih + 4), s0 = *(const f32x4*)(sn + 8 * ih), s1 = *(const f32x4*)(sn + 8 * ih + 4);
    float o[8];
#pragma unroll
    for (int j = 0; j < 8; ++j) { const float other = (GL == 16) ? dpp_mov<0x128>(x[j]) : dpp_mov<0x1B>(dpp_mov<0x141>(x[j])), cc = j < 4 ? c0[j] : c1[j - 4], ss_ = j < 4 ? s0[j] : s1[j - 4];
        o[j] = x[j] * cc + (second ? other * ss_ : -other * ss_); }
    u32x4 r; r.x = cvt_pk(o[0], o[1]); r.y = cvt_pk(o[2], o[3]); r.z = cvt_pk(o[4], o[5]); r.w = cvt_pk(o[6], o[7]); return r;
}
namespace mp {
constexpr int RAW_OFF = 0, QS_OFF = 51712, KS_OFF = 70144, MT_OFF = 88576, GC_OFF = 154112, BT_OFF = 155136, RED_OFF = 156160, CNT_OFF = 157184;
}
__device__ __forceinline__ void p_mixprep(const Args& a, int layer, char* smem, bool do_store, int skip = 0) {
    using namespace mp;
    unsigned char* ws = a.ws; { size_t z_ = 0; asm volatile("" : "+s"(z_)); ws += z_; }
    bf16_t* qkv = (bf16_t*)(ws + OFF_QKV); const bf16_t* halo = (const bf16_t*)(ws + OFF_HALO); const bf16_t* mraw = (const bf16_t*)(ws + M_RAW);
    bf16_t* mchunk = (bf16_t*)(ws + M_CHUNK); bf16_t* TQ = (bf16_t*)(ws + OFF_TQ); bf16_t* mTQ = (bf16_t*)(ws + M_TQ);
    const float* conv_a = a.in[I_CONV_A] + (size_t)layer * 4 * 1536;
    const float* a_log = a.in[I_A_LOG] + layer * 4; const float* dt_bias = a.in[I_DT_BIAS] + layer * 4;
    const float* qn = a.in[I_Q_NORM] + layer * 128; const float* kn = a.in[I_K_NORM] + layer * 128; const float* kin = a.in[I_KIDX_NORM] + layer * 64;
    const float* cosA = (const float*)(ws + OFF_COSA); const float* sinA = (const float*)(ws + OFF_SINA); const float* cosI = (const float*)(ws + OFF_COSI); const float* sinI = (const float*)(ws + OFF_SINI);
    float* GCs = (float*)(smem + GC_OFF); float* BTs = (float*)(smem + BT_OFF); float* RED = (float*)(smem + RED_OFF);
    bf16_t* QS = (bf16_t*)(smem + QS_OFF); bf16_t* KS = (bf16_t*)(smem + KS_OFF); bf16_t* RV = (bf16_t*)(smem + RAW_OFF + 2 * 67 * 256);
    for (int item = blockIdx.x; item < 1028; item += gridDim.x) {
        int tid_ = threadIdx.x; asm volatile("" : "+v"(tid_));
        const int tid = tid_, lane = tid & 63, wid = __builtin_amdgcn_readfirstlane(tid >> 6);
        const bool is_meta = item >= 1024; const int b = item >> 5, c = item & 31, row0 = b * 2048 + 64 * c;
        const int h_lo = is_meta ? item - 1024 : 0, h_hi = is_meta ? h_lo + 1 : 4;
        { float g = 0.f, be = 0.f; const int t = tid >> 2, h = tid & 3;
          if (tid < 256 && (!is_meta || t >= 48)) { const float* mpp = is_meta ? (const float*)(ws + M_MISC) + (t - 48) * 16 : (const float*)(ws + OFF_MISC) + (size_t)(row0 + t) * 16;
              g = -__expf(a_log[h]) * softplus_f(mpp[h] + dt_bias[h]); be = SIG_BETA(mpp[4 + h]); }
          float s = g;
#pragma unroll
          for (int o = 4; o < 64; o <<= 1) { const float v = __shfl_up(s, o); if (lane >= o) s += v; }
          if (tid < 256 && lane >= 60) RED[wid * 4 + (lane & 3)] = s;
          __syncthreads();
          if (tid < 256) { for (int w = 0; w < wid; ++w) s += RED[w * 4 + h]; GCs[tid] = s; BTs[tid] = be; } }
        __syncthreads();
        if (do_store && tid < 256 && item <= 1024) { float* gd = is_meta ? (float*)(ws + M_GC) : (float*)(ws + OFF_GC) + (size_t)row0 * 4; float* bd = is_meta ? (float*)(ws + M_BETA) : (float*)(ws + OFF_BETA) + (size_t)row0 * 4;
            gd[tid] = GCs[tid]; bd[tid] = BTs[tid]; }
        const bf16_t* zsrc = (const bf16_t*)(ws + OFF_KB) + (size_t)TPOS * 128;
#define MP_DMA(hh, plo, phi) do { int td_ = tid; asm volatile("" : "+v"(td_)); _Pragma("unroll 1") for (int it = 0; it < 7; ++it) { const int p = td_ + 512 * it; \
            if (p >= (plo) && p < (phi)) { const int tensor = p / (67 * 16), rem = p - tensor * (67 * 16), rr = rem >> 4, cc = (rem & 15) * 8, tt = rr - 3, col = tensor * 512 + (hh) * 128 + cc; \
                const bf16_t* sp = zsrc; \
                if (!is_meta) { if (tt >= 0) sp = qkv + (size_t)(row0 + tt) * 1536 + col; else if (c > 0) sp = halo + ((size_t)((row0 >> 6) - 1) * 3 + (tt + 3)) * 1536 + col; \
                    else sp = mraw + (size_t)(16 + tt) * 1536 + col; } \
                else if (tt >= 48) sp = mraw + (size_t)(tt - 48) * 1536 + col; \
                __builtin_amdgcn_global_load_lds((const unsigned*)sp, (LAS unsigned*)(smem + RAW_OFF + (wid * 64 + 512 * it) * 16), 16, 0, 0); } } } while (0)
        MP_DMA(h_lo, 0, 3 * 67 * 16);
        for (int h = h_lo; h < ((skip & 8) ? h_lo : h_hi); ++h) {
            asm volatile("s_waitcnt vmcnt(0)" ::: "memory");
            __syncthreads();
            const int ch = tid & 127, part = tid >> 7;
            float y[3][16];
            if (is_meta && part < 3) {
#pragma unroll
                for (int tensor = 0; tensor < 3; ++tensor)
#pragma unroll
                    for (int i = 0; i < 16; ++i) y[tensor][i] = 0.f;
            } else
#pragma unroll
            for (int tensor = 0; tensor < 3; ++tensor) {
                const int wc = tensor * 512 + h * 128 + ch;
                const float w0 = conv_a[wc], w1 = conv_a[1536 + wc], w2 = conv_a[3072 + wc], w3 = conv_a[4608 + wc];
                const bf16_t* rp = (const bf16_t*)(smem + RAW_OFF + tensor * 67 * 256) + ch + part * 16 * 128;
                float x0 = bf2f(rp[0]), x1 = bf2f(rp[128]), x2 = bf2f(rp[256]);
#pragma unroll
                for (int i = 0; i < 16; ++i) { const float x3 = bf2f(rp[(3 + i) * 128]); float v = (skip & 32) ? x3 : silu_f(w0 * x0 + w1 * x1 + w2 * x2 + w3 * x3);
                    if (is_meta && part * 16 + i < 48) v = 0.f; y[tensor][i] = v; x0 = x1; x1 = x2; x2 = x3; }
            }
#pragma unroll
            for (int i = 0; i < 16; ++i) { const float sq = (skip & 1) ? y[0][i] : wave_sum_hi(y[0][i] * y[0][i]), sk = (skip & 1) ? y[1][i] : wave_sum_hi(y[1][i] * y[1][i]);
                if (lane == 63) { const int t = part * 16 + i; RED[t * 2 + (wid & 1)] = sq; RED[(64 + t) * 2 + (wid & 1)] = sk; } }
            __syncthreads();
            if (h + 1 < h_hi) MP_DMA(h + 1, 0, 2 * 67 * 16);
#pragma unroll
            for (int i = 0; i < 16; ++i) { const int t = part * 16 + i;
                const float rq = rsqrtf(RED[t * 2] + RED[t * 2 + 1] + EPSF) * 0.08838834764831845f, rk = rsqrtf(RED[(64 + t) * 2] + RED[(64 + t) * 2 + 1] + EPSF);
                QS[t * 144 + ch] = f2bf(y[0][i] * rq); KS[t * 144 + ch] = f2bf(y[1][i] * rk); RV[(t + 3) * 128 + ch] = f2bf(y[2][i]); }
            __syncthreads();
            if (!(skip & 128)) { bf16_t* dbase = is_meta ? mchunk : qkv + (size_t)row0 * 1536;
              for (int p = tid; p < 3072; p += 512) { const int tensor = p >> 10, t = (p & 1023) >> 4, cc = (p & 15) * 8;
                  const bf16_t* sp = tensor == 0 ? QS + t * 144 + cc : (tensor == 1 ? KS + t * 144 + cc : RV + (t + 3) * 128 + cc);
                  if (do_store) *(u32x4*)(dbase + (size_t)t * 1536 + tensor * 512 + h * 128 + cc) = *(const u32x4*)sp; } }
            if (!(skip & 256)) { const int r = lane & 15, g = lane >> 4, mt = wid >> 1;
              bf16_t* tqd = is_meta ? mTQ + h * 8192 : TQ + (size_t)((row0 >> 6) * 4 + h) * 8192;
              float* MT = (float*)(smem + MT_OFF) + h * 4096;
#pragma unroll
              for (int nti = 0; nti < 2; ++nti) { const int nt = 2 * (wid & 1) + nti;
                  f32x4 akk = {0.f, 0.f, 0.f, 0.f}, aqk = {0.f, 0.f, 0.f, 0.f};
#pragma unroll
                  for (int s = 0; s < 4; ++s) {
                      const bf16x8 fk = *(const bf16x8*)(KS + (16 * mt + r) * 144 + 32 * s + 8 * g);
                      const bf16x8 fq = *(const bf16x8*)(QS + (16 * mt + r) * 144 + 32 * s + 8 * g);
                      const bf16x8 fb = *(const bf16x8*)(KS + (16 * nt + r) * 144 + 32 * s + 8 * g);
                      akk = mfma16(fk, fb, akk); aqk = mfma16(fq, fb, aqk); }
                  const int j = 16 * nt + r; const float gcj = GCs[j * 4 + h];
#pragma unroll
                  for (int rr = 0; rr < 4; ++rr) { const int i = 16 * mt + 4 * g + rr; const float gci = GCs[i * 4 + h], bi = BTs[i * 4 + h];
                      const float dec = (i >= j) ? __expf(gci - gcj) : 0.f;
                      MT[i * 64 + j] = (i > j) ? bi * akk[rr] * dec : 0.f;
                      if (do_store) tqd[4096 + i * 64 + j] = f2bf((i >= j) ? aqk[rr] * dec : 0.f); } } }
            __syncthreads();
            if (h + 1 < h_hi) MP_DMA(h + 1, 2 * 67 * 16, 3 * 67 * 16);
        }
#undef MP_DMA
        if (!(skip & 2) && wid < 4 && wid >= h_lo && wid < h_hi) { const int hh = wid;
            float* MT = (float*)(smem + MT_OFF) + hh * 4096;
            const int ib = is_meta ? 48 : 0;
            if (is_meta) for (int i = 0; i < 48; ++i) MT[i * 64 + lane] = (lane == i) ? 1.f : 0.f;
            for (int i0 = ib; i0 < 64; i0 += 4) {
                float a0 = (lane == i0) ? 1.f : 0.f, a1 = (lane == i0 + 1) ? 1.f : 0.f, a2 = (lane == i0 + 2) ? 1.f : 0.f, a3 = (lane == i0 + 3) ? 1.f : 0.f;
#pragma unroll 2
                for (int j = ib; j < i0; j += 4) {
                    const f32x4 m0 = *(const f32x4*)(MT + (i0 + 0) * 64 + j), m1 = *(const f32x4*)(MT + (i0 + 1) * 64 + j), m2 = *(const f32x4*)(MT + (i0 + 2) * 64 + j), m3 = *(const f32x4*)(MT + (i0 + 3) * 64 + j);
                    const float t0 = MT[(j + 0) * 64 + lane], t1 = MT[(j + 1) * 64 + lane], t2 = MT[(j + 2) * 64 + lane], t3 = MT[(j + 3) * 64 + lane];
                    a0 -= m0[0] * t0 + m0[1] * t1 + m0[2] * t2 + m0[3] * t3; a1 -= m1[0] * t0 + m1[1] * t1 + m1[2] * t2 + m1[3] * t3;
                    a2 -= m2[0] * t0 + m2[1] * t1 + m2[2] * t2 + m2[3] * t3; a3 -= m3[0] * t0 + m3[1] * t1 + m3[2] * t2 + m3[3] * t3; }
                const f32x4 d1 = *(const f32x4*)(MT + (i0 + 1) * 64 + i0), d2 = *(const f32x4*)(MT + (i0 + 2) * 64 + i0), d3 = *(const f32x4*)(MT + (i0 + 3) * 64 + i0);
                a1 -= d1[0] * a0; a2 -= d2[0] * a0 + d2[1] * a1; a3 -= d3[0] * a0 + d3[1] * a1 + d3[2] * a2;
                MT[(i0 + 0) * 64 + lane] = a0; MT[(i0 + 1) * 64 + lane] = a1; MT[(i0 + 2) * 64 + lane] = a2; MT[(i0 + 3) * 64 + lane] = a3;
            }
            bf16_t* td = is_meta ? mTQ + hh * 8192 : TQ + (size_t)((row0 >> 6) * 4 + hh) * 8192;
            if (do_store) for (int i = 0; i < 64; ++i) td[i * 64 + lane] = f2bf(MT[i * 64 + lane]);
        }
        if (!(skip & 4) && item <= 1024 && (wid >= 4 || !is_meta)) {
            bf16_t* kb = (bf16_t*)(ws + OFF_KB); bf16_t* vb = (bf16_t*)(ws + OFF_VB); bf16_t* ikb = (bf16_t*)(ws + OFF_IKB);
            const int ntok = is_meta ? 4 : (wid >= 4 ? 12 : 4), tbase = is_meta ? (wid - 4) * 4 : (wid >= 4 ? (wid - 4) * 12 : 48 + wid * 4);
            for (int t0 = 0; t0 < ntok; t0 += 4) {
                u32x4 rq[4], ri[4], rm[4];
#pragma unroll
                for (int u = 0; u < 4; ++u) { const int tl = tbase + t0 + u; const size_t row = (size_t)row0 + tl; const int pos = is_meta ? tl : 16 + 64 * c + tl;
                    const bf16_t* qp = is_meta ? (const bf16_t*)(ws + M_BQ) + tl * 512 : (const bf16_t*)(ws + OFF_BQ) + row * 512;
                    const bf16_t* ip = is_meta ? (const bf16_t*)(ws + M_IQ) + tl * 512 : (const bf16_t*)(ws + OFF_IQ) + row * 512;
                    rq[u] = *(const u32x4*)(qp + lane * 8); ri[u] = *(const u32x4*)(ip + lane * 8);
                    const bf16_t* mp = is_meta ? (const bf16_t*)(ws + M_K) + tl * 128 + (lane & 15) * 8
                                               : (lane < 16 ? kb + ((size_t)b * TP + pos) * 128 + lane * 8 : ikb + ((size_t)b * TP + pos) * 64 + (lane & 7) * 8);
                    rm[u] = *(const u32x4*)mp; }
#pragma unroll
                for (int u = 0; u < 4; ++u) { const int tl = tbase + t0 + u; const size_t row = (size_t)row0 + tl; const int pos = is_meta ? tl : 16 + 64 * c + tl;
                    const u32x4 oq = rope8<16, true>(rq[u], lane & 15, qn, cosA + pos * 64, sinA + pos * 64);
                    const u32x4 oi = rope8<8, false>(ri[u], lane & 7, nullptr, cosI + pos * 32, sinI + pos * 32);
                    const u32x4 ok = rope8<16, true>(rm[u], lane & 15, kn, cosA + pos * 64, sinA + pos * 64);
                    const u32x4 oik = rope8<8, true>(rm[u], lane & 7, kin, cosI + pos * 32, sinI + pos * 32);
                    bf16_t* qp = is_meta ? (bf16_t*)(ws + M_BQ) + tl * 512 : (bf16_t*)(ws + OFF_BQ) + row * 512;
                    bf16_t* ip = is_meta ? (bf16_t*)(ws + M_IQ) + tl * 512 : (bf16_t*)(ws + OFF_IQ) + row * 512;
                    if (do_store) { *(u32x4*)(qp + lane * 8) = oq; *(u32x4*)(ip + lane * 8) = oi; }
                    if (!do_store) { } else if (!is_meta) { if (lane < 16) *(u32x4*)(kb + ((size_t)b * TP + pos) * 128 + lane * 8) = ok; else if (lane < 24) *(u32x4*)(ikb + ((size_t)b * TP + pos) * 64 + (lane & 7) * 8) = oik; }
                    else {
                        const u32x4 vv = *(const u32x4*)((const bf16_t*)(ws + M_V) + tl * 128 + (lane & 15) * 8);
                        if (lane < 16) for (int bb = 0; bb < NB; ++bb) { *(u32x4*)(kb + ((size_t)bb * TP + tl) * 128 + lane * 8) = ok; *(u32x4*)(vb + ((size_t)bb * TP + tl) * 128 + lane * 8) = vv; } }
                }
            }
        }
        __syncthreads();
    }
}

namespace gs { constexpr int KN_OFF = 0, KT_OFF = 17408, QN_OFF = 35840, VT_OFF = 53248, TT_OFF = 71680, QK_OFF = 80896, GC_OFF = 90112, BT_OFF = 90368, OT_OFF = 90624; }
__device__ __forceinline__ bf16x8 frag2(const char* base, int off) { return *(const bf16x8*)(base + off); }
__device__ __forceinline__ void gdn_scan_item(const Args& a, int layer, int b, int h, char* smem) {
    using namespace gs;
    unsigned char* ws = a.ws; { size_t z_ = 0; asm volatile("" : "+s"(z_)); ws += z_; }
    int tid_ = threadIdx.x; asm volatile("" : "+v"(tid_));
    const int tid = tid_, lane = tid & 63, wid = __builtin_amdgcn_readfirstlane(tid >> 6), r = lane & 15, g = lane >> 4, e0 = 16 * wid;
    const bf16_t* qkv = (const bf16_t*)(ws + OFF_QKV); const bf16_t* mchunk = (const bf16_t*)(ws + M_CHUNK);
    const bf16_t* TQ = (const bf16_t*)(ws + OFF_TQ); const bf16_t* mTQ = (const bf16_t*)(ws + M_TQ);
    const float* ng = a.in[I_A_OUT_NORM] + layer * 128;
    const float ng1 = ng[lane], ng2 = ng[lane + 64];
    f32x4 S[8];
#pragma unroll
    for (int i = 0; i < 8; ++i) S[i] = (f32x4){0.f, 0.f, 0.f, 0.f};
    u32x4 pk[2], pq[2], pv[2], pt, pqk; float psc = 0.f;
#define GS_LOAD(n) do { const int n_ = (n); \
        const bf16_t* qb_ = n_ == 0 ? mchunk : qkv + (size_t)(b * 2048 + 64 * (n_ - 1)) * 1536; \
        const bf16_t* tq_ = n_ == 0 ? mTQ + h * 8192 : TQ + (size_t)((b * 32 + n_ - 1) * 4 + h) * 8192; \
        const float* gc_ = n_ == 0 ? (const float*)(ws + M_GC) : (const float*)(ws + OFF_GC) + (size_t)(b * 2048 + 64 * (n_ - 1)) * 4; \
        const float* bt_ = n_ == 0 ? (const float*)(ws + M_BETA) : (const float*)(ws + OFF_BETA) + (size_t)(b * 2048 + 64 * (n_ - 1)) * 4; \
        _Pragma("unroll") for (int i_ = 0; i_ < 2; ++i_) { const int p_ = tid + 512 * i_, cr_ = p_ >> 4, d0_ = (p_ & 15) * 8; const bf16_t* rp_ = qb_ + (size_t)cr_ * 1536 + h * 128 + d0_; \
            pq[i_] = *(const u32x4*)rp_; pk[i_] = *(const u32x4*)(rp_ + 512); pv[i_] = *(const u32x4*)(rp_ + 1024); } \
        pt = *(const u32x4*)(tq_ + (tid >> 3) * 64 + (tid & 7) * 8); pqk = *(const u32x4*)(tq_ + 4096 + (tid >> 3) * 64 + (tid & 7) * 8); \
        if (tid < 64) psc = gc_[tid * 4 + h]; else if (tid < 128) psc = bt_[(tid - 64) * 4 + h]; } while (0)
    GS_LOAD(0);
    for (int n = 0; n < 33; ++n) {
#pragma unroll
        for (int i = 0; i < 2; ++i) { const int p = tid + 512 * i, cr = p >> 4, d0 = (p & 15) * 8;
            { const int u = (d0 >> 3) & 3, pa = (d0 & ~31) + 16 * (u & 1) + 4 * (u >> 1);
              *(u32x2*)(smem + KN_OFF + cr * 272 + pa * 2) = (u32x2){pk[i].x, pk[i].y}; *(u32x2*)(smem + KN_OFF + cr * 272 + (pa + 8) * 2) = (u32x2){pk[i].z, pk[i].w};
              *(u32x2*)(smem + QN_OFF + cr * 272 + pa * 2) = (u32x2){pq[i].x, pq[i].y}; *(u32x2*)(smem + QN_OFF + cr * 272 + (pa + 8) * 2) = (u32x2){pq[i].z, pq[i].w}; }
            const int cp = (cr & ~31) + 8 * ((cr >> 2) & 3) + 4 * ((cr >> 4) & 1) + (cr & 3);
            bf16_t* kt = (bf16_t*)(smem + KT_OFF) + d0 * 72 + cp; bf16_t* vt = (bf16_t*)(smem + VT_OFF) + d0 * 72 + cp;
            const unsigned kw[4] = {pk[i].x, pk[i].y, pk[i].z, pk[i].w}, vw[4] = {pv[i].x, pv[i].y, pv[i].z, pv[i].w};
#pragma unroll
            for (int jj = 0; jj < 4; ++jj) { kt[(2 * jj) * 72] = (bf16_t)(kw[jj] & 0xffffu); kt[(2 * jj + 1) * 72] = (bf16_t)(kw[jj] >> 16);
                vt[(2 * jj) * 72] = (bf16_t)(vw[jj] & 0xffffu); vt[(2 * jj + 1) * 72] = (bf16_t)(vw[jj] >> 16); } }
        { const int c0 = (tid & 7) * 8, u = (c0 >> 3) & 3, pa = (c0 & ~31) + 16 * (u & 1) + 4 * (u >> 1), ro = (tid >> 3) * 144;
          *(u32x2*)(smem + TT_OFF + ro + pa * 2) = (u32x2){pt.x, pt.y}; *(u32x2*)(smem + TT_OFF + ro + (pa + 8) * 2) = (u32x2){pt.z, pt.w};
          *(u32x2*)(smem + QK_OFF + ro + pa * 2) = (u32x2){pqk.x, pqk.y}; *(u32x2*)(smem + QK_OFF + ro + (pa + 8) * 2) = (u32x2){pqk.z, pqk.w}; }
        if (tid < 64) ((float*)(smem + GC_OFF))[tid] = psc; else if (tid < 128) ((float*)(smem + BT_OFF))[tid - 64] = psc;
        __syncthreads();
        if (n < 32) GS_LOAD(n + 1);
        bf16_t zz1[8], zz2[8];
#pragma unroll
        for (int i = 0; i < 8; ++i) { const int c = 8 * wid + i; const bf16_t* zp;
            if (n == 0) zp = (const bf16_t*)(ws + M_Z) + (c >= 48 ? c - 48 : 0) * 512 + h * 128;
            else zp = (const bf16_t*)(ws + OFF_Z) + ((size_t)b * 2048 + 64 * (n - 1) + c) * 512 + h * 128;
            zz1[i] = zp[lane]; zz2[i] = zp[lane + 64]; }
        const float* GC = (const float*)(smem + GC_OFF); const float* BT = (const float*)(smem + BT_OFF);
        bf16x8 Sb[4];
#pragma unroll
        for (int s = 0; s < 4; ++s) Sb[s] = as_bf8(pack8(S[2 * s], S[2 * s + 1]));
        f32x4 X[4], P[4];
#pragma unroll
        for (int mt = 0; mt < 4; ++mt) { X[mt] = (f32x4){0.f, 0.f, 0.f, 0.f}; P[mt] = (f32x4){0.f, 0.f, 0.f, 0.f};
#pragma unroll
            for (int s = 0; s < 4; ++s) { const int off = (16 * mt + r) * 272 + (32 * s + 8 * g) * 2;
                X[mt] = mfma16(frag2(smem + KN_OFF, off), Sb[s], X[mt]); P[mt] = mfma16(frag2(smem + QN_OFF, off), Sb[s], P[mt]); } }
        f32x4 Rr[4], eg[4], gcv[4];
#pragma unroll
        for (int mt = 0; mt < 4; ++mt) { const int c0 = 16 * mt + 4 * g; gcv[mt] = *(const f32x4*)(GC + c0); const f32x4 bt4 = *(const f32x4*)(BT + c0);
            const u32x2 vt = *(const u32x2*)(smem + VT_OFF + (e0 + r) * 144 + (32 * (mt >> 1) + 8 * g + 4 * (mt & 1)) * 2);
            const float vv[4] = {bflo(vt.x), bfhi(vt.x), bflo(vt.y), bfhi(vt.y)};
#pragma unroll
            for (int rr = 0; rr < 4; ++rr) { eg[mt][rr] = __expf(gcv[mt][rr]); Rr[mt][rr] = bt4[rr] * (vv[rr] - eg[mt][rr] * X[mt][rr]); } }
        bf16x8 Rb[2] = {as_bf8(pack8(Rr[0], Rr[1])), as_bf8(pack8(Rr[2], Rr[3]))};
        f32x4 Vn[4];
#pragma unroll
        for (int mt = 0; mt < 4; ++mt) { Vn[mt] = (f32x4){0.f, 0.f, 0.f, 0.f};
#pragma unroll
            for (int s = 0; s < 2; ++s) Vn[mt] = mfma16(frag2(smem + TT_OFF, (16 * mt + r) * 144 + (32 * s + 8 * g) * 2), Rb[s], Vn[mt]); }
        bf16x8 Vnb[2] = {as_bf8(pack8(Vn[0], Vn[1])), as_bf8(pack8(Vn[2], Vn[3]))};
        const float glast = GC[63];
        f32x4 O[4], Vp[4];
#pragma unroll
        for (int mt = 0; mt < 4; ++mt) {
#pragma unroll
            for (int rr = 0; rr < 4; ++rr) { O[mt][rr] = P[mt][rr] * eg[mt][rr]; Vp[mt][rr] = Vn[mt][rr] * __expf(glast - gcv[mt][rr]); }
#pragma unroll
            for (int s = 0; s < 2; ++s) O[mt] = mfma16(frag2(smem + QK_OFF, (16 * mt + r) * 144 + (32 * s + 8 * g) * 2), Vnb[s], O[mt]); }
        bf16x8 Vpb[2] = {as_bf8(pack8(Vp[0], Vp[1])), as_bf8(pack8(Vp[2], Vp[3]))};
        const float egl = __expf(glast);
#pragma unroll
        for (int dt = 0; dt < 8; ++dt) { S[dt] = S[dt] * egl;
#pragma unroll
            for (int s = 0; s < 2; ++s) S[dt] = mfma16(frag2(smem + KT_OFF, (16 * dt + r) * 144 + (32 * s + 8 * g) * 2), Vpb[s], S[dt]); }
        float* OT = (float*)(smem + OT_OFF);
#pragma unroll
        for (int mt = 0; mt < 4; ++mt)
#pragma unroll
            for (int rr = 0; rr < 4; ++rr) OT[(16 * mt + 4 * g + rr) * 132 + e0 + r] = O[mt][rr];
        __syncthreads();
#pragma unroll
        for (int i = 0; i < 8; ++i) { const int c = 8 * wid + i;
            const float o1 = OT[c * 132 + lane], o2 = OT[c * 132 + lane + 64];
            const float ss = wave_sum(o1 * o1 + o2 * o2), rstd = rsqrtf(ss * (1.f / 128.f) + EPSF);
            bf16_t* op; bool wrt;
            if (n == 0) { wrt = (b == 0 && c >= 48); op = (bf16_t*)(ws + M_OAB) + (c - 48) * 1024 + h * 128; }
            else { const size_t row = (size_t)b * 2048 + 64 * (n - 1) + c; op = (bf16_t*)(ws + OFF_OAB) + row * 1024 + h * 128; wrt = true; }
            if (wrt) { op[lane] = f2bf(o1 * rstd * ng1 * silu_f(bf2f(zz1[i]))); op[lane + 64] = f2bf(o2 * rstd * ng2 * silu_f(bf2f(zz2[i]))); } }
    }
#undef GS_LOAD
    __syncthreads();
}

#ifndef DSASEL
#define DSASEL 3
#endif
#ifndef DSA_REP
#define DSA_REP 0
#endif
namespace da {
constexpr int SC_PITCH = 2112, SC_OFF = 0, MASK_OFF = 16 * SC_PITCH * 4, IWL_OFF = MASK_OFF + 64 * 34 * 8, END_OFF = IWL_OFF + 64 * 8 * 4;
constexpr int KSEL = 272;
static_assert(END_OFF + 8 * 128 * 4 <= LDS_XB - 16, "dsa lds");
constexpr float SCALE = 0.088388347648318440f, THR = 8.f;
constexpr int SHM_V = 64 * 128 * 2, SHM_K = 64 * 128 * 2;
#define KSWZ(row, colB) ((row) * 256 + ((colB) ^ (((row) & 7) << 4)))
#define SBAR() __builtin_amdgcn_sched_barrier(0)
__device__ __forceinline__ int crow(int r, int hi) { return (r & 3) + 8 * (r >> 2) + 4 * hi; }
__device__ __forceinline__ void partialSM(f32x16& p0, f32x16& p1, float& m_reg, float& mn, float& alpha) {
  constexpr float C = SCALE * 1.4426950408889634f;
  float pmax = p0[0]; for (int r = 1; r < 16; ++r) pmax = fmaxf(pmax, p0[r]); for (int r = 0; r < 16; ++r) pmax = fmaxf(pmax, p1[r]);
  { auto rr = __builtin_amdgcn_permlane32_swap(__float_as_uint(pmax), __float_as_uint(pmax), false, false);
    pmax = fmaxf(__uint_as_float(rr[0]), __uint_as_float(rr[1])); }
  if (__builtin_expect(__all(pmax - m_reg <= THR / SCALE), 1)) { mn = m_reg; alpha = 1.f; }
  else { mn = fmaxf(m_reg, pmax); alpha = __builtin_amdgcn_exp2f((m_reg - mn) * C); m_reg = mn; }
  float mnC = -mn * C;
  for (int r = 0; r < 16; ++r) p0[r] = fmaf(p0[r], C, mnC); for (int r = 0; r < 16; ++r) p1[r] = fmaf(p1[r], C, mnC);
  for (int r = 0; r < 16; ++r) p0[r] = __builtin_amdgcn_exp2f(p0[r]);
}
__device__ __forceinline__ void finishSM(f32x16& p0, f32x16& p1, float alpha, float& l_reg, bf16x8& pa0, bf16x8& pa1, bf16x8& pa2, bf16x8& pa3) {
  for (int r = 0; r < 16; ++r) p1[r] = __builtin_amdgcn_exp2f(p1[r]);
  float ps = 0; for (int r = 0; r < 16; ++r) ps += p0[r]; for (int r = 0; r < 16; ++r) ps += p1[r];
  { auto rr = __builtin_amdgcn_permlane32_swap(__float_as_uint(ps), __float_as_uint(ps), false, false);
    ps = __uint_as_float(rr[0]) + __uint_as_float(rr[1]); }
  l_reg = l_reg * alpha + ps;
#define PK4(P, BASE, OUT) do { unsigned a0 = cvt_pk(P[BASE + 0], P[BASE + 1]), a1 = cvt_pk(P[BASE + 2], P[BASE + 3]);   \
    unsigned b0 = cvt_pk(P[BASE + 4], P[BASE + 5]), b1 = cvt_pk(P[BASE + 6], P[BASE + 7]);                              \
    auto r0 = __builtin_amdgcn_permlane32_swap(a0, b0, false, false); auto r1 = __builtin_amdgcn_permlane32_swap(a1, b1, false, false); \
    u32x4 w = {r0[0], r1[0], r0[1], r1[1]}; OUT = as_bf8(w); } while (0)
  PK4(p0, 0, pa0); PK4(p0, 8, pa1); PK4(p1, 0, pa2); PK4(p1, 8, pa3);
#undef PK4
}
__device__ __forceinline__ void qkt(f32x16& p0, f32x16& p1, const char* Ks, const bf16x8* qr, int r32, int hi) {
  p0 = f32x16{}; p1 = f32x16{};
  for (int d0 = 0; d0 < 8; ++d0) { int cb = (d0 * 16 + hi * 8) * 2;
    bf16x8 b0 = *reinterpret_cast<const bf16x8*>(Ks + KSWZ(r32, cb));
    bf16x8 b1 = *reinterpret_cast<const bf16x8*>(Ks + KSWZ(32 + r32, cb));
    p0 = __builtin_amdgcn_mfma_f32_32x32x16_bf16(b0, qr[d0], p0, 0, 0, 0);
    p1 = __builtin_amdgcn_mfma_f32_32x32x16_bf16(b1, qr[d0], p1, 0, 0, 0); }
}
__device__ __forceinline__ void maskp(f32x16& p0, f32x16& p1, const char* mrow, int tile, int hi) {
  const u32x2 mw = *(const u32x2*)(mrow + tile * 8); const unsigned w0 = mw.x >> (4 * hi), w1 = mw.y >> (4 * hi);
#pragma unroll
  for (int r = 0; r < 16; ++r) { const int bit = (r & 3) + 8 * (r >> 2);
    p0[r] = ((w0 >> bit) & 1u) ? p0[r] : -1e30f; p1[r] = ((w1 >> bit) & 1u) ? p1[r] : -1e30f; }
}
__device__ __forceinline__ int v_st(int k, int c) { const int kk = (k & ~0xC) | ((k & 4) << 1) | ((k & 8) >> 1); return ((kk >> 3) * 4 + (c >> 5)) * 512 + ((kk & 7) * 32 + (c & 31)) * 2; }
__device__ __forceinline__ int v_rd_base(int lane) { return ((lane & 3) << 3) | (((lane >> 2) & 3) << 6) | (((lane >> 4) & 1) << 5) | (((lane >> 5) & 1) << 8); }
constexpr int v_rd_off(int d0, int ks, int half) { return d0 * 512 + ks * 4096 + half * 2048; }
template <int OFF> __device__ __forceinline__ s16x4 tr_read(int vb) {
  s16x4 r; asm volatile("ds_read_b64_tr_b16 %0, %1 offset:%2" : "=&v"(r) : "v"(vb), "i"(OFF) : "memory"); return r;
}
template <int D0> __device__ __forceinline__ void pv_one(f32x16& od, int vb, bf16x8 pa0, bf16x8 pa1, bf16x8 pa2, bf16x8 pa3) {
  const s16x4 l0 = tr_read<v_rd_off(D0, 0, 0)>(vb), h0 = tr_read<v_rd_off(D0, 0, 1)>(vb), l1 = tr_read<v_rd_off(D0, 1, 0)>(vb), h1 = tr_read<v_rd_off(D0, 1, 1)>(vb);
  const s16x4 l2 = tr_read<v_rd_off(D0, 2, 0)>(vb), h2 = tr_read<v_rd_off(D0, 2, 1)>(vb), l3 = tr_read<v_rd_off(D0, 3, 0)>(vb), h3 = tr_read<v_rd_off(D0, 3, 1)>(vb);
  asm volatile("s_waitcnt lgkmcnt(0)" ::: "memory"); SBAR();
#define PK(L, H) (bf16x8){L[0], L[1], L[2], L[3], H[0], H[1], H[2], H[3]}
  od = __builtin_amdgcn_mfma_f32_32x32x16_bf16(pa0, PK(l0, h0), od, 0, 0, 0);
  od = __builtin_amdgcn_mfma_f32_32x32x16_bf16(pa1, PK(l1, h1), od, 0, 0, 0);
  od = __builtin_amdgcn_mfma_f32_32x32x16_bf16(pa2, PK(l2, h2), od, 0, 0, 0);
  od = __builtin_amdgcn_mfma_f32_32x32x16_bf16(pa3, PK(l3, h3), od, 0, 0, 0);
#undef PK
}
__device__ __forceinline__ void pv_d0(f32x16* o, int vb, bf16x8 pa0, bf16x8 pa1, bf16x8 pa2, bf16x8 pa3) {
  pv_one<0>(o[0], vb, pa0, pa1, pa2, pa3); pv_one<1>(o[1], vb, pa0, pa1, pa2, pa3); pv_one<2>(o[2], vb, pa0, pa1, pa2, pa3); pv_one<3>(o[3], vb, pa0, pa1, pa2, pa3);
}
__device__ __forceinline__ void attn_body(const bf16_t* Qb, const bf16_t* Kh, const bf16_t* Vh, bf16_t* Ob, int NT, const char* maskbase, char* lds) {
  int tid_ = threadIdx.x; asm volatile("" : "+v"(tid_));
  const int tid = tid_, wid = tid >> 6, lane = tid & 63, r32 = lane & 31, hi = lane >> 5;
  char* V_lds = lds; char* K_lds = lds + 2 * SHM_V;
  float* wsf = (float*)(lds + 2 * SHM_V + 2 * SHM_K) + wid * 64; float* li_l = wsf; float* al_l = wsf + 32;
  float m_reg = -1e30f, l_reg = 0; f32x16 o[4] = {}; bf16x8 qr[8];
  const int head = wid >> 1, qloc0 = (wid & 1) * 32;
  const char* mrow = maskbase + (qloc0 + r32) * (34 * 8);
  const bf16_t* Qw = Qb + (size_t)(qloc0 + r32) * 512 + head * 128 + hi * 8;
#pragma unroll
  for (int d0 = 0; d0 < 8; ++d0) qr[d0] = *(const bf16x8*)(Qw + d0 * 16);
  const int sr = tid >> 4, sc = (tid & 15) * 8;
  const int vb0 = (int)(uintptr_t)V_lds + v_rd_base(lane);
  struct { bf16x8 vs0, vs1, ks0, ks1; } sr_[2];
#define SLOAD(i, k0) do { sr_[i].vs0 = *(const bf16x8*)(&Vh[(long)((k0) + sr) * 128 + sc]); sr_[i].vs1 = *(const bf16x8*)(&Vh[(long)((k0) + 32 + sr) * 128 + sc]); \
    sr_[i].ks0 = *(const bf16x8*)(&Kh[(long)((k0) + sr) * 128 + sc]); sr_[i].ks1 = *(const bf16x8*)(&Kh[(long)((k0) + 32 + sr) * 128 + sc]); } while (0)
#define SWRITE(b, i) do { int t_ = tid; asm volatile("" : "+v"(t_)); const int sr_w = t_ >> 4, sc_w = (t_ & 15) * 8;     \
    *(bf16x8*)(V_lds + (b) * SHM_V + v_st(sr_w, sc_w)) = sr_[i].vs0;          \
    *(bf16x8*)(V_lds + (b) * SHM_V + v_st(32 + sr_w, sc_w)) = sr_[i].vs1; int kc = sc_w * 2;               \
    *(bf16x8*)(K_lds + (b) * SHM_K + KSWZ(sr_w, kc)) = sr_[i].ks0;                       \
    *(bf16x8*)(K_lds + (b) * SHM_K + KSWZ(32 + sr_w, kc)) = sr_[i].ks1; } while (0)
#define SWAIT() asm volatile("s_waitcnt vmcnt(4)" ::: "memory")
#define RESC(a) do { if (__any((a) < 1.f)) { if (hi == 0) al_l[r32] = (a); asm volatile("s_waitcnt lgkmcnt(0)" ::: "memory"); \
    for (int d = 0; d < 4; ++d) for (int r = 0; r < 16; ++r) o[d][r] *= al_l[crow(r, hi)]; } } while (0)
  f32x16 pA0, pA1, pB0, pB1; float mnA, mnB, alA, alB; bf16x8 pa0, pa1, pa2, pa3;
  constexpr int SE = 0, SO = 1;
  SLOAD(SE, 0); asm volatile("s_waitcnt vmcnt(0)" ::: "memory"); SWRITE(0, SE); __syncthreads();
  qkt(pA0, pA1, K_lds, qr, r32, hi); maskp(pA0, pA1, mrow, 0, hi); partialSM(pA0, pA1, m_reg, mnA, alA);
  SLOAD(SO, 64); if (2 < NT) SLOAD(SE, 2 * 64);
  SWAIT(); SWRITE(1, SO); __syncthreads();
  for (int j = 1; j + 1 < NT; j += 2) {
    SBAR(); qkt(pB0, pB1, K_lds + SHM_K, qr, r32, hi); maskp(pB0, pB1, mrow, j, hi);
    finishSM(pA0, pA1, alA, l_reg, pa0, pa1, pa2, pa3); SBAR();
    SLOAD(SO, (j + 2) * 64); SBAR();
    pv_d0(o, vb0, pa0, pa1, pa2, pa3); partialSM(pB0, pB1, m_reg, mnB, alB);
    __syncthreads(); SWAIT(); SWRITE(0, SE);
    RESC(alB); __syncthreads();
    SBAR(); qkt(pA0, pA1, K_lds, qr, r32, hi); maskp(pA0, pA1, mrow, j + 1, hi);
    finishSM(pB0, pB1, alB, l_reg, pa0, pa1, pa2, pa3); SBAR();
    if (j + 3 < NT) SLOAD(SE, (j + 3) * 64); SBAR();
    pv_d0(o, vb0 + SHM_V, pa0, pa1, pa2, pa3); partialSM(pA0, pA1, m_reg, mnA, alA);
    __syncthreads(); SWAIT(); SWRITE(1, SO);
    RESC(alA); __syncthreads();
  }
  SBAR(); qkt(pB0, pB1, K_lds + SHM_K, qr, r32, hi); maskp(pB0, pB1, mrow, NT - 1, hi);
  finishSM(pA0, pA1, alA, l_reg, pa0, pa1, pa2, pa3); SBAR();
  pv_d0(o, vb0, pa0, pa1, pa2, pa3); partialSM(pB0, pB1, m_reg, mnB, alB);
  __syncthreads(); RESC(alB);
  finishSM(pB0, pB1, alB, l_reg, pa0, pa1, pa2, pa3); SBAR();
  pv_d0(o, vb0 + SHM_V, pa0, pa1, pa2, pa3);
  if (hi == 0) li_l[r32] = l_reg; asm volatile("s_waitcnt lgkmcnt(0)" ::: "memory");
  float rli[16];
#pragma unroll
  for (int r = 0; r < 16; ++r) rli[r] = __builtin_amdgcn_rcpf(li_l[crow(r, hi)]);
#pragma unroll
  for (int r = 0; r < 16; ++r) { bf16_t* orow = Ob + (size_t)(qloc0 + crow(r, hi)) * 1024 + head * 128 + r32;
#pragma unroll
    for (int d0 = 0; d0 < 4; ++d0) orow[d0 * 32] = f2bf(o[d0][r] * rli[r]); }
  asm volatile("s_waitcnt vmcnt(0)" ::: "memory");
#undef SLOAD
#undef SWRITE
#undef SWAIT
#undef RESC
}
__device__ __forceinline__ int wave_total(int x) {
    x += __builtin_amdgcn_update_dpp(0, x, 0x128, 0xf, 0xf, false);
    x += __builtin_amdgcn_update_dpp(0, x, 0x124, 0xf, 0xf, false);
    x += __builtin_amdgcn_update_dpp(0, x, 0x122, 0xf, 0xf, false);
    x += __builtin_amdgcn_update_dpp(0, x, 0x121, 0xf, 0xf, false);
    return __builtin_amdgcn_readlane(x, 0) + __builtin_amdgcn_readlane(x, 16) + __builtin_amdgcn_readlane(x, 32) + __builtin_amdgcn_readlane(x, 48);
}
__device__ __forceinline__ unsigned ordkey(float x) { const unsigned b = __float_as_uint(x); return (b & 0x80000000u) ? ~b : (b | 0x80000000u); }
typedef unsigned short us2_t __attribute__((ext_vector_type(2)));
template <int NTW> __device__ __forceinline__ void select2_t(const float* scA, const float* scB, unsigned long long* mrowA, unsigned long long* mrowB, int NT, int NTe, int lane, unsigned* cand) {
    constexpr int NP2 = (NTW + 1) / 2;
    unsigned ua[NTW], ub[NTW];
#pragma unroll
    for (int i = 0; i < NTW; ++i) { ua[i] = (i < NT) ? ordkey(scA[64 * i + lane]) : 0u; ub[i] = (i < NT) ? ordkey(scB[64 * i + lane]) : 0u; }
    unsigned pa[NP2], pb[NP2];
#pragma unroll
    for (int p = 0; p < NP2; ++p) { const unsigned a0 = ua[2 * p] >> 17, a1 = (2 * p + 1 < NTW) ? (ua[2 * p + 1 < NTW ? 2 * p + 1 : 0] >> 17) : 0u, b0 = ub[2 * p] >> 17, b1 = (2 * p + 1 < NTW) ? (ub[2 * p + 1 < NTW ? 2 * p + 1 : 0] >> 17) : 0u;
        pa[p] = (a0 | 0x8000u) | ((a1 | 0x8000u) << 16); pb[p] = (b0 | 0x8000u) | ((b1 | 0x8000u) << 16); }
    unsigned ta = 0u, tb = 0u; int gea = 64 * NTW, geb = 64 * NTW;
#pragma unroll 1
    for (int bit = 14; bit >= 0; --bit) { const unsigned ca = ta | (1u << bit), cb = tb | (1u << bit); const unsigned ca2 = ca | (ca << 16), cb2 = cb | (cb << 16);
        unsigned sa = 0u, sb = 0u; int na = 0, nb = 0;
#pragma unroll
        for (int p = 0; p < NP2; ++p) {
            const unsigned da = __builtin_bit_cast(unsigned, __builtin_bit_cast(us2_t, pa[p]) - __builtin_bit_cast(us2_t, ca2)), db = __builtin_bit_cast(unsigned, __builtin_bit_cast(us2_t, pb[p]) - __builtin_bit_cast(us2_t, cb2));
            sa = (sa >> 1) | (da & 0x80008000u); sb = (sb >> 1) | (db & 0x80008000u);
            if ((p & 15) == 15) { na += __popc(sa); nb += __popc(sb); sa = 0u; sb = 0u; } }
        na = wave_total(na + __popc(sa)); nb = wave_total(nb + __popc(sb));
        if (na >= KSEL) { ta = ca; gea = na; } if (nb >= KSEL) { tb = cb; geb = nb; } }
#pragma unroll 1
    for (int q = 0; q < 2; ++q) {
        unsigned long long* mrow = q ? mrowB : mrowA; const unsigned t15 = q ? tb : ta;
        unsigned u[NTW];
#pragma unroll
        for (int i = 0; i < NTW; ++i) u[i] = q ? ub[i] : ua[i];
        int ncand = 0;
#pragma unroll
        for (int i = 0; i < NTW; ++i) { const unsigned long long mc = __ballot((u[i] >> 17) == t15);
            if (mc) { const int idx = ncand + (int)__builtin_amdgcn_mbcnt_hi((unsigned)(mc >> 32), __builtin_amdgcn_mbcnt_lo((unsigned)mc, 0u));
                if (((u[i] >> 17) == t15) && idx < 128) cand[idx] = (u[i] & 0x1FFFFu) + 1u; }
            ncand += __popcll(mc); }
        const int ngt = (q ? geb : gea) - ncand;
        const int kk = KSEL - ngt;
        unsigned t;
#ifndef CAND_CAP
#define CAND_CAP 128
#endif
        if (ncand <= CAND_CAP) {
            asm volatile("s_waitcnt lgkmcnt(0)" ::: "memory");
            const unsigned c0 = lane < ncand ? cand[lane] : 0u, c1 = lane + 64 < ncand ? cand[lane + 64] : 0u;
            unsigned tl = 0u;
            for (int bit = 17; bit >= 0; --bit) { const unsigned cc = tl | (1u << bit); const int n = __popcll(__ballot(c0 >= cc)) + __popcll(__ballot(c1 >= cc)); if (n >= kk) tl = cc; }
            t = (t15 << 17) | (tl - 1u);
        } else {
            int tt = (int)(t15 << 16);
            for (int bit = 15; bit >= 0; --bit) { const int cc = tt | (1 << bit); int n = 0;
#pragma unroll
                for (int i = 0; i < NTW; ++i) n += __popcll(__ballot((int)(u[i] >> 1) >= cc));
                if (n >= KSEL) tt = cc; }
            t = ((unsigned)tt << 1) | 1u; int n1 = 0;
#pragma unroll
            for (int i = 0; i < NTW; ++i) n1 += __popcll(__ballot(u[i] >= t));
            if (n1 < KSEL) t -= 1u;
        }
        int tot = 0;
#pragma unroll
        for (int i = 0; i < NTW; ++i) { const unsigned long long w = __ballot(u[i] >= t); tot += __popcll(w); if (i < NT && lane == 0) mrow[i] = w; }
        if (tot > KSEL) {
            int need = KSEL;
#pragma unroll
            for (int i = 0; i < NTW; ++i) need -= __popcll(__ballot(u[i] > t));
#pragma unroll
            for (int i = 0; i < NTW; ++i) {
                unsigned long long w = __ballot(u[i] > t); unsigned long long e = __ballot(u[i] == t);
                if (need > 0 && e) { const int pe = __popcll(e); if (pe <= need) { w |= e; need -= pe; } else { while (need > 0) { const unsigned long long low = e & (~e + 1ull); w |= low; e ^= low; --need; } } }
                if (i < NT && lane == 0) mrow[i] = w; } }
        if (NTe > NT && lane == 0) mrow[NT] = 0ull;
    }
}
__device__ __forceinline__ void select2(const float* scA, const float* scB, unsigned long long* mrowA, unsigned long long* mrowB, int NT, int NTe, int NP, int lane, unsigned* cand) {
    if (NP <= KSEL) {
        for (int i = 0; i < NTe; ++i) { const int lo = 64 * i; const unsigned long long w = (lo + 64 <= NP) ? ~0ull : (lo >= NP ? 0ull : ((1ull << (NP - lo)) - 1ull)); if (lane == 0) { mrowA[i] = w; mrowB[i] = w; } }
        return;
    }
    if (NT <= 9) select2_t<9>(scA, scB, mrowA, mrowB, NT, NTe, lane, cand);
    else if (NT <= 17) select2_t<17>(scA, scB, mrowA, mrowB, NT, NTe, lane, cand);
    else if (NT <= 25) select2_t<25>(scA, scB, mrowA, mrowB, NT, NTe, lane, cand);
    else select2_t<33>(scA, scB, mrowA, mrowB, NT, NTe, lane, cand);
}
__device__ __forceinline__ void dsa_item(const Args& a, int b, int j, char* smem, int dry = 0) {
    unsigned char* ws = a.ws; { size_t z_ = 0; asm volatile("" : "+s"(z_)); ws += z_; }
    int tid_ = threadIdx.x; asm volatile("" : "+v"(tid_));
    const int tid = tid_, lane = tid & 63, wid = __builtin_amdgcn_readfirstlane(tid >> 6), hi = lane >> 5;
    const int limit = 64 * (j + 1), NP = 16 + limit, NT = j + 2, NTe = (NT + 1) & ~1, row0 = b * 2048 + 64 * j;
    const bf16_t* iq = (const bf16_t*)(ws + OFF_IQ); const bf16_t* ikb = (const bf16_t*)(ws + OFF_IKB); const float* misc = (const float*)(ws + OFF_MISC);
    float* SC = (float*)(smem + SC_OFF); float* IWL = (float*)(smem + IWL_OFF); unsigned long long* MASK = (unsigned long long*)(smem + MASK_OFF);
    { const int q = tid >> 3, hh = tid & 7; IWL[tid] = misc[(size_t)(row0 + q) * 16 + 8 + hh] * 0.044194173824159216f; }
    bf16x8 af[4][4];
#define DSA_AF_LOAD(sb) do { const int rho = lane & 31, qq = 2 * ((rho >> 2) & 1) + (rho >> 4), hh = 4 * ((rho >> 3) & 1) + (rho & 3); \
        _Pragma("unroll") for (int mt = 0; mt < 4; ++mt) _Pragma("unroll") for (int ks = 0; ks < 4; ++ks) \
            af[mt][ks] = *(const bf16x8*)(iq + (size_t)(row0 + (sb) * 16 + 4 * mt + qq) * 512 + hh * 64 + 16 * ks + 8 * hi); } while (0)
    DSA_AF_LOAD(0);
    if ((DSASEL & 1) && !(dry & 1)) for (int sub = 0; sub < 4; ++sub) {
        for (int p = tid; p < 16 * 16; p += 512) SC[(p >> 4) * SC_PITCH + (p & 15)] = __builtin_inff();
        for (int p = tid; p < 16 * 48; p += 512) { const int q = p / 48, x = p - q * 48; SC[q * SC_PITCH + NP + x] = -__builtin_inff(); }
        __syncthreads();
        for (int rep_i = 0; rep_i < 1 + (DSA_REP & 1); ++rep_i) {
        const bf16_t* ikp = ikb + ((size_t)b * TP + 16 + (lane & 31)) * 64 + 8 * hi;
        bf16x8 bnx[4];
        { const int kt0 = wid < 2 * (j + 1) ? wid : 0;
#pragma unroll
          for (int ks = 0; ks < 4; ++ks) bnx[ks] = *(const bf16x8*)(ikp + (size_t)(32 * kt0) * 64 + 16 * ks); }
        for (int kt = wid; kt < 2 * (j + 1); kt += 8) {
            bf16x8 bfr[4];
#pragma unroll
            for (int ks = 0; ks < 4; ++ks) bfr[ks] = bnx[ks];
            { const int ktn = (kt + 8 < 2 * (j + 1)) ? kt + 8 : kt;
#pragma unroll
              for (int ks = 0; ks < 4; ++ks) bnx[ks] = *(const bf16x8*)(ikp + (size_t)(32 * ktn) * 64 + 16 * ks); }
#pragma unroll
            for (int mt = 0; mt < 4; ++mt) {
                f32x16 acc = {};
#pragma unroll
                for (int ks = 0; ks < 4; ++ks) acc = __builtin_amdgcn_mfma_f32_32x32x16_bf16(af[mt][ks], bfr[ks], acc, 0, 0, 0);
                const float* iw0 = IWL + (sub * 16 + 4 * mt + 2 * hi) * 8;
                float s0 = 0.f, s1 = 0.f;
#pragma unroll
                for (int rg = 0; rg < 8; ++rg) { s0 += fmaxf(acc[rg], 0.f) * iw0[rg]; s1 += fmaxf(acc[8 + rg], 0.f) * iw0[8 + rg]; }
                if (s0 == 0.f) s0 = 0.f; if (s1 == 0.f) s1 = 0.f;
                float* sp = SC + (4 * mt + 2 * hi) * SC_PITCH + 16 + 32 * kt + (lane & 31);
                sp[0] = s0; sp[SC_PITCH] = s1;
            }
        }
        }
        if (sub < 3) DSA_AF_LOAD(sub + 1);
        __syncthreads();
#pragma unroll 1
        for (int rep_s = 0; rep_s < 1 + ((DSA_REP >> 1) & 1); ++rep_s)
        { const int ql = 2 * wid; select2(SC + ql * SC_PITCH, SC + (ql + 1) * SC_PITCH, MASK + (sub * 16 + ql) * 34, MASK + (sub * 16 + ql + 1) * 34, NT, NTe, NP, lane, (unsigned*)(smem + END_OFF) + wid * 128); }
        __syncthreads();
    }
#pragma unroll 1
    for (int rep_a = 0; rep_a < 1 + ((DSA_REP >> 2) & 1); ++rep_a)
    if ((DSASEL & 2) && !(dry & 2)) attn_body((const bf16_t*)(ws + OFF_BQ) + (size_t)row0 * 512, (const bf16_t*)(ws + OFF_KB) + (size_t)b * TP * 128, (const bf16_t*)(ws + OFF_VB) + (size_t)b * TP * 128,
              (bf16_t*)(ws + OFF_OAB) + (size_t)row0 * 1024 + 512, NTe, smem + MASK_OFF, smem);
    __syncthreads();
}
__device__ __forceinline__ void dsa_meta_item(const Args& a) {
    unsigned char* ws = a.ws; { size_t z_ = 0; asm volatile("" : "+s"(z_)); ws += z_; }
    int tid_ = threadIdx.x; asm volatile("" : "+v"(tid_));
    if (tid_ >= 64) return;
    const int lane = tid_, q = lane >> 2, h = lane & 3;
    const bf16_t* qp = (const bf16_t*)(ws + M_BQ) + q * 512 + h * 128; const bf16_t* kb = (const bf16_t*)(ws + OFF_KB); const bf16_t* vb = (const bf16_t*)(ws + OFF_VB);
    float s[16]; float mx = -1e30f;
#pragma unroll
    for (int k = 0; k < 16; ++k) { float acc = 0.f; for (int d = 0; d < 128; ++d) acc += bf2f(qp[d]) * bf2f(kb[k * 128 + d]); s[k] = acc * SCALE; mx = fmaxf(mx, s[k]); }
    float l = 0.f;
#pragma unroll
    for (int k = 0; k < 16; ++k) { s[k] = __expf(s[k] - mx); l += s[k]; }
    const float rl = 1.f / l;
    bf16_t* op = (bf16_t*)(ws + M_OAB) + q * 1024 + 512 + h * 128;
    for (int d = 0; d < 128; ++d) { float acc = 0.f;
#pragma unroll
        for (int k = 0; k < 16; ++k) acc += s[k] * bf2f(vb[k * 128 + d]); op[d] = f2bf(acc * rl); }
}
}

__device__ __forceinline__ void p_mixers(const Args& a, int layer_rep, char* smem, int dry = 0) {
    const int layer = layer_rep & 1;
    unsigned* ctr = (unsigned*)(a.ws + OFF_CTL) + CW_QUEUE + 64 * layer_rep;
    int* slot = (int*)(smem + LDS_XB - 16);
    constexpr int NSCAN = NB * 4, NDSA = NB * 32, NITEM = NSCAN + NDSA + 1;
    for (;;) {
        __syncthreads();
        if (threadIdx.x == 0) *slot = (int)__hip_atomic_fetch_add(ctr, 1u, __ATOMIC_RELAXED, __HIP_MEMORY_SCOPE_AGENT);
        __syncthreads();
        const int it = *slot;
        if (it >= NITEM) break;
#ifndef MIXSEL
#define MIXSEL 7
#endif
        if (it == 0) { if ((MIXSEL & 4) && !dry) da::dsa_meta_item(a); }
        else if (it <= NSCAN) { const int si = it - 1; for (int rep_g = 0; rep_g < 1 + ((DSA_REP >> 3) & 1); ++rep_g) if ((MIXSEL & 1) && !(dry & 4)) gdn_scan_item(a, layer, si >> 2, si & 3, smem); }
        else { const int k = it - 1 - NSCAN, j = 31 - (k >> 5), b = k & 31; if (MIXSEL & 2) da::dsa_item(a, b, j, smem, dry); }
    }
}

__device__ __forceinline__ void p_halo(const Args& a, int layer) {
    unsigned char* ws = a.ws; { size_t z_ = 0; asm volatile("" : "+s"(z_)); ws += z_; }
    int tid_ = threadIdx.x; asm volatile("" : "+v"(tid_));
    const int lane = tid_ & 63, wid = tid_ >> 6, r = lane & 15, g = lane >> 4, gw = blockIdx.x * 8 + wid, nW = gridDim.x * 8;
    const bf16_t* hb = (const bf16_t*)(ws + OFF_HB); const bf16_t* WupT = (const bf16_t*)(ws + OFF_WUP) + (size_t)layer * NIN * DM;
    const u64_t* ssq = (const u64_t*)(ws + OFF_SSQ) + (size_t)(2 * layer + 1) * RR; float* hg = (float*)(ws + OFF_HG);
    for (int job = gw; job < 32 * 176; job += nW) {
        const int rt = job & 31, ct = job >> 5;
        const int rowA = ((r >> 1) == 0) ? 0 : 256 * (8 * rt + (r >> 1)) - 2 + (r & 1);
        const bf16_t* ap = hb + (size_t)rowA * DM + g * 8; const bf16_t* bp = WupT + (size_t)(256 * (ct >> 3) + 16 * (ct & 7) + r) * DM + g * 8;
        f32x4 acc = {0.f, 0.f, 0.f, 0.f};
#pragma unroll 8
        for (int k = 0; k < DM; k += 32) acc = mfma16(*(const bf16x8*)(ap + k), *(const bf16x8*)(bp + k), acc);
#pragma unroll
        for (int rr = 0; rr < 4; ++rr) { const int ri = 4 * g + rr;
            if ((ri >> 1) != 0) { const int pmD = 8 * rt + (ri >> 1), rowD = 256 * pmD - 2 + (ri & 1);
                hg[(size_t)(pmD * 2 + (ri & 1)) * DFF + 128 * (ct >> 3) + 16 * (ct & 7) + r] = acc[rr] * rstd_of(ssq, rowD); } }
    }
}
__device__ __forceinline__ void meta_act(const Args& a, int layer) {
    unsigned char* ws = a.ws; { size_t z_ = 0; asm volatile("" : "+s"(z_)); ws += z_; }
    int tid_ = threadIdx.x; asm volatile("" : "+v"(tid_));
    const float* cw = a.in[I_CONV_FFN] + (size_t)layer * 3 * DFF; const float* mgu = (const float*)(ws + M_GU); bf16_t* mact = (bf16_t*)(ws + M_ACT);
    for (int c = blockIdx.x * 512 + tid_; c < DFF; c += gridDim.x * 512) { const int gi = (c >> 7) * 256 + (c & 127); const float w0 = cw[c], w1 = cw[DFF + c], w2 = cw[2 * DFF + c]; float g0 = 0.f, g1 = 0.f;
        for (int t = 0; t < 16; ++t) { const float g2 = mgu[t * 5632 + gi], uu = mgu[t * 5632 + gi + 128]; mact[t * DFF + c] = f2bf(silu_f(w0 * g0 + w1 * g1 + w2 * g2) * uu); g0 = g1; g1 = g2; } }
}

constexpr int NPH = 1 + 8 * NLAYER;
#ifndef ONE_LAUNCH
#define ONE_LAUNCH 0
#endif
#ifndef STAGGER_US
#define STAGGER_US 0
#endif
__device__ __forceinline__ void stagger_delay(int us) {
    if (us > 0 && (blockIdx.x & 1)) { const unsigned long long t0 = __builtin_amdgcn_s_memrealtime(); while (__builtin_amdgcn_s_memrealtime() - t0 < (unsigned long long)us * 100ull) __builtin_amdgcn_s_sleep(8); }
}
__device__ __forceinline__ void meta_y_lds(const unsigned char* ws, char* img) {
    const float* P = (const float*)(ws + M_GU);
    for (int i = threadIdx.x; i < 16 * 1024; i += 512) { const int t = i >> 10, ch = i & 1023, n = 256 * (ch >> 7) + (ch & 127);
        *(bf16_t*)(img + t * MN_PITCH + ch * 2) = f2bf(P[t * 5632 + n] + P[t * 5632 + n + 128]); }
    __syncthreads();
}
template <int L> __device__ __forceinline__ void layer_phases(const Args& a, char* smem, const XcdBarrier& bar, const int lo, const int hi) {
    constexpr int l = L;
    unsigned char* ws0 = a.ws;
    PG8_LAS unsigned char* glds = (PG8_LAS unsigned char*)smem;
    const int G = gridDim.x, bx = blockIdx.x;
#define IN(k) (lo <= (k) && (k) < hi)
#define SEAM(k) do { if (IN(k) && IN((k) + 1)) xcd_barrier(bar); } while (0)
#define OPQ_WS() unsigned char* ws = ws0; { size_t z_ = 0; asm volatile("" : "+s"(z_)); ws += z_; }
#ifndef EN_MASK
#define EN_MASK 0xFFFF
#endif
#ifndef REP_MASK
#define REP_MASK 0
#endif
#define NREP(k) (1 + ((REP_MASK >> (k)) & 1))
    constexpr int pb = 1 + 8 * l;
    for (int rep = 0; rep < NREP(0); ++rep) if (IN(pb + 0)) { OPQ_WS();
        const bf16_t* WinT = (const bf16_t*)(ws + OFF_WIN) + (size_t)l * NIN * DM;
        meta_norm_lds((const float*)(ws + M_H), smem);
        small_gemm16<true>(smem, WinT, NIN, DM, MEpiIn{ws, a.in[I_B_GATE] + l * 2048}, smem + 40960);
        __syncthreads();
        pg8::Gemm g{(const bf16_t*)(ws + OFF_HB), WinT, RR, NIN, DM}; pg8::StaticOrder S; S.init(RR, NIN, G, bx);
        EpiIn E{(bf16_t*)(ws + OFF_QKV), (bf16_t*)(ws + OFF_HALO), (bf16_t*)(ws + OFF_Z), (bf16_t*)(ws + OFF_BQ), (bf16_t*)(ws + OFF_IQ), (bf16_t*)(ws + OFF_KB), (bf16_t*)(ws + OFF_VB),
                (bf16_t*)(ws + OFF_IKB), (float*)(ws + OFF_MISC), (bf16_t*)a.out, a.in[I_B_GATE] + l * 2048, (const u64_t*)(ws + OFF_SSQ) + (size_t)(2 * l) * RR};
        stagger_delay(STAGGER_US);
        pg8::gemm_phase<EpiIn, pg8::StaticOrder>(glds, g, S, E, nullptr);
#if defined(PROBE_DUP_IN)
        pg8::gemm_phase<EpiIn, pg8::StaticOrder>(glds, g, S, E, nullptr);
#endif
    }
    SEAM(pb + 0);
#if defined(PROBE_DRY_PREP)
    if (IN(pb + 1)) p_mixprep(a, l, smem, a.ph_hi == 12345, PROBE_DRY_PREP);
#endif
    if (IN(pb + 1)) p_mixprep(a, l, smem, true);
    SEAM(pb + 1);
#if defined(PROBE_DRYMIX)
    if (IN(pb + 2)) p_mixers(a, l + 2, smem, PROBE_DRYMIX);
#endif
    for (int rep = 0; rep < NREP(2); ++rep) if (IN(pb + 2)) p_mixers(a, l + 2 * rep, smem);
    SEAM(pb + 2);
    for (int rep = 0; rep < NREP(3); ++rep) if (IN(pb + 3)) { OPQ_WS();
        const bf16_t* WbrT = (const bf16_t*)(ws + OFF_WBR) + (size_t)l * 2048 * DM;
        small_gemm16<false>((const bf16_t*)(ws + M_OAB), WbrT, 2048, DM, MEpiBr{ws, DBG_NO_GDN ? 0.f : 1.f, DBG_NO_DSA ? 0.f : 1.f}, smem + 40960);
        pg8::Gemm g{(const bf16_t*)(ws + OFF_OAB), WbrT, RR, 2048, DM}; pg8::StaticOrder S; S.init(RR, 2048, G, bx);
        EpiBr E{(bf16_t*)(ws + OFF_Y), (const bf16_t*)a.out, DBG_NO_GDN ? 0.f : 1.f, DBG_NO_DSA ? 0.f : 1.f};
        pg8::gemm_phase<EpiBr, pg8::StaticOrder>(glds, g, S, E, nullptr);
    }
    SEAM(pb + 3);
    for (int rep = 0; rep < NREP(4); ++rep) if (IN(pb + 4)) { OPQ_WS();
        const bf16_t* WoutT = (const bf16_t*)(ws + OFF_WOUT) + (size_t)l * DM * DM;
        meta_y_lds(ws, smem);
        small_gemm16<true>(smem, WoutT, DM, DM, MEpiResid{(float*)(ws + M_H), (DBG_NO_MIX || rep) ? 0.f : 1.f}, smem + 40960);
        __syncthreads();
        pg8::Gemm g{(const bf16_t*)(ws + OFF_Y), WoutT, RR, DM, DM}; pg8::StaticOrder S; S.init(RR, DM, G, bx);
        EpiResidB E{(bf16_t*)(ws + OFF_HB), rep ? nullptr : (u64_t*)(ws + OFF_SSQ) + (size_t)(2 * l + 1) * RR, (DBG_NO_MIX || rep) ? 0.f : 1.f};
        pg8::gemm_phase<EpiResidB, pg8::StaticOrder>(glds, g, S, E, nullptr);
    }
    SEAM(pb + 4);
    if (IN(pb + 5)) { OPQ_WS();
        const bf16_t* WupT = (const bf16_t*)(ws + OFF_WUP) + (size_t)l * NIN * DM;
        meta_norm_lds((const float*)(ws + M_H), smem);
        small_gemm16<true>(smem, WupT, NIN, DM, MEpiUp{(float*)(ws + M_GU)}, smem + 40960);
        p_halo(a, l);
    }
    SEAM(pb + 5);
    for (int rep = 0; rep < NREP(6); ++rep) if (IN(pb + 6)) { OPQ_WS();
        const bf16_t* WupT = (const bf16_t*)(ws + OFF_WUP) + (size_t)l * NIN * DM;
        if constexpr (L + 1 < NLAYER) meta_act(a, l);
#if defined(PANEL_UP)
        pg8::Gemm g{(const bf16_t*)(ws + OFF_HB), WupT, RR, NIN, DM}; PanelOrder S; S.init(RR, NIN, G, bx);
#else
        pg8::Gemm g{(const bf16_t*)(ws + OFF_HB), WupT, RR, NIN, DM}; pg8::StaticOrder S; S.init(RR, NIN, G, bx);
#endif
        EpiUpConv E{(bf16_t*)(ws + OFF_ACT), (const u64_t*)(ws + OFF_SSQ) + (size_t)(2 * l + 1) * RR, a.in[I_CONV_FFN] + (size_t)l * 3 * DFF, (const float*)(ws + OFF_HG), (const float*)(ws + M_GU), smem + 131072, a.ph_hi};
#if defined(PANEL_UP)
        pg8::gemm_phase<EpiUpConv, PanelOrder>(glds, g, S, E, nullptr);
#else
        pg8::gemm_phase<EpiUpConv, pg8::StaticOrder>(glds, g, S, E, nullptr);
#endif
#if defined(PROBE_UPMODE)
        { EpiUpConvT<PROBE_UPMODE> E2{(bf16_t*)(ws + OFF_ACT), (const u64_t*)(ws + OFF_SSQ) + (size_t)(2 * l + 1) * RR, a.in[I_CONV_FFN] + (size_t)l * 3 * DFF, (const float*)(ws + OFF_HG), (const float*)(ws + M_GU), smem + 131072, a.ph_hi};
          pg8::gemm_phase<EpiUpConvT<PROBE_UPMODE>, pg8::StaticOrder>(glds, g, S, E2, nullptr); }
#endif
#if defined(PROBE_NULLM)
        { EpiNull EN; pg8::Gemm g2{(const bf16_t*)(ws + OFF_OAB), (const bf16_t*)(ws + OFF_WUP) + (size_t)(1 - l) * NIN * DM, PROBE_NULLM, NIN, DM}; pg8::StaticOrder S2; S2.init(PROBE_NULLM, NIN, G, bx);
          pg8::gemm_phase<EpiNull, pg8::StaticOrder>(glds, g2, S2, EN, nullptr); }
#endif
    }
    SEAM(pb + 6);
    for (int rep = 0; rep < NREP(7); ++rep) if (IN(pb + 7)) { OPQ_WS();
        const bf16_t* WdnT = (const bf16_t*)(ws + OFF_WDN) + (size_t)l * DM * DFF;
        if constexpr (L + 1 < NLAYER) small_gemm16<false>((const bf16_t*)(ws + M_ACT), WdnT, DM, DFF, MEpiResid{(float*)(ws + M_H), (DBG_NO_FFN || rep) ? 0.f : 1.f}, smem + 40960);
        pg8::Gemm g{(const bf16_t*)(ws + OFF_ACT), WdnT, RR, DM, DFF}; pg8::StaticOrder S; S.init(RR, DM, G, bx);
#if defined(PROBE_NULLDOWN)
        { EpiNull EN; pg8::gemm_phase<EpiNull, pg8::StaticOrder>(glds, g, S, EN, nullptr); }
#endif
        if constexpr (L + 1 < NLAYER) {
            EpiResidB E{(bf16_t*)(ws + OFF_HB), rep ? nullptr : (u64_t*)(ws + OFF_SSQ) + (size_t)(2 * l + 2) * RR, (DBG_NO_FFN || rep) ? 0.f : 1.f};
            pg8::gemm_phase<EpiResidB, pg8::StaticOrder>(glds, g, S, E, nullptr);
        } else {
            EpiFinal E{(const bf16_t*)(ws + OFF_HB), a.out, DBG_NO_FFN ? 0.f : 1.f};
            pg8::gemm_phase<EpiFinal, pg8::StaticOrder>(glds, g, S, E, nullptr);
        }
    }
    SEAM(pb + 7);
#undef IN
#undef SEAM
#undef OPQ_WS
}
__global__ void __launch_bounds__(512, 2) fwd(Args a) {
    extern __shared__ __attribute__((aligned(16))) char smem[];
    unsigned char* ws = a.ws;
    const int lo = a.ph_lo, hi = a.ph_hi;
    const bool fused = (hi - lo) > 1;
    if (threadIdx.x == 0) *(u32x4*)(smem + LDS_XB) = (u32x4){0u, 0u, 0u, 0u};
    __syncthreads();
    XcdBarrier bar; bar.bar = (unsigned*)(ws + OFF_CTL); bar.x = 0; bar.st = (volatile LAS unsigned*)(smem + LDS_XB);
    if (fused) bar = xcd_barrier_post((unsigned*)(ws + OFF_CTL), (volatile LAS unsigned*)(smem + LDS_XB));
    for (int rep = 0; rep < 1 + ((REP_MASK >> 15) & 1); ++rep) if ((EN_MASK & 1) && lo <= 0 && 0 < hi) p_prologue(a, smem);
    if (lo <= 0 && 1 < hi) xcd_barrier(bar);
    layer_phases<0>(a, smem, bar, lo, hi);
    layer_phases<1>(a, smem, bar, lo, hi);
}


extern "C" void kernel_launch(void* const* d_in, const int* in_sizes, int n_in, void* d_out, int out_size, void* d_ws, size_t ws_size, hipStream_t stream) {
    static int grid = 0;
    if (grid == 0) {
        if (n_in != 20 || in_sizes[0] != RR * DM || out_size != RR * DM || ws_size < WS_END) {
            fprintf(stderr, "kernel_launch: shape mismatch: n_in %d in0 %d out %d ws %zu (need %zu)\n", n_in, n_in > 0 ? in_sizes[0] : -1, out_size, ws_size, (size_t)WS_END); grid = -1; return; }
        int dev = 0, cus = 0, per_cu = 0;
        if (hipGetDevice(&dev) != hipSuccess || hipDeviceGetAttribute(&cus, hipDeviceAttributeMultiprocessorCount, dev) != hipSuccess) { fprintf(stderr, "kernel_launch: device query failed\n"); grid = -1; return; }
        if (hipFuncSetAttribute((const void*)fwd, hipFuncAttributeMaxDynamicSharedMemorySize, LDS_BYTES) != hipSuccess) { fprintf(stderr, "kernel_launch: hipFuncSetAttribute failed\n"); grid = -1; return; }
        if (hipOccupancyMaxActiveBlocksPerMultiprocessor(&per_cu, (const void*)fwd, 512, LDS_BYTES) != hipSuccess || per_cu < 1)
            fprintf(stderr, "kernel_launch: note: occupancy query reports %d workgroups per CU\n", per_cu);
        (void)hipGetLastError();
        grid = cus;
    }
    if (grid < 0) return;
    if (hipMemsetAsync((char*)d_ws + OFF_CTL, 0, SZ_CTL, stream) != hipSuccess) { fprintf(stderr, "kernel_launch: memset failed\n"); return; }
    Args a{};
    for (int i = 0; i < 20; ++i) a.in[i] = (const float*)d_in[i];
    a.out = (float*)d_out; a.ws = (unsigned char*)d_ws;
#if ONE_LAUNCH
    a.ph_lo = 0; a.ph_hi = NPH;
    hipLaunchKernelGGL(fwd, dim3(grid), dim3(512), LDS_BYTES, stream, a);
#else
    for (int p = 0; p < NPH; ++p) { a.ph_lo = p; a.ph_hi = p + 1; hipLaunchKernelGGL(fwd, dim3(grid), dim3(512), LDS_BYTES, stream, a); }
#endif
    const hipError_t le = hipPeekAtLastError();
    if (le != hipSuccess) fprintf(stderr, "kernel_launch: launch failed: %s\n", hipGetErrorName(le));
}
```

```cpp
#define ONE_LAUNCH 1
#include <hip/hip_runtime.h>
#include <cstdio>
#include <cstdint>

#define LAS __attribute__((address_space(3)))
typedef unsigned short bf16_t;
typedef short bf16x8 __attribute__((ext_vector_type(8)));
typedef short s16x4 __attribute__((ext_vector_type(4)));
typedef float f32x4 __attribute__((ext_vector_type(4)));
typedef float f32x16 __attribute__((ext_vector_type(16)));
typedef unsigned u32x4 __attribute__((ext_vector_type(4)));
typedef unsigned u32x2 __attribute__((ext_vector_type(2)));

constexpr int NB = 32, SQ = 2048, RR = NB * SQ, NMETA = 16, TP = 2176, DM = 1024, TPOS = 2064;
constexpr int NIN = 5632, DFF = 2816, NLAYER = 2;
constexpr float EPSF = 1e-6f;

constexpr size_t al256(size_t x) { return (x + 255) / 256 * 256; }
constexpr size_t OFF_CTL = 0, SZ_CTL = 65536;
constexpr size_t OFF_WIN = OFF_CTL + SZ_CTL, SZ_WIN = (size_t)NLAYER * NIN * DM * 2;
constexpr size_t OFF_WBR = OFF_WIN + SZ_WIN, SZ_WBR = (size_t)NLAYER * 2048 * DM * 2;
constexpr size_t OFF_WOUT = OFF_WBR + SZ_WBR, SZ_WOUT = (size_t)NLAYER * DM * DM * 2;
constexpr size_t OFF_WUP = OFF_WOUT + SZ_WOUT, SZ_WUP = (size_t)NLAYER * NIN * DM * 2;
constexpr size_t OFF_WDN = OFF_WUP + SZ_WUP, SZ_WDN = (size_t)NLAYER * DM * DFF * 2;
constexpr size_t OFF_COSA = OFF_WDN + SZ_WDN, SZ_ROPA = (size_t)TPOS * 64 * 4;
constexpr size_t OFF_SINA = OFF_COSA + SZ_ROPA;
constexpr size_t OFF_COSI = OFF_SINA + SZ_ROPA, SZ_ROPI = (size_t)TPOS * 32 * 4;
constexpr size_t OFF_SINI = OFF_COSI + SZ_ROPI;
constexpr size_t OFF_M = al256(OFF_SINI + SZ_ROPI);
constexpr size_t M_H = OFF_M;
constexpr size_t M_RAW = M_H + 16 * 1024 * 4;
constexpr size_t M_CHUNK = M_RAW + 16 * 1536 * 2;
constexpr size_t M_Z = M_CHUNK + 64 * 1536 * 2;
constexpr size_t M_BQ = M_Z + 16 * 512 * 2;
constexpr size_t M_IQ = M_BQ + 16 * 512 * 2;
constexpr size_t M_K = M_IQ + 16 * 512 * 2;
constexpr size_t M_V = M_K + 16 * 128 * 2;
constexpr size_t M_MISC = M_V + 16 * 128 * 2;
constexpr size_t M_GATES = M_MISC + 16 * 16 * 4;
constexpr size_t M_TQ = M_GATES + 16 * 2048 * 2;
constexpr size_t M_GC = M_TQ + 4 * 2 * 4096 * 2;
constexpr size_t M_BETA = M_GC + 64 * 4 * 4;
constexpr size_t M_OAB = M_BETA + 64 * 4 * 4;
constexpr size_t M_Y = M_OAB + 16 * 1024 * 2;
constexpr size_t M_GU = M_Y + 16 * 1024 * 2;
constexpr size_t M_ACT = M_GU + 16 * 5632 * 4;
constexpr size_t M_END = M_ACT + 16 * 2816 * 2;
constexpr size_t OFF_HB = al256(M_END), SZ_HB = (size_t)RR * DM * 2;
constexpr size_t OFF_SSQ = OFF_HB + SZ_HB, SZ_SSQ = (size_t)4 * RR * 8;
constexpr size_t OFF_QKV = OFF_SSQ + SZ_SSQ, SZ_QKV = (size_t)RR * 1536 * 2;
constexpr size_t OFF_HALO = OFF_QKV + SZ_QKV, SZ_HALO = (size_t)(RR / 64) * 3 * 1536 * 2;
constexpr size_t OFF_Z = OFF_HALO + SZ_HALO, SZ_512 = (size_t)RR * 512 * 2;
constexpr size_t OFF_BQ = OFF_Z + SZ_512;
constexpr size_t OFF_IQ = OFF_BQ + SZ_512;
constexpr size_t OFF_KB = OFF_IQ + SZ_512, SZ_KB = (size_t)NB * TP * 128 * 2;
constexpr size_t OFF_VB = OFF_KB + SZ_KB;
constexpr size_t OFF_IKB = OFF_VB + SZ_KB, SZ_IKB = (size_t)NB * TP * 64 * 2;
constexpr size_t OFF_MISC = OFF_IKB + SZ_IKB, SZ_MISC = (size_t)RR * 16 * 4;
constexpr size_t OFF_GC = OFF_MISC + SZ_MISC, SZ_GC = (size_t)RR * 4 * 4;
constexpr size_t OFF_BETA = OFF_GC + SZ_GC;
constexpr size_t OFF_TQ = OFF_BETA + SZ_GC, SZ_TQ = (size_t)NB * 32 * 4 * 2 * 4096 * 2;
constexpr size_t OFF_OAB = OFF_TQ + SZ_TQ, SZ_OAB = (size_t)RR * DM * 2;
constexpr size_t OFF_HG = OFF_OAB + SZ_OAB, SZ_HG = (size_t)256 * 2 * DFF * 4;
constexpr size_t WS_END = OFF_HG + SZ_HG;
constexpr size_t OFF_Y = OFF_QKV;
constexpr size_t OFF_ACT = OFF_QKV, SZ_FF = (size_t)RR * DFF * 2;
static_assert(OFF_ACT + SZ_FF <= OFF_OAB, "ffn alias region");
static_assert(WS_END <= (size_t)1073741824, "workspace budget");
constexpr int CW_QUEUE = 4096;

constexpr int LDS_BYTES = 163840, LDS_XB = LDS_BYTES - 16;

#define AS_GLOBAL(p) ((unsigned char*)(__attribute__((address_space(1))) unsigned char*)(p))
typedef __bf16 bf16x2_t __attribute__((ext_vector_type(2)));
__device__ __forceinline__ unsigned cvt_pk(float lo, float hi) { bf16x2_t v; v[0] = (__bf16)lo; v[1] = (__bf16)hi; return __builtin_bit_cast(unsigned, v); }
__device__ __forceinline__ bf16_t f2bf(float x) { return (bf16_t)(cvt_pk(x, 0.f) & 0xffffu); }
__device__ __forceinline__ float bf2f(bf16_t b) { return __uint_as_float(((unsigned)b) << 16); }
__device__ __forceinline__ float bflo(unsigned w) { return __uint_as_float(w << 16); }
__device__ __forceinline__ float bfhi(unsigned w) { return __uint_as_float(w & 0xffff0000u); }
template <int CTRL, int RM = 0xf> __device__ __forceinline__ float dpp_mov(float v) {
    return __builtin_bit_cast(float, __builtin_amdgcn_update_dpp(0, __builtin_bit_cast(int, v), CTRL, RM, 0xf, false)); }
__device__ __forceinline__ float row_sum16(float v) {
    v += dpp_mov<0xB1>(v); v += dpp_mov<0x4E>(v); v += dpp_mov<0x141>(v); v += dpp_mov<0x140>(v); return v; }
__device__ __forceinline__ float wave_sum_hi(float v) {
    v = row_sum16(v); v += dpp_mov<0x142, 0xa>(v); v += dpp_mov<0x143, 0xc>(v); return v; }
__device__ __forceinline__ float wave_sum(float v) { return __builtin_bit_cast(float, __builtin_amdgcn_readlane(__builtin_bit_cast(int, wave_sum_hi(v)), 63)); }
__device__ __forceinline__ float half_sum(float v) {
#pragma unroll
    for (int o = 16; o; o >>= 1) v += __shfl_xor(v, o);
    return v; }
typedef unsigned long long u64_t;
constexpr float SSQ_SCALE = 1048576.f, SSQ_INV = 1.f / 1048576.f;
__device__ __forceinline__ float rstd_of(const u64_t* ssq, int row) { return rsqrtf((float)ssq[row] * (SSQ_INV / DM) + EPSF); }
#ifndef FAST_SIG
#define FAST_SIG 1
#endif
#ifndef FAST_SILU
#define FAST_SILU 1
#endif
__device__ __forceinline__ float sigmoid_f(float x) { return FAST_SIG ? __builtin_amdgcn_rcpf(1.f + __expf(-x)) : 1.f / (1.f + __expf(-x)); }
__device__ __forceinline__ float sigmoid_slow(float x) { return 1.f / (1.f + __expf(-x)); }
__device__ __forceinline__ float sigmoid_fast(float x) { return __builtin_amdgcn_rcpf(1.f + __expf(-x)); }
__device__ __forceinline__ float silu_f(float x) { return FAST_SILU ? x * __builtin_amdgcn_rcpf(1.f + __expf(-x)) : x / (1.f + __expf(-x)); }
__device__ __forceinline__ float softplus_f(float x) { return fmaxf(x, 0.f) + log1pf(__expf(-fabsf(x))); }
__device__ __forceinline__ u32x4 pack8(f32x4 a, f32x4 b) { u32x4 w; w.x = cvt_pk(a[0], a[1]); w.y = cvt_pk(a[2], a[3]); w.z = cvt_pk(b[0], b[1]); w.w = cvt_pk(b[2], b[3]); return w; }
__device__ __forceinline__ bf16x8 as_bf8(u32x4 w) { return __builtin_bit_cast(bf16x8, w); }
__device__ __forceinline__ f32x4 mfma16(bf16x8 a, bf16x8 b, f32x4 c) { return __builtin_amdgcn_mfma_f32_16x16x32_bf16(a, b, c, 0, 0, 0); }

#define XB_TMO      128
#define XB_XCNT(j)  (256  + 64 * (j))
#define XB_XSUB(j)  (1280 + 64 * (j))
#define XB_XGEN(j)  (2304 + 64 * (j))
#define XB_TOP      3328
#define XB_TOPGEN   3392
#define XCD_BAR_WORDS 3456
#define XB_SPIN_CAP (1u << 18)
__device__ __forceinline__ unsigned xb_ld(unsigned* p)              { return __hip_atomic_load(p, __ATOMIC_RELAXED, __HIP_MEMORY_SCOPE_AGENT); }
__device__ __forceinline__ unsigned xb_add(unsigned* p, unsigned v) { return __hip_atomic_fetch_add(p, v, __ATOMIC_RELAXED, __HIP_MEMORY_SCOPE_AGENT); }
__device__ __forceinline__ unsigned xb_xcc_id() { return (unsigned)__builtin_amdgcn_s_getreg((3 << 11) | 20) & 0xFu; }
#define XB_SPIN(cond, bar) do { unsigned _sp = 0; while (cond) { __builtin_amdgcn_s_sleep(1); \
    if ((++_sp & 255u) == 0u) { if (xb_ld(&(bar)[XB_TMO])) break; if (_sp > XB_SPIN_CAP) { atomicAdd(&(bar)[XB_TMO], 1u); break; } } } } while (0)
struct XcdBarrier { unsigned* bar; unsigned x; volatile LAS unsigned* st; };
__device__ __forceinline__ XcdBarrier xcd_barrier_post(unsigned* bar, volatile LAS unsigned* st) {
    XcdBarrier b; b.bar = bar; b.x = xb_xcc_id(); b.st = st;
    if (threadIdx.x == 0) (void)xb_add(&bar[XB_XCNT(b.x)], 1u);
    return b;
}
__device__ __forceinline__ void xcd_barrier_complete(unsigned* bar, unsigned x, unsigned& nloc, unsigned& nx) {
    const unsigned G = gridDim.x * gridDim.y * gridDim.z;
    unsigned sum, cnt, mine, sp = 0u;
    for (;;) {
        sum = 0u; cnt = 0u; mine = 0u;
#pragma unroll
        for (unsigned j = 0; j < 16; ++j) { const unsigned c = xb_ld(&bar[XB_XCNT(j)]); sum += c; cnt += (c > 0u) ? 1u : 0u; mine = (j == x) ? c : mine; }
        if (sum == G) break;
        __builtin_amdgcn_s_sleep(1);
        if ((++sp & 255u) == 0u) { if (xb_ld(&bar[XB_TMO])) break; if (sp > XB_SPIN_CAP) { atomicAdd(&bar[XB_TMO], 1u); break; } }
    }
    nloc = mine > 0u ? mine : 1u; nx = cnt > 0u ? cnt : 1u;
}
__device__ __forceinline__ void xcd_barrier(const XcdBarrier& b) {
    asm volatile("s_waitcnt vmcnt(0)" ::: "memory");
    __syncthreads();
    if (threadIdx.x == 0) {
        unsigned* bar = b.bar;
        __builtin_amdgcn_s_waitcnt(0);
        unsigned nloc = b.st[0], nx = b.st[1];
        if (nloc == 0u) { xcd_barrier_complete(bar, b.x, nloc, nx); b.st[0] = nloc; b.st[1] = nx; }
        const unsigned old = xb_add(&bar[XB_XSUB(b.x)], 1u);
        const unsigned gen = old / nloc;
        if (old + 1u == (gen + 1u) * nloc) {
            __builtin_amdgcn_fence(__ATOMIC_RELEASE, "agent");
            asm volatile("s_waitcnt vmcnt(0)" ::: "memory");
            const unsigned og = xb_add(&bar[XB_TOP], 1u);
            const unsigned tg = og / nx;
            if (og + 1u == (tg + 1u) * nx) xb_add(&bar[XB_TOPGEN], 1u);
            else XB_SPIN(xb_ld(&bar[XB_TOPGEN]) == tg, bar);
            __builtin_amdgcn_fence(__ATOMIC_ACQUIRE, "agent");
            xb_add(&bar[XB_XGEN(b.x)], 1u);
            asm volatile("s_waitcnt vmcnt(0)" ::: "memory");
        } else {
            XB_SPIN(xb_ld(&bar[XB_XGEN(b.x)]) == gen, bar);
            __builtin_amdgcn_fence(__ATOMIC_ACQUIRE, "agent");
            asm volatile("s_waitcnt vmcnt(0)" ::: "memory");
        }
    }
    __syncthreads();
}

namespace pg8 {
#define PG8_LAS __attribute__((address_space(3)))
typedef unsigned short bf16_t;
typedef short bf16x8 __attribute__((ext_vector_type(8)));
typedef float f32x4 __attribute__((ext_vector_type(4)));
typedef unsigned u32x4 __attribute__((ext_vector_type(4)));
constexpr int BM = 256, BK = 64, HALF = 128, HTB = HALF * BK * 2  , STAGE_BYTES = 8 * HTB, NXCD = 8, WGM = 8;

__host__ __device__ __forceinline__ int lds_byte(int r, int c) { const int st = (r >> 4) * 2 + (c >> 5), rr = r & 15, cc = c & 31, ob = rr * 64 + cc * 2; return st * 1024 + (ob ^ (((ob >> 9) & 1) << 5)); }
__host__ __device__ __forceinline__ void stage_rc(int b, int& R, int& C) { const int st = b / 1024, sb = b % 1024, swz = sb ^ (((sb >> 9) & 1) << 5); R = (st >> 1) * 16 + swz / 64; C = (st & 1) * 32 + (swz % 64) / 2; }
__host__ __device__ __forceinline__ int perm32(int rho) { const int n = rho >> 4, i = rho & 15; return 8 * (i >> 2) + 4 * n + (i & 3); }

struct Unit { int pm, pn; };
struct Gemm { const bf16_t* A; const bf16_t* Bt; int M, N, K; };

struct StaticOrder {
    int nM, nN, nwg, G, c;
    __host__ __device__ void init(int M, int N, int G_, int c_) { nM = M / BM; nN = N / BM; nwg = nM * nN; G = G_; c = c_; }
    __host__ __device__ bool next(int i, Unit& u) const {
        const long L = (long)i * G + c; if (L >= nwg) return false;
        int wgid = (int)L; { const int q = nwg / NXCD, r = nwg % NXCD, xcd = wgid % NXCD, off = wgid / NXCD; wgid = (xcd < r ? xcd * (q + 1) : r * (q + 1) + (xcd - r) * q) + off; }
        const int nig = WGM * nN, gid = wgid / nig, fm = gid * WGM, gsz = (nM - fm) < WGM ? (nM - fm) : WGM;
        u.pm = fm + ((wgid % nig) % gsz); u.pn = (wgid % nig) / gsz; return true;
    }
    __device__ __forceinline__ void a_ready(const Unit&) const {}
    __device__ __forceinline__ void done(const Unit&) const {}
};
__device__ __forceinline__ unsigned cvt_pk_bf16(float lo, float hi) { unsigned r; asm volatile("v_cvt_pk_bf16_f32 %0, %1, %2" : "=v"(r) : "v"(lo), "v"(hi)); return r; }
typedef float f32x2 __attribute__((ext_vector_type(2)));
template <class Epi, class Sched, bool STAMP = false>
__device__ __forceinline__ void gemm_phase(PG8_LAS unsigned char* lds, const Gemm g, const Sched& S, const Epi& E, unsigned long long* stamps) {
    int tid_ = threadIdx.x; asm volatile("" : "+v"(tid_));
    const int tid = tid_, wid = __builtin_amdgcn_readfirstlane(tid >> 6), lane = tid & 63, wr = wid >> 2, wc = wid & 3, fr = lane & 15, fq = lane >> 4;
    const int K = g.K, nt = K / BK;
    int ts_lo = 0, ts_hi = 0, nts = 0; const unsigned long long rt_entry = STAMP ? (unsigned long long)wall_clock64() : 0ull;
#define PG8_STAMP() do { if (STAMP && wid == 0 && nts < 64) { const unsigned long long _c = (unsigned long long)clock64(); \
        ts_lo = (lane == nts) ? (int)(unsigned)_c : ts_lo; ts_hi = (lane == nts) ? (int)(unsigned)(_c >> 32) : ts_hi; ++nts; } } while (0)
    PG8_STAMP();
    unsigned voffA[2], voffB[2];
#pragma unroll
    for (int i = 0; i < 2; ++i) { int R, C; stage_rc(tid * 16 + i * 8192, R, C); const int Rb = Epi::PERM ? ((R & ~31) + perm32(R & 31)) : R;
        const int Ra = Epi::APERM ? (8 * (16 * (R >> 6) + (R & 15)) + ((R >> 4) & 3)) : R;
        voffA[i] = (unsigned)(Ra * K + C) * 2u; voffB[i] = (unsigned)(Rb * K + C) * 2u; }
    const size_t kstep = (size_t)(BK * 2);
    const size_t hstep = (size_t)HALF * K * 2;
    const size_t tstep = 2 * hstep;
    const size_t hstepA = Epi::APERM ? (size_t)4 * K * 2 : hstep;
    const unsigned ldsw = (unsigned)wid * 1024u;
    const int aoff = lds_byte(wr * 64 + fr, fq * 8), boff = lds_byte(wc * 32 + fr, fq * 8);
#define PG8_SA(b, h) (((b) * 2 + (h)) * HTB)
#define PG8_SB(b, h) ((4 + (b) * 2 + (h)) * HTB)
#define PG8_STAGE(bufoff, gbase, voff) do { _Pragma("unroll") for (int _i = 0; _i < 2; ++_i) \
        __builtin_amdgcn_global_load_lds((const unsigned*)((const char*)(gbase) + (voff)[_i]), (PG8_LAS unsigned*)(lds + (bufoff) + ldsw + _i * 8192), 16, 0, 0); } while (0)
#define PG8_LDA(dst, b, h) do { _Pragma("unroll") for (int m = 0; m < 4; ++m) _Pragma("unroll") for (int k = 0; k < 2; ++k) dst[m][k] = *(const PG8_LAS bf16x8*)(lds + PG8_SA(b, h) + aoff + m * 2048 + k * 1024); } while (0)
#define PG8_LDB(dst, b, h) do { _Pragma("unroll") for (int n = 0; n < 2; ++n) _Pragma("unroll") for (int k = 0; k < 2; ++k) dst[n][k] = *(const PG8_LAS bf16x8*)(lds + PG8_SB(b, h) + boff + n * 2048 + k * 1024); } while (0)
#define PG8_MMA(ai, bj, At, Bt) do { __builtin_amdgcn_s_setprio(1); _Pragma("unroll") for (int m = 0; m < 4; ++m) _Pragma("unroll") for (int n = 0; n < 2; ++n) _Pragma("unroll") for (int k = 0; k < 2; ++k) \
        acc[ai][bj][m][n] = __builtin_amdgcn_mfma_f32_16x16x32_bf16(Bt[n][k], At[m][k], acc[ai][bj][m][n], 0, 0, 0); __builtin_amdgcn_s_setprio(0); } while (0)
#define PG8_WAIT_V(n) asm volatile("s_waitcnt vmcnt(" #n ")" ::: "memory")
#define PG8_WAIT_L(n) asm volatile("s_waitcnt lgkmcnt(" #n ")" ::: "memory")
#define PG8_BAR __builtin_amdgcn_s_barrier()
#define PG8_SCHED __builtin_amdgcn_sched_barrier(0)
    Unit cur, nxt; int ui = 0;
    if (!S.next(0, cur)) return;
    f32x4 acc[2][2][4][2];
#pragma unroll
    for (int a = 0; a < 2; ++a)
#pragma unroll
        for (int b = 0; b < 2; ++b)
#pragma unroll
            for (int m = 0; m < 4; ++m)
#pragma unroll
                for (int n = 0; n < 2; ++n) acc[a][b][m][n] = (f32x4){0.f, 0.f, 0.f, 0.f};
    bf16x8 At[4][2], B0[2][2], B1[2][2];
    const char* cA = (const char*)g.A + (size_t)cur.pm * tstep; const char* cB = (const char*)g.Bt + (size_t)cur.pn * tstep;
    S.a_ready(cur);
    PG8_STAGE(PG8_SB(0, 0), cB, voffB); PG8_STAGE(PG8_SA(0, 0), cA, voffA); PG8_STAGE(PG8_SB(0, 1), cB + hstep, voffB); PG8_STAGE(PG8_SA(0, 1), cA + hstepA, voffA);
    if (wr == 1) PG8_BAR;
    PG8_WAIT_V(4); PG8_BAR;
    PG8_STAGE(PG8_SB(1, 0), cB + kstep, voffB); PG8_STAGE(PG8_SA(1, 0), cA + kstep, voffA); PG8_STAGE(PG8_SB(1, 1), cB + hstep + kstep, voffB);
    PG8_WAIT_V(6); PG8_BAR;
    PG8_STAMP();
    for (;;) {
        const bool has_next = S.next(ui + 1, nxt);
        const char* nA = has_next ? (const char*)g.A + (size_t)nxt.pm * tstep : cA; const char* nB = has_next ? (const char*)g.Bt + (size_t)nxt.pn * tstep : cB;
        for (int t = 0; t < nt; t += 2) {
            const bool last = (t == nt - 2);
            const bool bd_lo = !Epi::BD || (t * BK * 2 < K), bd_hi = !Epi::BD || !(t * BK * 2 < K);
            const char* a1 = cA + (size_t)(t + 1) * kstep;
            const char* a2 = last ? nA : cA + (size_t)(t + 2) * kstep; const char* b2 = last ? nB : cB + (size_t)(t + 2) * kstep;
            const char* a3 = a2 + kstep; const char* b3 = b2 + kstep;
            if (last && has_next) S.a_ready(nxt);
            PG8_LDB(B0, 0, 0); PG8_SCHED; PG8_LDA(At, 0, 0); PG8_STAGE(PG8_SA(1, 1), a1 + hstepA, voffA);
            PG8_WAIT_L(8); PG8_BAR; PG8_WAIT_L(0); if (bd_lo) PG8_MMA(0, 0, At, B0); PG8_BAR; PG8_SCHED;
            PG8_LDB(B1, 0, 1); PG8_STAGE(PG8_SB(0, 0), b2, voffB);
            PG8_BAR; PG8_WAIT_L(0); if (bd_hi) PG8_MMA(0, 1, At, B1); PG8_BAR;
            PG8_LDA(At, 0, 1); PG8_STAGE(PG8_SA(0, 0), a2, voffA);
            PG8_BAR; PG8_WAIT_L(0); if (bd_lo) PG8_MMA(1, 0, At, B0); PG8_BAR; PG8_SCHED;
            PG8_STAGE(PG8_SB(0, 1), b2 + hstep, voffB);
            PG8_WAIT_V(6); PG8_BAR; if (bd_hi) PG8_MMA(1, 1, At, B1); PG8_BAR;
            PG8_LDB(B0, 1, 0); PG8_SCHED; PG8_LDA(At, 1, 0); PG8_STAGE(PG8_SA(0, 1), a2 + hstepA, voffA);
            PG8_WAIT_L(8); PG8_BAR; PG8_WAIT_L(0); if (bd_lo) PG8_MMA(0, 0, At, B0); PG8_BAR; PG8_SCHED;
            PG8_LDB(B1, 1, 1); PG8_STAGE(PG8_SB(1, 0), b3, voffB);
            PG8_BAR; PG8_WAIT_L(0); if (bd_hi) PG8_MMA(0, 1, At, B1); PG8_BAR;
            PG8_LDA(At, 1, 1); PG8_STAGE(PG8_SA(1, 0), a3, voffA);
            PG8_BAR; PG8_WAIT_L(0); if (bd_lo) PG8_MMA(1, 0, At, B0); PG8_BAR; PG8_SCHED;
            PG8_STAGE(PG8_SB(1, 1), b3 + hstep, voffB);
            PG8_WAIT_V(6); PG8_BAR; if (bd_hi) PG8_MMA(1, 1, At, B1); PG8_BAR;
        }
        PG8_STAMP();
        if constexpr (!Epi::AFTER_DRAIN) { E(acc, cur, wr, wc, fr, fq); S.done(cur); }
        PG8_STAMP();
        if (!has_next) break;
#pragma unroll
        for (int a = 0; a < 2; ++a)
#pragma unroll
            for (int b = 0; b < 2; ++b)
#pragma unroll
                for (int m = 0; m < 4; ++m)
#pragma unroll
                    for (int n = 0; n < 2; ++n) acc[a][b][m][n] = (f32x4){0.f, 0.f, 0.f, 0.f};
        cur = nxt; cA = nA; cB = nB; ++ui;
    }
    PG8_WAIT_V(0);
    if (wr == 0) PG8_BAR;
    PG8_BAR;
    if constexpr (Epi::AFTER_DRAIN) { E.fused(acc, cur, wr, wc, fr, fq, lds, wid, lane); S.done(cur); }
    PG8_STAMP();
    if (STAMP && wid == 0) { stamps[lane] = lane < nts ? (((unsigned long long)(unsigned)ts_hi << 32) | (unsigned)ts_lo) : 0ull;
        if (lane == 62) stamps[62] = rt_entry; if (lane == 63) stamps[63] = (unsigned long long)wall_clock64(); }
#undef PG8_STAMP
#undef PG8_SA
#undef PG8_SB
#undef PG8_STAGE
#undef PG8_LDA
#undef PG8_LDB
#undef PG8_MMA
#undef PG8_WAIT_V
#undef PG8_WAIT_L
#undef PG8_BAR
#undef PG8_SCHED
}
}

struct Args { const float* in[20]; float* out; unsigned char* ws; int ph_lo, ph_hi; };
enum { I_X = 0, I_META, I_NORM_MIX, I_W_IN, I_CONV_A, I_A_LOG, I_DT_BIAS, I_A_OUT_NORM, I_Q_NORM, I_K_NORM, I_KIDX_NORM, I_W_BA, I_W_BB, I_W_GATE, I_B_GATE, I_W_OUT, I_NORM_FFN, I_W_UP, I_CONV_FFN, I_W_DOWN };

#ifndef DBG_NO_DSA
#define DBG_NO_DSA 0
#endif
#ifndef DBG_NO_GDN
#define DBG_NO_GDN 0
#endif
#ifndef DBG_NO_MIX
#define DBG_NO_MIX 0
#endif
#ifndef DBG_NO_FFN
#define DBG_NO_FFN 0
#endif

#ifndef SIG_EPI
#define SIG_EPI sigmoid_fast
#endif
#ifndef SIG_META
#define SIG_META sigmoid_fast
#endif
#ifndef SIG_BETA
#define SIG_BETA sigmoid_fast
#endif
#ifndef GATE_ROT
#define GATE_ROT 0
#endif
#define GATE_COL(row, col) (GATE_ROT ? (((col) + 128 * ((row) & 15)) & 2047) : (col))
#ifndef NT_STORE
#define NT_STORE 0
#endif
#define ST16(ptr, val) do { if (NT_STORE) __builtin_nontemporal_store((val), (u32x4*)(ptr)); else *(u32x4*)(ptr) = (val); } while (0)
struct PanelOrder : pg8::StaticOrder {
    __host__ __device__ bool next(int i, pg8::Unit& u) const { if (i >= nN || c >= nM) return false; u.pm = c; u.pn = i; return true; }
};
using pg8::Unit;
struct EpiIn {
    static constexpr bool PERM = true, AFTER_DRAIN = false, APERM = false, BD = false;
    bf16_t *qkv, *halo, *z, *bq, *iq, *kb, *vb, *ikb; float* misc; bf16_t* gates; const float* bgate; const u64_t* ssq;
    __device__ __forceinline__ void operator()(const f32x4 (&acc)[2][2][4][2], const Unit& u, int wr, int wc, int fr, int fq) const {
        const int pn = u.pn, row0 = u.pm * 256 + wr * 64 + fr, cl = wc * 32 + 8 * fq;
        float rs[2][4];
        { u64_t sv[2][4];
#pragma unroll
          for (int ai = 0; ai < 2; ++ai)
#pragma unroll
              for (int m = 0; m < 4; ++m) sv[ai][m] = ssq[row0 + ai * 128 + m * 16];
#pragma unroll
          for (int ai = 0; ai < 2; ++ai)
#pragma unroll
              for (int m = 0; m < 4; ++m) rs[ai][m] = rsqrtf((float)sv[ai][m] * (SSQ_INV / DM) + EPSF); }
        if (pn < 12) {
            bf16_t* base; int ld, cb;
            if (pn < 6) { base = qkv; ld = 1536; cb = pn * 256; } else if (pn < 8) { base = z; ld = 512; cb = (pn - 6) * 256; }
            else if (pn < 10) { base = bq; ld = 512; cb = (pn - 8) * 256; } else { base = iq; ld = 512; cb = (pn - 10) * 256; }
#pragma unroll
            for (int ai = 0; ai < 2; ++ai)
#pragma unroll
                for (int m = 0; m < 4; ++m) {
                    const int row = row0 + ai * 128 + m * 16; const float r = rs[ai][m];
                    bf16_t* p = base + (size_t)row * ld + cb + cl;
                    const u32x4 w0 = pack8(acc[ai][0][m][0] * r, acc[ai][0][m][1] * r), w1 = pack8(acc[ai][1][m][0] * r, acc[ai][1][m][1] * r);
                    ST16(p, w0); ST16(p + 128, w1);
                    if (pn < 6 && (row & 63) >= 61) {
                        bf16_t* hp = halo + ((size_t)(row >> 6) * 3 + ((row & 63) - 61)) * 1536 + cb + cl;
                        *(u32x4*)hp = w0; *(u32x4*)(hp + 128) = w1;
                    }
                }
        } else if (pn == 12) {
#pragma unroll
            for (int ai = 0; ai < 2; ++ai)
#pragma unroll
                for (int m = 0; m < 4; ++m) {
                    const int row = row0 + ai * 128 + m * 16; const float r = rs[ai][m];
                    const size_t prow = (size_t)(row >> 11) * TP + 16 + (row & 2047);
                    *(u32x4*)(kb + prow * 128 + cl) = pack8(acc[ai][0][m][0] * r, acc[ai][0][m][1] * r);
                    *(u32x4*)(vb + prow * 128 + cl) = pack8(acc[ai][1][m][0] * r, acc[ai][1][m][1] * r);
                }
        } else if (pn == 13) {
#pragma unroll
            for (int ai = 0; ai < 2; ++ai)
#pragma unroll
                for (int m = 0; m < 4; ++m) {
                    const int row = row0 + ai * 128 + m * 16; const float r = rs[ai][m];
                    if (cl < 64) { const size_t prow = (size_t)(row >> 11) * TP + 16 + (row & 2047); *(u32x4*)(ikb + prow * 64 + cl) = pack8(acc[ai][0][m][0] * r, acc[ai][0][m][1] * r); }
                    else if (cl < 80) { float* mp = misc + (size_t)row * 16 + (cl - 64); *(f32x4*)mp = acc[ai][0][m][0] * r; *(f32x4*)(mp + 4) = acc[ai][0][m][1] * r; }
                }
        } else {
            const int cb = (pn - 14) * 256 + cl;
            f32x4 bv[2][2];
#pragma unroll
            for (int bj = 0; bj < 2; ++bj) { bv[bj][0] = *(const f32x4*)(bgate + cb + bj * 128); bv[bj][1] = *(const f32x4*)(bgate + cb + bj * 128 + 4); }
#pragma unroll
            for (int ai = 0; ai < 2; ++ai)
#pragma unroll
                for (int m = 0; m < 4; ++m) {
                    const int row = row0 + ai * 128 + m * 16; const float r = rs[ai][m];
                    bf16_t* p = gates + (size_t)row * 2048;
#pragma unroll
                    for (int bj = 0; bj < 2; ++bj) {
                        f32x4 v0 = acc[ai][bj][m][0] * r + bv[bj][0], v1 = acc[ai][bj][m][1] * r + bv[bj][1];
#pragma unroll
                        for (int j = 0; j < 4; ++j) { v0[j] = SIG_EPI(v0[j]); v1[j] = SIG_EPI(v1[j]); }
                        ST16(p + GATE_COL(row, cb + bj * 128), pack8(v0, v1));
                    }
                }
        }
    }
};
struct EpiBr {
    static constexpr bool PERM = true, AFTER_DRAIN = false, APERM = false, BD = true;
    bf16_t* y; const bf16_t* gates; float sca, scb;
    __device__ __forceinline__ u32x4 comb(const f32x4 (&acc)[2][2][4][2], int ai, int m, u32x4 ga, u32x4 gb) const {
        f32x4 a0 = acc[ai][0][m][0] * sca, a1 = acc[ai][0][m][1] * sca, b0 = acc[ai][1][m][0] * scb, b1 = acc[ai][1][m][1] * scb, v0, v1;
        v0[0] = bflo(ga.x) * a0[0] + bflo(gb.x) * b0[0]; v0[1] = bfhi(ga.x) * a0[1] + bfhi(gb.x) * b0[1]; v0[2] = bflo(ga.y) * a0[2] + bflo(gb.y) * b0[2]; v0[3] = bfhi(ga.y) * a0[3] + bfhi(gb.y) * b0[3];
        v1[0] = bflo(ga.z) * a1[0] + bflo(gb.z) * b1[0]; v1[1] = bfhi(ga.z) * a1[1] + bfhi(gb.z) * b1[1]; v1[2] = bflo(ga.w) * a1[2] + bflo(gb.w) * b1[2]; v1[3] = bfhi(ga.w) * a1[3] + bfhi(gb.w) * b1[3];
        return pack8(v0, v1); }
    __device__ __forceinline__ void operator()(const f32x4 (&acc)[2][2][4][2], const Unit& u, int wr, int wc, int fr, int fq) const {
        const int row0 = u.pm * 256 + wr * 64 + fr, c0 = u.pn * 128 + wc * 32 + 8 * fq;
        u32x4 ga[4], gb[4], w0[4];
#pragma unroll
        for (int m = 0; m < 4; ++m) { const int rw = row0 + m * 16; const size_t go = (size_t)rw * 2048; ga[m] = *(const u32x4*)(gates + go + GATE_COL(rw, c0)); gb[m] = *(const u32x4*)(gates + go + GATE_COL(rw, 1024 + c0)); }
#pragma unroll
        for (int m = 0; m < 4; ++m) w0[m] = comb(acc, 0, m, ga[m], gb[m]);
#pragma unroll
        for (int m = 0; m < 4; ++m) { const int rw = row0 + 128 + m * 16; const size_t go = (size_t)rw * 2048; ga[m] = *(const u32x4*)(gates + go + GATE_COL(rw, c0)); gb[m] = *(const u32x4*)(gates + go + GATE_COL(rw, 1024 + c0)); }
#pragma unroll
        for (int m = 0; m < 4; ++m) *(u32x4*)(y + (size_t)(row0 + m * 16) * 1024 + c0) = w0[m];
#pragma unroll
        for (int m = 0; m < 4; ++m) *(u32x4*)(y + (size_t)(row0 + 128 + m * 16) * 1024 + c0) = comb(acc, 1, m, ga[m], gb[m]);
    }
};
struct EpiResidB {
    static constexpr bool PERM = true, AFTER_DRAIN = false, APERM = false, BD = false;
    bf16_t* hb; u64_t* ssq; float sc;
    __device__ __forceinline__ u32x4 upd(const f32x4 (&acc)[2][2][4][2], int ai, int bj, int m, u32x4 ov, float& part) const {
        f32x4 v0 = acc[ai][bj][m][0] * sc, v1 = acc[ai][bj][m][1] * sc;
        v0[0] += bflo(ov.x); v0[1] += bfhi(ov.x); v0[2] += bflo(ov.y); v0[3] += bfhi(ov.y); v1[0] += bflo(ov.z); v1[1] += bfhi(ov.z); v1[2] += bflo(ov.w); v1[3] += bfhi(ov.w);
        const u32x4 w = pack8(v0, v1);
        part += bflo(w.x) * bflo(w.x) + bfhi(w.x) * bfhi(w.x) + bflo(w.y) * bflo(w.y) + bfhi(w.y) * bfhi(w.y) + bflo(w.z) * bflo(w.z) + bfhi(w.z) * bfhi(w.z) + bflo(w.w) * bflo(w.w) + bfhi(w.w) * bfhi(w.w);
        return w; }
    __device__ __forceinline__ void operator()(const f32x4 (&acc)[2][2][4][2], const Unit& u, int wr, int wc, int fr, int fq) const {
        const int row0 = u.pm * 256 + wr * 64 + fr, c0 = u.pn * 256 + wc * 32 + 8 * fq;
        u32x4 o[4][2], w0[4][2]; float p0[4], p1[4];
#pragma unroll
        for (int m = 0; m < 4; ++m)
#pragma unroll
            for (int bj = 0; bj < 2; ++bj) o[m][bj] = *(const u32x4*)(hb + (size_t)(row0 + m * 16) * DM + c0 + bj * 128);
#pragma unroll
        for (int m = 0; m < 4; ++m) { p0[m] = 0.f; w0[m][0] = upd(acc, 0, 0, m, o[m][0], p0[m]); w0[m][1] = upd(acc, 0, 1, m, o[m][1], p0[m]); }
#pragma unroll
        for (int m = 0; m < 4; ++m)
#pragma unroll
            for (int bj = 0; bj < 2; ++bj) o[m][bj] = *(const u32x4*)(hb + (size_t)(row0 + 128 + m * 16) * DM + c0 + bj * 128);
#pragma unroll
        for (int m = 0; m < 4; ++m)
#pragma unroll
            for (int bj = 0; bj < 2; ++bj) *(u32x4*)(hb + (size_t)(row0 + m * 16) * DM + c0 + bj * 128) = w0[m][bj];
#pragma unroll
        for (int m = 0; m < 4; ++m) { p1[m] = 0.f;
#pragma unroll
            for (int bj = 0; bj < 2; ++bj) *(u32x4*)(hb + (size_t)(row0 + 128 + m * 16) * DM + c0 + bj * 128) = upd(acc, 1, bj, m, o[m][bj], p1[m]); }
#pragma unroll
        for (int m = 0; m < 4; ++m) {
            float a = p0[m], b = p1[m];
            a += __shfl_xor(a, 16); a += __shfl_xor(a, 32); b += __shfl_xor(b, 16); b += __shfl_xor(b, 32);
            if (ssq != nullptr && fq == 0) { atomicAdd(ssq + row0 + m * 16, (u64_t)(unsigned)(a * SSQ_SCALE + 0.5f)); atomicAdd(ssq + row0 + 128 + m * 16, (u64_t)(unsigned)(b * SSQ_SCALE + 0.5f)); }
        }
    }
};
struct EpiFinal {
    static constexpr bool PERM = true, AFTER_DRAIN = false, APERM = false, BD = false;
    const bf16_t* hb; float* out; float sc;
    __device__ __forceinline__ void operator()(const f32x4 (&acc)[2][2][4][2], const Unit& u, int wr, int wc, int fr, int fq) const {
        const int row0 = u.pm * 256 + wr * 64 + fr, c0 = u.pn * 256 + wc * 32 + 8 * fq;
        u32x4 o[2][4][2];
#pragma unroll
        for (int ai = 0; ai < 2; ++ai)
#pragma unroll
            for (int m = 0; m < 4; ++m)
#pragma unroll
                for (int bj = 0; bj < 2; ++bj) o[ai][m][bj] = *(const u32x4*)(hb + (size_t)(row0 + ai * 128 + m * 16) * DM + c0 + bj * 128);
#pragma unroll
        for (int ai = 0; ai < 2; ++ai)
#pragma unroll
            for (int m = 0; m < 4; ++m) {
                const size_t ro = (size_t)(row0 + ai * 128 + m * 16) * DM + c0;
#pragma unroll
                for (int bj = 0; bj < 2; ++bj) { const u32x4 ov = o[ai][m][bj]; f32x4 v0 = acc[ai][bj][m][0] * sc, v1 = acc[ai][bj][m][1] * sc;
                    v0[0] += bflo(ov.x); v0[1] += bfhi(ov.x); v0[2] += bflo(ov.y); v0[3] += bfhi(ov.y); v1[0] += bflo(ov.z); v1[1] += bfhi(ov.z); v1[2] += bflo(ov.w); v1[3] += bfhi(ov.w);
                    *(f32x4*)(out + ro + bj * 128) = v0; *(f32x4*)(out + ro + bj * 128 + 4) = v1; }
            }
    }
};
struct EpiNull {
    static constexpr bool PERM = true, AFTER_DRAIN = false, APERM = false, BD = false;
    __device__ __forceinline__ void operator()(const f32x4 (&acc)[2][2][4][2], const Unit& u, int wr, int wc, int fr, int fq) const {
#pragma unroll
        for (int ai = 0; ai < 2; ++ai)
#pragma unroll
            for (int bj = 0; bj < 2; ++bj)
#pragma unroll
                for (int m = 0; m < 4; ++m)
#pragma unroll
                    for (int n = 0; n < 2; ++n) asm volatile("" :: "v"(acc[ai][bj][m][n]));
    }
};
struct EpiUp {
    static constexpr bool PERM = true, AFTER_DRAIN = false, APERM = false, BD = false;
    bf16_t *gpre, *up; const u64_t* ssq;
    __device__ __forceinline__ void operator()(const f32x4 (&acc)[2][2][4][2], const Unit& u, int wr, int wc, int fr, int fq) const {
        const int row0 = u.pm * 256 + wr * 64 + fr, c0 = u.pn * 128 + wc * 32 + 8 * fq;
        u64_t sv[2][4];
#pragma unroll
        for (int ai = 0; ai < 2; ++ai)
#pragma unroll
            for (int m = 0; m < 4; ++m) sv[ai][m] = ssq[row0 + ai * 128 + m * 16];
#pragma unroll
        for (int ai = 0; ai < 2; ++ai)
#pragma unroll
            for (int m = 0; m < 4; ++m) {
                const int row = row0 + ai * 128 + m * 16; const float r = rsqrtf((float)sv[ai][m] * (SSQ_INV / DM) + EPSF);
                const size_t o = (size_t)row * DFF + c0;
                *(u32x4*)(gpre + o) = pack8(acc[ai][0][m][0] * r, acc[ai][0][m][1] * r);
                *(u32x4*)(up + o) = pack8(acc[ai][1][m][0] * r, acc[ai][1][m][1] * r);
            }
    }
};

template <int MODE> struct EpiUpConvT {
    static constexpr bool PERM = true, AFTER_DRAIN = false, APERM = true, BD = false;
    bf16_t* act; const u64_t* ssq; const float* cw; const float* hg; const float* mgu; char* xlds; int rt;
    __device__ __forceinline__ void operator()(const f32x4 (&acc)[2][2][4][2], const Unit& u, int wr, int wc, int fr, int fq) const {
        const int pm = u.pm, pn = u.pn, cl = wc * 32 + 8 * fq, ch0 = pn * 128 + cl, t0 = pm * 256 + 8 * (16 * wr + fr);
        u64_t sv[8];
#pragma unroll
        for (int j = 0; j < 8; ++j) sv[j] = (MODE == 2) ? (u64_t)(1000000 + j + rt) : ssq[t0 + j];
        float w0[8], w1[8], w2[8], b1[8], b2[8];
        { const f32x4 a0 = *(const f32x4*)(cw + ch0), a1 = *(const f32x4*)(cw + ch0 + 4), c0 = *(const f32x4*)(cw + DFF + ch0), c1 = *(const f32x4*)(cw + DFF + ch0 + 4),
                      e0 = *(const f32x4*)(cw + 2 * DFF + ch0), e1 = *(const f32x4*)(cw + 2 * DFF + ch0 + 4);
          const float* h2 = ((pm & 7) == 0) ? mgu + 14 * 5632 + pn * 256 + cl : hg + (size_t)(pm * 2) * DFF + ch0;
          const float* h1 = ((pm & 7) == 0) ? mgu + 15 * 5632 + pn * 256 + cl : hg + (size_t)(pm * 2 + 1) * DFF + ch0;
          const f32x4 p20 = *(const f32x4*)h2, p21 = *(const f32x4*)(h2 + 4), p10 = *(const f32x4*)h1, p11 = *(const f32x4*)(h1 + 4);
#pragma unroll
          for (int c = 0; c < 4; ++c) { w0[c] = a0[c]; w0[4 + c] = a1[c]; w1[c] = c0[c]; w1[4 + c] = c1[c]; w2[c] = e0[c]; w2[4 + c] = e1[c]; b2[c] = p20[c]; b2[4 + c] = p21[c]; b1[c] = p10[c]; b1[4 + c] = p11[c]; } }
        float rs[8];
#pragma unroll
        for (int j = 0; j < 8; ++j) rs[j] = rsqrtf((float)sv[j] * (SSQ_INV / DM) + EPSF);
        float g6[8], g7[8];
#pragma unroll
        for (int c = 0; c < 8; ++c) { g6[c] = acc[1][0][2][c >> 2][c & 3] * rs[6]; g7[c] = acc[1][0][3][c >> 2][c & 3] * rs[7]; }
        float* xw = (float*)(xlds + ((wc * 4 + fq) * 16) * 4);
        if (wr == 0 && fr == 15) { *(f32x4*)xw = (f32x4){g6[0], g6[1], g6[2], g6[3]}; *(f32x4*)(xw + 4) = (f32x4){g6[4], g6[5], g6[6], g6[7]};
                                   *(f32x4*)(xw + 8) = (f32x4){g7[0], g7[1], g7[2], g7[3]}; *(f32x4*)(xw + 12) = (f32x4){g7[4], g7[5], g7[6], g7[7]}; }
        asm volatile("s_waitcnt lgkmcnt(0)" ::: "memory");
        __builtin_amdgcn_s_barrier();
        asm volatile("" ::: "memory");
        if (wr == 1) { const f32x4 q0 = *(const f32x4*)xw, q1 = *(const f32x4*)(xw + 4), q2 = *(const f32x4*)(xw + 8), q3 = *(const f32x4*)(xw + 12);
#pragma unroll
            for (int c = 0; c < 4; ++c) { b2[c] = q0[c]; b2[4 + c] = q1[c]; b1[c] = q2[c]; b1[4 + c] = q3[c]; } }
        float gm1[8], gm2[8];
#pragma unroll
        for (int c = 0; c < 8; ++c) {
            gm1[c] = __int_as_float(__builtin_amdgcn_update_dpp(__float_as_int(b1[c]), __float_as_int(g7[c]), 0x111, 0xf, 0xf, false));
            gm2[c] = __int_as_float(__builtin_amdgcn_update_dpp(__float_as_int(b2[c]), __float_as_int(g6[c]), 0x111, 0xf, 0xf, false)); }
#pragma unroll
        for (int j = 0; j < 8; ++j) { const int ai = j >> 2, m = j & 3; float o[8];
#pragma unroll
            for (int c = 0; c < 8; ++c) { const float g = acc[ai][0][m][c >> 2][c & 3] * rs[j], up = acc[ai][1][m][c >> 2][c & 3] * rs[j];
                o[c] = silu_f(w0[c] * gm2[c] + w1[c] * gm1[c] + w2[c] * g) * up; gm2[c] = gm1[c]; gm1[c] = g; }
            u32x4 w; w.x = cvt_pk(o[0], o[1]); w.y = cvt_pk(o[2], o[3]); w.z = cvt_pk(o[4], o[5]); w.w = cvt_pk(o[6], o[7]);
            if (MODE != 1 || rt == 12345) ST16(act + (size_t)(t0 + j) * DFF + ch0, w); }
    }
};
typedef EpiUpConvT<0> EpiUpConv;

constexpr int MN_PITCH = 2064;
template <bool ALDS, class F> __device__ __forceinline__ void small_gemm16(const void* Ain, const bf16_t* Bt, int N, int K, const F& epi, char* red) {
    int tid_ = threadIdx.x; asm volatile("" : "+v"(tid_));
    const int lane = tid_ & 63, wid = tid_ >> 6, r = lane & 15, g = lane >> 4;
    const int kw = K >> 3, kb0 = wid * kw;
    for (int ct = blockIdx.x; ct < N / 16; ct += gridDim.x) {
        f32x4 acc = {0.f, 0.f, 0.f, 0.f};
        const bf16_t* bp = Bt + (size_t)(ct * 16 + r) * K + kb0 + g * 8;
        if (ALDS) { const char* ap = (const char*)Ain + r * MN_PITCH + (kb0 + g * 8) * 2;
#pragma unroll 4
            for (int k = 0; k < kw; k += 32) acc = mfma16(*(const bf16x8*)(ap + k * 2), *(const bf16x8*)(bp + k), acc);
        } else { const bf16_t* ap = (const bf16_t*)Ain + (size_t)r * K + kb0 + g * 8;
#pragma unroll 4
            for (int k = 0; k < kw; k += 32) acc = mfma16(*(const bf16x8*)(ap + k), *(const bf16x8*)(bp + k), acc); }
        *(f32x4*)(red + (wid * 64 + lane) * 16) = acc;
        __syncthreads();
        if (wid == 0) { f32x4 s = *(const f32x4*)(red + lane * 16);
#pragma unroll
            for (int w = 1; w < 8; ++w) s += *(const f32x4*)(red + (w * 64 + lane) * 16);
#pragma unroll
            for (int rr = 0; rr < 4; ++rr) epi(4 * g + rr, ct * 16 + r, s[rr]); }
        __syncthreads();
    }
}
__device__ __forceinline__ void meta_norm_lds(const float* hmeta, char* img) {
    int tid_ = threadIdx.x; asm volatile("" : "+v"(tid_));
    const int lane = tid_ & 63, wid = tid_ >> 6;
#pragma unroll
    for (int rr = 0; rr < 2; ++rr) { const int row = 2 * wid + rr; const float* src = hmeta + row * DM;
        f32x4 v[4]; float ss = 0.f;
#pragma unroll
        for (int i = 0; i < 4; ++i) { v[i] = ((const f32x4*)src)[lane + 64 * i]; ss += v[i][0] * v[i][0] + v[i][1] * v[i][1] + v[i][2] * v[i][2] + v[i][3] * v[i][3]; }
        ss = wave_sum(ss); const float rstd = rsqrtf(ss * (1.f / DM) + EPSF);
#pragma unroll
        for (int i = 0; i < 4; ++i) { u32x2 w; w.x = cvt_pk(v[i][0] * rstd, v[i][1] * rstd); w.y = cvt_pk(v[i][2] * rstd, v[i][3] * rstd); *(u32x2*)(img + row * MN_PITCH + (lane + 64 * i) * 8) = w; } }
    __syncthreads();
}
struct MEpiIn { unsigned char* ws; const float* bgate;
    __device__ __forceinline__ void operator()(int t, int n, float v) const {
        if (n < 1536) ((bf16_t*)(ws + M_RAW))[t * 1536 + n] = f2bf(v);
        else if (n < 2048) ((bf16_t*)(ws + M_Z))[t * 512 + n - 1536] = f2bf(v);
        else if (n < 2560) ((bf16_t*)(ws + M_BQ))[t * 512 + n - 2048] = f2bf(v);
        else if (n < 3072) ((bf16_t*)(ws + M_IQ))[t * 512 + n - 2560] = f2bf(v);
        else if (n < 3200) ((bf16_t*)(ws + M_K))[t * 128 + n - 3072] = f2bf(v);
        else if (n < 3328) ((bf16_t*)(ws + M_V))[t * 128 + n - 3200] = f2bf(v);
        else if (n < 3392) { }
        else if (n < 3408) ((float*)(ws + M_MISC))[t * 16 + n - 3392] = v;
        else if (n < 3584) { }
        else ((bf16_t*)(ws + M_GATES))[t * 2048 + n - 3584] = f2bf(SIG_META(v + bgate[n - 3584]));
    } };
struct MEpiBr { unsigned char* ws; float sca, scb;
    __device__ __forceinline__ void operator()(int t, int n, float v) const {
        const int ch = 128 * (n >> 8) + (n & 127), br = (n >> 7) & 1;
        const float g = bf2f(((const bf16_t*)(ws + M_GATES))[t * 2048 + br * 1024 + ch]);
        ((float*)(ws + M_GU))[t * 5632 + n] = g * v * (br ? scb : sca);
    } };
struct MEpiResid { float* h; float sc; __device__ __forceinline__ void operator()(int t, int n, float v) const { h[t * 1024 + n] += v * sc; } };
struct MEpiUp { float* gu; __device__ __forceinline__ void operator()(int t, int n, float v) const { gu[t * 5632 + n] = v; } };

struct MapId { __device__ __forceinline__ int operator()(int n) const { return n; } };
struct MapWin { __device__ __forceinline__ int operator()(int n) const {
    if (n < 2048) return n; if (n < 2560) return n - 2048 + 2056; if (n < 3072) return n - 2560 + 2824; if (n < 3200) return n - 3072 + 2568;
    if (n < 3328) return n - 3200 + 2696; if (n < 3392) return n - 3328 + 3336; if (n < 3400) return n - 3392 + 2048; if (n < 3408) return n; return -1; } };
struct MapWup { __device__ __forceinline__ int operator()(int n) const { const int t = n >> 8, w = n & 255; return w < 128 ? 128 * t + w : 2816 + 128 * t + (w - 128); } };
struct MapBrA { __device__ __forceinline__ int operator()(int n) const { return (n & 255) < 128 ? 128 * (n >> 8) + (n & 127) : -1; } };
struct MapBrB { __device__ __forceinline__ int operator()(int n) const { return (n & 255) >= 128 ? 128 * (n >> 8) + (n & 127) : -1; } };
template <class Map> __device__ __forceinline__ void tr_cvt(const float* __restrict__ src, int ldsrc, int K, bf16_t* __restrict__ dst, int ldd, int koff, int Nd, const Map& map, const float* gain, float* tile, int& g0) {
    const int G = gridDim.x, tid = threadIdx.x, nnt = Nd / 64, nt = nnt * (K / 128);
    int t = ((int)blockIdx.x - (g0 % G) + G) % G;
    for (; t < nt; t += G) {
        const int n0 = (t % nnt) * 64, k0 = (t / nnt) * 128;
        { const int nn = tid & 63, col = map(n0 + nn); float v[16];
#pragma unroll
          for (int i = 0; i < 16; ++i) { const int kk = (tid >> 6) + 8 * i; v[i] = col >= 0 ? src[(size_t)(k0 + kk) * ldsrc + col] : 0.f; }
#pragma unroll
          for (int i = 0; i < 16; ++i) { const int kk = (tid >> 6) + 8 * i; tile[kk * 65 + nn] = v[i]; } }
        __syncthreads();
#pragma unroll
        for (int hh = 0; hh < 2; ++hh) { const int nn = tid >> 3, part = (tid & 7) + 8 * hh; float v[8];
#pragma unroll
          for (int jj = 0; jj < 8; ++jj) { const int kk = part * 8 + jj; v[jj] = tile[kk * 65 + nn] * (gain ? gain[k0 + kk] : 1.f); }
          u32x4 w; w.x = cvt_pk(v[0], v[1]); w.y = cvt_pk(v[2], v[3]); w.z = cvt_pk(v[4], v[5]); w.w = cvt_pk(v[6], v[7]);
          *(u32x4*)(dst + (size_t)(n0 + nn) * ldd + koff + k0 + part * 8) = w; }
        __syncthreads();
    }
    g0 += nt;
}
__device__ __forceinline__ void p_prologue(const Args& a, char* smem) {
    unsigned char* ws = a.ws; { size_t z_ = 0; asm volatile("" : "+s"(z_)); ws += z_; } float* tile = (float*)smem; int g0 = 0;
    for (int l = 0; l < NLAYER; ++l) {
        const float* gmix = a.in[I_NORM_MIX] + l * DM; const float* gffn = a.in[I_NORM_FFN] + l * DM;
        tr_cvt(a.in[I_W_IN] + (size_t)l * DM * 3408, 3408, DM, (bf16_t*)(ws + OFF_WIN) + (size_t)l * NIN * DM, DM, 0, 3584, MapWin(), gmix, tile, g0);
        tr_cvt(a.in[I_W_GATE] + (size_t)l * DM * 2048, 2048, DM, (bf16_t*)(ws + OFF_WIN) + ((size_t)l * NIN + 3584) * DM, DM, 0, 2048, MapId(), gmix, tile, g0);
        tr_cvt(a.in[I_W_BA] + (size_t)l * 512 * DM, DM, 512, (bf16_t*)(ws + OFF_WBR) + (size_t)l * 2048 * DM, DM, 0, 2048, MapBrA(), nullptr, tile, g0);
        tr_cvt(a.in[I_W_BB] + (size_t)l * 512 * DM, DM, 512, (bf16_t*)(ws + OFF_WBR) + (size_t)l * 2048 * DM, DM, 512, 2048, MapBrB(), nullptr, tile, g0);
        tr_cvt(a.in[I_W_OUT] + (size_t)l * DM * DM, DM, DM, (bf16_t*)(ws + OFF_WOUT) + (size_t)l * DM * DM, DM, 0, DM, MapId(), nullptr, tile, g0);
        tr_cvt(a.in[I_W_UP] + (size_t)l * DM * 5632, 5632, DM, (bf16_t*)(ws + OFF_WUP) + (size_t)l * NIN * DM, DM, 0, NIN, MapWup(), gffn, tile, g0);
        tr_cvt(a.in[I_W_DOWN] + (size_t)l * DFF * DM, DM, DFF, (bf16_t*)(ws + OFF_WDN) + (size_t)l * DM * DFF, DFF, 0, DM, MapId(), nullptr, tile, g0);
    }
    const int gt = blockIdx.x * 512 + threadIdx.x, nT = gridDim.x * 512;
    { const int lane = threadIdx.x & 63, gw = blockIdx.x * 8 + (threadIdx.x >> 6), nW = gridDim.x * 8;
      bf16_t* hb = (bf16_t*)(ws + OFF_HB); u64_t* ssq = (u64_t*)(ws + OFF_SSQ);
      for (int row = 2 * gw; row < RR; row += 2 * nW) { const float* src = a.in[I_X] + (size_t)row * DM; float ss0 = 0.f, ss1 = 0.f; f32x4 v[8];
#pragma unroll
          for (int i = 0; i < 8; ++i) v[i] = ((const f32x4*)src)[lane + 64 * i];
#pragma unroll
          for (int i = 0; i < 8; ++i) { u32x2 w; w.x = cvt_pk(v[i][0], v[i][1]); w.y = cvt_pk(v[i][2], v[i][3]);
              const float q = bflo(w.x) * bflo(w.x) + bfhi(w.x) * bfhi(w.x) + bflo(w.y) * bflo(w.y) + bfhi(w.y) * bfhi(w.y); if (i < 4) ss0 += q; else ss1 += q;
              ((u32x2*)(hb + (size_t)row * DM))[lane + 64 * i] = w; }
          ss0 = wave_sum(ss0); ss1 = wave_sum(ss1); if (lane == 0) { ssq[row] = (u64_t)(ss0 * SSQ_SCALE + 0.5f); ssq[row + 1] = (u64_t)(ss1 * SSQ_SCALE + 0.5f); } }
      for (int i = gt; i < 3 * RR; i += nT) ssq[RR + i] = 0ull; }
    float* cosA = (float*)(ws + OFF_COSA); float* sinA = (float*)(ws + OFF_SINA); float* cosI = (float*)(ws + OFF_COSI); float* sinI = (float*)(ws + OFF_SINI);
    for (int i = gt; i < TPOS * 96; i += nT) {
        const int pos = i / 96, j = i % 96;
        if (j < 64) { const float inv = 1.0f / powf(10000.f, (float)(2 * j) / 128.f), ang = (float)pos * inv; cosA[pos * 64 + j] = cosf(ang); sinA[pos * 64 + j] = sinf(ang); }
        else { const int jj = j - 64; const float inv = 1.0f / powf(10000.f, (float)(2 * jj) / 64.f), ang = (float)pos * inv; cosI[pos * 32 + jj] = cosf(ang); sinI[pos * 32 + jj] = sinf(ang); }
    }
    for (int i = gt; i < 16 * 1024; i += nT) ((float*)(ws + M_H))[i] = a.in[I_META][i];
    for (int i = gt; i < NB * (TP - TPOS) * 16; i += nT) {
        const int b = i / ((TP - TPOS) * 16), r = i % ((TP - TPOS) * 16);
        const size_t o = ((size_t)b * TP + TPOS) * 128 + (size_t)r * 8;
        *(u32x4*)((bf16_t*)(ws + OFF_KB) + o) = (u32x4){0u, 0u, 0u, 0u}; *(u32x4*)((bf16_t*)(ws + OFF_VB) + o) = (u32x4){0u, 0u, 0u, 0u};
    }
}

template <int GL, bool NORM> __device__ __forceinline__ u32x4 rope8(u32x4 raw, int lig, const float* w, const float* cs, const float* sn) {
    float x[8] = {bflo(raw.x), bfhi(raw.x), bflo(raw.y), bfhi(raw.y), bflo(raw.z), bfhi(raw.z), bflo(raw.w), bfhi(raw.w)};
    if (NORM) { float ss = 0.f;
#pragma unroll
        for (int j = 0; j < 8; ++j) ss += x[j] * x[j];
        ss += dpp_mov<0xB1>(ss); ss += dpp_mov<0x4E>(ss); ss += dpp_mov<0x141>(ss); if (GL == 16) ss += dpp_mov<0x140>(ss);
        const float rstd = rsqrtf(ss * (1.f / (8 * GL)) + EPSF);
        const f32x4 w0 = *(const f32x4*)(w + 8 * lig), w1 = *(const f32x4*)(w + 8 * lig + 4);
#pragma unroll
        for (int j = 0; j < 4; ++j) { x[j] *= rstd * w0[j]; x[4 + j] *= rstd * w1[j]; } }
    const int ih = lig & (GL / 2 - 1); const bool second = lig >= GL / 2;
    const f32x4 c0 = *(const f32x4*)(cs + 8 * ih), c1 = *(const f32x4*)(cs + 8 * ih + 4), s0 = *(const f32x4*)(sn + 8 * ih), s1 = *(const f32x4*)(sn + 8 * ih + 4);
    float o[8];
#pragma unroll
    for (int j = 0; j < 8; ++j) { const float other = (GL == 16) ? dpp_mov<0x128>(x[j]) : dpp_mov<0x1B>(dpp_mov<0x141>(x[j])), cc = j < 4 ? c0[j] : c1[j - 4], ss_ = j < 4 ? s0[j] : s1[j - 4];
        o[j] = x[j] * cc + (second ? other * ss_ : -other * ss_); }
    u32x4 r; r.x = cvt_pk(o[0], o[1]); r.y = cvt_pk(o[2], o[3]); r.z = cvt_pk(o[4], o[5]); r.w = cvt_pk(o[6], o[7]); return r;
}
namespace mp {
constexpr int RAW_OFF = 0, QS_OFF = 51712, KS_OFF = 70144, MT_OFF = 88576, GC_OFF = 154112, BT_OFF = 155136, RED_OFF = 156160, CNT_OFF = 157184;
}
__device__ __forceinline__ void p_mixprep(const Args& a, int layer, char* smem, bool do_store, int skip = 0) {
    using namespace mp;
    unsigned char* ws = a.ws; { size_t z_ = 0; asm volatile("" : "+s"(z_)); ws += z_; }
    bf16_t* qkv = (bf16_t*)(ws + OFF_QKV); const bf16_t* halo = (const bf16_t*)(ws + OFF_HALO); const bf16_t* mraw = (const bf16_t*)(ws + M_RAW);
    bf16_t* mchunk = (bf16_t*)(ws + M_CHUNK); bf16_t* TQ = (bf16_t*)(ws + OFF_TQ); bf16_t* mTQ = (bf16_t*)(ws + M_TQ);
    const float* conv_a = a.in[I_CONV_A] + (size_t)layer * 4 * 1536;
    const float* a_log = a.in[I_A_LOG] + layer * 4; const float* dt_bias = a.in[I_DT_BIAS] + layer * 4;
    const float* qn = a.in[I_Q_NORM] + layer * 128; const float* kn = a.in[I_K_NORM] + layer * 128; const float* kin = a.in[I_KIDX_NORM] + layer * 64;
    const float* cosA = (const float*)(ws + OFF_COSA); const float* sinA = (const float*)(ws + OFF_SINA); const float* cosI = (const float*)(ws + OFF_COSI); const float* sinI = (const float*)(ws + OFF_SINI);
    float* GCs = (float*)(smem + GC_OFF); float* BTs = (float*)(smem + BT_OFF); float* RED = (float*)(smem + RED_OFF);
    bf16_t* QS = (bf16_t*)(smem + QS_OFF); bf16_t* KS = (bf16_t*)(smem + KS_OFF); bf16_t* RV = (bf16_t*)(smem + RAW_OFF + 2 * 67 * 256);
    for (int item = blockIdx.x; item < 1028; item += gridDim.x) {
        int tid_ = threadIdx.x; asm volatile("" : "+v"(tid_));
        const int tid = tid_, lane = tid & 63, wid = __builtin_amdgcn_readfirstlane(tid >> 6);
        const bool is_meta = item >= 1024; const int b = item >> 5, c = item & 31, row0 = b * 2048 + 64 * c;
        const int h_lo = is_meta ? item - 1024 : 0, h_hi = is_meta ? h_lo + 1 : 4;
        { float g = 0.f, be = 0.f; const int t = tid >> 2, h = tid & 3;
          if (tid < 256 && (!is_meta || t >= 48)) { const float* mpp = is_meta ? (const float*)(ws + M_MISC) + (t - 48) * 16 : (const float*)(ws + OFF_MISC) + (size_t)(row0 + t) * 16;
              g = -__expf(a_log[h]) * softplus_f(mpp[h] + dt_bias[h]); be = SIG_BETA(mpp[4 + h]); }
          float s = g;
#pragma unroll
          for (int o = 4; o < 64; o <<= 1) { const float v = __shfl_up(s, o); if (lane >= o) s += v; }
          if (tid < 256 && lane >= 60) RED[wid * 4 + (lane & 3)] = s;
          __syncthreads();
          if (tid < 256) { for (int w = 0; w < wid; ++w) s += RED[w * 4 + h]; GCs[tid] = s; BTs[tid] = be; } }
        __syncthreads();
        if (do_store && tid < 256 && item <= 1024) { float* gd = is_meta ? (float*)(ws + M_GC) : (float*)(ws + OFF_GC) + (size_t)row0 * 4; float* bd = is_meta ? (float*)(ws + M_BETA) : (float*)(ws + OFF_BETA) + (size_t)row0 * 4;
            gd[tid] = GCs[tid]; bd[tid] = BTs[tid]; }
        const bf16_t* zsrc = (const bf16_t*)(ws + OFF_KB) + (size_t)TPOS * 128;
#define MP_DMA(hh, plo, phi) do { int td_ = tid; asm volatile("" : "+v"(td_)); _Pragma("unroll 1") for (int it = 0; it < 7; ++it) { const int p = td_ + 512 * it; \
            if (p >= (plo) && p < (phi)) { const int tensor = p / (67 * 16), rem = p - tensor * (67 * 16), rr = rem >> 4, cc = (rem & 15) * 8, tt = rr - 3, col = tensor * 512 + (hh) * 128 + cc; \
                const bf16_t* sp = zsrc; \
                if (!is_meta) { if (tt >= 0) sp = qkv + (size_t)(row0 + tt) * 1536 + col; else if (c > 0) sp = halo + ((size_t)((row0 >> 6) - 1) * 3 + (tt + 3)) * 1536 + col; \
                    else sp = mraw + (size_t)(16 + tt) * 1536 + col; } \
                else if (tt >= 48) sp = mraw + (size_t)(tt - 48) * 1536 + col; \
                __builtin_amdgcn_global_load_lds((const unsigned*)sp, (LAS unsigned*)(smem + RAW_OFF + (wid * 64 + 512 * it) * 16), 16, 0, 0); } } } while (0)
        MP_DMA(h_lo, 0, 3 * 67 * 16);
        for (int h = h_lo; h < ((skip & 8) ? h_lo : h_hi); ++h) {
            const int co = lane & 15, t0 = 2 * (wid * 4 + (lane >> 4));
            f32x4 cw[3][4][2];
#pragma unroll
            for (int tensor = 0; tensor < 3; ++tensor)
#pragma unroll
                for (int k = 0; k < 4; ++k) { const float* wp = conv_a + k * 1536 + tensor * 512 + h * 128 + 8 * co; cw[tensor][k][0] = *(const f32x4*)wp; cw[tensor][k][1] = *(const f32x4*)(wp + 4); }
            asm volatile("s_waitcnt vmcnt(0)" ::: "memory");
            __syncthreads();
            u32x4 ov[2];
#pragma unroll
            for (int tensor = 0; tensor < 3; ++tensor) {
                const char* rp = smem + RAW_OFF + tensor * 67 * 256 + t0 * 256 + co * 16;
                float x[5][8];
#pragma unroll
                for (int r = 0; r < 5; ++r) { const u32x4 v = *(const u32x4*)(rp + r * 256);
                    x[r][0] = bflo(v.x); x[r][1] = bfhi(v.x); x[r][2] = bflo(v.y); x[r][3] = bfhi(v.y); x[r][4] = bflo(v.z); x[r][5] = bfhi(v.z); x[r][6] = bflo(v.w); x[r][7] = bfhi(v.w); }
#pragma unroll
                for (int i = 0; i < 2; ++i) { float y[8]; float ss = 0.f;
#pragma unroll
                    for (int j = 0; j < 8; ++j) { const float pre = cw[tensor][0][j >> 2][j & 3] * x[i][j] + cw[tensor][1][j >> 2][j & 3] * x[i + 1][j] + cw[tensor][2][j >> 2][j & 3] * x[i + 2][j] + cw[tensor][3][j >> 2][j & 3] * x[i + 3][j];
                        y[j] = (skip & 32) ? x[i + 3][j] : silu_f(pre); ss += y[j] * y[j]; }
                    if (tensor < 2) { if (!(skip & 1)) ss = row_sum16(ss);
                        const float rn = rsqrtf(ss + EPSF) * (tensor == 0 ? 0.08838834764831845f : 1.f);
#pragma unroll
                        for (int j = 0; j < 8; ++j) y[j] *= rn; }
                    u32x4 o; o.x = cvt_pk(y[0], y[1]); o.y = cvt_pk(y[2], y[3]); o.z = cvt_pk(y[4], y[5]); o.w = cvt_pk(y[6], y[7]);
                    if (tensor == 0) *(u32x4*)(QS + (t0 + i) * 144 + 8 * co) = o; else if (tensor == 1) *(u32x4*)(KS + (t0 + i) * 144 + 8 * co) = o; else ov[i] = o; }
            }
            __syncthreads();
            if (h + 1 < h_hi) MP_DMA(h + 1, 0, 2 * 67 * 16);
            *(u32x4*)(RV + (t0 + 3) * 128 + 8 * co) = ov[0]; *(u32x4*)(RV + (t0 + 4) * 128 + 8 * co) = ov[1];
            __syncthreads();
            if (!(skip & 128)) { bf16_t* dbase = is_meta ? mchunk : qkv + (size_t)row0 * 1536;
              for (int p = tid; p < 3072; p += 512) { const int tensor = p >> 10, t = (p & 1023) >> 4, cc = (p & 15) * 8;
                  const bf16_t* sp = tensor == 0 ? QS + t * 144 + cc : (tensor == 1 ? KS + t * 144 + cc : RV + (t + 3) * 128 + cc);
                  if (do_store) *(u32x4*)(dbase + (size_t)t * 1536 + tensor * 512 + h * 128 + cc) = *(const u32x4*)sp; } }
            if (!(skip & 256)) { const int r = lane & 15, g = lane >> 4, mt = wid >> 1;
              bf16_t* tqd = is_meta ? mTQ + h * 8192 : TQ + (size_t)((row0 >> 6) * 4 + h) * 8192;
              float* MT = (float*)(smem + MT_OFF) + h * 4096;
#pragma unroll
              for (int nti = 0; nti < 2; ++nti) { const int nt = 2 * (wid & 1) + nti;
                  f32x4 akk = {0.f, 0.f, 0.f, 0.f}, aqk = {0.f, 0.f, 0.f, 0.f};
#pragma unroll
                  for (int s = 0; s < 4; ++s) {
                      const bf16x8 fk = *(const bf16x8*)(KS + (16 * mt + r) * 144 + 32 * s + 8 * g);
                      const bf16x8 fq = *(const bf16x8*)(QS + (16 * mt + r) * 144 + 32 * s + 8 * g);
                      const bf16x8 fb = *(const bf16x8*)(KS + (16 * nt + r) * 144 + 32 * s + 8 * g);
                      akk = mfma16(fk, fb, akk); aqk = mfma16(fq, fb, aqk); }
                  const int j = 16 * nt + r; const float gcj = GCs[j * 4 + h];
#pragma unroll
                  for (int rr = 0; rr < 4; ++rr) { const int i = 16 * mt + 4 * g + rr; const float gci = GCs[i * 4 + h], bi = BTs[i * 4 + h];
                      const float dec = (i >= j) ? __expf(gci - gcj) : 0.f;
                      MT[i * 64 + j] = (i > j) ? bi * akk[rr] * dec : 0.f;
                      if (do_store) tqd[4096 + i * 64 + j] = f2bf((i >= j) ? aqk[rr] * dec : 0.f); } } }
            __syncthreads();
            if (h + 1 < h_hi) MP_DMA(h + 1, 2 * 67 * 16, 3 * 67 * 16);
        }
#undef MP_DMA
        if (!(skip & 2) && wid < 4 && wid >= h_lo && wid < h_hi) { const int hh = wid;
            float* MT = (float*)(smem + MT_OFF) + hh * 4096;
            const int ib = is_meta ? 48 : 0;
            if (is_meta) for (int i = 0; i < 48; ++i) MT[i * 64 + lane] = (lane == i) ? 1.f : 0.f;
            for (int i0 = ib; i0 < 64; i0 += 4) {
                float a0 = (lane == i0) ? 1.f : 0.f, a1 = (lane == i0 + 1) ? 1.f : 0.f, a2 = (lane == i0 + 2) ? 1.f : 0.f, a3 = (lane == i0 + 3) ? 1.f : 0.f;
#pragma unroll 2
                for (int j = ib; j < i0; j += 4) {
                    const f32x4 m0 = *(const f32x4*)(MT + (i0 + 0) * 64 + j), m1 = *(const f32x4*)(MT + (i0 + 1) * 64 + j), m2 = *(const f32x4*)(MT + (i0 + 2) * 64 + j), m3 = *(const f32x4*)(MT + (i0 + 3) * 64 + j);
                    const float t0 = MT[(j + 0) * 64 + lane], t1 = MT[(j + 1) * 64 + lane], t2 = MT[(j + 2) * 64 + lane], t3 = MT[(j + 3) * 64 + lane];
                    a0 -= m0[0] * t0 + m0[1] * t1 + m0[2] * t2 + m0[3] * t3; a1 -= m1[0] * t0 + m1[1] * t1 + m1[2] * t2 + m1[3] * t3;
                    a2 -= m2[0] * t0 + m2[1] * t1 + m2[2] * t2 + m2[3] * t3; a3 -= m3[0] * t0 + m3[1] * t1 + m3[2] * t2 + m3[3] * t3; }
                const f32x4 d1 = *(const f32x4*)(MT + (i0 + 1) * 64 + i0), d2 = *(const f32x4*)(MT + (i0 + 2) * 64 + i0), d3 = *(const f32x4*)(MT + (i0 + 3) * 64 + i0);
                a1 -= d1[0] * a0; a2 -= d2[0] * a0 + d2[1] * a1; a3 -= d3[0] * a0 + d3[1] * a1 + d3[2] * a2;
                MT[(i0 + 0) * 64 + lane] = a0; MT[(i0 + 1) * 64 + lane] = a1; MT[(i0 + 2) * 64 + lane] = a2; MT[(i0 + 3) * 64 + lane] = a3;
            }
            bf16_t* td = is_meta ? mTQ + hh * 8192 : TQ + (size_t)((row0 >> 6) * 4 + hh) * 8192;
            if (do_store) for (int it = 0; it < 8; ++it) { const int p = lane + 64 * it; const f32x4 v0 = *(const f32x4*)(MT + p * 8), v1 = *(const f32x4*)(MT + p * 8 + 4);
                *(u32x4*)(td + p * 8) = pack8(v0, v1); }
        }
        if (!(skip & 4) && item <= 1024 && (wid >= 4 || !is_meta)) {
            bf16_t* kb = (bf16_t*)(ws + OFF_KB); bf16_t* vb = (bf16_t*)(ws + OFF_VB); bf16_t* ikb = (bf16_t*)(ws + OFF_IKB);
            const int ntok = is_meta ? 4 : (wid >= 4 ? 12 : 4), tbase = is_meta ? (wid - 4) * 4 : (wid >= 4 ? (wid - 4) * 12 : 48 + wid * 4);
            for (int t0 = 0; t0 < ntok; t0 += 4) {
                u32x4 rq[4], ri[4], rm[4];
#pragma unroll
                for (int u = 0; u < 4; ++u) { const int tl = tbase + t0 + u; const size_t row = (size_t)row0 + tl; const int pos = is_meta ? tl : 16 + 64 * c + tl;
                    const bf16_t* qp = is_meta ? (const bf16_t*)(ws + M_BQ) + tl * 512 : (const bf16_t*)(ws + OFF_BQ) + row * 512;
                    const bf16_t* ip = is_meta ? (const bf16_t*)(ws + M_IQ) + tl * 512 : (const bf16_t*)(ws + OFF_IQ) + row * 512;
                    rq[u] = *(const u32x4*)(qp + lane * 8); ri[u] = *(const u32x4*)(ip + lane * 8);
                    const bf16_t* mp = is_meta ? (const bf16_t*)(ws + M_K) + tl * 128 + (lane & 15) * 8
                                               : (lane < 16 ? kb + ((size_t)b * TP + pos) * 128 + lane * 8 : ikb + ((size_t)b * TP + pos) * 64 + (lane & 7) * 8);
                    rm[u] = *(const u32x4*)mp; }
#pragma unroll
                for (int u = 0; u < 4; ++u) { const int tl = tbase + t0 + u; const size_t row = (size_t)row0 + tl; const int pos = is_meta ? tl : 16 + 64 * c + tl;
                    const u32x4 oq = rope8<16, true>(rq[u], lane & 15, qn, cosA + pos * 64, sinA + pos * 64);
                    const u32x4 oi = rope8<8, false>(ri[u], lane & 7, nullptr, cosI + pos * 32, sinI + pos * 32);
                    const u32x4 ok = rope8<16, true>(rm[u], lane & 15, kn, cosA + pos * 64, sinA + pos * 64);
                    const u32x4 oik = rope8<8, true>(rm[u], lane & 7, kin, cosI + pos * 32, sinI + pos * 32);
                    bf16_t* qp = is_meta ? (bf16_t*)(ws + M_BQ) + tl * 512 : (bf16_t*)(ws + OFF_BQ) + row * 512;
                    bf16_t* ip = is_meta ? (bf16_t*)(ws + M_IQ) + tl * 512 : (bf16_t*)(ws + OFF_IQ) + row * 512;
                    if (do_store) { *(u32x4*)(qp + lane * 8) = oq; *(u32x4*)(ip + lane * 8) = oi; }
                    if (!do_store) { } else if (!is_meta) { if (lane < 16) *(u32x4*)(kb + ((size_t)b * TP + pos) * 128 + lane * 8) = ok; else if (lane < 24) *(u32x4*)(ikb + ((size_t)b * TP + pos) * 64 + (lane & 7) * 8) = oik; }
                    else {
                        const u32x4 vv = *(const u32x4*)((const bf16_t*)(ws + M_V) + tl * 128 + (lane & 15) * 8);
                        if (lane < 16) for (int bb = 0; bb < NB; ++bb) { *(u32x4*)(kb + ((size_t)bb * TP + tl) * 128 + lane * 8) = ok; *(u32x4*)(vb + ((size_t)bb * TP + tl) * 128 + lane * 8) = vv; } }
                }
            }
        }
        __syncthreads();
    }
}

namespace gs { constexpr int KN_OFF = 0, KT_OFF = 17408, QN_OFF = 35840, VT_OFF = 53248, TT_OFF = 71680, QK_OFF = 80896, GC_OFF = 90112, BT_OFF = 90368, OT_OFF = 90624; }
__device__ __forceinline__ bf16x8 frag2(const char* base, int off) { return *(const bf16x8*)(base + off); }
__device__ __forceinline__ void gdn_scan_item(const Args& a, int layer, int b, int h, char* smem) {
    using namespace gs;
    unsigned char* ws = a.ws; { size_t z_ = 0; asm volatile("" : "+s"(z_)); ws += z_; }
    int tid_ = threadIdx.x; asm volatile("" : "+v"(tid_));
    const int tid = tid_, lane = tid & 63, wid = __builtin_amdgcn_readfirstlane(tid >> 6), r = lane & 15, g = lane >> 4, e0 = 16 * wid;
    const bf16_t* qkv = (const bf16_t*)(ws + OFF_QKV); const bf16_t* mchunk = (const bf16_t*)(ws + M_CHUNK);
    const bf16_t* TQ = (const bf16_t*)(ws + OFF_TQ); const bf16_t* mTQ = (const bf16_t*)(ws + M_TQ);
    const float* ng = a.in[I_A_OUT_NORM] + layer * 128;
    const float ng1 = ng[lane], ng2 = ng[lane + 64];
    f32x4 S[8];
#pragma unroll
    for (int i = 0; i < 8; ++i) S[i] = (f32x4){0.f, 0.f, 0.f, 0.f};
    u32x4 pk[2], pq[2], pv[2], pt, pqk; float psc = 0.f;
#define GS_LOAD(n) do { const int n_ = (n); \
        const bf16_t* qb_ = n_ == 0 ? mchunk : qkv + (size_t)(b * 2048 + 64 * (n_ - 1)) * 1536; \
        const bf16_t* tq_ = n_ == 0 ? mTQ + h * 8192 : TQ + (size_t)((b * 32 + n_ - 1) * 4 + h) * 8192; \
        const float* gc_ = n_ == 0 ? (const float*)(ws + M_GC) : (const float*)(ws + OFF_GC) + (size_t)(b * 2048 + 64 * (n_ - 1)) * 4; \
        const float* bt_ = n_ == 0 ? (const float*)(ws + M_BETA) : (const float*)(ws + OFF_BETA) + (size_t)(b * 2048 + 64 * (n_ - 1)) * 4; \
        _Pragma("unroll") for (int i_ = 0; i_ < 2; ++i_) { const int p_ = tid + 512 * i_, cr_ = p_ >> 4, d0_ = (p_ & 15) * 8; const bf16_t* rp_ = qb_ + (size_t)cr_ * 1536 + h * 128 + d0_; \
            pq[i_] = *(const u32x4*)rp_; pk[i_] = *(const u32x4*)(rp_ + 512); pv[i_] = *(const u32x4*)(rp_ + 1024); } \
        pt = *(const u32x4*)(tq_ + (tid >> 3) * 64 + (tid & 7) * 8); pqk = *(const u32x4*)(tq_ + 4096 + (tid >> 3) * 64 + (tid & 7) * 8); \
        if (tid < 64) psc = gc_[tid * 4 + h]; else if (tid < 128) psc = bt_[(tid - 64) * 4 + h]; } while (0)
    GS_LOAD(0);
    for (int n = 0; n < 33; ++n) {
#pragma unroll
        for (int i = 0; i < 2; ++i) { const int p = tid + 512 * i, cr = p >> 4, d0 = (p & 15) * 8;
            { const int u = (d0 >> 3) & 3, pa = (d0 & ~31) + 16 * (u & 1) + 4 * (u >> 1);
              *(u32x2*)(smem + KN_OFF + cr * 272 + pa * 2) = (u32x2){pk[i].x, pk[i].y}; *(u32x2*)(smem + KN_OFF + cr * 272 + (pa + 8) * 2) = (u32x2){pk[i].z, pk[i].w};
              *(u32x2*)(smem + QN_OFF + cr * 272 + pa * 2) = (u32x2){pq[i].x, pq[i].y}; *(u32x2*)(smem + QN_OFF + cr * 272 + (pa + 8) * 2) = (u32x2){pq[i].z, pq[i].w}; }
            const int cp = (cr & ~31) + 8 * ((cr >> 2) & 3) + 4 * ((cr >> 4) & 1) + (cr & 3);
            bf16_t* kt = (bf16_t*)(smem + KT_OFF) + d0 * 72 + cp; bf16_t* vt = (bf16_t*)(smem + VT_OFF) + d0 * 72 + cp;
            const unsigned kw[4] = {pk[i].x, pk[i].y, pk[i].z, pk[i].w}, vw[4] = {pv[i].x, pv[i].y, pv[i].z, pv[i].w};
#pragma unroll
            for (int jj = 0; jj < 4; ++jj) { kt[(2 * jj) * 72] = (bf16_t)(kw[jj] & 0xffffu); kt[(2 * jj + 1) * 72] = (bf16_t)(kw[jj] >> 16);
                vt[(2 * jj) * 72] = (bf16_t)(vw[jj] & 0xffffu); vt[(2 * jj + 1) * 72] = (bf16_t)(vw[jj] >> 16); } }
        { const int c0 = (tid & 7) * 8, u = (c0 >> 3) & 3, pa = (c0 & ~31) + 16 * (u & 1) + 4 * (u >> 1), ro = (tid >> 3) * 144;
          *(u32x2*)(smem + TT_OFF + ro + pa * 2) = (u32x2){pt.x, pt.y}; *(u32x2*)(smem + TT_OFF + ro + (pa + 8) * 2) = (u32x2){pt.z, pt.w};
          *(u32x2*)(smem + QK_OFF + ro + pa * 2) = (u32x2){pqk.x, pqk.y}; *(u32x2*)(smem + QK_OFF + ro + (pa + 8) * 2) = (u32x2){pqk.z, pqk.w}; }
        if (tid < 64) ((float*)(smem + GC_OFF))[tid] = psc; else if (tid < 128) ((float*)(smem + BT_OFF))[tid - 64] = psc;
        __syncthreads();
        if (n < 32) GS_LOAD(n + 1);
        bf16_t zz1[8], zz2[8];
#pragma unroll
        for (int i = 0; i < 8; ++i) { const int c = 8 * wid + i; const bf16_t* zp;
            if (n == 0) zp = (const bf16_t*)(ws + M_Z) + (c >= 48 ? c - 48 : 0) * 512 + h * 128;
            else zp = (const bf16_t*)(ws + OFF_Z) + ((size_t)b * 2048 + 64 * (n - 1) + c) * 512 + h * 128;
            zz1[i] = zp[lane]; zz2[i] = zp[lane + 64]; }
        const float* GC = (const float*)(smem + GC_OFF); const float* BT = (const float*)(smem + BT_OFF);
        bf16x8 Sb[4];
#pragma unroll
        for (int s = 0; s < 4; ++s) Sb[s] = as_bf8(pack8(S[2 * s], S[2 * s + 1]));
        f32x4 X[4], P[4];
#pragma unroll
        for (int mt = 0; mt < 4; ++mt) { X[mt] = (f32x4){0.f, 0.f, 0.f, 0.f}; P[mt] = (f32x4){0.f, 0.f, 0.f, 0.f};
#pragma unroll
            for (int s = 0; s < 4; ++s) { const int off = (16 * mt + r) * 272 + (32 * s + 8 * g) * 2;
                X[mt] = mfma16(frag2(smem + KN_OFF, off), Sb[s], X[mt]); P[mt] = mfma16(frag2(smem + QN_OFF, off), Sb[s], P[mt]); } }
        f32x4 Rr[4], eg[4], gcv[4];
#pragma unroll
        for (int mt = 0; mt < 4; ++mt) { const int c0 = 16 * mt + 4 * g; gcv[mt] = *(const f32x4*)(GC + c0); const f32x4 bt4 = *(const f32x4*)(BT + c0);
            const u32x2 vt = *(const u32x2*)(smem + VT_OFF + (e0 + r) * 144 + (32 * (mt >> 1) + 8 * g + 4 * (mt & 1)) * 2);
            const float vv[4] = {bflo(vt.x), bfhi(vt.x), bflo(vt.y), bfhi(vt.y)};
#pragma unroll
            for (int rr = 0; rr < 4; ++rr) { eg[mt][rr] = __expf(gcv[mt][rr]); Rr[mt][rr] = bt4[rr] * (vv[rr] - eg[mt][rr] * X[mt][rr]); } }
        bf16x8 Rb[2] = {as_bf8(pack8(Rr[0], Rr[1])), as_bf8(pack8(Rr[2], Rr[3]))};
        f32x4 Vn[4];
#pragma unroll
        for (int mt = 0; mt < 4; ++mt) { Vn[mt] = (f32x4){0.f, 0.f, 0.f, 0.f};
#pragma unroll
            for (int s = 0; s < 2; ++s) Vn[mt] = mfma16(frag2(smem + TT_OFF, (16 * mt + r) * 144 + (32 * s + 8 * g) * 2), Rb[s], Vn[mt]); }
        bf16x8 Vnb[2] = {as_bf8(pack8(Vn[0], Vn[1])), as_bf8(pack8(Vn[2], Vn[3]))};
        const float glast = GC[63];
        f32x4 O[4], Vp[4];
#pragma unroll
        for (int mt = 0; mt < 4; ++mt) {
#pragma unroll
            for (int rr = 0; rr < 4; ++rr) { O[mt][rr] = P[mt][rr] * eg[mt][rr]; Vp[mt][rr] = Vn[mt][rr] * __expf(glast - gcv[mt][rr]); }
#pragma unroll
            for (int s = 0; s < 2; ++s) O[mt] = mfma16(frag2(smem + QK_OFF, (16 * mt + r) * 144 + (32 * s + 8 * g) * 2), Vnb[s], O[mt]); }
        bf16x8 Vpb[2] = {as_bf8(pack8(Vp[0], Vp[1])), as_bf8(pack8(Vp[2], Vp[3]))};
        const float egl = __expf(glast);
#pragma unroll
        for (int dt = 0; dt < 8; ++dt) { S[dt] = S[dt] * egl;
#pragma unroll
            for (int s = 0; s < 2; ++s) S[dt] = mfma16(frag2(smem + KT_OFF, (16 * dt + r) * 144 + (32 * s + 8 * g) * 2), Vpb[s], S[dt]); }
        float* OT = (float*)(smem + OT_OFF);
#pragma unroll
        for (int mt = 0; mt < 4; ++mt)
#pragma unroll
            for (int rr = 0; rr < 4; ++rr) OT[(16 * mt + 4 * g + rr) * 132 + e0 + r] = O[mt][rr];
        __syncthreads();
#pragma unroll
        for (int i = 0; i < 8; ++i) { const int c = 8 * wid + i;
            const float o1 = OT[c * 132 + lane], o2 = OT[c * 132 + lane + 64];
            const float ss = wave_sum(o1 * o1 + o2 * o2), rstd = rsqrtf(ss * (1.f / 128.f) + EPSF);
            bf16_t* op; bool wrt;
            if (n == 0) { wrt = (b == 0 && c >= 48); op = (bf16_t*)(ws + M_OAB) + (c - 48) * 1024 + h * 128; }
            else { const size_t row = (size_t)b * 2048 + 64 * (n - 1) + c; op = (bf16_t*)(ws + OFF_OAB) + row * 1024 + h * 128; wrt = true; }
            if (wrt) { op[lane] = f2bf(o1 * rstd * ng1 * silu_f(bf2f(zz1[i]))); op[lane + 64] = f2bf(o2 * rstd * ng2 * silu_f(bf2f(zz2[i]))); } }
    }
#undef GS_LOAD
    __syncthreads();
}

#ifndef DSASEL
#define DSASEL 3
#endif
#ifndef DSA_REP
#define DSA_REP 0
#endif
namespace da {
constexpr int SC_PITCH = 2112, SC_OFF = 0, MASK_OFF = 16 * SC_PITCH * 4, IWL_OFF = MASK_OFF + 64 * 34 * 8, END_OFF = IWL_OFF + 64 * 8 * 4;
constexpr int KSEL = 272;
static_assert(END_OFF + 8 * 128 * 4 <= LDS_XB - 16, "dsa lds");
constexpr float SCALE = 0.088388347648318440f, THR = 8.f;
constexpr int SHM_V = 64 * 128 * 2, SHM_K = 64 * 128 * 2;
#define KSWZ(row, colB) ((row) * 256 + ((colB) ^ (((row) & 7) << 4)))
#define SBAR() __builtin_amdgcn_sched_barrier(0)
__device__ __forceinline__ int crow(int r, int hi) { return (r & 3) + 8 * (r >> 2) + 4 * hi; }
__device__ __forceinline__ void partialSM(f32x16& p0, f32x16& p1, float& m_reg, float& mn, float& alpha) {
  constexpr float C = SCALE * 1.4426950408889634f;
  float pmax = p0[0]; for (int r = 1; r < 16; ++r) pmax = fmaxf(pmax, p0[r]); for (int r = 0; r < 16; ++r) pmax = fmaxf(pmax, p1[r]);
  { auto rr = __builtin_amdgcn_permlane32_swap(__float_as_uint(pmax), __float_as_uint(pmax), false, false);
    pmax = fmaxf(__uint_as_float(rr[0]), __uint_as_float(rr[1])); }
  if (__builtin_expect(__all(pmax - m_reg <= THR / SCALE), 1)) { mn = m_reg; alpha = 1.f; }
  else { mn = fmaxf(m_reg, pmax); alpha = __builtin_amdgcn_exp2f((m_reg - mn) * C); m_reg = mn; }
  float mnC = -mn * C;
  for (int r = 0; r < 16; ++r) p0[r] = fmaf(p0[r], C, mnC); for (int r = 0; r < 16; ++r) p1[r] = fmaf(p1[r], C, mnC);
  for (int r = 0; r < 16; ++r) p0[r] = __builtin_amdgcn_exp2f(p0[r]);
}
__device__ __forceinline__ void finishSM(f32x16& p0, f32x16& p1, float alpha, float& l_reg, bf16x8& pa0, bf16x8& pa1, bf16x8& pa2, bf16x8& pa3) {
  for (int r = 0; r < 16; ++r) p1[r] = __builtin_amdgcn_exp2f(p1[r]);
  float ps = 0; for (int r = 0; r < 16; ++r) ps += p0[r]; for (int r = 0; r < 16; ++r) ps += p1[r];
  { auto rr = __builtin_amdgcn_permlane32_swap(__float_as_uint(ps), __float_as_uint(ps), false, false);
    ps = __uint_as_float(rr[0]) + __uint_as_float(rr[1]); }
  l_reg = l_reg * alpha + ps;
#define PK4(P, BASE, OUT) do { unsigned a0 = cvt_pk(P[BASE + 0], P[BASE + 1]), a1 = cvt_pk(P[BASE + 2], P[BASE + 3]);   \
    unsigned b0 = cvt_pk(P[BASE + 4], P[BASE + 5]), b1 = cvt_pk(P[BASE + 6], P[BASE + 7]);                              \
    auto r0 = __builtin_amdgcn_permlane32_swap(a0, b0, false, false); auto r1 = __builtin_amdgcn_permlane32_swap(a1, b1, false, false); \
    u32x4 w = {r0[0], r1[0], r0[1], r1[1]}; OUT = as_bf8(w); } while (0)
  PK4(p0, 0, pa0); PK4(p0, 8, pa1); PK4(p1, 0, pa2); PK4(p1, 8, pa3);
#undef PK4
}
__device__ __forceinline__ void qkt(f32x16& p0, f32x16& p1, const char* Ks, const bf16x8* qr, int r32, int hi) {
  p0 = f32x16{}; p1 = f32x16{};
  for (int d0 = 0; d0 < 8; ++d0) { int cb = (d0 * 16 + hi * 8) * 2;
    bf16x8 b0 = *reinterpret_cast<const bf16x8*>(Ks + KSWZ(r32, cb));
    bf16x8 b1 = *reinterpret_cast<const bf16x8*>(Ks + KSWZ(32 + r32, cb));
    p0 = __builtin_amdgcn_mfma_f32_32x32x16_bf16(b0, qr[d0], p0, 0, 0, 0);
    p1 = __builtin_amdgcn_mfma_f32_32x32x16_bf16(b1, qr[d0], p1, 0, 0, 0); }
}
__device__ __forceinline__ void maskp(f32x16& p0, f32x16& p1, const char* mrow, int tile, int hi) {
  const u32x2 mw = *(const u32x2*)(mrow + tile * 8); const unsigned w0 = mw.x >> (4 * hi), w1 = mw.y >> (4 * hi);
#pragma unroll
  for (int r = 0; r < 16; ++r) { const int bit = (r & 3) + 8 * (r >> 2);
    p0[r] = ((w0 >> bit) & 1u) ? p0[r] : -1e30f; p1[r] = ((w1 >> bit) & 1u) ? p1[r] : -1e30f; }
}
__device__ __forceinline__ int v_st(int k, int c) { const int kk = (k & ~0xC) | ((k & 4) << 1) | ((k & 8) >> 1); return ((kk >> 3) * 4 + (c >> 5)) * 512 + ((kk & 7) * 32 + (c & 31)) * 2; }
__device__ __forceinline__ int v_rd_base(int lane) { return ((lane & 3) << 3) | (((lane >> 2) & 3) << 6) | (((lane >> 4) & 1) << 5) | (((lane >> 5) & 1) << 8); }
constexpr int v_rd_off(int d0, int ks, int half) { return d0 * 512 + ks * 4096 + half * 2048; }
template <int OFF> __device__ __forceinline__ s16x4 tr_read(int vb) {
  s16x4 r; asm volatile("ds_read_b64_tr_b16 %0, %1 offset:%2" : "=&v"(r) : "v"(vb), "i"(OFF) : "memory"); return r;
}
template <int D0> __device__ __forceinline__ void pv_one(f32x16& od, int vb, bf16x8 pa0, bf16x8 pa1, bf16x8 pa2, bf16x8 pa3) {
  const s16x4 l0 = tr_read<v_rd_off(D0, 0, 0)>(vb), h0 = tr_read<v_rd_off(D0, 0, 1)>(vb), l1 = tr_read<v_rd_off(D0, 1, 0)>(vb), h1 = tr_read<v_rd_off(D0, 1, 1)>(vb);
  const s16x4 l2 = tr_read<v_rd_off(D0, 2, 0)>(vb), h2 = tr_read<v_rd_off(D0, 2, 1)>(vb), l3 = tr_read<v_rd_off(D0, 3, 0)>(vb), h3 = tr_read<v_rd_off(D0, 3, 1)>(vb);
  asm volatile("s_waitcnt lgkmcnt(0)" ::: "memory"); SBAR();
#define PK(L, H) (bf16x8){L[0], L[1], L[2], L[3], H[0], H[1], H[2], H[3]}
  od = __builtin_amdgcn_mfma_f32_32x32x16_bf16(pa0, PK(l0, h0), od, 0, 0, 0);
  od = __builtin_amdgcn_mfma_f32_32x32x16_bf16(pa1, PK(l1, h1), od, 0, 0, 0);
  od = __builtin_amdgcn_mfma_f32_32x32x16_bf16(pa2, PK(l2, h2), od, 0, 0, 0);
  od = __builtin_amdgcn_mfma_f32_32x32x16_bf16(pa3, PK(l3, h3), od, 0, 0, 0);
#undef PK
}
__device__ __forceinline__ void pv_d0(f32x16* o, int vb, bf16x8 pa0, bf16x8 pa1, bf16x8 pa2, bf16x8 pa3) {
  pv_one<0>(o[0], vb, pa0, pa1, pa2, pa3); pv_one<1>(o[1], vb, pa0, pa1, pa2, pa3); pv_one<2>(o[2], vb, pa0, pa1, pa2, pa3); pv_one<3>(o[3], vb, pa0, pa1, pa2, pa3);
}
__device__ __forceinline__ void attn_body(const bf16_t* Qb, const bf16_t* Kh, const bf16_t* Vh, bf16_t* Ob, int NT, const char* maskbase, char* lds) {
  int tid_ = threadIdx.x; asm volatile("" : "+v"(tid_));
  const int tid = tid_, wid = tid >> 6, lane = tid & 63, r32 = lane & 31, hi = lane >> 5;
  char* V_lds = lds; char* K_lds = lds + 2 * SHM_V;
  float* wsf = (float*)(lds + 2 * SHM_V + 2 * SHM_K) + wid * 64; float* li_l = wsf; float* al_l = wsf + 32;
  float m_reg = -1e30f, l_reg = 0; f32x16 o[4] = {}; bf16x8 qr[8];
  const int head = wid >> 1, qloc0 = (wid & 1) * 32;
  const char* mrow = maskbase + (qloc0 + r32) * (34 * 8);
  const bf16_t* Qw = Qb + (size_t)(qloc0 + r32) * 512 + head * 128 + hi * 8;
#pragma unroll
  for (int d0 = 0; d0 < 8; ++d0) qr[d0] = *(const bf16x8*)(Qw + d0 * 16);
  const int sr = tid >> 4, sc = (tid & 15) * 8;
  const int vb0 = (int)(uintptr_t)V_lds + v_rd_base(lane);
  struct { bf16x8 vs0, vs1, ks0, ks1; } sr_[2];
#define SLOAD(i, k0) do { sr_[i].vs0 = *(const bf16x8*)(&Vh[(long)((k0) + sr) * 128 + sc]); sr_[i].vs1 = *(const bf16x8*)(&Vh[(long)((k0) + 32 + sr) * 128 + sc]); \
    sr_[i].ks0 = *(const bf16x8*)(&Kh[(long)((k0) + sr) * 128 + sc]); sr_[i].ks1 = *(const bf16x8*)(&Kh[(long)((k0) + 32 + sr) * 128 + sc]); } while (0)
#define SWRITE(b, i) do { int t_ = tid; asm volatile("" : "+v"(t_)); const int sr_w = t_ >> 4, sc_w = (t_ & 15) * 8;     \
    *(bf16x8*)(V_lds + (b) * SHM_V + v_st(sr_w, sc_w)) = sr_[i].vs0;          \
    *(bf16x8*)(V_lds + (b) * SHM_V + v_st(32 + sr_w, sc_w)) = sr_[i].vs1; int kc = sc_w * 2;               \
    *(bf16x8*)(K_lds + (b) * SHM_K + KSWZ(sr_w, kc)) = sr_[i].ks0;                       \
    *(bf16x8*)(K_lds + (b) * SHM_K + KSWZ(32 + sr_w, kc)) = sr_[i].ks1; } while (0)
#define SWAIT() asm volatile("s_waitcnt vmcnt(4)" ::: "memory")
#define RESC(a) do { if (__any((a) < 1.f)) { if (hi == 0) al_l[r32] = (a); asm volatile("s_waitcnt lgkmcnt(0)" ::: "memory"); \
    for (int d = 0; d < 4; ++d) for (int r = 0; r < 16; ++r) o[d][r] *= al_l[crow(r, hi)]; } } while (0)
  f32x16 pA0, pA1, pB0, pB1; float mnA, mnB, alA, alB; bf16x8 pa0, pa1, pa2, pa3;
  constexpr int SE = 0, SO = 1;
  SLOAD(SE, 0); asm volatile("s_waitcnt vmcnt(0)" ::: "memory"); SWRITE(0, SE); __syncthreads();
  qkt(pA0, pA1, K_lds, qr, r32, hi); maskp(pA0, pA1, mrow, 0, hi); partialSM(pA0, pA1, m_reg, mnA, alA);
  SLOAD(SO, 64); if (2 < NT) SLOAD(SE, 2 * 64);
  SWAIT(); SWRITE(1, SO); __syncthreads();
  for (int j = 1; j + 1 < NT; j += 2) {
    SBAR(); qkt(pB0, pB1, K_lds + SHM_K, qr, r32, hi); maskp(pB0, pB1, mrow, j, hi);
    finishSM(pA0, pA1, alA, l_reg, pa0, pa1, pa2, pa3); SBAR();
    SLOAD(SO, (j + 2) * 64); SBAR();
    pv_d0(o, vb0, pa0, pa1, pa2, pa3); partialSM(pB0, pB1, m_reg, mnB, alB);
    __syncthreads(); SWAIT(); SWRITE(0, SE);
    RESC(alB); __syncthreads();
    SBAR(); qkt(pA0, pA1, K_lds, qr, r32, hi); maskp(pA0, pA1, mrow, j + 1, hi);
    finishSM(pB0, pB1, alB, l_reg, pa0, pa1, pa2, pa3); SBAR();
    if (j + 3 < NT) SLOAD(SE, (j + 3) * 64); SBAR();
    pv_d0(o, vb0 + SHM_V, pa0, pa1, pa2, pa3); partialSM(pA0, pA1, m_reg, mnA, alA);
    __syncthreads(); SWAIT(); SWRITE(1, SO);
    RESC(alA); __syncthreads();
  }
  SBAR(); qkt(pB0, pB1, K_lds + SHM_K, qr, r32, hi); maskp(pB0, pB1, mrow, NT - 1, hi);
  finishSM(pA0, pA1, alA, l_reg, pa0, pa1, pa2, pa3); SBAR();
  pv_d0(o, vb0, pa0, pa1, pa2, pa3); partialSM(pB0, pB1, m_reg, mnB, alB);
  __syncthreads(); RESC(alB);
  finishSM(pB0, pB1, alB, l_reg, pa0, pa1, pa2, pa3); SBAR();
  pv_d0(o, vb0 + SHM_V, pa0, pa1, pa2, pa3);
  if (hi == 0) li_l[r32] = l_reg; asm volatile("s_waitcnt lgkmcnt(0)" ::: "memory");
  float rli[16];
#pragma unroll
  for (int r = 0; r < 16; ++r) rli[r] = __builtin_amdgcn_rcpf(li_l[crow(r, hi)]);
#pragma unroll
  for (int r = 0; r < 16; ++r) { bf16_t* orow = Ob + (size_t)(qloc0 + crow(r, hi)) * 1024 + head * 128 + r32;
#pragma unroll
    for (int d0 = 0; d0 < 4; ++d0) orow[d0 * 32] = f2bf(o[d0][r] * rli[r]); }
  asm volatile("s_waitcnt vmcnt(0)" ::: "memory");
#undef SLOAD
#undef SWRITE
#undef SWAIT
#undef RESC
}
__device__ __forceinline__ int wave_total(int x) {
    x += __builtin_amdgcn_update_dpp(0, x, 0x128, 0xf, 0xf, false);
    x += __builtin_amdgcn_update_dpp(0, x, 0x124, 0xf, 0xf, false);
    x += __builtin_amdgcn_update_dpp(0, x, 0x122, 0xf, 0xf, false);
    x += __builtin_amdgcn_update_dpp(0, x, 0x121, 0xf, 0xf, false);
    return __builtin_amdgcn_readlane(x, 0) + __builtin_amdgcn_readlane(x, 16) + __builtin_amdgcn_readlane(x, 32) + __builtin_amdgcn_readlane(x, 48);
}
__device__ __forceinline__ unsigned ordkey(float x) { const unsigned b = __float_as_uint(x); return (b & 0x80000000u) ? ~b : (b | 0x80000000u); }
typedef unsigned short us2_t __attribute__((ext_vector_type(2)));
template <int NTW> __device__ __forceinline__ void select2_t(const float* scA, const float* scB, unsigned long long* mrowA, unsigned long long* mrowB, int NT, int NTe, int lane, unsigned* cand) {
    constexpr int NP2 = (NTW + 1) / 2;
    unsigned ua[NTW], ub[NTW];
#pragma unroll
    for (int i = 0; i < NTW; ++i) { ua[i] = (i < NT) ? ordkey(scA[64 * i + lane]) : 0u; ub[i] = (i < NT) ? ordkey(scB[64 * i + lane]) : 0u; }
    unsigned pa[NP2], pb[NP2];
#pragma unroll
    for (int p = 0; p < NP2; ++p) { const unsigned a0 = ua[2 * p] >> 17, a1 = (2 * p + 1 < NTW) ? (ua[2 * p + 1 < NTW ? 2 * p + 1 : 0] >> 17) : 0u, b0 = ub[2 * p] >> 17, b1 = (2 * p + 1 < NTW) ? (ub[2 * p + 1 < NTW ? 2 * p + 1 : 0] >> 17) : 0u;
        pa[p] = (a0 | 0x8000u) | ((a1 | 0x8000u) << 16); pb[p] = (b0 | 0x8000u) | ((b1 | 0x8000u) << 16); }
    unsigned ta = 0u, tb = 0u; int gea = 64 * NTW, geb = 64 * NTW;
#pragma unroll 1
    for (int bit = 14; bit >= 0; --bit) { const unsigned ca = ta | (1u << bit), cb = tb | (1u << bit); const unsigned ca2 = ca | (ca << 16), cb2 = cb | (cb << 16);
        unsigned sa = 0u, sb = 0u; int na = 0, nb = 0;
#pragma unroll
        for (int p = 0; p < NP2; ++p) {
            const unsigned da = __builtin_bit_cast(unsigned, __builtin_bit_cast(us2_t, pa[p]) - __builtin_bit_cast(us2_t, ca2)), db = __builtin_bit_cast(unsigned, __builtin_bit_cast(us2_t, pb[p]) - __builtin_bit_cast(us2_t, cb2));
            sa = (sa >> 1) | (da & 0x80008000u); sb = (sb >> 1) | (db & 0x80008000u);
            if ((p & 15) == 15) { na += __popc(sa); nb += __popc(sb); sa = 0u; sb = 0u; } }
        na = wave_total(na + __popc(sa)); nb = wave_total(nb + __popc(sb));
        if (na >= KSEL) { ta = ca; gea = na; } if (nb >= KSEL) { tb = cb; geb = nb; } }
#pragma unroll 1
    for (int q = 0; q < 2; ++q) {
        unsigned long long* mrow = q ? mrowB : mrowA; const unsigned t15 = q ? tb : ta;
        unsigned u[NTW];
#pragma unroll
        for (int i = 0; i < NTW; ++i) u[i] = q ? ub[i] : ua[i];
        int ncand = 0;
#pragma unroll
        for (int i = 0; i < NTW; ++i) { const unsigned long long mc = __ballot((u[i] >> 17) == t15);
            if (mc) { const int idx = ncand + (int)__builtin_amdgcn_mbcnt_hi((unsigned)(mc >> 32), __builtin_amdgcn_mbcnt_lo((unsigned)mc, 0u));
                if (((u[i] >> 17) == t15) && idx < 128) cand[idx] = (u[i] & 0x1FFFFu) + 1u; }
            ncand += __popcll(mc); }
        const int ngt = (q ? geb : gea) - ncand;
        const int kk = KSEL - ngt;
        unsigned t;
#ifndef CAND_CAP
#define CAND_CAP 128
#endif
        if (ncand <= CAND_CAP) {
            asm volatile("s_waitcnt lgkmcnt(0)" ::: "memory");
            const unsigned c0 = lane < ncand ? cand[lane] : 0u, c1 = lane + 64 < ncand ? cand[lane + 64] : 0u;
            unsigned tl = 0u;
            for (int bit = 17; bit >= 0; --bit) { const unsigned cc = tl | (1u << bit); const int n = __popcll(__ballot(c0 >= cc)) + __popcll(__ballot(c1 >= cc)); if (n >= kk) tl = cc; }
            t = (t15 << 17) | (tl - 1u);
        } else {
            int tt = (int)(t15 << 16);
            for (int bit = 15; bit >= 0; --bit) { const int cc = tt | (1 << bit); int n = 0;
#pragma unroll
                for (int i = 0; i < NTW; ++i) n += __popcll(__ballot((int)(u[i] >> 1) >= cc));
                if (n >= KSEL) tt = cc; }
            t = ((unsigned)tt << 1) | 1u; int n1 = 0;
#pragma unroll
            for (int i = 0; i < NTW; ++i) n1 += __popcll(__ballot(u[i] >= t));
            if (n1 < KSEL) t -= 1u;
        }
        int tot = 0;
#pragma unroll
        for (int i = 0; i < NTW; ++i) { const unsigned long long w = __ballot(u[i] >= t); tot += __popcll(w); if (i < NT && lane == 0) mrow[i] = w; }
        if (tot > KSEL) {
            int need = KSEL;
#pragma unroll
            for (int i = 0; i < NTW; ++i) need -= __popcll(__ballot(u[i] > t));
#pragma unroll
            for (int i = 0; i < NTW; ++i) {
                unsigned long long w = __ballot(u[i] > t); unsigned long long e = __ballot(u[i] == t);
                if (need > 0 && e) { const int pe = __popcll(e); if (pe <= need) { w |= e; need -= pe; } else { while (need > 0) { const unsigned long long low = e & (~e + 1ull); w |= low; e ^= low; --need; } } }
                if (i < NT && lane == 0) mrow[i] = w; } }
        if (NTe > NT && lane == 0) mrow[NT] = 0ull;
    }
}
__device__ __forceinline__ void select2(const float* scA, const float* scB, unsigned long long* mrowA, unsigned long long* mrowB, int NT, int NTe, int NP, int lane, unsigned* cand) {
    if (NP <= KSEL) {
        for (int i = 0; i < NTe; ++i) { const int lo = 64 * i; const unsigned long long w = (lo + 64 <= NP) ? ~0ull : (lo >= NP ? 0ull : ((1ull << (NP - lo)) - 1ull)); if (lane == 0) { mrowA[i] = w; mrowB[i] = w; } }
        return;
    }
    if (NT <= 9) select2_t<9>(scA, scB, mrowA, mrowB, NT, NTe, lane, cand);
    else if (NT <= 17) select2_t<17>(scA, scB, mrowA, mrowB, NT, NTe, lane, cand);
    else if (NT <= 25) select2_t<25>(scA, scB, mrowA, mrowB, NT, NTe, lane, cand);
    else select2_t<33>(scA, scB, mrowA, mrowB, NT, NTe, lane, cand);
}
__device__ __forceinline__ void dsa_item(const Args& a, int b, int j, char* smem, int dry = 0) {
    unsigned char* ws = a.ws; { size_t z_ = 0; asm volatile("" : "+s"(z_)); ws += z_; }
    int tid_ = threadIdx.x; asm volatile("" : "+v"(tid_));
    const int tid = tid_, lane = tid & 63, wid = __builtin_amdgcn_readfirstlane(tid >> 6), hi = lane >> 5;
    const int limit = 64 * (j + 1), NP = 16 + limit, NT = j + 2, NTe = (NT + 1) & ~1, row0 = b * 2048 + 64 * j;
    const bf16_t* iq = (const bf16_t*)(ws + OFF_IQ); const bf16_t* ikb = (const bf16_t*)(ws + OFF_IKB); const float* misc = (const float*)(ws + OFF_MISC);
    float* SC = (float*)(smem + SC_OFF); float* IWL = (float*)(smem + IWL_OFF); unsigned long long* MASK = (unsigned long long*)(smem + MASK_OFF);
    { const int q = tid >> 3, hh = tid & 7; IWL[tid] = misc[(size_t)(row0 + q) * 16 + 8 + hh] * 0.044194173824159216f; }
    bf16x8 af[4][4];
#define DSA_AF_LOAD(sb) do { const int rho = lane & 31, qq = 2 * ((rho >> 2) & 1) + (rho >> 4), hh = 4 * ((rho >> 3) & 1) + (rho & 3); \
        _Pragma("unroll") for (int mt = 0; mt < 4; ++mt) _Pragma("unroll") for (int ks = 0; ks < 4; ++ks) \
            af[mt][ks] = *(const bf16x8*)(iq + (size_t)(row0 + (sb) * 16 + 4 * mt + qq) * 512 + hh * 64 + 16 * ks + 8 * hi); } while (0)
    DSA_AF_LOAD(0);
    if ((DSASEL & 1) && !(dry & 1)) for (int sub = 0; sub < 4; ++sub) {
        for (int p = tid; p < 16 * 16; p += 512) SC[(p >> 4) * SC_PITCH + (p & 15)] = __builtin_inff();
        for (int p = tid; p < 16 * 48; p += 512) { const int q = p / 48, x = p - q * 48; SC[q * SC_PITCH + NP + x] = -__builtin_inff(); }
        __syncthreads();
        for (int rep_i = 0; rep_i < 1 + (DSA_REP & 1); ++rep_i) {
        const bf16_t* ikp = ikb + ((size_t)b * TP + 16 + (lane & 31)) * 64 + 8 * hi;
        bf16x8 bnx[4];
        { const int kt0 = wid < 2 * (j + 1) ? wid : 0;
#pragma unroll
          for (int ks = 0; ks < 4; ++ks) bnx[ks] = *(const bf16x8*)(ikp + (size_t)(32 * kt0) * 64 + 16 * ks); }
        for (int kt = wid; kt < 2 * (j + 1); kt += 8) {
            bf16x8 bfr[4];
#pragma unroll
            for (int ks = 0; ks < 4; ++ks) bfr[ks] = bnx[ks];
            { const int ktn = (kt + 8 < 2 * (j + 1)) ? kt + 8 : kt;
#pragma unroll
              for (int ks = 0; ks < 4; ++ks) bnx[ks] = *(const bf16x8*)(ikp + (size_t)(32 * ktn) * 64 + 16 * ks); }
#pragma unroll
            for (int mt = 0; mt < 4; ++mt) {
                f32x16 acc = {};
#pragma unroll
                for (int ks = 0; ks < 4; ++ks) acc = __builtin_amdgcn_mfma_f32_32x32x16_bf16(af[mt][ks], bfr[ks], acc, 0, 0, 0);
                const float* iw0 = IWL + (sub * 16 + 4 * mt + 2 * hi) * 8;
                float s0 = 0.f, s1 = 0.f;
#pragma unroll
                for (int rg = 0; rg < 8; ++rg) { s0 += fmaxf(acc[rg], 0.f) * iw0[rg]; s1 += fmaxf(acc[8 + rg], 0.f) * iw0[8 + rg]; }
                if (s0 == 0.f) s0 = 0.f; if (s1 == 0.f) s1 = 0.f;
                float* sp = SC + (4 * mt + 2 * hi) * SC_PITCH + 16 + 32 * kt + (lane & 31);
                sp[0] = s0; sp[SC_PITCH] = s1;
            }
        }
        }
        if (sub < 3) DSA_AF_LOAD(sub + 1);
        __syncthreads();
#pragma unroll 1
        for (int rep_s = 0; rep_s < 1 + ((DSA_REP >> 1) & 1); ++rep_s)
        { const int ql = 2 * wid; select2(SC + ql * SC_PITCH, SC + (ql + 1) * SC_PITCH, MASK + (sub * 16 + ql) * 34, MASK + (sub * 16 + ql + 1) * 34, NT, NTe, NP, lane, (unsigned*)(smem + END_OFF) + wid * 128); }
        __syncthreads();
    }
#pragma unroll 1
    for (int rep_a = 0; rep_a < 1 + ((DSA_REP >> 2) & 1); ++rep_a)
    if ((DSASEL & 2) && !(dry & 2)) attn_body((const bf16_t*)(ws + OFF_BQ) + (size_t)row0 * 512, (const bf16_t*)(ws + OFF_KB) + (size_t)b * TP * 128, (const bf16_t*)(ws + OFF_VB) + (size_t)b * TP * 128,
              (bf16_t*)(ws + OFF_OAB) + (size_t)row0 * 1024 + 512, NTe, smem + MASK_OFF, smem);
    __syncthreads();
}
__device__ __forceinline__ void dsa_meta_item(const Args& a) {
    unsigned char* ws = a.ws; { size_t z_ = 0; asm volatile("" : "+s"(z_)); ws += z_; }
    int tid_ = threadIdx.x; asm volatile("" : "+v"(tid_));
    if (tid_ >= 64) return;
    const int lane = tid_, q = lane >> 2, h = lane & 3;
    const bf16_t* qp = (const bf16_t*)(ws + M_BQ) + q * 512 + h * 128; const bf16_t* kb = (const bf16_t*)(ws + OFF_KB); const bf16_t* vb = (const bf16_t*)(ws + OFF_VB);
    float s[16]; float mx = -1e30f;
#pragma unroll
    for (int k = 0; k < 16; ++k) { float acc = 0.f; for (int d = 0; d < 128; ++d) acc += bf2f(qp[d]) * bf2f(kb[k * 128 + d]); s[k] = acc * SCALE; mx = fmaxf(mx, s[k]); }
    float l = 0.f;
#pragma unroll
    for (int k = 0; k < 16; ++k) { s[k] = __expf(s[k] - mx); l += s[k]; }
    const float rl = 1.f / l;
    bf16_t* op = (bf16_t*)(ws + M_OAB) + q * 1024 + 512 + h * 128;
    for (int d = 0; d < 128; ++d) { float acc = 0.f;
#pragma unroll
        for (int k = 0; k < 16; ++k) acc += s[k] * bf2f(vb[k * 128 + d]); op[d] = f2bf(acc * rl); }
}
}

__device__ __forceinline__ void p_mixers(const Args& a, int layer_rep, char* smem, int dry = 0) {
    const int layer = layer_rep & 1;
    unsigned* ctr = (unsigned*)(a.ws + OFF_CTL) + CW_QUEUE + 64 * layer_rep;
    int* slot = (int*)(smem + LDS_XB - 16);
    constexpr int NSCAN = NB * 4, NDSA = NB * 32, NITEM = NSCAN + NDSA + 1;
    for (;;) {
        __syncthreads();
        if (threadIdx.x == 0) *slot = (int)__hip_atomic_fetch_add(ctr, 1u, __ATOMIC_RELAXED, __HIP_MEMORY_SCOPE_AGENT);
        __syncthreads();
        const int it = *slot;
        if (it >= NITEM) break;
#ifndef MIXSEL
#define MIXSEL 7
#endif
        if (it == 0) { if ((MIXSEL & 4) && !dry) da::dsa_meta_item(a); }
        else if (it <= NSCAN) { const int si = it - 1; for (int rep_g = 0; rep_g < 1 + ((DSA_REP >> 3) & 1); ++rep_g) if ((MIXSEL & 1) && !(dry & 4)) gdn_scan_item(a, layer, si >> 2, si & 3, smem); }
        else { const int k = it - 1 - NSCAN, j = 31 - (k >> 5), b = k & 31; if (MIXSEL & 2) da::dsa_item(a, b, j, smem, dry); }
    }
}

__device__ __forceinline__ void p_halo(const Args& a, int layer) {
    unsigned char* ws = a.ws; { size_t z_ = 0; asm volatile("" : "+s"(z_)); ws += z_; }
    int tid_ = threadIdx.x; asm volatile("" : "+v"(tid_));
    const int lane = tid_ & 63, wid = tid_ >> 6, r = lane & 15, g = lane >> 4, gw = blockIdx.x * 8 + wid, nW = gridDim.x * 8;
    const bf16_t* hb = (const bf16_t*)(ws + OFF_HB); const bf16_t* WupT = (const bf16_t*)(ws + OFF_WUP) + (size_t)layer * NIN * DM;
    const u64_t* ssq = (const u64_t*)(ws + OFF_SSQ) + (size_t)(2 * layer + 1) * RR; float* hg = (float*)(ws + OFF_HG);
    for (int job = gw; job < 32 * 176; job += nW) {
        const int rt = job & 31, ct = job >> 5;
        const int rowA = ((r >> 1) == 0) ? 0 : 256 * (8 * rt + (r >> 1)) - 2 + (r & 1);
        const bf16_t* ap = hb + (size_t)rowA * DM + g * 8; const bf16_t* bp = WupT + (size_t)(256 * (ct >> 3) + 16 * (ct & 7) + r) * DM + g * 8;
        f32x4 acc = {0.f, 0.f, 0.f, 0.f};
#pragma unroll 8
        for (int k = 0; k < DM; k += 32) acc = mfma16(*(const bf16x8*)(ap + k), *(const bf16x8*)(bp + k), acc);
#pragma unroll
        for (int rr = 0; rr < 4; ++rr) { const int ri = 4 * g + rr;
            if ((ri >> 1) != 0) { const int pmD = 8 * rt + (ri >> 1), rowD = 256 * pmD - 2 + (ri & 1);
                hg[(size_t)(pmD * 2 + (ri & 1)) * DFF + 128 * (ct >> 3) + 16 * (ct & 7) + r] = acc[rr] * rstd_of(ssq, rowD); } }
    }
}
__device__ __forceinline__ void meta_act(const Args& a, int layer) {
    unsigned char* ws = a.ws; { size_t z_ = 0; asm volatile("" : "+s"(z_)); ws += z_; }
    int tid_ = threadIdx.x; asm volatile("" : "+v"(tid_));
    const float* cw = a.in[I_CONV_FFN] + (size_t)layer * 3 * DFF; const float* mgu = (const float*)(ws + M_GU); bf16_t* mact = (bf16_t*)(ws + M_ACT);
    for (int c = blockIdx.x * 512 + tid_; c < DFF; c += gridDim.x * 512) { const int gi = (c >> 7) * 256 + (c & 127); const float w0 = cw[c], w1 = cw[DFF + c], w2 = cw[2 * DFF + c]; float g0 = 0.f, g1 = 0.f;
        for (int t = 0; t < 16; ++t) { const float g2 = mgu[t * 5632 + gi], uu = mgu[t * 5632 + gi + 128]; mact[t * DFF + c] = f2bf(silu_f(w0 * g0 + w1 * g1 + w2 * g2) * uu); g0 = g1; g1 = g2; } }
}

constexpr int NPH = 1 + 8 * NLAYER;
#ifndef ONE_LAUNCH
#define ONE_LAUNCH 0
#endif
#ifndef STAGGER_US
#define STAGGER_US 0
#endif
__device__ __forceinline__ void stagger_delay(int us) {
    if (us > 0 && (blockIdx.x & 1)) { const unsigned long long t0 = __builtin_amdgcn_s_memrealtime(); while (__builtin_amdgcn_s_memrealtime() - t0 < (unsigned long long)us * 100ull) __builtin_amdgcn_s_sleep(8); }
}
__device__ __forceinline__ void meta_y_lds(const unsigned char* ws, char* img) {
    const float* P = (const float*)(ws + M_GU);
    for (int i = threadIdx.x; i < 16 * 1024; i += 512) { const int t = i >> 10, ch = i & 1023, n = 256 * (ch >> 7) + (ch & 127);
        *(bf16_t*)(img + t * MN_PITCH + ch * 2) = f2bf(P[t * 5632 + n] + P[t * 5632 + n + 128]); }
    __syncthreads();
}
template <int L> __device__ __forceinline__ void layer_phases(const Args& a, char* smem, const XcdBarrier& bar, const int lo, const int hi) {
    constexpr int l = L;
    unsigned char* ws0 = a.ws;
    PG8_LAS unsigned char* glds = (PG8_LAS unsigned char*)smem;
    const int G = gridDim.x, bx = blockIdx.x;
#define IN(k) (lo <= (k) && (k) < hi)
#define SEAM(k) do { if (IN(k) && IN((k) + 1)) xcd_barrier(bar); } while (0)
#define OPQ_WS() unsigned char* ws = ws0; { size_t z_ = 0; asm volatile("" : "+s"(z_)); ws += z_; }
#ifndef EN_MASK
#define EN_MASK 0xFFFF
#endif
#ifndef REP_MASK
#define REP_MASK 0
#endif
#define NREP(k) (1 + ((REP_MASK >> (k)) & 1))
    constexpr int pb = 1 + 8 * l;
    for (int rep = 0; rep < NREP(0); ++rep) if (IN(pb + 0)) { OPQ_WS();
        const bf16_t* WinT = (const bf16_t*)(ws + OFF_WIN) + (size_t)l * NIN * DM;
        meta_norm_lds((const float*)(ws + M_H), smem);
        small_gemm16<true>(smem, WinT, NIN, DM, MEpiIn{ws, a.in[I_B_GATE] + l * 2048}, smem + 40960);
        __syncthreads();
        pg8::Gemm g{(const bf16_t*)(ws + OFF_HB), WinT, RR, NIN, DM}; pg8::StaticOrder S; S.init(RR, NIN, G, bx);
        EpiIn E{(bf16_t*)(ws + OFF_QKV), (bf16_t*)(ws + OFF_HALO), (bf16_t*)(ws + OFF_Z), (bf16_t*)(ws + OFF_BQ), (bf16_t*)(ws + OFF_IQ), (bf16_t*)(ws + OFF_KB), (bf16_t*)(ws + OFF_VB),
                (bf16_t*)(ws + OFF_IKB), (float*)(ws + OFF_MISC), (bf16_t*)a.out, a.in[I_B_GATE] + l * 2048, (const u64_t*)(ws + OFF_SSQ) + (size_t)(2 * l) * RR};
        stagger_delay(STAGGER_US);
        pg8::gemm_phase<EpiIn, pg8::StaticOrder>(glds, g, S, E, nullptr);
#if defined(PROBE_DUP_IN)
        pg8::gemm_phase<EpiIn, pg8::StaticOrder>(glds, g, S, E, nullptr);
#endif
    }
    SEAM(pb + 0);
#if defined(PROBE_DRY_PREP)
    if (IN(pb + 1)) p_mixprep(a, l, smem, a.ph_hi == 12345, PROBE_DRY_PREP);
#endif
    if (IN(pb + 1)) p_mixprep(a, l, smem, true);
    SEAM(pb + 1);
#if defined(PROBE_DRYMIX)
    if (IN(pb + 2)) p_mixers(a, l + 2, smem, PROBE_DRYMIX);
#endif
    for (int rep = 0; rep < NREP(2); ++rep) if (IN(pb + 2)) p_mixers(a, l + 2 * rep, smem);
    SEAM(pb + 2);
    for (int rep = 0; rep < NREP(3); ++rep) if (IN(pb + 3)) { OPQ_WS();
        const bf16_t* WbrT = (const bf16_t*)(ws + OFF_WBR) + (size_t)l * 2048 * DM;
        small_gemm16<false>((const bf16_t*)(ws + M_OAB), WbrT, 2048, DM, MEpiBr{ws, DBG_NO_GDN ? 0.f : 1.f, DBG_NO_DSA ? 0.f : 1.f}, smem + 40960);
        pg8::Gemm g{(const bf16_t*)(ws + OFF_OAB), WbrT, RR, 2048, DM}; pg8::StaticOrder S; S.init(RR, 2048, G, bx);
        EpiBr E{(bf16_t*)(ws + OFF_Y), (const bf16_t*)a.out, DBG_NO_GDN ? 0.f : 1.f, DBG_NO_DSA ? 0.f : 1.f};
        pg8::gemm_phase<EpiBr, pg8::StaticOrder>(glds, g, S, E, nullptr);
    }
    SEAM(pb + 3);
    for (int rep = 0; rep < NREP(4); ++rep) if (IN(pb + 4)) { OPQ_WS();
        const bf16_t* WoutT = (const bf16_t*)(ws + OFF_WOUT) + (size_t)l * DM * DM;
        meta_y_lds(ws, smem);
        small_gemm16<true>(smem, WoutT, DM, DM, MEpiResid{(float*)(ws + M_H), (DBG_NO_MIX || rep) ? 0.f : 1.f}, smem + 40960);
        __syncthreads();
        pg8::Gemm g{(const bf16_t*)(ws + OFF_Y), WoutT, RR, DM, DM}; pg8::StaticOrder S; S.init(RR, DM, G, bx);
        EpiResidB E{(bf16_t*)(ws + OFF_HB), rep ? nullptr : (u64_t*)(ws + OFF_SSQ) + (size_t)(2 * l + 1) * RR, (DBG_NO_MIX || rep) ? 0.f : 1.f};
        pg8::gemm_phase<EpiResidB, pg8::StaticOrder>(glds, g, S, E, nullptr);
    }
    SEAM(pb + 4);
    if (IN(pb + 5)) { OPQ_WS();
        const bf16_t* WupT = (const bf16_t*)(ws + OFF_WUP) + (size_t)l * NIN * DM;
        meta_norm_lds((const float*)(ws + M_H), smem);
        small_gemm16<true>(smem, WupT, NIN, DM, MEpiUp{(float*)(ws + M_GU)}, smem + 40960);
        p_halo(a, l);
    }
    SEAM(pb + 5);
    for (int rep = 0; rep < NREP(6); ++rep) if (IN(pb + 6)) { OPQ_WS();
        const bf16_t* WupT = (const bf16_t*)(ws + OFF_WUP) + (size_t)l * NIN * DM;
        if constexpr (L + 1 < NLAYER) meta_act(a, l);
#if defined(PANEL_UP)
        pg8::Gemm g{(const bf16_t*)(ws + OFF_HB), WupT, RR, NIN, DM}; PanelOrder S; S.init(RR, NIN, G, bx);
#else
        pg8::Gemm g{(const bf16_t*)(ws + OFF_HB), WupT, RR, NIN, DM}; pg8::StaticOrder S; S.init(RR, NIN, G, bx);
#endif
        EpiUpConv E{(bf16_t*)(ws + OFF_ACT), (const u64_t*)(ws + OFF_SSQ) + (size_t)(2 * l + 1) * RR, a.in[I_CONV_FFN] + (size_t)l * 3 * DFF, (const float*)(ws + OFF_HG), (const float*)(ws + M_GU), smem + 131072, a.ph_hi};
#if defined(PANEL_UP)
        pg8::gemm_phase<EpiUpConv, PanelOrder>(glds, g, S, E, nullptr);
#else
        pg8::gemm_phase<EpiUpConv, pg8::StaticOrder>(glds, g, S, E, nullptr);
#endif
#if defined(PROBE_UPMODE)
        { EpiUpConvT<PROBE_UPMODE> E2{(bf16_t*)(ws + OFF_ACT), (const u64_t*)(ws + OFF_SSQ) + (size_t)(2 * l + 1) * RR, a.in[I_CONV_FFN] + (size_t)l * 3 * DFF, (const float*)(ws + OFF_HG), (const float*)(ws + M_GU), smem + 131072, a.ph_hi};
          pg8::gemm_phase<EpiUpConvT<PROBE_UPMODE>, pg8::StaticOrder>(glds, g, S, E2, nullptr); }
#endif
#if defined(PROBE_NULLM)
        { EpiNull EN; pg8::Gemm g2{(const bf16_t*)(ws + OFF_OAB), (const bf16_t*)(ws + OFF_WUP) + (size_t)(1 - l) * NIN * DM, PROBE_NULLM, NIN, DM}; pg8::StaticOrder S2; S2.init(PROBE_NULLM, NIN, G, bx);
          pg8::gemm_phase<EpiNull, pg8::StaticOrder>(glds, g2, S2, EN, nullptr); }
#endif
    }
    SEAM(pb + 6);
    for (int rep = 0; rep < NREP(7); ++rep) if (IN(pb + 7)) { OPQ_WS();
        const bf16_t* WdnT = (const bf16_t*)(ws + OFF_WDN) + (size_t)l * DM * DFF;
        if constexpr (L + 1 < NLAYER) small_gemm16<false>((const bf16_t*)(ws + M_ACT), WdnT, DM, DFF, MEpiResid{(float*)(ws + M_H), (DBG_NO_FFN || rep) ? 0.f : 1.f}, smem + 40960);
        pg8::Gemm g{(const bf16_t*)(ws + OFF_ACT), WdnT, RR, DM, DFF}; pg8::StaticOrder S; S.init(RR, DM, G, bx);
#if defined(PROBE_NULLDOWN)
        { EpiNull EN; pg8::gemm_phase<EpiNull, pg8::StaticOrder>(glds, g, S, EN, nullptr); }
#endif
        if constexpr (L + 1 < NLAYER) {
            EpiResidB E{(bf16_t*)(ws + OFF_HB), rep ? nullptr : (u64_t*)(ws + OFF_SSQ) + (size_t)(2 * l + 2) * RR, (DBG_NO_FFN || rep) ? 0.f : 1.f};
            pg8::gemm_phase<EpiResidB, pg8::StaticOrder>(glds, g, S, E, nullptr);
        } else {
            EpiFinal E{(const bf16_t*)(ws + OFF_HB), a.out, DBG_NO_FFN ? 0.f : 1.f};
            pg8::gemm_phase<EpiFinal, pg8::StaticOrder>(glds, g, S, E, nullptr);
        }
    }
    SEAM(pb + 7);
#undef IN
#undef SEAM
#undef OPQ_WS
}
__global__ void __launch_bounds__(512, 2) fwd(Args a) {
    extern __shared__ __attribute__((aligned(16))) char smem[];
    unsigned char* ws = a.ws;
    const int lo = a.ph_lo, hi = a.ph_hi;
    const bool fused = (hi - lo) > 1;
    if (threadIdx.x == 0) *(u32x4*)(smem + LDS_XB) = (u32x4){0u, 0u, 0u, 0u};
    __syncthreads();
    XcdBarrier bar; bar.bar = (unsigned*)(ws + OFF_CTL); bar.x = 0; bar.st = (volatile LAS unsigned*)(smem + LDS_XB);
    if (fused) bar = xcd_barrier_post((unsigned*)(ws + OFF_CTL), (volatile LAS unsigned*)(smem + LDS_XB));
    for (int rep = 0; rep < 1 + ((REP_MASK >> 15) & 1); ++rep) if ((EN_MASK & 1) && lo <= 0 && 0 < hi) p_prologue(a, smem);
    if (lo <= 0 && 1 < hi) xcd_barrier(bar);
    layer_phases<0>(a, smem, bar, lo, hi);
    layer_phases<1>(a, smem, bar, lo, hi);
}


extern "C" void kernel_launch(void* const* d_in, const int* in_sizes, int n_in, void* d_out, int out_size, void* d_ws, size_t ws_size, hipStream_t stream) {
    static int grid = 0;
    if (grid == 0) {
        if (n_in != 20 || in_sizes[0] != RR * DM || out_size != RR * DM || ws_size < WS_END) {
            fprintf(stderr, "kernel_launch: shape mismatch: n_in %d in0 %d out %d ws %zu (need %zu)\n", n_in, n_in > 0 ? in_sizes[0] : -1, out_size, ws_size, (size_t)WS_END); grid = -1; return; }
        int dev = 0, cus = 0, per_cu = 0;
        if (hipGetDevice(&dev) != hipSuccess || hipDeviceGetAttribute(&cus, hipDeviceAttributeMultiprocessorCount, dev) != hipSuccess) { fprintf(stderr, "kernel_launch: device query failed\n"); grid = -1; return; }
        if (hipFuncSetAttribute((const void*)fwd, hipFuncAttributeMaxDynamicSharedMemorySize, LDS_BYTES) != hipSuccess) { fprintf(stderr, "kernel_launch: hipFuncSetAttribute failed\n"); grid = -1; return; }
        if (hipOccupancyMaxActiveBlocksPerMultiprocessor(&per_cu, (const void*)fwd, 512, LDS_BYTES) != hipSuccess || per_cu < 1)
            fprintf(stderr, "kernel_launch: note: occupancy query reports %d workgroups per CU\n", per_cu);
        (void)hipGetLastError();
        grid = cus;
    }
    if (grid < 0) return;
    if (hipMemsetAsync((char*)d_ws + OFF_CTL, 0, SZ_CTL, stream) != hipSuccess) { fprintf(stderr, "kernel_launch: memset failed\n"); return; }
    Args a{};
    for (int i = 0; i < 20; ++i) a.in[i] = (const float*)d_in[i];
    a.out = (float*)d_out; a.ws = (unsigned char*)d_ws;
#if ONE_LAUNCH
    a.ph_lo = 0; a.ph_hi = NPH;
    hipLaunchKernelGGL(fwd, dim3(grid), dim3(512), LDS_BYTES, stream, a);
#else
    for (int p = 0; p < NPH; ++p) { a.ph_lo = p; a.ph_hi = p + 1; hipLaunchKernelGGL(fwd, dim3(grid), dim3(512), LDS_BYTES, stream, a); }
#endif
    const hipError_t le = hipPeekAtLastError();
    if (le != hipSuccess) fprintf(stderr, "kernel_launch: launch failed: %s\n", hipGetErrorName(le));
}
```

```cpp
#define ONE_LAUNCH 1
#define TOK_SPLIT 1
#include <hip/hip_runtime.h>
#include <cstdio>
#include <cstdint>

#define LAS __attribute__((address_space(3)))
typedef unsigned short bf16_t;
typedef short bf16x8 __attribute__((ext_vector_type(8)));
typedef short s16x4 __attribute__((ext_vector_type(4)));
typedef float f32x4 __attribute__((ext_vector_type(4)));
typedef float f32x16 __attribute__((ext_vector_type(16)));
typedef unsigned u32x4 __attribute__((ext_vector_type(4)));
typedef unsigned u32x2 __attribute__((ext_vector_type(2)));

constexpr int NB = 32, SQ = 2048, RR = NB * SQ, NMETA = 16, TP = 2176, DM = 1024, TPOS = 2064;
constexpr int NIN = 5632, DFF = 2816, NLAYER = 2;
constexpr float EPSF = 1e-6f;

constexpr size_t al256(size_t x) { return (x + 255) / 256 * 256; }
constexpr size_t OFF_CTL = 0, SZ_CTL = 65536;
constexpr size_t OFF_WIN = OFF_CTL + SZ_CTL, SZ_WIN = (size_t)NLAYER * NIN * DM * 2;
constexpr size_t OFF_WBR = OFF_WIN + SZ_WIN, SZ_WBR = (size_t)NLAYER * 2048 * DM * 2;
constexpr size_t OFF_WOUT = OFF_WBR + SZ_WBR, SZ_WOUT = (size_t)NLAYER * DM * DM * 2;
constexpr size_t OFF_WUP = OFF_WOUT + SZ_WOUT, SZ_WUP = (size_t)NLAYER * NIN * DM * 2;
constexpr size_t OFF_WDN = OFF_WUP + SZ_WUP, SZ_WDN = (size_t)NLAYER * DM * DFF * 2;
constexpr size_t OFF_COSA = OFF_WDN + SZ_WDN, SZ_ROPA = (size_t)TPOS * 64 * 4;
constexpr size_t OFF_SINA = OFF_COSA + SZ_ROPA;
constexpr size_t OFF_COSI = OFF_SINA + SZ_ROPA, SZ_ROPI = (size_t)TPOS * 32 * 4;
constexpr size_t OFF_SINI = OFF_COSI + SZ_ROPI;
constexpr size_t OFF_M = al256(OFF_SINI + SZ_ROPI);
constexpr size_t M_H = OFF_M;
constexpr size_t M_RAW = M_H + 16 * 1024 * 4;
constexpr size_t M_CHUNK = M_RAW + 16 * 1536 * 2;
constexpr size_t M_Z = M_CHUNK + 64 * 1536 * 2;
constexpr size_t M_BQ = M_Z + 16 * 512 * 2;
constexpr size_t M_IQ = M_BQ + 16 * 512 * 2;
constexpr size_t M_K = M_IQ + 16 * 512 * 2;
constexpr size_t M_V = M_K + 16 * 128 * 2;
constexpr size_t M_MISC = M_V + 16 * 128 * 2;
constexpr size_t M_GATES = M_MISC + 16 * 16 * 4;
constexpr size_t M_TQ = M_GATES + 16 * 2048 * 2;
constexpr size_t M_GC = M_TQ + 4 * 2 * 4096 * 2;
constexpr size_t M_BETA = M_GC + 64 * 4 * 4;
constexpr size_t M_OAB = M_BETA + 64 * 4 * 4;
constexpr size_t M_Y = M_OAB + 16 * 1024 * 2;
constexpr size_t M_GU = M_Y + 16 * 1024 * 2;
constexpr size_t M_ACT = M_GU + 16 * 5632 * 4;
constexpr size_t M_END = M_ACT + 16 * 2816 * 2;
constexpr size_t OFF_HB = al256(M_END), SZ_HB = (size_t)RR * DM * 2;
constexpr size_t OFF_SSQ = OFF_HB + SZ_HB, SZ_SSQ = (size_t)4 * RR * 8;
constexpr size_t OFF_QKV = OFF_SSQ + SZ_SSQ, SZ_QKV = (size_t)RR * 1536 * 2;
constexpr size_t OFF_HALO = OFF_QKV + SZ_QKV, SZ_HALO = (size_t)(RR / 64) * 3 * 1536 * 2;
constexpr size_t OFF_Z = OFF_HALO + SZ_HALO, SZ_512 = (size_t)RR * 512 * 2;
constexpr size_t OFF_BQ = OFF_Z + SZ_512;
constexpr size_t OFF_IQ = OFF_BQ + SZ_512;
constexpr size_t OFF_KB = OFF_IQ + SZ_512, SZ_KB = (size_t)NB * TP * 128 * 2;
constexpr size_t OFF_VB = OFF_KB + SZ_KB;
constexpr size_t OFF_IKB = OFF_VB + SZ_KB, SZ_IKB = (size_t)NB * TP * 64 * 2;
constexpr size_t OFF_MISC = OFF_IKB + SZ_IKB, SZ_MISC = (size_t)RR * 16 * 4;
constexpr size_t OFF_GC = OFF_MISC + SZ_MISC, SZ_GC = (size_t)RR * 4 * 4;
constexpr size_t OFF_BETA = OFF_GC + SZ_GC;
constexpr size_t OFF_TQ = OFF_BETA + SZ_GC, SZ_TQ = (size_t)NB * 32 * 4 * 2 * 4096 * 2;
constexpr size_t OFF_OAB = OFF_TQ + SZ_TQ, SZ_OAB = (size_t)RR * DM * 2;
constexpr size_t OFF_HG = OFF_OAB + SZ_OAB, SZ_HG = (size_t)256 * 2 * DFF * 4;
constexpr size_t WS_END = OFF_HG + SZ_HG;
constexpr size_t OFF_Y = OFF_QKV;
constexpr size_t OFF_ACT = OFF_QKV, SZ_FF = (size_t)RR * DFF * 2;
static_assert(OFF_ACT + SZ_FF <= OFF_OAB, "ffn alias region");
static_assert(WS_END <= (size_t)1073741824, "workspace budget");
constexpr int CW_QUEUE = 4096;

constexpr int LDS_BYTES = 163840, LDS_XB = LDS_BYTES - 16;

#define AS_GLOBAL(p) ((unsigned char*)(__attribute__((address_space(1))) unsigned char*)(p))
typedef __bf16 bf16x2_t __attribute__((ext_vector_type(2)));
__device__ __forceinline__ unsigned cvt_pk(float lo, float hi) { bf16x2_t v; v[0] = (__bf16)lo; v[1] = (__bf16)hi; return __builtin_bit_cast(unsigned, v); }
__device__ __forceinline__ bf16_t f2bf(float x) { return (bf16_t)(cvt_pk(x, 0.f) & 0xffffu); }
__device__ __forceinline__ float bf2f(bf16_t b) { return __uint_as_float(((unsigned)b) << 16); }
__device__ __forceinline__ float bflo(unsigned w) { return __uint_as_float(w << 16); }
__device__ __forceinline__ float bfhi(unsigned w) { return __uint_as_float(w & 0xffff0000u); }
template <int CTRL, int RM = 0xf> __device__ __forceinline__ float dpp_mov(float v) {
    return __builtin_bit_cast(float, __builtin_amdgcn_update_dpp(0, __builtin_bit_cast(int, v), CTRL, RM, 0xf, false)); }
__device__ __forceinline__ float row_sum16(float v) {
    v += dpp_mov<0xB1>(v); v += dpp_mov<0x4E>(v); v += dpp_mov<0x141>(v); v += dpp_mov<0x140>(v); return v; }
__device__ __forceinline__ float wave_sum_hi(float v) {
    v = row_sum16(v); v += dpp_mov<0x142, 0xa>(v); v += dpp_mov<0x143, 0xc>(v); return v; }
__device__ __forceinline__ float wave_sum(float v) { return __builtin_bit_cast(float, __builtin_amdgcn_readlane(__builtin_bit_cast(int, wave_sum_hi(v)), 63)); }
__device__ __forceinline__ float half_sum(float v) {
#pragma unroll
    for (int o = 16; o; o >>= 1) v += __shfl_xor(v, o);
    return v; }
typedef unsigned long long u64_t;
constexpr float SSQ_SCALE = 1048576.f, SSQ_INV = 1.f / 1048576.f;
__device__ __forceinline__ float rstd_of(const u64_t* ssq, int row) { return rsqrtf((float)ssq[row] * (SSQ_INV / DM) + EPSF); }
#ifndef FAST_SIG
#define FAST_SIG 1
#endif
#ifndef FAST_SILU
#define FAST_SILU 1
#endif
__device__ __forceinline__ float sigmoid_f(float x) { return FAST_SIG ? __builtin_amdgcn_rcpf(1.f + __expf(-x)) : 1.f / (1.f + __expf(-x)); }
__device__ __forceinline__ float sigmoid_slow(float x) { return 1.f / (1.f + __expf(-x)); }
__device__ __forceinline__ float sigmoid_fast(float x) { return __builtin_amdgcn_rcpf(1.f + __expf(-x)); }
__device__ __forceinline__ float silu_f(float x) { return FAST_SILU ? x * __builtin_amdgcn_rcpf(1.f + __expf(-x)) : x / (1.f + __expf(-x)); }
__device__ __forceinline__ float softplus_f(float x) { return fmaxf(x, 0.f) + log1pf(__expf(-fabsf(x))); }
__device__ __forceinline__ u32x4 pack8(f32x4 a, f32x4 b) { u32x4 w; w.x = cvt_pk(a[0], a[1]); w.y = cvt_pk(a[2], a[3]); w.z = cvt_pk(b[0], b[1]); w.w = cvt_pk(b[2], b[3]); return w; }
__device__ __forceinline__ bf16x8 as_bf8(u32x4 w) { return __builtin_bit_cast(bf16x8, w); }
__device__ __forceinline__ f32x4 mfma16(bf16x8 a, bf16x8 b, f32x4 c) { return __builtin_amdgcn_mfma_f32_16x16x32_bf16(a, b, c, 0, 0, 0); }

#define XB_TMO      128
#define XB_XCNT(j)  (256  + 64 * (j))
#define XB_XSUB(j)  (1280 + 64 * (j))
#define XB_XGEN(j)  (2304 + 64 * (j))
#define XB_TOP      3328
#define XB_TOPGEN   3392
#define XCD_BAR_WORDS 3456
#define XB_SPIN_CAP (1u << 18)
__device__ __forceinline__ unsigned xb_ld(unsigned* p)              { return __hip_atomic_load(p, __ATOMIC_RELAXED, __HIP_MEMORY_SCOPE_AGENT); }
__device__ __forceinline__ unsigned xb_add(unsigned* p, unsigned v) { return __hip_atomic_fetch_add(p, v, __ATOMIC_RELAXED, __HIP_MEMORY_SCOPE_AGENT); }
__device__ __forceinline__ unsigned xb_xcc_id() { return (unsigned)__builtin_amdgcn_s_getreg((3 << 11) | 20) & 0xFu; }
#define XB_SPIN(cond, bar) do { unsigned _sp = 0; while (cond) { __builtin_amdgcn_s_sleep(1); \
    if ((++_sp & 255u) == 0u) { if (xb_ld(&(bar)[XB_TMO])) break; if (_sp > XB_SPIN_CAP) { atomicAdd(&(bar)[XB_TMO], 1u); break; } } } } while (0)
struct XcdBarrier { unsigned* bar; unsigned x; volatile LAS unsigned* st; };
__device__ __forceinline__ XcdBarrier xcd_barrier_post(unsigned* bar, volatile LAS unsigned* st) {
    XcdBarrier b; b.bar = bar; b.x = xb_xcc_id(); b.st = st;
    if (threadIdx.x == 0) (void)xb_add(&bar[XB_XCNT(b.x)], 1u);
    return b;
}
__device__ __forceinline__ void xcd_barrier_complete(unsigned* bar, unsigned x, unsigned& nloc, unsigned& nx) {
    const unsigned G = gridDim.x * gridDim.y * gridDim.z;
    unsigned sum, cnt, mine, sp = 0u;
    for (;;) {
        sum = 0u; cnt = 0u; mine = 0u;
#pragma unroll
        for (unsigned j = 0; j < 16; ++j) { const unsigned c = xb_ld(&bar[XB_XCNT(j)]); sum += c; cnt += (c > 0u) ? 1u : 0u; mine = (j == x) ? c : mine; }
        if (sum == G) break;
        __builtin_amdgcn_s_sleep(1);
        if ((++sp & 255u) == 0u) { if (xb_ld(&bar[XB_TMO])) break; if (sp > XB_SPIN_CAP) { atomicAdd(&bar[XB_TMO], 1u); break; } }
    }
    nloc = mine > 0u ? mine : 1u; nx = cnt > 0u ? cnt : 1u;
}
__device__ __forceinline__ void xcd_barrier(const XcdBarrier& b) {
    asm volatile("s_waitcnt vmcnt(0)" ::: "memory");
    __syncthreads();
    if (threadIdx.x == 0) {
        unsigned* bar = b.bar;
        __builtin_amdgcn_s_waitcnt(0);
        unsigned nloc = b.st[0], nx = b.st[1];
        if (nloc == 0u) { xcd_barrier_complete(bar, b.x, nloc, nx); b.st[0] = nloc; b.st[1] = nx; }
        const unsigned old = xb_add(&bar[XB_XSUB(b.x)], 1u);
        const unsigned gen = old / nloc;
        if (old + 1u == (gen + 1u) * nloc) {
            __builtin_amdgcn_fence(__ATOMIC_RELEASE, "agent");
            asm volatile("s_waitcnt vmcnt(0)" ::: "memory");
            const unsigned og = xb_add(&bar[XB_TOP], 1u);
            const unsigned tg = og / nx;
            if (og + 1u == (tg + 1u) * nx) xb_add(&bar[XB_TOPGEN], 1u);
            else XB_SPIN(xb_ld(&bar[XB_TOPGEN]) == tg, bar);
            __builtin_amdgcn_fence(__ATOMIC_ACQUIRE, "agent");
            xb_add(&bar[XB_XGEN(b.x)], 1u);
            asm volatile("s_waitcnt vmcnt(0)" ::: "memory");
        } else {
            XB_SPIN(xb_ld(&bar[XB_XGEN(b.x)]) == gen, bar);
            __builtin_amdgcn_fence(__ATOMIC_ACQUIRE, "agent");
            asm volatile("s_waitcnt vmcnt(0)" ::: "memory");
        }
    }
    __syncthreads();
}

namespace pg8 {
#define PG8_LAS __attribute__((address_space(3)))
typedef unsigned short bf16_t;
typedef short bf16x8 __attribute__((ext_vector_type(8)));
typedef float f32x4 __attribute__((ext_vector_type(4)));
typedef unsigned u32x4 __attribute__((ext_vector_type(4)));
constexpr int BM = 256, BK = 64, HALF = 128, HTB = HALF * BK * 2  , STAGE_BYTES = 8 * HTB, NXCD = 8, WGM = 8;

__host__ __device__ __forceinline__ int lds_byte(int r, int c) { const int st = (r >> 4) * 2 + (c >> 5), rr = r & 15, cc = c & 31, ob = rr * 64 + cc * 2; return st * 1024 + (ob ^ (((ob >> 9) & 1) << 5)); }
__host__ __device__ __forceinline__ void stage_rc(int b, int& R, int& C) { const int st = b / 1024, sb = b % 1024, swz = sb ^ (((sb >> 9) & 1) << 5); R = (st >> 1) * 16 + swz / 64; C = (st & 1) * 32 + (swz % 64) / 2; }
__host__ __device__ __forceinline__ int perm32(int rho) { const int n = rho >> 4, i = rho & 15; return 8 * (i >> 2) + 4 * n + (i & 3); }

struct Unit { int pm, pn; };
struct Gemm { const bf16_t* A; const bf16_t* Bt; int M, N, K; };

struct StaticOrder {
    int nM, nN, nwg, G, c;
    __host__ __device__ void init(int M, int N, int G_, int c_) { nM = M / BM; nN = N / BM; nwg = nM * nN; G = G_; c = c_; }
    __host__ __device__ bool next(int i, Unit& u) const {
        const long L = (long)i * G + c; if (L >= nwg) return false;
        int wgid = (int)L; { const int q = nwg / NXCD, r = nwg % NXCD, xcd = wgid % NXCD, off = wgid / NXCD; wgid = (xcd < r ? xcd * (q + 1) : r * (q + 1) + (xcd - r) * q) + off; }
        const int nig = WGM * nN, gid = wgid / nig, fm = gid * WGM, gsz = (nM - fm) < WGM ? (nM - fm) : WGM;
        u.pm = fm + ((wgid % nig) % gsz); u.pn = (wgid % nig) / gsz; return true;
    }
    __device__ __forceinline__ void a_ready(const Unit&) const {}
    __device__ __forceinline__ void done(const Unit&) const {}
};
__device__ __forceinline__ unsigned cvt_pk_bf16(float lo, float hi) { unsigned r; asm volatile("v_cvt_pk_bf16_f32 %0, %1, %2" : "=v"(r) : "v"(lo), "v"(hi)); return r; }
typedef float f32x2 __attribute__((ext_vector_type(2)));
template <class Epi, class Sched, bool STAMP = false>
__device__ __forceinline__ void gemm_phase(PG8_LAS unsigned char* lds, const Gemm g, const Sched& S, const Epi& E, unsigned long long* stamps) {
    int tid_ = threadIdx.x; asm volatile("" : "+v"(tid_));
    const int tid = tid_, wid = __builtin_amdgcn_readfirstlane(tid >> 6), lane = tid & 63, wr = wid >> 2, wc = wid & 3, fr = lane & 15, fq = lane >> 4;
    const int K = g.K, nt = K / BK;
    int ts_lo = 0, ts_hi = 0, nts = 0; const unsigned long long rt_entry = STAMP ? (unsigned long long)wall_clock64() : 0ull;
#define PG8_STAMP() do { if (STAMP && wid == 0 && nts < 64) { const unsigned long long _c = (unsigned long long)clock64(); \
        ts_lo = (lane == nts) ? (int)(unsigned)_c : ts_lo; ts_hi = (lane == nts) ? (int)(unsigned)(_c >> 32) : ts_hi; ++nts; } } while (0)
    PG8_STAMP();
    unsigned voffA[2], voffB[2];
#pragma unroll
    for (int i = 0; i < 2; ++i) { int R, C; stage_rc(tid * 16 + i * 8192, R, C); const int Rb = Epi::PERM ? ((R & ~31) + perm32(R & 31)) : R;
        const int Ra = Epi::APERM ? (8 * (16 * (R >> 6) + (R & 15)) + ((R >> 4) & 3)) : R;
        voffA[i] = (unsigned)(Ra * K + C) * 2u; voffB[i] = (unsigned)(Rb * K + C) * 2u; }
    const size_t kstep = (size_t)(BK * 2);
    const size_t hstep = (size_t)HALF * K * 2;
    const size_t tstep = 2 * hstep;
    const size_t hstepA = Epi::APERM ? (size_t)4 * K * 2 : hstep;
    const unsigned ldsw = (unsigned)wid * 1024u;
    const int aoff = lds_byte(wr * 64 + fr, fq * 8), boff = lds_byte(wc * 32 + fr, fq * 8);
#define PG8_SA(b, h) (((b) * 2 + (h)) * HTB)
#define PG8_SB(b, h) ((4 + (b) * 2 + (h)) * HTB)
#define PG8_STAGE(bufoff, gbase, voff) do { _Pragma("unroll") for (int _i = 0; _i < 2; ++_i) \
        __builtin_amdgcn_global_load_lds((const unsigned*)((const char*)(gbase) + (voff)[_i]), (PG8_LAS unsigned*)(lds + (bufoff) + ldsw + _i * 8192), 16, 0, 0); } while (0)
#define PG8_LDA(dst, b, h) do { _Pragma("unroll") for (int m = 0; m < 4; ++m) _Pragma("unroll") for (int k = 0; k < 2; ++k) dst[m][k] = *(const PG8_LAS bf16x8*)(lds + PG8_SA(b, h) + aoff + m * 2048 + k * 1024); } while (0)
#define PG8_LDB(dst, b, h) do { _Pragma("unroll") for (int n = 0; n < 2; ++n) _Pragma("unroll") for (int k = 0; k < 2; ++k) dst[n][k] = *(const PG8_LAS bf16x8*)(lds + PG8_SB(b, h) + boff + n * 2048 + k * 1024); } while (0)
#define PG8_MMA(ai, bj, At, Bt) do { __builtin_amdgcn_s_setprio(1); _Pragma("unroll") for (int m = 0; m < 4; ++m) _Pragma("unroll") for (int n = 0; n < 2; ++n) _Pragma("unroll") for (int k = 0; k < 2; ++k) \
        acc[ai][bj][m][n] = __builtin_amdgcn_mfma_f32_16x16x32_bf16(Bt[n][k], At[m][k], acc[ai][bj][m][n], 0, 0, 0); __builtin_amdgcn_s_setprio(0); } while (0)
#define PG8_WAIT_V(n) asm volatile("s_waitcnt vmcnt(" #n ")" ::: "memory")
#define PG8_WAIT_L(n) asm volatile("s_waitcnt lgkmcnt(" #n ")" ::: "memory")
#define PG8_BAR __builtin_amdgcn_s_barrier()
#define PG8_SCHED __builtin_amdgcn_sched_barrier(0)
    Unit cur, nxt; int ui = 0;
    if (!S.next(0, cur)) return;
    f32x4 acc[2][2][4][2];
#pragma unroll
    for (int a = 0; a < 2; ++a)
#pragma unroll
        for (int b = 0; b < 2; ++b)
#pragma unroll
            for (int m = 0; m < 4; ++m)
#pragma unroll
                for (int n = 0; n < 2; ++n) acc[a][b][m][n] = (f32x4){0.f, 0.f, 0.f, 0.f};
    bf16x8 At[4][2], B0[2][2], B1[2][2];
    const char* cA = (const char*)g.A + (size_t)cur.pm * tstep; const char* cB = (const char*)g.Bt + (size_t)cur.pn * tstep;
    S.a_ready(cur);
    PG8_STAGE(PG8_SB(0, 0), cB, voffB); PG8_STAGE(PG8_SA(0, 0), cA, voffA); PG8_STAGE(PG8_SB(0, 1), cB + hstep, voffB); PG8_STAGE(PG8_SA(0, 1), cA + hstepA, voffA);
    if (wr == 1) PG8_BAR;
    PG8_WAIT_V(4); PG8_BAR;
    PG8_STAGE(PG8_SB(1, 0), cB + kstep, voffB); PG8_STAGE(PG8_SA(1, 0), cA + kstep, voffA); PG8_STAGE(PG8_SB(1, 1), cB + hstep + kstep, voffB);
    PG8_WAIT_V(6); PG8_BAR;
    PG8_STAMP();
    for (;;) {
        const bool has_next = S.next(ui + 1, nxt);
        const char* nA = has_next ? (const char*)g.A + (size_t)nxt.pm * tstep : cA; const char* nB = has_next ? (const char*)g.Bt + (size_t)nxt.pn * tstep : cB;
        for (int t = 0; t < nt; t += 2) {
            const bool last = (t == nt - 2);
            const bool bd_lo = !Epi::BD || (t * BK * 2 < K), bd_hi = !Epi::BD || !(t * BK * 2 < K);
            const char* a1 = cA + (size_t)(t + 1) * kstep;
            const char* a2 = last ? nA : cA + (size_t)(t + 2) * kstep; const char* b2 = last ? nB : cB + (size_t)(t + 2) * kstep;
            const char* a3 = a2 + kstep; const char* b3 = b2 + kstep;
            if (last && has_next) S.a_ready(nxt);
            PG8_LDB(B0, 0, 0); PG8_SCHED; PG8_LDA(At, 0, 0); PG8_STAGE(PG8_SA(1, 1), a1 + hstepA, voffA);
            PG8_WAIT_L(8); PG8_BAR; PG8_WAIT_L(0); if (bd_lo) PG8_MMA(0, 0, At, B0); PG8_BAR; PG8_SCHED;
            PG8_LDB(B1, 0, 1); PG8_STAGE(PG8_SB(0, 0), b2, voffB);
            PG8_BAR; PG8_WAIT_L(0); if (bd_hi) PG8_MMA(0, 1, At, B1); PG8_BAR;
            PG8_LDA(At, 0, 1); PG8_STAGE(PG8_SA(0, 0), a2, voffA);
            PG8_BAR; PG8_WAIT_L(0); if (bd_lo) PG8_MMA(1, 0, At, B0); PG8_BAR; PG8_SCHED;
            PG8_STAGE(PG8_SB(0, 1), b2 + hstep, voffB);
            PG8_WAIT_V(6); PG8_BAR; if (bd_hi) PG8_MMA(1, 1, At, B1); PG8_BAR;
            PG8_LDB(B0, 1, 0); PG8_SCHED; PG8_LDA(At, 1, 0); PG8_STAGE(PG8_SA(0, 1), a2 + hstepA, voffA);
            PG8_WAIT_L(8); PG8_BAR; PG8_WAIT_L(0); if (bd_lo) PG8_MMA(0, 0, At, B0); PG8_BAR; PG8_SCHED;
            PG8_LDB(B1, 1, 1); PG8_STAGE(PG8_SB(1, 0), b3, voffB);
            PG8_BAR; PG8_WAIT_L(0); if (bd_hi) PG8_MMA(0, 1, At, B1); PG8_BAR;
            PG8_LDA(At, 1, 1); PG8_STAGE(PG8_SA(1, 0), a3, voffA);
            PG8_BAR; PG8_WAIT_L(0); if (bd_lo) PG8_MMA(1, 0, At, B0); PG8_BAR; PG8_SCHED;
            PG8_STAGE(PG8_SB(1, 1), b3 + hstep, voffB);
            PG8_WAIT_V(6); PG8_BAR; if (bd_hi) PG8_MMA(1, 1, At, B1); PG8_BAR;
        }
        PG8_STAMP();
        if constexpr (!Epi::AFTER_DRAIN) { E(acc, cur, wr, wc, fr, fq); S.done(cur); }
        PG8_STAMP();
        if (!has_next) break;
#pragma unroll
        for (int a = 0; a < 2; ++a)
#pragma unroll
            for (int b = 0; b < 2; ++b)
#pragma unroll
                for (int m = 0; m < 4; ++m)
#pragma unroll
                    for (int n = 0; n < 2; ++n) acc[a][b][m][n] = (f32x4){0.f, 0.f, 0.f, 0.f};
        cur = nxt; cA = nA; cB = nB; ++ui;
    }
    PG8_WAIT_V(0);
    if (wr == 0) PG8_BAR;
    PG8_BAR;
    if constexpr (Epi::AFTER_DRAIN) { E.fused(acc, cur, wr, wc, fr, fq, lds, wid, lane); S.done(cur); }
    PG8_STAMP();
    if (STAMP && wid == 0) { stamps[lane] = lane < nts ? (((unsigned long long)(unsigned)ts_hi << 32) | (unsigned)ts_lo) : 0ull;
        if (lane == 62) stamps[62] = rt_entry; if (lane == 63) stamps[63] = (unsigned long long)wall_clock64(); }
#undef PG8_STAMP
#undef PG8_SA
#undef PG8_SB
#undef PG8_STAGE
#undef PG8_LDA
#undef PG8_LDB
#undef PG8_MMA
#undef PG8_WAIT_V
#undef PG8_WAIT_L
#undef PG8_BAR
#undef PG8_SCHED
}
}

struct Args { const float* in[20]; float* out; unsigned char* ws; int ph_lo, ph_hi; };
enum { I_X = 0, I_META, I_NORM_MIX, I_W_IN, I_CONV_A, I_A_LOG, I_DT_BIAS, I_A_OUT_NORM, I_Q_NORM, I_K_NORM, I_KIDX_NORM, I_W_BA, I_W_BB, I_W_GATE, I_B_GATE, I_W_OUT, I_NORM_FFN, I_W_UP, I_CONV_FFN, I_W_DOWN };

#ifndef DBG_NO_DSA
#define DBG_NO_DSA 0
#endif
#ifndef DBG_NO_GDN
#define DBG_NO_GDN 0
#endif
#ifndef DBG_NO_MIX
#define DBG_NO_MIX 0
#endif
#ifndef DBG_NO_FFN
#define DBG_NO_FFN 0
#endif

#ifndef SIG_EPI
#define SIG_EPI sigmoid_fast
#endif
#ifndef SIG_META
#define SIG_META sigmoid_fast
#endif
#ifndef SIG_BETA
#define SIG_BETA sigmoid_fast
#endif
#ifndef GATE_ROT
#define GATE_ROT 0
#endif
#define GATE_COL(row, col) (GATE_ROT ? (((col) + 128 * ((row) & 15)) & 2047) : (col))
#ifndef NT_STORE
#define NT_STORE 0
#endif
#define ST16(ptr, val) do { if (NT_STORE) __builtin_nontemporal_store((val), (u32x4*)(ptr)); else *(u32x4*)(ptr) = (val); } while (0)
struct PanelOrder : pg8::StaticOrder {
    __host__ __device__ bool next(int i, pg8::Unit& u) const { if (i >= nN || c >= nM) return false; u.pm = c; u.pn = i; return true; }
};
using pg8::Unit;
struct EpiIn {
    static constexpr bool PERM = true, AFTER_DRAIN = false, APERM = false, BD = false;
    bf16_t *qkv, *halo, *z, *bq, *iq, *kb, *vb, *ikb; float* misc; bf16_t* gates; const float* bgate; const u64_t* ssq;
    __device__ __forceinline__ void operator()(const f32x4 (&acc)[2][2][4][2], const Unit& u, int wr, int wc, int fr, int fq) const {
        const int pn = u.pn, row0 = u.pm * 256 + wr * 64 + fr, cl = wc * 32 + 8 * fq;
        float rs[2][4];
        { u64_t sv[2][4];
#pragma unroll
          for (int ai = 0; ai < 2; ++ai)
#pragma unroll
              for (int m = 0; m < 4; ++m) sv[ai][m] = ssq[row0 + ai * 128 + m * 16];
#pragma unroll
          for (int ai = 0; ai < 2; ++ai)
#pragma unroll
              for (int m = 0; m < 4; ++m) rs[ai][m] = rsqrtf((float)sv[ai][m] * (SSQ_INV / DM) + EPSF); }
        if (pn < 12) {
            bf16_t* base; int ld, cb;
            if (pn < 6) { base = qkv; ld = 1536; cb = pn * 256; } else if (pn < 8) { base = z; ld = 512; cb = (pn - 6) * 256; }
            else if (pn < 10) { base = bq; ld = 512; cb = (pn - 8) * 256; } else { base = iq; ld = 512; cb = (pn - 10) * 256; }
#pragma unroll
            for (int ai = 0; ai < 2; ++ai)
#pragma unroll
                for (int m = 0; m < 4; ++m) {
                    const int row = row0 + ai * 128 + m * 16; const float r = rs[ai][m];
                    bf16_t* p = base + (size_t)row * ld + cb + cl;
                    const u32x4 w0 = pack8(acc[ai][0][m][0] * r, acc[ai][0][m][1] * r), w1 = pack8(acc[ai][1][m][0] * r, acc[ai][1][m][1] * r);
                    ST16(p, w0); ST16(p + 128, w1);
                    if (pn < 6 && (row & 63) >= 61) {
                        bf16_t* hp = halo + ((size_t)(row >> 6) * 3 + ((row & 63) - 61)) * 1536 + cb + cl;
                        *(u32x4*)hp = w0; *(u32x4*)(hp + 128) = w1;
                    }
                }
        } else if (pn == 12) {
#pragma unroll
            for (int ai = 0; ai < 2; ++ai)
#pragma unroll
                for (int m = 0; m < 4; ++m) {
                    const int row = row0 + ai * 128 + m * 16; const float r = rs[ai][m];
                    const size_t prow = (size_t)(row >> 11) * TP + 16 + (row & 2047);
                    *(u32x4*)(kb + prow * 128 + cl) = pack8(acc[ai][0][m][0] * r, acc[ai][0][m][1] * r);
                    *(u32x4*)(vb + prow * 128 + cl) = pack8(acc[ai][1][m][0] * r, acc[ai][1][m][1] * r);
                }
        } else if (pn == 13) {
#pragma unroll
            for (int ai = 0; ai < 2; ++ai)
#pragma unroll
                for (int m = 0; m < 4; ++m) {
                    const int row = row0 + ai * 128 + m * 16; const float r = rs[ai][m];
                    if (cl < 64) { const size_t prow = (size_t)(row >> 11) * TP + 16 + (row & 2047); *(u32x4*)(ikb + prow * 64 + cl) = pack8(acc[ai][0][m][0] * r, acc[ai][0][m][1] * r); }
                    else if (cl < 80) { float* mp = misc + (size_t)row * 16 + (cl - 64); *(f32x4*)mp = acc[ai][0][m][0] * r; *(f32x4*)(mp + 4) = acc[ai][0][m][1] * r; }
                }
        } else {
            const int cb = (pn - 14) * 256 + cl;
            f32x4 bv[2][2];
#pragma unroll
            for (int bj = 0; bj < 2; ++bj) { bv[bj][0] = *(const f32x4*)(bgate + cb + bj * 128); bv[bj][1] = *(const f32x4*)(bgate + cb + bj * 128 + 4); }
#pragma unroll
            for (int ai = 0; ai < 2; ++ai)
#pragma unroll
                for (int m = 0; m < 4; ++m) {
                    const int row = row0 + ai * 128 + m * 16; const float r = rs[ai][m];
                    bf16_t* p = gates + (size_t)row * 2048;
#pragma unroll
                    for (int bj = 0; bj < 2; ++bj) {
                        f32x4 v0 = acc[ai][bj][m][0] * r + bv[bj][0], v1 = acc[ai][bj][m][1] * r + bv[bj][1];
#pragma unroll
                        for (int j = 0; j < 4; ++j) { v0[j] = SIG_EPI(v0[j]); v1[j] = SIG_EPI(v1[j]); }
                        ST16(p + GATE_COL(row, cb + bj * 128), pack8(v0, v1));
                    }
                }
        }
    }
};
struct EpiBr {
    static constexpr bool PERM = true, AFTER_DRAIN = false, APERM = false, BD = true;
    bf16_t* y; const bf16_t* gates; float sca, scb;
    __device__ __forceinline__ u32x4 comb(const f32x4 (&acc)[2][2][4][2], int ai, int m, u32x4 ga, u32x4 gb) const {
        f32x4 a0 = acc[ai][0][m][0] * sca, a1 = acc[ai][0][m][1] * sca, b0 = acc[ai][1][m][0] * scb, b1 = acc[ai][1][m][1] * scb, v0, v1;
        v0[0] = bflo(ga.x) * a0[0] + bflo(gb.x) * b0[0]; v0[1] = bfhi(ga.x) * a0[1] + bfhi(gb.x) * b0[1]; v0[2] = bflo(ga.y) * a0[2] + bflo(gb.y) * b0[2]; v0[3] = bfhi(ga.y) * a0[3] + bfhi(gb.y) * b0[3];
        v1[0] = bflo(ga.z) * a1[0] + bflo(gb.z) * b1[0]; v1[1] = bfhi(ga.z) * a1[1] + bfhi(gb.z) * b1[1]; v1[2] = bflo(ga.w) * a1[2] + bflo(gb.w) * b1[2]; v1[3] = bfhi(ga.w) * a1[3] + bfhi(gb.w) * b1[3];
        return pack8(v0, v1); }
    __device__ __forceinline__ void operator()(const f32x4 (&acc)[2][2][4][2], const Unit& u, int wr, int wc, int fr, int fq) const {
        const int row0 = u.pm * 256 + wr * 64 + fr, c0 = u.pn * 128 + wc * 32 + 8 * fq;
        u32x4 ga[4], gb[4], w0[4];
#pragma unroll
        for (int m = 0; m < 4; ++m) { const int rw = row0 + m * 16; const size_t go = (size_t)rw * 2048; ga[m] = *(const u32x4*)(gates + go + GATE_COL(rw, c0)); gb[m] = *(const u32x4*)(gates + go + GATE_COL(rw, 1024 + c0)); }
#pragma unroll
        for (int m = 0; m < 4; ++m) w0[m] = comb(acc, 0, m, ga[m], gb[m]);
#pragma unroll
        for (int m = 0; m < 4; ++m) { const int rw = row0 + 128 + m * 16; const size_t go = (size_t)rw * 2048; ga[m] = *(const u32x4*)(gates + go + GATE_COL(rw, c0)); gb[m] = *(const u32x4*)(gates + go + GATE_COL(rw, 1024 + c0)); }
#pragma unroll
        for (int m = 0; m < 4; ++m) *(u32x4*)(y + (size_t)(row0 + m * 16) * 1024 + c0) = w0[m];
#pragma unroll
        for (int m = 0; m < 4; ++m) *(u32x4*)(y + (size_t)(row0 + 128 + m * 16) * 1024 + c0) = comb(acc, 1, m, ga[m], gb[m]);
    }
};
struct EpiResidB {
    static constexpr bool PERM = true, AFTER_DRAIN = false, APERM = false, BD = false;
    bf16_t* hb; u64_t* ssq; float sc;
    __device__ __forceinline__ u32x4 upd(const f32x4 (&acc)[2][2][4][2], int ai, int bj, int m, u32x4 ov, float& part) const {
        f32x4 v0 = acc[ai][bj][m][0] * sc, v1 = acc[ai][bj][m][1] * sc;
        v0[0] += bflo(ov.x); v0[1] += bfhi(ov.x); v0[2] += bflo(ov.y); v0[3] += bfhi(ov.y); v1[0] += bflo(ov.z); v1[1] += bfhi(ov.z); v1[2] += bflo(ov.w); v1[3] += bfhi(ov.w);
        const u32x4 w = pack8(v0, v1);
        part += bflo(w.x) * bflo(w.x) + bfhi(w.x) * bfhi(w.x) + bflo(w.y) * bflo(w.y) + bfhi(w.y) * bfhi(w.y) + bflo(w.z) * bflo(w.z) + bfhi(w.z) * bfhi(w.z) + bflo(w.w) * bflo(w.w) + bfhi(w.w) * bfhi(w.w);
        return w; }
    __device__ __forceinline__ void operator()(const f32x4 (&acc)[2][2][4][2], const Unit& u, int wr, int wc, int fr, int fq) const {
        const int row0 = u.pm * 256 + wr * 64 + fr, c0 = u.pn * 256 + wc * 32 + 8 * fq;
        u32x4 o[4][2], w0[4][2]; float p0[4], p1[4];
#pragma unroll
        for (int m = 0; m < 4; ++m)
#pragma unroll
            for (int bj = 0; bj < 2; ++bj) o[m][bj] = *(const u32x4*)(hb + (size_t)(row0 + m * 16) * DM + c0 + bj * 128);
#pragma unroll
        for (int m = 0; m < 4; ++m) { p0[m] = 0.f; w0[m][0] = upd(acc, 0, 0, m, o[m][0], p0[m]); w0[m][1] = upd(acc, 0, 1, m, o[m][1], p0[m]); }
#pragma unroll
        for (int m = 0; m < 4; ++m)
#pragma unroll
            for (int bj = 0; bj < 2; ++bj) o[m][bj] = *(const u32x4*)(hb + (size_t)(row0 + 128 + m * 16) * DM + c0 + bj * 128);
#pragma unroll
        for (int m = 0; m < 4; ++m)
#pragma unroll
            for (int bj = 0; bj < 2; ++bj) *(u32x4*)(hb + (size_t)(row0 + m * 16) * DM + c0 + bj * 128) = w0[m][bj];
#pragma unroll
        for (int m = 0; m < 4; ++m) { p1[m] = 0.f;
#pragma unroll
            for (int bj = 0; bj < 2; ++bj) *(u32x4*)(hb + (size_t)(row0 + 128 + m * 16) * DM + c0 + bj * 128) = upd(acc, 1, bj, m, o[m][bj], p1[m]); }
#pragma unroll
        for (int m = 0; m < 4; ++m) {
            float a = p0[m], b = p1[m];
            a += __shfl_xor(a, 16); a += __shfl_xor(a, 32); b += __shfl_xor(b, 16); b += __shfl_xor(b, 32);
            if (ssq != nullptr && fq == 0) { atomicAdd(ssq + row0 + m * 16, (u64_t)(unsigned)(a * SSQ_SCALE + 0.5f)); atomicAdd(ssq + row0 + 128 + m * 16, (u64_t)(unsigned)(b * SSQ_SCALE + 0.5f)); }
        }
    }
};
struct EpiFinal {
    static constexpr bool PERM = true, AFTER_DRAIN = false, APERM = false, BD = false;
    const bf16_t* hb; float* out; float sc;
    __device__ __forceinline__ void operator()(const f32x4 (&acc)[2][2][4][2], const Unit& u, int wr, int wc, int fr, int fq) const {
        const int row0 = u.pm * 256 + wr * 64 + fr, c0 = u.pn * 256 + wc * 32 + 8 * fq;
        u32x4 o[2][4][2];
#pragma unroll
        for (int ai = 0; ai < 2; ++ai)
#pragma unroll
            for (int m = 0; m < 4; ++m)
#pragma unroll
                for (int bj = 0; bj < 2; ++bj) o[ai][m][bj] = *(const u32x4*)(hb + (size_t)(row0 + ai * 128 + m * 16) * DM + c0 + bj * 128);
#pragma unroll
        for (int ai = 0; ai < 2; ++ai)
#pragma unroll
            for (int m = 0; m < 4; ++m) {
                const size_t ro = (size_t)(row0 + ai * 128 + m * 16) * DM + c0;
#pragma unroll
                for (int bj = 0; bj < 2; ++bj) { const u32x4 ov = o[ai][m][bj]; f32x4 v0 = acc[ai][bj][m][0] * sc, v1 = acc[ai][bj][m][1] * sc;
                    v0[0] += bflo(ov.x); v0[1] += bfhi(ov.x); v0[2] += bflo(ov.y); v0[3] += bfhi(ov.y); v1[0] += bflo(ov.z); v1[1] += bfhi(ov.z); v1[2] += bflo(ov.w); v1[3] += bfhi(ov.w);
                    *(f32x4*)(out + ro + bj * 128) = v0; *(f32x4*)(out + ro + bj * 128 + 4) = v1; }
            }
    }
};
struct EpiNull {
    static constexpr bool PERM = true, AFTER_DRAIN = false, APERM = false, BD = false;
    __device__ __forceinline__ void operator()(const f32x4 (&acc)[2][2][4][2], const Unit& u, int wr, int wc, int fr, int fq) const {
#pragma unroll
        for (int ai = 0; ai < 2; ++ai)
#pragma unroll
            for (int bj = 0; bj < 2; ++bj)
#pragma unroll
                for (int m = 0; m < 4; ++m)
#pragma unroll
                    for (int n = 0; n < 2; ++n) asm volatile("" :: "v"(acc[ai][bj][m][n]));
    }
};
struct EpiUp {
    static constexpr bool PERM = true, AFTER_DRAIN = false, APERM = false, BD = false;
    bf16_t *gpre, *up; const u64_t* ssq;
    __device__ __forceinline__ void operator()(const f32x4 (&acc)[2][2][4][2], const Unit& u, int wr, int wc, int fr, int fq) const {
        const int row0 = u.pm * 256 + wr * 64 + fr, c0 = u.pn * 128 + wc * 32 + 8 * fq;
        u64_t sv[2][4];
#pragma unroll
        for (int ai = 0; ai < 2; ++ai)
#pragma unroll
            for (int m = 0; m < 4; ++m) sv[ai][m] = ssq[row0 + ai * 128 + m * 16];
#pragma unroll
        for (int ai = 0; ai < 2; ++ai)
#pragma unroll
            for (int m = 0; m < 4; ++m) {
                const int row = row0 + ai * 128 + m * 16; const float r = rsqrtf((float)sv[ai][m] * (SSQ_INV / DM) + EPSF);
                const size_t o = (size_t)row * DFF + c0;
                *(u32x4*)(gpre + o) = pack8(acc[ai][0][m][0] * r, acc[ai][0][m][1] * r);
                *(u32x4*)(up + o) = pack8(acc[ai][1][m][0] * r, acc[ai][1][m][1] * r);
            }
    }
};

template <int MODE> struct EpiUpConvT {
    static constexpr bool PERM = true, AFTER_DRAIN = false, APERM = true, BD = false;
    bf16_t* act; const u64_t* ssq; const float* cw; const float* hg; const float* mgu; char* xlds; int rt;
    __device__ __forceinline__ void operator()(const f32x4 (&acc)[2][2][4][2], const Unit& u, int wr, int wc, int fr, int fq) const {
        const int pm = u.pm, pn = u.pn, cl = wc * 32 + 8 * fq, ch0 = pn * 128 + cl, t0 = pm * 256 + 8 * (16 * wr + fr);
        u64_t sv[8];
#pragma unroll
        for (int j = 0; j < 8; ++j) sv[j] = (MODE == 2) ? (u64_t)(1000000 + j + rt) : ssq[t0 + j];
        float w0[8], w1[8], w2[8], b1[8], b2[8];
        { const f32x4 a0 = *(const f32x4*)(cw + ch0), a1 = *(const f32x4*)(cw + ch0 + 4), c0 = *(const f32x4*)(cw + DFF + ch0), c1 = *(const f32x4*)(cw + DFF + ch0 + 4),
                      e0 = *(const f32x4*)(cw + 2 * DFF + ch0), e1 = *(const f32x4*)(cw + 2 * DFF + ch0 + 4);
          const float* h2 = ((pm & 7) == 0) ? mgu + 14 * 5632 + pn * 256 + cl : hg + (size_t)(pm * 2) * DFF + ch0;
          const float* h1 = ((pm & 7) == 0) ? mgu + 15 * 5632 + pn * 256 + cl : hg + (size_t)(pm * 2 + 1) * DFF + ch0;
          const f32x4 p20 = *(const f32x4*)h2, p21 = *(const f32x4*)(h2 + 4), p10 = *(const f32x4*)h1, p11 = *(const f32x4*)(h1 + 4);
#pragma unroll
          for (int c = 0; c < 4; ++c) { w0[c] = a0[c]; w0[4 + c] = a1[c]; w1[c] = c0[c]; w1[4 + c] = c1[c]; w2[c] = e0[c]; w2[4 + c] = e1[c]; b2[c] = p20[c]; b2[4 + c] = p21[c]; b1[c] = p10[c]; b1[4 + c] = p11[c]; } }
        float rs[8];
#pragma unroll
        for (int j = 0; j < 8; ++j) rs[j] = rsqrtf((float)sv[j] * (SSQ_INV / DM) + EPSF);
        float g6[8], g7[8];
#pragma unroll
        for (int c = 0; c < 8; ++c) { g6[c] = acc[1][0][2][c >> 2][c & 3] * rs[6]; g7[c] = acc[1][0][3][c >> 2][c & 3] * rs[7]; }
        float* xw = (float*)(xlds + ((wc * 4 + fq) * 16) * 4);
        if (wr == 0 && fr == 15) { *(f32x4*)xw = (f32x4){g6[0], g6[1], g6[2], g6[3]}; *(f32x4*)(xw + 4) = (f32x4){g6[4], g6[5], g6[6], g6[7]};
                                   *(f32x4*)(xw + 8) = (f32x4){g7[0], g7[1], g7[2], g7[3]}; *(f32x4*)(xw + 12) = (f32x4){g7[4], g7[5], g7[6], g7[7]}; }
        asm volatile("s_waitcnt lgkmcnt(0)" ::: "memory");
        __builtin_amdgcn_s_barrier();
        asm volatile("" ::: "memory");
        if (wr == 1) { const f32x4 q0 = *(const f32x4*)xw, q1 = *(const f32x4*)(xw + 4), q2 = *(const f32x4*)(xw + 8), q3 = *(const f32x4*)(xw + 12);
#pragma unroll
            for (int c = 0; c < 4; ++c) { b2[c] = q0[c]; b2[4 + c] = q1[c]; b1[c] = q2[c]; b1[4 + c] = q3[c]; } }
        float gm1[8], gm2[8];
#pragma unroll
        for (int c = 0; c < 8; ++c) {
            gm1[c] = __int_as_float(__builtin_amdgcn_update_dpp(__float_as_int(b1[c]), __float_as_int(g7[c]), 0x111, 0xf, 0xf, false));
            gm2[c] = __int_as_float(__builtin_amdgcn_update_dpp(__float_as_int(b2[c]), __float_as_int(g6[c]), 0x111, 0xf, 0xf, false)); }
#pragma unroll
        for (int j = 0; j < 8; ++j) { const int ai = j >> 2, m = j & 3; float o[8];
#pragma unroll
            for (int c = 0; c < 8; ++c) { const float g = acc[ai][0][m][c >> 2][c & 3] * rs[j], up = acc[ai][1][m][c >> 2][c & 3] * rs[j];
                o[c] = silu_f(w0[c] * gm2[c] + w1[c] * gm1[c] + w2[c] * g) * up; gm2[c] = gm1[c]; gm1[c] = g; }
            u32x4 w; w.x = cvt_pk(o[0], o[1]); w.y = cvt_pk(o[2], o[3]); w.z = cvt_pk(o[4], o[5]); w.w = cvt_pk(o[6], o[7]);
            if (MODE != 1 || rt == 12345) ST16(act + (size_t)(t0 + j) * DFF + ch0, w); }
    }
};
typedef EpiUpConvT<0> EpiUpConv;

constexpr int MN_PITCH = 2064;
template <bool ALDS, class F> __device__ __forceinline__ void small_gemm16(const void* Ain, const bf16_t* Bt, int N, int K, const F& epi, char* red) {
    int tid_ = threadIdx.x; asm volatile("" : "+v"(tid_));
    const int lane = tid_ & 63, wid = tid_ >> 6, r = lane & 15, g = lane >> 4;
    const int kw = K >> 3, kb0 = wid * kw;
    for (int ct = blockIdx.x; ct < N / 16; ct += gridDim.x) {
        f32x4 acc = {0.f, 0.f, 0.f, 0.f};
        const bf16_t* bp = Bt + (size_t)(ct * 16 + r) * K + kb0 + g * 8;
        if (ALDS) { const char* ap = (const char*)Ain + r * MN_PITCH + (kb0 + g * 8) * 2;
#pragma unroll 4
            for (int k = 0; k < kw; k += 32) acc = mfma16(*(const bf16x8*)(ap + k * 2), *(const bf16x8*)(bp + k), acc);
        } else { const bf16_t* ap = (const bf16_t*)Ain + (size_t)r * K + kb0 + g * 8;
#pragma unroll 4
            for (int k = 0; k < kw; k += 32) acc = mfma16(*(const bf16x8*)(ap + k), *(const bf16x8*)(bp + k), acc); }
        *(f32x4*)(red + (wid * 64 + lane) * 16) = acc;
        __syncthreads();
        if (wid == 0) { f32x4 s = *(const f32x4*)(red + lane * 16);
#pragma unroll
            for (int w = 1; w < 8; ++w) s += *(const f32x4*)(red + (w * 64 + lane) * 16);
#pragma unroll
            for (int rr = 0; rr < 4; ++rr) epi(4 * g + rr, ct * 16 + r, s[rr]); }
        __syncthreads();
    }
}
__device__ __forceinline__ void meta_norm_lds(const float* hmeta, char* img) {
    int tid_ = threadIdx.x; asm volatile("" : "+v"(tid_));
    const int lane = tid_ & 63, wid = tid_ >> 6;
#pragma unroll
    for (int rr = 0; rr < 2; ++rr) { const int row = 2 * wid + rr; const float* src = hmeta + row * DM;
        f32x4 v[4]; float ss = 0.f;
#pragma unroll
        for (int i = 0; i < 4; ++i) { v[i] = ((const f32x4*)src)[lane + 64 * i]; ss += v[i][0] * v[i][0] + v[i][1] * v[i][1] + v[i][2] * v[i][2] + v[i][3] * v[i][3]; }
        ss = wave_sum(ss); const float rstd = rsqrtf(ss * (1.f / DM) + EPSF);
#pragma unroll
        for (int i = 0; i < 4; ++i) { u32x2 w; w.x = cvt_pk(v[i][0] * rstd, v[i][1] * rstd); w.y = cvt_pk(v[i][2] * rstd, v[i][3] * rstd); *(u32x2*)(img + row * MN_PITCH + (lane + 64 * i) * 8) = w; } }
    __syncthreads();
}
struct MEpiIn { unsigned char* ws; const float* bgate;
    __device__ __forceinline__ void operator()(int t, int n, float v) const {
        if (n < 1536) ((bf16_t*)(ws + M_RAW))[t * 1536 + n] = f2bf(v);
        else if (n < 2048) ((bf16_t*)(ws + M_Z))[t * 512 + n - 1536] = f2bf(v);
        else if (n < 2560) ((bf16_t*)(ws + M_BQ))[t * 512 + n - 2048] = f2bf(v);
        else if (n < 3072) ((bf16_t*)(ws + M_IQ))[t * 512 + n - 2560] = f2bf(v);
        else if (n < 3200) ((bf16_t*)(ws + M_K))[t * 128 + n - 3072] = f2bf(v);
        else if (n < 3328) ((bf16_t*)(ws + M_V))[t * 128 + n - 3200] = f2bf(v);
        else if (n < 3392) { }
        else if (n < 3408) ((float*)(ws + M_MISC))[t * 16 + n - 3392] = v;
        else if (n < 3584) { }
        else ((bf16_t*)(ws + M_GATES))[t * 2048 + n - 3584] = f2bf(SIG_META(v + bgate[n - 3584]));
    } };
struct MEpiBr { unsigned char* ws; float sca, scb;
    __device__ __forceinline__ void operator()(int t, int n, float v) const {
        const int ch = 128 * (n >> 8) + (n & 127), br = (n >> 7) & 1;
        const float g = bf2f(((const bf16_t*)(ws + M_GATES))[t * 2048 + br * 1024 + ch]);
        ((float*)(ws + M_GU))[t * 5632 + n] = g * v * (br ? scb : sca);
    } };
struct MEpiResid { float* h; float sc; __device__ __forceinline__ void operator()(int t, int n, float v) const { h[t * 1024 + n] += v * sc; } };
struct MEpiUp { float* gu; __device__ __forceinline__ void operator()(int t, int n, float v) const { gu[t * 5632 + n] = v; } };

struct MapId { __device__ __forceinline__ int operator()(int n) const { return n; } };
struct MapWin { __device__ __forceinline__ int operator()(int n) const {
    if (n < 2048) return n; if (n < 2560) return n - 2048 + 2056; if (n < 3072) return n - 2560 + 2824; if (n < 3200) return n - 3072 + 2568;
    if (n < 3328) return n - 3200 + 2696; if (n < 3392) return n - 3328 + 3336; if (n < 3400) return n - 3392 + 2048; if (n < 3408) return n; return -1; } };
struct MapWup { __device__ __forceinline__ int operator()(int n) const { const int t = n >> 8, w = n & 255; return w < 128 ? 128 * t + w : 2816 + 128 * t + (w - 128); } };
struct MapBrA { __device__ __forceinline__ int operator()(int n) const { return (n & 255) < 128 ? 128 * (n >> 8) + (n & 127) : -1; } };
struct MapBrB { __device__ __forceinline__ int operator()(int n) const { return (n & 255) >= 128 ? 128 * (n >> 8) + (n & 127) : -1; } };
template <class Map> __device__ __forceinline__ void tr_cvt(const float* __restrict__ src, int ldsrc, int K, bf16_t* __restrict__ dst, int ldd, int koff, int Nd, const Map& map, const float* gain, float* tile, int& g0) {
    const int G = gridDim.x, tid = threadIdx.x, nnt = Nd / 64, nt = nnt * (K / 128);
    int t = ((int)blockIdx.x - (g0 % G) + G) % G;
    for (; t < nt; t += G) {
        const int n0 = (t % nnt) * 64, k0 = (t / nnt) * 128;
        { const int nn = tid & 63, col = map(n0 + nn); float v[16];
#pragma unroll
          for (int i = 0; i < 16; ++i) { const int kk = (tid >> 6) + 8 * i; v[i] = col >= 0 ? src[(size_t)(k0 + kk) * ldsrc + col] : 0.f; }
#pragma unroll
          for (int i = 0; i < 16; ++i) { const int kk = (tid >> 6) + 8 * i; tile[kk * 65 + nn] = v[i]; } }
        __syncthreads();
#pragma unroll
        for (int hh = 0; hh < 2; ++hh) { const int nn = tid >> 3, part = (tid & 7) + 8 * hh; float v[8];
#pragma unroll
          for (int jj = 0; jj < 8; ++jj) { const int kk = part * 8 + jj; v[jj] = tile[kk * 65 + nn] * (gain ? gain[k0 + kk] : 1.f); }
          u32x4 w; w.x = cvt_pk(v[0], v[1]); w.y = cvt_pk(v[2], v[3]); w.z = cvt_pk(v[4], v[5]); w.w = cvt_pk(v[6], v[7]);
          *(u32x4*)(dst + (size_t)(n0 + nn) * ldd + koff + k0 + part * 8) = w; }
        __syncthreads();
    }
    g0 += nt;
}
__device__ __forceinline__ void p_prologue(const Args& a, char* smem) {
    unsigned char* ws = a.ws; { size_t z_ = 0; asm volatile("" : "+s"(z_)); ws += z_; } float* tile = (float*)smem; int g0 = 0;
    for (int l = 0; l < NLAYER; ++l) {
        const float* gmix = a.in[I_NORM_MIX] + l * DM; const float* gffn = a.in[I_NORM_FFN] + l * DM;
        tr_cvt(a.in[I_W_IN] + (size_t)l * DM * 3408, 3408, DM, (bf16_t*)(ws + OFF_WIN) + (size_t)l * NIN * DM, DM, 0, 3584, MapWin(), gmix, tile, g0);
        tr_cvt(a.in[I_W_GATE] + (size_t)l * DM * 2048, 2048, DM, (bf16_t*)(ws + OFF_WIN) + ((size_t)l * NIN + 3584) * DM, DM, 0, 2048, MapId(), gmix, tile, g0);
        tr_cvt(a.in[I_W_BA] + (size_t)l * 512 * DM, DM, 512, (bf16_t*)(ws + OFF_WBR) + (size_t)l * 2048 * DM, DM, 0, 2048, MapBrA(), nullptr, tile, g0);
        tr_cvt(a.in[I_W_BB] + (size_t)l * 512 * DM, DM, 512, (bf16_t*)(ws + OFF_WBR) + (size_t)l * 2048 * DM, DM, 512, 2048, MapBrB(), nullptr, tile, g0);
        tr_cvt(a.in[I_W_OUT] + (size_t)l * DM * DM, DM, DM, (bf16_t*)(ws + OFF_WOUT) + (size_t)l * DM * DM, DM, 0, DM, MapId(), nullptr, tile, g0);
        tr_cvt(a.in[I_W_UP] + (size_t)l * DM * 5632, 5632, DM, (bf16_t*)(ws + OFF_WUP) + (size_t)l * NIN * DM, DM, 0, NIN, MapWup(), gffn, tile, g0);
        tr_cvt(a.in[I_W_DOWN] + (size_t)l * DFF * DM, DM, DFF, (bf16_t*)(ws + OFF_WDN) + (size_t)l * DM * DFF, DFF, 0, DM, MapId(), nullptr, tile, g0);
    }
    const int gt = blockIdx.x * 512 + threadIdx.x, nT = gridDim.x * 512;
    { const int lane = threadIdx.x & 63, gw = blockIdx.x * 8 + (threadIdx.x >> 6), nW = gridDim.x * 8;
      bf16_t* hb = (bf16_t*)(ws + OFF_HB); u64_t* ssq = (u64_t*)(ws + OFF_SSQ);
      for (int row = 2 * gw; row < RR; row += 2 * nW) { const float* src = a.in[I_X] + (size_t)row * DM; float ss0 = 0.f, ss1 = 0.f; f32x4 v[8];
#pragma unroll
          for (int i = 0; i < 8; ++i) v[i] = ((const f32x4*)src)[lane + 64 * i];
#pragma unroll
          for (int i = 0; i < 8; ++i) { u32x2 w; w.x = cvt_pk(v[i][0], v[i][1]); w.y = cvt_pk(v[i][2], v[i][3]);
              const float q = bflo(w.x) * bflo(w.x) + bfhi(w.x) * bfhi(w.x) + bflo(w.y) * bflo(w.y) + bfhi(w.y) * bfhi(w.y); if (i < 4) ss0 += q; else ss1 += q;
              ((u32x2*)(hb + (size_t)row * DM))[lane + 64 * i] = w; }
          ss0 = wave_sum(ss0); ss1 = wave_sum(ss1); if (lane == 0) { ssq[row] = (u64_t)(ss0 * SSQ_SCALE + 0.5f); ssq[row + 1] = (u64_t)(ss1 * SSQ_SCALE + 0.5f); } }
      for (int i = gt; i < 3 * RR; i += nT) ssq[RR + i] = 0ull; }
    float* cosA = (float*)(ws + OFF_COSA); float* sinA = (float*)(ws + OFF_SINA); float* cosI = (float*)(ws + OFF_COSI); float* sinI = (float*)(ws + OFF_SINI);
    for (int i = gt; i < TPOS * 96; i += nT) {
        const int pos = i / 96, j = i % 96;
        if (j < 64) { const float inv = 1.0f / powf(10000.f, (float)(2 * j) / 128.f), ang = (float)pos * inv; cosA[pos * 64 + j] = cosf(ang); sinA[pos * 64 + j] = sinf(ang); }
        else { const int jj = j - 64; const float inv = 1.0f / powf(10000.f, (float)(2 * jj) / 64.f), ang = (float)pos * inv; cosI[pos * 32 + jj] = cosf(ang); sinI[pos * 32 + jj] = sinf(ang); }
    }
    for (int i = gt; i < 16 * 1024; i += nT) ((float*)(ws + M_H))[i] = a.in[I_META][i];
    for (int i = gt; i < NB * (TP - TPOS) * 16; i += nT) {
        const int b = i / ((TP - TPOS) * 16), r = i % ((TP - TPOS) * 16);
        const size_t o = ((size_t)b * TP + TPOS) * 128 + (size_t)r * 8;
        *(u32x4*)((bf16_t*)(ws + OFF_KB) + o) = (u32x4){0u, 0u, 0u, 0u}; *(u32x4*)((bf16_t*)(ws + OFF_VB) + o) = (u32x4){0u, 0u, 0u, 0u};
    }
}

template <int GL, bool NORM> __device__ __forceinline__ u32x4 rope8(u32x4 raw, int lig, const float* w, const float* cs, const float* sn) {
    float x[8] = {bflo(raw.x), bfhi(raw.x), bflo(raw.y), bfhi(raw.y), bflo(raw.z), bfhi(raw.z), bflo(raw.w), bfhi(raw.w)};
    if (NORM) { float ss = 0.f;
#pragma unroll
        for (int j = 0; j < 8; ++j) ss += x[j] * x[j];
        ss += dpp_mov<0xB1>(ss); ss += dpp_mov<0x4E>(ss); ss += dpp_mov<0x141>(ss); if (GL == 16) ss += dpp_mov<0x140>(ss);
        const float rstd = rsqrtf(ss * (1.f / (8 * GL)) + EPSF);
        const f32x4 w0 = *(const f32x4*)(w + 8 * lig), w1 = *(const f32x4*)(w + 8 * lig + 4);
#pragma unroll
        for (int j = 0; j < 4; ++j) { x[j] *= rstd * w0[j]; x[4 + j] *= rstd * w1[j]; } }
    const int ih = lig & (GL / 2 - 1); const bool second = lig >= GL / 2;
    const f32x4 c0 = *(const f32x4*)(cs + 8 * ih), c1 = *(const f32x4*)(cs + 8 * ih + 4), s0 = *(const f32x4*)(sn + 8 * ih), s1 = *(const f32x4*)(sn + 8 * ih + 4);
    float o[8];
#pragma unroll
    for (int j = 0; j < 8; ++j) { const float other = (GL == 16) ? dpp_mov<0x128>(x[j]) : dpp_mov<0x1B>(dpp_mov<0x141>(x[j])), cc = j < 4 ? c0[j] : c1[j - 4], ss_ = j < 4 ? s0[j] : s1[j - 4];
        o[j] = x[j] * cc + (second ? other * ss_ : -other * ss_); }
    u32x4 r; r.x = cvt_pk(o[0], o[1]); r.y = cvt_pk(o[2], o[3]); r.z = cvt_pk(o[4], o[5]); r.w = cvt_pk(o[6], o[7]); return r;
}
namespace mp {
constexpr int RAW_OFF = 0, QS_OFF = 51712, KS_OFF = 70144, MT_OFF = 88576, GC_OFF = 154112, BT_OFF = 155136, RED_OFF = 156160, CNT_OFF = 157184;
}
__device__ __forceinline__ void p_mixprep(const Args& a, int layer, char* smem, bool do_store, int skip = 0) {
    using namespace mp;
    unsigned char* ws = a.ws; { size_t z_ = 0; asm volatile("" : "+s"(z_)); ws += z_; }
    bf16_t* qkv = (bf16_t*)(ws + OFF_QKV); const bf16_t* halo = (const bf16_t*)(ws + OFF_HALO); const bf16_t* mraw = (const bf16_t*)(ws + M_RAW);
    bf16_t* mchunk = (bf16_t*)(ws + M_CHUNK); bf16_t* TQ = (bf16_t*)(ws + OFF_TQ); bf16_t* mTQ = (bf16_t*)(ws + M_TQ);
    const float* conv_a = a.in[I_CONV_A] + (size_t)layer * 4 * 1536;
    const float* a_log = a.in[I_A_LOG] + layer * 4; const float* dt_bias = a.in[I_DT_BIAS] + layer * 4;
    const float* qn = a.in[I_Q_NORM] + layer * 128; const float* kn = a.in[I_K_NORM] + layer * 128; const float* kin = a.in[I_KIDX_NORM] + layer * 64;
    const float* cosA = (const float*)(ws + OFF_COSA); const float* sinA = (const float*)(ws + OFF_SINA); const float* cosI = (const float*)(ws + OFF_COSI); const float* sinI = (const float*)(ws + OFF_SINI);
    float* GCs = (float*)(smem + GC_OFF); float* BTs = (float*)(smem + BT_OFF); float* RED = (float*)(smem + RED_OFF);
    bf16_t* QS = (bf16_t*)(smem + QS_OFF); bf16_t* KS = (bf16_t*)(smem + KS_OFF); bf16_t* RV = (bf16_t*)(smem + RAW_OFF + 2 * 67 * 256);
    for (int item = blockIdx.x; item < 1028; item += gridDim.x) {
        int tid_ = threadIdx.x; asm volatile("" : "+v"(tid_));
        const int tid = tid_, lane = tid & 63, wid = __builtin_amdgcn_readfirstlane(tid >> 6);
        const bool is_meta = item >= 1024; const int b = item >> 5, c = item & 31, row0 = b * 2048 + 64 * c;
        const int h_lo = is_meta ? item - 1024 : 0, h_hi = is_meta ? h_lo + 1 : 4;
        { float g = 0.f, be = 0.f; const int t = tid >> 2, h = tid & 3;
          if (tid < 256 && (!is_meta || t >= 48)) { const float* mpp = is_meta ? (const float*)(ws + M_MISC) + (t - 48) * 16 : (const float*)(ws + OFF_MISC) + (size_t)(row0 + t) * 16;
              g = -__expf(a_log[h]) * softplus_f(mpp[h] + dt_bias[h]); be = SIG_BETA(mpp[4 + h]); }
          float s = g;
#pragma unroll
          for (int o = 4; o < 64; o <<= 1) { const float v = __shfl_up(s, o); if (lane >= o) s += v; }
          if (tid < 256 && lane >= 60) RED[wid * 4 + (lane & 3)] = s;
          __syncthreads();
          if (tid < 256) { for (int w = 0; w < wid; ++w) s += RED[w * 4 + h]; GCs[tid] = s; BTs[tid] = be; } }
        __syncthreads();
        if (do_store && tid < 256 && item <= 1024) { float* gd = is_meta ? (float*)(ws + M_GC) : (float*)(ws + OFF_GC) + (size_t)row0 * 4; float* bd = is_meta ? (float*)(ws + M_BETA) : (float*)(ws + OFF_BETA) + (size_t)row0 * 4;
            gd[tid] = GCs[tid]; bd[tid] = BTs[tid]; }
        const bf16_t* zsrc = (const bf16_t*)(ws + OFF_KB) + (size_t)TPOS * 128;
#define MP_DMA(hh, plo, phi) do { int td_ = tid; asm volatile("" : "+v"(td_)); _Pragma("unroll 1") for (int it = 0; it < 7; ++it) { const int p = td_ + 512 * it; \
            if (p >= (plo) && p < (phi)) { const int tensor = p / (67 * 16), rem = p - tensor * (67 * 16), rr = rem >> 4, cc = (rem & 15) * 8, tt = rr - 3, col = tensor * 512 + (hh) * 128 + cc; \
                const bf16_t* sp = zsrc; \
                if (!is_meta) { if (tt >= 0) sp = qkv + (size_t)(row0 + tt) * 1536 + col; else if (c > 0) sp = halo + ((size_t)((row0 >> 6) - 1) * 3 + (tt + 3)) * 1536 + col; \
                    else sp = mraw + (size_t)(16 + tt) * 1536 + col; } \
                else if (tt >= 48) sp = mraw + (size_t)(tt - 48) * 1536 + col; \
                __builtin_amdgcn_global_load_lds((const unsigned*)sp, (LAS unsigned*)(smem + RAW_OFF + (wid * 64 + 512 * it) * 16), 16, 0, 0); } } } while (0)
        MP_DMA(h_lo, 0, 3 * 67 * 16);
        for (int h = h_lo; h < ((skip & 8) ? h_lo : h_hi); ++h) {
            const int co = lane & 15, t0 = 2 * (wid * 4 + (lane >> 4));
            f32x4 cw[3][4][2];
#pragma unroll
            for (int tensor = 0; tensor < 3; ++tensor)
#pragma unroll
                for (int k = 0; k < 4; ++k) { const float* wp = conv_a + k * 1536 + tensor * 512 + h * 128 + 8 * co; cw[tensor][k][0] = *(const f32x4*)wp; cw[tensor][k][1] = *(const f32x4*)(wp + 4); }
            asm volatile("s_waitcnt vmcnt(0)" ::: "memory");
            __syncthreads();
            u32x4 ov[2];
#pragma unroll
            for (int tensor = 0; tensor < 3; ++tensor) {
                const char* rp = smem + RAW_OFF + tensor * 67 * 256 + t0 * 256 + co * 16;
                float x[5][8];
#pragma unroll
                for (int r = 0; r < 5; ++r) { const u32x4 v = *(const u32x4*)(rp + r * 256);
                    x[r][0] = bflo(v.x); x[r][1] = bfhi(v.x); x[r][2] = bflo(v.y); x[r][3] = bfhi(v.y); x[r][4] = bflo(v.z); x[r][5] = bfhi(v.z); x[r][6] = bflo(v.w); x[r][7] = bfhi(v.w); }
#pragma unroll
                for (int i = 0; i < 2; ++i) { float y[8]; float ss = 0.f;
#pragma unroll
                    for (int j = 0; j < 8; ++j) { const float pre = cw[tensor][0][j >> 2][j & 3] * x[i][j] + cw[tensor][1][j >> 2][j & 3] * x[i + 1][j] + cw[tensor][2][j >> 2][j & 3] * x[i + 2][j] + cw[tensor][3][j >> 2][j & 3] * x[i + 3][j];
                        y[j] = (skip & 32) ? x[i + 3][j] : silu_f(pre); ss += y[j] * y[j]; }
                    if (tensor < 2) { if (!(skip & 1)) ss = row_sum16(ss);
                        const float rn = rsqrtf(ss + EPSF) * (tensor == 0 ? 0.08838834764831845f : 1.f);
#pragma unroll
                        for (int j = 0; j < 8; ++j) y[j] *= rn; }
                    u32x4 o; o.x = cvt_pk(y[0], y[1]); o.y = cvt_pk(y[2], y[3]); o.z = cvt_pk(y[4], y[5]); o.w = cvt_pk(y[6], y[7]);
                    if (tensor == 0) *(u32x4*)(QS + (t0 + i) * 144 + 8 * co) = o; else if (tensor == 1) *(u32x4*)(KS + (t0 + i) * 144 + 8 * co) = o; else ov[i] = o; }
            }
            __syncthreads();
            if (h + 1 < h_hi) MP_DMA(h + 1, 0, 2 * 67 * 16);
            *(u32x4*)(RV + (t0 + 3) * 128 + 8 * co) = ov[0]; *(u32x4*)(RV + (t0 + 4) * 128 + 8 * co) = ov[1];
            __syncthreads();
            if (!(skip & 128)) { bf16_t* dbase = is_meta ? mchunk : qkv + (size_t)row0 * 1536;
              for (int p = tid; p < 3072; p += 512) { const int tensor = p >> 10, t = (p & 1023) >> 4, cc = (p & 15) * 8;
                  const bf16_t* sp = tensor == 0 ? QS + t * 144 + cc : (tensor == 1 ? KS + t * 144 + cc : RV + (t + 3) * 128 + cc);
                  if (do_store) *(u32x4*)(dbase + (size_t)t * 1536 + tensor * 512 + h * 128 + cc) = *(const u32x4*)sp; } }
            if (!(skip & 256)) { const int r = lane & 15, g = lane >> 4, mt = wid >> 1;
              bf16_t* tqd = is_meta ? mTQ + h * 8192 : TQ + (size_t)((row0 >> 6) * 4 + h) * 8192;
              float* MT = (float*)(smem + MT_OFF) + h * 4096;
#pragma unroll
              for (int nti = 0; nti < 2; ++nti) { const int nt = 2 * (wid & 1) + nti;
                  f32x4 akk = {0.f, 0.f, 0.f, 0.f}, aqk = {0.f, 0.f, 0.f, 0.f};
#pragma unroll
                  for (int s = 0; s < 4; ++s) {
                      const bf16x8 fk = *(const bf16x8*)(KS + (16 * mt + r) * 144 + 32 * s + 8 * g);
                      const bf16x8 fq = *(const bf16x8*)(QS + (16 * mt + r) * 144 + 32 * s + 8 * g);
                      const bf16x8 fb = *(const bf16x8*)(KS + (16 * nt + r) * 144 + 32 * s + 8 * g);
                      akk = mfma16(fk, fb, akk); aqk = mfma16(fq, fb, aqk); }
                  const int j = 16 * nt + r; const float gcj = GCs[j * 4 + h];
#pragma unroll
                  for (int rr = 0; rr < 4; ++rr) { const int i = 16 * mt + 4 * g + rr; const float gci = GCs[i * 4 + h], bi = BTs[i * 4 + h];
                      const float dec = (i >= j) ? __expf(gci - gcj) : 0.f;
                      MT[i * 64 + j] = (i > j) ? bi * akk[rr] * dec : 0.f;
                      if (do_store) tqd[4096 + i * 64 + j] = f2bf((i >= j) ? aqk[rr] * dec : 0.f); } } }
            __syncthreads();
            if (h + 1 < h_hi) MP_DMA(h + 1, 2 * 67 * 16, 3 * 67 * 16);
        }
#undef MP_DMA
        if (!(skip & 2) && wid < 4 && wid >= h_lo && wid < h_hi) { const int hh = wid;
            float* MT = (float*)(smem + MT_OFF) + hh * 4096;
            const int ib = is_meta ? 48 : 0;
            if (is_meta) for (int i = 0; i < 48; ++i) MT[i * 64 + lane] = (lane == i) ? 1.f : 0.f;
            for (int i0 = ib; i0 < 64; i0 += 4) {
                float a0 = (lane == i0) ? 1.f : 0.f, a1 = (lane == i0 + 1) ? 1.f : 0.f, a2 = (lane == i0 + 2) ? 1.f : 0.f, a3 = (lane == i0 + 3) ? 1.f : 0.f;
#pragma unroll 2
                for (int j = ib; j < i0; j += 4) {
                    const f32x4 m0 = *(const f32x4*)(MT + (i0 + 0) * 64 + j), m1 = *(const f32x4*)(MT + (i0 + 1) * 64 + j), m2 = *(const f32x4*)(MT + (i0 + 2) * 64 + j), m3 = *(const f32x4*)(MT + (i0 + 3) * 64 + j);
                    const float t0 = MT[(j + 0) * 64 + lane], t1 = MT[(j + 1) * 64 + lane], t2 = MT[(j + 2) * 64 + lane], t3 = MT[(j + 3) * 64 + lane];
                    a0 -= m0[0] * t0 + m0[1] * t1 + m0[2] * t2 + m0[3] * t3; a1 -= m1[0] * t0 + m1[1] * t1 + m1[2] * t2 + m1[3] * t3;
                    a2 -= m2[0] * t0 + m2[1] * t1 + m2[2] * t2 + m2[3] * t3; a3 -= m3[0] * t0 + m3[1] * t1 + m3[2] * t2 + m3[3] * t3; }
                const f32x4 d1 = *(const f32x4*)(MT + (i0 + 1) * 64 + i0), d2 = *(const f32x4*)(MT + (i0 + 2) * 64 + i0), d3 = *(const f32x4*)(MT + (i0 + 3) * 64 + i0);
                a1 -= d1[0] * a0; a2 -= d2[0] * a0 + d2[1] * a1; a3 -= d3[0] * a0 + d3[1] * a1 + d3[2] * a2;
                MT[(i0 + 0) * 64 + lane] = a0; MT[(i0 + 1) * 64 + lane] = a1; MT[(i0 + 2) * 64 + lane] = a2; MT[(i0 + 3) * 64 + lane] = a3;
            }
            bf16_t* td = is_meta ? mTQ + hh * 8192 : TQ + (size_t)((row0 >> 6) * 4 + hh) * 8192;
            if (do_store) for (int it = 0; it < 8; ++it) { const int p = lane + 64 * it; const f32x4 v0 = *(const f32x4*)(MT + p * 8), v1 = *(const f32x4*)(MT + p * 8 + 4);
                *(u32x4*)(td + p * 8) = pack8(v0, v1); }
        }
#ifndef TOK_SPLIT
#define TOK_SPLIT 0
#endif
        if (!(skip & 4) && item <= 1024 && (wid >= 4 || (TOK_SPLIT && !is_meta))) {
            bf16_t* kb = (bf16_t*)(ws + OFF_KB); bf16_t* vb = (bf16_t*)(ws + OFF_VB); bf16_t* ikb = (bf16_t*)(ws + OFF_IKB);
            const int ntok = is_meta ? 4 : (TOK_SPLIT ? (wid >= 4 ? 12 : 4) : 16), tbase = is_meta ? (wid - 4) * 4 : (TOK_SPLIT ? (wid >= 4 ? (wid - 4) * 12 : 48 + wid * 4) : (wid - 4) * 16);
            u32x4 rq[4], ri[4], rm[4], nq[4], ni[4], nm[4];
#define TP_LOAD(Q, I, M, tb) do { _Pragma("unroll") for (int u = 0; u < 4; ++u) { const int tl = (tb) + u; const size_t row = (size_t)row0 + tl; const int pos = is_meta ? tl : 16 + 64 * c + tl; \
                    const bf16_t* qp = is_meta ? (const bf16_t*)(ws + M_BQ) + tl * 512 : (const bf16_t*)(ws + OFF_BQ) + row * 512; \
                    const bf16_t* ip = is_meta ? (const bf16_t*)(ws + M_IQ) + tl * 512 : (const bf16_t*)(ws + OFF_IQ) + row * 512; \
                    Q[u] = *(const u32x4*)(qp + lane * 8); I[u] = *(const u32x4*)(ip + lane * 8); \
                    const bf16_t* mp = is_meta ? (const bf16_t*)(ws + M_K) + tl * 128 + (lane & 15) * 8 \
                                               : (lane < 16 ? kb + ((size_t)b * TP + pos) * 128 + lane * 8 : ikb + ((size_t)b * TP + pos) * 64 + (lane & 7) * 8); \
                    M[u] = *(const u32x4*)mp; } } while (0)
            TP_LOAD(rq, ri, rm, tbase);
            for (int t0 = 0; t0 < ntok; t0 += 4) {
                if (t0 + 4 < ntok) TP_LOAD(nq, ni, nm, tbase + t0 + 4);
#pragma unroll
                for (int u = 0; u < 4; ++u) { const int tl = tbase + t0 + u; const size_t row = (size_t)row0 + tl; const int pos = is_meta ? tl : 16 + 64 * c + tl;
                    const u32x4 oq = rope8<16, true>(rq[u], lane & 15, qn, cosA + pos * 64, sinA + pos * 64);
                    const u32x4 oi = rope8<8, false>(ri[u], lane & 7, nullptr, cosI + pos * 32, sinI + pos * 32);
                    const u32x4 ok = rope8<16, true>(rm[u], lane & 15, kn, cosA + pos * 64, sinA + pos * 64);
                    const u32x4 oik = rope8<8, true>(rm[u], lane & 7, kin, cosI + pos * 32, sinI + pos * 32);
                    bf16_t* qp = is_meta ? (bf16_t*)(ws + M_BQ) + tl * 512 : (bf16_t*)(ws + OFF_BQ) + row * 512;
                    bf16_t* ip = is_meta ? (bf16_t*)(ws + M_IQ) + tl * 512 : (bf16_t*)(ws + OFF_IQ) + row * 512;
                    if (do_store) { *(u32x4*)(qp + lane * 8) = oq; *(u32x4*)(ip + lane * 8) = oi; }
                    if (!do_store) { } else if (!is_meta) { if (lane < 16) *(u32x4*)(kb + ((size_t)b * TP + pos) * 128 + lane * 8) = ok; else if (lane < 24) *(u32x4*)(ikb + ((size_t)b * TP + pos) * 64 + (lane & 7) * 8) = oik; }
                    else {
                        const u32x4 vv = *(const u32x4*)((const bf16_t*)(ws + M_V) + tl * 128 + (lane & 15) * 8);
                        if (lane < 16) for (int bb = 0; bb < NB; ++bb) { *(u32x4*)(kb + ((size_t)bb * TP + tl) * 128 + lane * 8) = ok; *(u32x4*)(vb + ((size_t)bb * TP + tl) * 128 + lane * 8) = vv; } }
                }
#pragma unroll
                for (int u = 0; u < 4; ++u) { rq[u] = nq[u]; ri[u] = ni[u]; rm[u] = nm[u]; }
            }
#undef TP_LOAD
        }
        __syncthreads();
    }
}

namespace gs { constexpr int KN_OFF = 0, KT_OFF = 17408, QN_OFF = 35840, VT_OFF = 53248, TT_OFF = 71680, QK_OFF = 80896, GC_OFF = 90112, BT_OFF = 90368, OT_OFF = 90624; }
__device__ __forceinline__ bf16x8 frag2(const char* base, int off) { return *(const bf16x8*)(base + off); }
__device__ __forceinline__ void gdn_scan_item(const Args& a, int layer, int b, int h, char* smem) {
    using namespace gs;
    unsigned char* ws = a.ws; { size_t z_ = 0; asm volatile("" : "+s"(z_)); ws += z_; }
    int tid_ = threadIdx.x; asm volatile("" : "+v"(tid_));
    const int tid = tid_, lane = tid & 63, wid = __builtin_amdgcn_readfirstlane(tid >> 6), r = lane & 15, g = lane >> 4, e0 = 16 * wid;
    const bf16_t* qkv = (const bf16_t*)(ws + OFF_QKV); const bf16_t* mchunk = (const bf16_t*)(ws + M_CHUNK);
    const bf16_t* TQ = (const bf16_t*)(ws + OFF_TQ); const bf16_t* mTQ = (const bf16_t*)(ws + M_TQ);
    const float* ng = a.in[I_A_OUT_NORM] + layer * 128;
    const float ng1 = ng[lane], ng2 = ng[lane + 64];
    f32x4 S[8];
#pragma unroll
    for (int i = 0; i < 8; ++i) S[i] = (f32x4){0.f, 0.f, 0.f, 0.f};
    u32x4 pk[2], pq[2], pv[2], pt, pqk; float psc = 0.f;
#define GS_LOAD(n) do { const int n_ = (n); \
        const bf16_t* qb_ = n_ == 0 ? mchunk : qkv + (size_t)(b * 2048 + 64 * (n_ - 1)) * 1536; \
        const bf16_t* tq_ = n_ == 0 ? mTQ + h * 8192 : TQ + (size_t)((b * 32 + n_ - 1) * 4 + h) * 8192; \
        const float* gc_ = n_ == 0 ? (const float*)(ws + M_GC) : (const float*)(ws + OFF_GC) + (size_t)(b * 2048 + 64 * (n_ - 1)) * 4; \
        const float* bt_ = n_ == 0 ? (const float*)(ws + M_BETA) : (const float*)(ws + OFF_BETA) + (size_t)(b * 2048 + 64 * (n_ - 1)) * 4; \
        _Pragma("unroll") for (int i_ = 0; i_ < 2; ++i_) { const int p_ = tid + 512 * i_, cr_ = p_ >> 4, d0_ = (p_ & 15) * 8; const bf16_t* rp_ = qb_ + (size_t)cr_ * 1536 + h * 128 + d0_; \
            pq[i_] = *(const u32x4*)rp_; pk[i_] = *(const u32x4*)(rp_ + 512); pv[i_] = *(const u32x4*)(rp_ + 1024); } \
        pt = *(const u32x4*)(tq_ + (tid >> 3) * 64 + (tid & 7) * 8); pqk = *(const u32x4*)(tq_ + 4096 + (tid >> 3) * 64 + (tid & 7) * 8); \
        if (tid < 64) psc = gc_[tid * 4 + h]; else if (tid < 128) psc = bt_[(tid - 64) * 4 + h]; } while (0)
    GS_LOAD(0);
    for (int n = 0; n < 33; ++n) {
#pragma unroll
        for (int i = 0; i < 2; ++i) { const int p = tid + 512 * i, cr = p >> 4, d0 = (p & 15) * 8;
            { const int u = (d0 >> 3) & 3, pa = (d0 & ~31) + 16 * (u & 1) + 4 * (u >> 1);
              *(u32x2*)(smem + KN_OFF + cr * 272 + pa * 2) = (u32x2){pk[i].x, pk[i].y}; *(u32x2*)(smem + KN_OFF + cr * 272 + (pa + 8) * 2) = (u32x2){pk[i].z, pk[i].w};
              *(u32x2*)(smem + QN_OFF + cr * 272 + pa * 2) = (u32x2){pq[i].x, pq[i].y}; *(u32x2*)(smem + QN_OFF + cr * 272 + (pa + 8) * 2) = (u32x2){pq[i].z, pq[i].w}; }
            const int cp = (cr & ~31) + 8 * ((cr >> 2) & 3) + 4 * ((cr >> 4) & 1) + (cr & 3);
            bf16_t* kt = (bf16_t*)(smem + KT_OFF) + d0 * 72 + cp; bf16_t* vt = (bf16_t*)(smem + VT_OFF) + d0 * 72 + cp;
            const unsigned kw[4] = {pk[i].x, pk[i].y, pk[i].z, pk[i].w}, vw[4] = {pv[i].x, pv[i].y, pv[i].z, pv[i].w};
#pragma unroll
            for (int jj = 0; jj < 4; ++jj) { kt[(2 * jj) * 72] = (bf16_t)(kw[jj] & 0xffffu); kt[(2 * jj + 1) * 72] = (bf16_t)(kw[jj] >> 16);
                vt[(2 * jj) * 72] = (bf16_t)(vw[jj] & 0xffffu); vt[(2 * jj + 1) * 72] = (bf16_t)(vw[jj] >> 16); } }
        { const int c0 = (tid & 7) * 8, u = (c0 >> 3) & 3, pa = (c0 & ~31) + 16 * (u & 1) + 4 * (u >> 1), ro = (tid >> 3) * 144;
          *(u32x2*)(smem + TT_OFF + ro + pa * 2) = (u32x2){pt.x, pt.y}; *(u32x2*)(smem + TT_OFF + ro + (pa + 8) * 2) = (u32x2){pt.z, pt.w};
          *(u32x2*)(smem + QK_OFF + ro + pa * 2) = (u32x2){pqk.x, pqk.y}; *(u32x2*)(smem + QK_OFF + ro + (pa + 8) * 2) = (u32x2){pqk.z, pqk.w}; }
        if (tid < 64) ((float*)(smem + GC_OFF))[tid] = psc; else if (tid < 128) ((float*)(smem + BT_OFF))[tid - 64] = psc;
        __syncthreads();
        if (n < 32) GS_LOAD(n + 1);
        bf16_t zz1[8], zz2[8];
#pragma unroll
        for (int i = 0; i < 8; ++i) { const int c = 8 * wid + i; const bf16_t* zp;
            if (n == 0) zp = (const bf16_t*)(ws + M_Z) + (c >= 48 ? c - 48 : 0) * 512 + h * 128;
            else zp = (const bf16_t*)(ws + OFF_Z) + ((size_t)b * 2048 + 64 * (n - 1) + c) * 512 + h * 128;
            zz1[i] = zp[lane]; zz2[i] = zp[lane + 64]; }
        const float* GC = (const float*)(smem + GC_OFF); const float* BT = (const float*)(smem + BT_OFF);
        bf16x8 Sb[4];
#pragma unroll
        for (int s = 0; s < 4; ++s) Sb[s] = as_bf8(pack8(S[2 * s], S[2 * s + 1]));
        f32x4 X[4], P[4];
#pragma unroll
        for (int mt = 0; mt < 4; ++mt) { X[mt] = (f32x4){0.f, 0.f, 0.f, 0.f}; P[mt] = (f32x4){0.f, 0.f, 0.f, 0.f};
#pragma unroll
            for (int s = 0; s < 4; ++s) { const int off = (16 * mt + r) * 272 + (32 * s + 8 * g) * 2;
                X[mt] = mfma16(frag2(smem + KN_OFF, off), Sb[s], X[mt]); P[mt] = mfma16(frag2(smem + QN_OFF, off), Sb[s], P[mt]); } }
        f32x4 Rr[4], eg[4], gcv[4];
#pragma unroll
        for (int mt = 0; mt < 4; ++mt) { const int c0 = 16 * mt + 4 * g; gcv[mt] = *(const f32x4*)(GC + c0); const f32x4 bt4 = *(const f32x4*)(BT + c0);
            const u32x2 vt = *(const u32x2*)(smem + VT_OFF + (e0 + r) * 144 + (32 * (mt >> 1) + 8 * g + 4 * (mt & 1)) * 2);
            const float vv[4] = {bflo(vt.x), bfhi(vt.x), bflo(vt.y), bfhi(vt.y)};
#pragma unroll
            for (int rr = 0; rr < 4; ++rr) { eg[mt][rr] = __expf(gcv[mt][rr]); Rr[mt][rr] = bt4[rr] * (vv[rr] - eg[mt][rr] * X[mt][rr]); } }
        bf16x8 Rb[2] = {as_bf8(pack8(Rr[0], Rr[1])), as_bf8(pack8(Rr[2], Rr[3]))};
        f32x4 Vn[4];
#pragma unroll
        for (int mt = 0; mt < 4; ++mt) { Vn[mt] = (f32x4){0.f, 0.f, 0.f, 0.f};
#pragma unroll
            for (int s = 0; s < 2; ++s) Vn[mt] = mfma16(frag2(smem + TT_OFF, (16 * mt + r) * 144 + (32 * s + 8 * g) * 2), Rb[s], Vn[mt]); }
        bf16x8 Vnb[2] = {as_bf8(pack8(Vn[0], Vn[1])), as_bf8(pack8(Vn[2], Vn[3]))};
        const float glast = GC[63];
        f32x4 O[4], Vp[4];
#pragma unroll
        for (int mt = 0; mt < 4; ++mt) {
#pragma unroll
            for (int rr = 0; rr < 4; ++rr) { O[mt][rr] = P[mt][rr] * eg[mt][rr]; Vp[mt][rr] = Vn[mt][rr] * __expf(glast - gcv[mt][rr]); }
#pragma unroll
            for (int s = 0; s < 2; ++s) O[mt] = mfma16(frag2(smem + QK_OFF, (16 * mt + r) * 144 + (32 * s + 8 * g) * 2), Vnb[s], O[mt]); }
        bf16x8 Vpb[2] = {as_bf8(pack8(Vp[0], Vp[1])), as_bf8(pack8(Vp[2], Vp[3]))};
        const float egl = __expf(glast);
#pragma unroll
        for (int dt = 0; dt < 8; ++dt) { S[dt] = S[dt] * egl;
#pragma unroll
            for (int s = 0; s < 2; ++s) S[dt] = mfma16(frag2(smem + KT_OFF, (16 * dt + r) * 144 + (32 * s + 8 * g) * 2), Vpb[s], S[dt]); }
        float* OT = (float*)(smem + OT_OFF);
#pragma unroll
        for (int mt = 0; mt < 4; ++mt)
#pragma unroll
            for (int rr = 0; rr < 4; ++rr) OT[(16 * mt + 4 * g + rr) * 132 + e0 + r] = O[mt][rr];
        __syncthreads();
#pragma unroll
        for (int i = 0; i < 8; ++i) { const int c = 8 * wid + i;
            const float o1 = OT[c * 132 + lane], o2 = OT[c * 132 + lane + 64];
            const float ss = wave_sum(o1 * o1 + o2 * o2), rstd = rsqrtf(ss * (1.f / 128.f) + EPSF);
            bf16_t* op; bool wrt;
            if (n == 0) { wrt = (b == 0 && c >= 48); op = (bf16_t*)(ws + M_OAB) + (c - 48) * 1024 + h * 128; }
            else { const size_t row = (size_t)b * 2048 + 64 * (n - 1) + c; op = (bf16_t*)(ws + OFF_OAB) + row * 1024 + h * 128; wrt = true; }
            if (wrt) { op[lane] = f2bf(o1 * rstd * ng1 * silu_f(bf2f(zz1[i]))); op[lane + 64] = f2bf(o2 * rstd * ng2 * silu_f(bf2f(zz2[i]))); } }
    }
#undef GS_LOAD
    __syncthreads();
}

#ifndef DSASEL
#define DSASEL 3
#endif
#ifndef DSA_REP
#define DSA_REP 0
#endif
namespace da {
constexpr int SC_PITCH = 2112, SC_OFF = 0, MASK_OFF = 16 * SC_PITCH * 4, IWL_OFF = MASK_OFF + 64 * 34 * 8, END_OFF = IWL_OFF + 64 * 8 * 4;
constexpr int KSEL = 272;
static_assert(END_OFF + 8 * 128 * 4 <= LDS_XB - 16, "dsa lds");
constexpr float SCALE = 0.088388347648318440f, THR = 8.f;
constexpr int SHM_V = 64 * 128 * 2, SHM_K = 64 * 128 * 2;
#define KSWZ(row, colB) ((row) * 256 + ((colB) ^ (((row) & 7) << 4)))
#define SBAR() __builtin_amdgcn_sched_barrier(0)
__device__ __forceinline__ int crow(int r, int hi) { return (r & 3) + 8 * (r >> 2) + 4 * hi; }
__device__ __forceinline__ void partialSM(f32x16& p0, f32x16& p1, float& m_reg, float& mn, float& alpha) {
  constexpr float C = SCALE * 1.4426950408889634f;
  float pmax = p0[0]; for (int r = 1; r < 16; ++r) pmax = fmaxf(pmax, p0[r]); for (int r = 0; r < 16; ++r) pmax = fmaxf(pmax, p1[r]);
  { auto rr = __builtin_amdgcn_permlane32_swap(__float_as_uint(pmax), __float_as_uint(pmax), false, false);
    pmax = fmaxf(__uint_as_float(rr[0]), __uint_as_float(rr[1])); }
  if (__builtin_expect(__all(pmax - m_reg <= THR / SCALE), 1)) { mn = m_reg; alpha = 1.f; }
  else { mn = fmaxf(m_reg, pmax); alpha = __builtin_amdgcn_exp2f((m_reg - mn) * C); m_reg = mn; }
  float mnC = -mn * C;
  for (int r = 0; r < 16; ++r) p0[r] = fmaf(p0[r], C, mnC); for (int r = 0; r < 16; ++r) p1[r] = fmaf(p1[r], C, mnC);
  for (int r = 0; r < 16; ++r) p0[r] = __builtin_amdgcn_exp2f(p0[r]);
}
__device__ __forceinline__ void finishSM(f32x16& p0, f32x16& p1, float alpha, float& l_reg, bf16x8& pa0, bf16x8& pa1, bf16x8& pa2, bf16x8& pa3) {
  for (int r = 0; r < 16; ++r) p1[r] = __builtin_amdgcn_exp2f(p1[r]);
  float ps = 0; for (int r = 0; r < 16; ++r) ps += p0[r]; for (int r = 0; r < 16; ++r) ps += p1[r];
  { auto rr = __builtin_amdgcn_permlane32_swap(__float_as_uint(ps), __float_as_uint(ps), false, false);
    ps = __uint_as_float(rr[0]) + __uint_as_float(rr[1]); }
  l_reg = l_reg * alpha + ps;
#define PK4(P, BASE, OUT) do { unsigned a0 = cvt_pk(P[BASE + 0], P[BASE + 1]), a1 = cvt_pk(P[BASE + 2], P[BASE + 3]);   \
    unsigned b0 = cvt_pk(P[BASE + 4], P[BASE + 5]), b1 = cvt_pk(P[BASE + 6], P[BASE + 7]);                              \
    auto r0 = __builtin_amdgcn_permlane32_swap(a0, b0, false, false); auto r1 = __builtin_amdgcn_permlane32_swap(a1, b1, false, false); \
    u32x4 w = {r0[0], r1[0], r0[1], r1[1]}; OUT = as_bf8(w); } while (0)
  PK4(p0, 0, pa0); PK4(p0, 8, pa1); PK4(p1, 0, pa2); PK4(p1, 8, pa3);
#undef PK4
}
__device__ __forceinline__ void qkt(f32x16& p0, f32x16& p1, const char* Ks, const bf16x8* qr, int r32, int hi) {
  p0 = f32x16{}; p1 = f32x16{};
  for (int d0 = 0; d0 < 8; ++d0) { int cb = (d0 * 16 + hi * 8) * 2;
    bf16x8 b0 = *reinterpret_cast<const bf16x8*>(Ks + KSWZ(r32, cb));
    bf16x8 b1 = *reinterpret_cast<const bf16x8*>(Ks + KSWZ(32 + r32, cb));
    p0 = __builtin_amdgcn_mfma_f32_32x32x16_bf16(b0, qr[d0], p0, 0, 0, 0);
    p1 = __builtin_amdgcn_mfma_f32_32x32x16_bf16(b1, qr[d0], p1, 0, 0, 0); }
}
__device__ __forceinline__ void maskp(f32x16& p0, f32x16& p1, const char* mrow, int tile, int hi) {
  const u32x2 mw = *(const u32x2*)(mrow + tile * 8); const unsigned w0 = mw.x >> (4 * hi), w1 = mw.y >> (4 * hi);
#pragma unroll
  for (int r = 0; r < 16; ++r) { const int bit = (r & 3) + 8 * (r >> 2);
    p0[r] = ((w0 >> bit) & 1u) ? p0[r] : -1e30f; p1[r] = ((w1 >> bit) & 1u) ? p1[r] : -1e30f; }
}
__device__ __forceinline__ int v_st(int k, int c) { const int kk = (k & ~0xC) | ((k & 4) << 1) | ((k & 8) >> 1); return ((kk >> 3) * 4 + (c >> 5)) * 512 + ((kk & 7) * 32 + (c & 31)) * 2; }
__device__ __forceinline__ int v_rd_base(int lane) { return ((lane & 3) << 3) | (((lane >> 2) & 3) << 6) | (((lane >> 4) & 1) << 5) | (((lane >> 5) & 1) << 8); }
constexpr int v_rd_off(int d0, int ks, int half) { return d0 * 512 + ks * 4096 + half * 2048; }
template <int OFF> __device__ __forceinline__ s16x4 tr_read(int vb) {
  s16x4 r; asm volatile("ds_read_b64_tr_b16 %0, %1 offset:%2" : "=&v"(r) : "v"(vb), "i"(OFF) : "memory"); return r;
}
template <int D0> __device__ __forceinline__ void pv_one(f32x16& od, int vb, bf16x8 pa0, bf16x8 pa1, bf16x8 pa2, bf16x8 pa3) {
  const s16x4 l0 = tr_read<v_rd_off(D0, 0, 0)>(vb), h0 = tr_read<v_rd_off(D0, 0, 1)>(vb), l1 = tr_read<v_rd_off(D0, 1, 0)>(vb), h1 = tr_read<v_rd_off(D0, 1, 1)>(vb);
  const s16x4 l2 = tr_read<v_rd_off(D0, 2, 0)>(vb), h2 = tr_read<v_rd_off(D0, 2, 1)>(vb), l3 = tr_read<v_rd_off(D0, 3, 0)>(vb), h3 = tr_read<v_rd_off(D0, 3, 1)>(vb);
  asm volatile("s_waitcnt lgkmcnt(0)" ::: "memory"); SBAR();
#define PK(L, H) (bf16x8){L[0], L[1], L[2], L[3], H[0], H[1], H[2], H[3]}
  od = __builtin_amdgcn_mfma_f32_32x32x16_bf16(pa0, PK(l0, h0), od, 0, 0, 0);
  od = __builtin_amdgcn_mfma_f32_32x32x16_bf16(pa1, PK(l1, h1), od, 0, 0, 0);
  od = __builtin_amdgcn_mfma_f32_32x32x16_bf16(pa2, PK(l2, h2), od, 0, 0, 0);
  od = __builtin_amdgcn_mfma_f32_32x32x16_bf16(pa3, PK(l3, h3), od, 0, 0, 0);
#undef PK
}
__device__ __forceinline__ void pv_d0(f32x16* o, int vb, bf16x8 pa0, bf16x8 pa1, bf16x8 pa2, bf16x8 pa3) {
  pv_one<0>(o[0], vb, pa0, pa1, pa2, pa3); pv_one<1>(o[1], vb, pa0, pa1, pa2, pa3); pv_one<2>(o[2], vb, pa0, pa1, pa2, pa3); pv_one<3>(o[3], vb, pa0, pa1, pa2, pa3);
}
__device__ __forceinline__ void attn_body(const bf16_t* Qb, const bf16_t* Kh, const bf16_t* Vh, bf16_t* Ob, int NT, const char* maskbase, char* lds) {
  int tid_ = threadIdx.x; asm volatile("" : "+v"(tid_));
  const int tid = tid_, wid = tid >> 6, lane = tid & 63, r32 = lane & 31, hi = lane >> 5;
  char* V_lds = lds; char* K_lds = lds + 2 * SHM_V;
  float* wsf = (float*)(lds + 2 * SHM_V + 2 * SHM_K) + wid * 64; float* li_l = wsf; float* al_l = wsf + 32;
  float m_reg = -1e30f, l_reg = 0; f32x16 o[4] = {}; bf16x8 qr[8];
  const int head = wid >> 1, qloc0 = (wid & 1) * 32;
  const char* mrow = maskbase + (qloc0 + r32) * (34 * 8);
  const bf16_t* Qw = Qb + (size_t)(qloc0 + r32) * 512 + head * 128 + hi * 8;
#pragma unroll
  for (int d0 = 0; d0 < 8; ++d0) qr[d0] = *(const bf16x8*)(Qw + d0 * 16);
  const int sr = tid >> 4, sc = (tid & 15) * 8;
  const int vb0 = (int)(uintptr_t)V_lds + v_rd_base(lane);
  struct { bf16x8 vs0, vs1, ks0, ks1; } sr_[2];
#define SLOAD(i, k0) do { sr_[i].vs0 = *(const bf16x8*)(&Vh[(long)((k0) + sr) * 128 + sc]); sr_[i].vs1 = *(const bf16x8*)(&Vh[(long)((k0) + 32 + sr) * 128 + sc]); \
    sr_[i].ks0 = *(const bf16x8*)(&Kh[(long)((k0) + sr) * 128 + sc]); sr_[i].ks1 = *(const bf16x8*)(&Kh[(long)((k0) + 32 + sr) * 128 + sc]); } while (0)
#define SWRITE(b, i) do { int t_ = tid; asm volatile("" : "+v"(t_)); const int sr_w = t_ >> 4, sc_w = (t_ & 15) * 8;     \
    *(bf16x8*)(V_lds + (b) * SHM_V + v_st(sr_w, sc_w)) = sr_[i].vs0;          \
    *(bf16x8*)(V_lds + (b) * SHM_V + v_st(32 + sr_w, sc_w)) = sr_[i].vs1; int kc = sc_w * 2;               \
    *(bf16x8*)(K_lds + (b) * SHM_K + KSWZ(sr_w, kc)) = sr_[i].ks0;                       \
    *(bf16x8*)(K_lds + (b) * SHM_K + KSWZ(32 + sr_w, kc)) = sr_[i].ks1; } while (0)
#define SWAIT() asm volatile("s_waitcnt vmcnt(4)" ::: "memory")
#define RESC(a) do { if (__any((a) < 1.f)) { if (hi == 0) al_l[r32] = (a); asm volatile("s_waitcnt lgkmcnt(0)" ::: "memory"); \
    for (int d = 0; d < 4; ++d) for (int r = 0; r < 16; ++r) o[d][r] *= al_l[crow(r, hi)]; } } while (0)
  f32x16 pA0, pA1, pB0, pB1; float mnA, mnB, alA, alB; bf16x8 pa0, pa1, pa2, pa3;
  constexpr int SE = 0, SO = 1;
  SLOAD(SE, 0); asm volatile("s_waitcnt vmcnt(0)" ::: "memory"); SWRITE(0, SE); __syncthreads();
  qkt(pA0, pA1, K_lds, qr, r32, hi); maskp(pA0, pA1, mrow, 0, hi); partialSM(pA0, pA1, m_reg, mnA, alA);
  SLOAD(SO, 64); if (2 < NT) SLOAD(SE, 2 * 64);
  SWAIT(); SWRITE(1, SO); __syncthreads();
  for (int j = 1; j + 1 < NT; j += 2) {
    SBAR(); qkt(pB0, pB1, K_lds + SHM_K, qr, r32, hi); maskp(pB0, pB1, mrow, j, hi);
    finishSM(pA0, pA1, alA, l_reg, pa0, pa1, pa2, pa3); SBAR();
    SLOAD(SO, (j + 2) * 64); SBAR();
    pv_d0(o, vb0, pa0, pa1, pa2, pa3); partialSM(pB0, pB1, m_reg, mnB, alB);
    __syncthreads(); SWAIT(); SWRITE(0, SE);
    RESC(alB); __syncthreads();
    SBAR(); qkt(pA0, pA1, K_lds, qr, r32, hi); maskp(pA0, pA1, mrow, j + 1, hi);
    finishSM(pB0, pB1, alB, l_reg, pa0, pa1, pa2, pa3); SBAR();
    if (j + 3 < NT) SLOAD(SE, (j + 3) * 64); SBAR();
    pv_d0(o, vb0 + SHM_V, pa0, pa1, pa2, pa3); partialSM(pA0, pA1, m_reg, mnA, alA);
    __syncthreads(); SWAIT(); SWRITE(1, SO);
    RESC(alA); __syncthreads();
  }
  SBAR(); qkt(pB0, pB1, K_lds + SHM_K, qr, r32, hi); maskp(pB0, pB1, mrow, NT - 1, hi);
  finishSM(pA0, pA1, alA, l_reg, pa0, pa1, pa2, pa3); SBAR();
  pv_d0(o, vb0, pa0, pa1, pa2, pa3); partialSM(pB0, pB1, m_reg, mnB, alB);
  __syncthreads(); RESC(alB);
  finishSM(pB0, pB1, alB, l_reg, pa0, pa1, pa2, pa3); SBAR();
  pv_d0(o, vb0 + SHM_V, pa0, pa1, pa2, pa3);
  if (hi == 0) li_l[r32] = l_reg; asm volatile("s_waitcnt lgkmcnt(0)" ::: "memory");
  float rli[16];
#pragma unroll
  for (int r = 0; r < 16; ++r) rli[r] = __builtin_amdgcn_rcpf(li_l[crow(r, hi)]);
#pragma unroll
  for (int r = 0; r < 16; ++r) { bf16_t* orow = Ob + (size_t)(qloc0 + crow(r, hi)) * 1024 + head * 128 + r32;
#pragma unroll
    for (int d0 = 0; d0 < 4; ++d0) orow[d0 * 32] = f2bf(o[d0][r] * rli[r]); }
  asm volatile("s_waitcnt vmcnt(0)" ::: "memory");
#undef SLOAD
#undef SWRITE
#undef SWAIT
#undef RESC
}
__device__ __forceinline__ int wave_total(int x) {
    x += __builtin_amdgcn_update_dpp(0, x, 0x128, 0xf, 0xf, false);
    x += __builtin_amdgcn_update_dpp(0, x, 0x124, 0xf, 0xf, false);
    x += __builtin_amdgcn_update_dpp(0, x, 0x122, 0xf, 0xf, false);
    x += __builtin_amdgcn_update_dpp(0, x, 0x121, 0xf, 0xf, false);
    return __builtin_amdgcn_readlane(x, 0) + __builtin_amdgcn_readlane(x, 16) + __builtin_amdgcn_readlane(x, 32) + __builtin_amdgcn_readlane(x, 48);
}
__device__ __forceinline__ unsigned ordkey(float x) { const unsigned b = __float_as_uint(x); return (b & 0x80000000u) ? ~b : (b | 0x80000000u); }
typedef unsigned short us2_t __attribute__((ext_vector_type(2)));
template <int NTW> __device__ __forceinline__ void select2_t(const float* scA, const float* scB, unsigned long long* mrowA, unsigned long long* mrowB, int NT, int NTe, int lane, unsigned* cand) {
    constexpr int NP2 = (NTW + 1) / 2;
    unsigned ua[NTW], ub[NTW];
#pragma unroll
    for (int i = 0; i < NTW; ++i) { ua[i] = (i < NT) ? ordkey(scA[64 * i + lane]) : 0u; ub[i] = (i < NT) ? ordkey(scB[64 * i + lane]) : 0u; }
    unsigned pa[NP2], pb[NP2];
#pragma unroll
    for (int p = 0; p < NP2; ++p) { const unsigned a0 = ua[2 * p] >> 17, a1 = (2 * p + 1 < NTW) ? (ua[2 * p + 1 < NTW ? 2 * p + 1 : 0] >> 17) : 0u, b0 = ub[2 * p] >> 17, b1 = (2 * p + 1 < NTW) ? (ub[2 * p + 1 < NTW ? 2 * p + 1 : 0] >> 17) : 0u;
        pa[p] = (a0 | 0x8000u) | ((a1 | 0x8000u) << 16); pb[p] = (b0 | 0x8000u) | ((b1 | 0x8000u) << 16); }
    unsigned ta = 0u, tb = 0u; int gea = 64 * NTW, geb = 64 * NTW;
#pragma unroll 1
    for (int bit = 14; bit >= 0; --bit) { const unsigned ca = ta | (1u << bit), cb = tb | (1u << bit); const unsigned ca2 = ca | (ca << 16), cb2 = cb | (cb << 16);
        unsigned sa = 0u, sb = 0u; int na = 0, nb = 0;
#pragma unroll
        for (int p = 0; p < NP2; ++p) {
            const unsigned da = __builtin_bit_cast(unsigned, __builtin_bit_cast(us2_t, pa[p]) - __builtin_bit_cast(us2_t, ca2)), db = __builtin_bit_cast(unsigned, __builtin_bit_cast(us2_t, pb[p]) - __builtin_bit_cast(us2_t, cb2));
            sa = (sa >> 1) | (da & 0x80008000u); sb = (sb >> 1) | (db & 0x80008000u);
            if ((p & 15) == 15) { na += __popc(sa); nb += __popc(sb); sa = 0u; sb = 0u; } }
        na = wave_total(na + __popc(sa)); nb = wave_total(nb + __popc(sb));
        if (na >= KSEL) { ta = ca; gea = na; } if (nb >= KSEL) { tb = cb; geb = nb; } }
#pragma unroll 1
    for (int q = 0; q < 2; ++q) {
        unsigned long long* mrow = q ? mrowB : mrowA; const unsigned t15 = q ? tb : ta;
        unsigned u[NTW];
#pragma unroll
        for (int i = 0; i < NTW; ++i) u[i] = q ? ub[i] : ua[i];
        int ncand = 0;
#pragma unroll
        for (int i = 0; i < NTW; ++i) { const unsigned long long mc = __ballot((u[i] >> 17) == t15);
            if (mc) { const int idx = ncand + (int)__builtin_amdgcn_mbcnt_hi((unsigned)(mc >> 32), __builtin_amdgcn_mbcnt_lo((unsigned)mc, 0u));
                if (((u[i] >> 17) == t15) && idx < 128) cand[idx] = (u[i] & 0x1FFFFu) + 1u; }
            ncand += __popcll(mc); }
        const int ngt = (q ? geb : gea) - ncand;
        const int kk = KSEL - ngt;
        unsigned t;
#ifndef CAND_CAP
#define CAND_CAP 128
#endif
        if (ncand <= CAND_CAP) {
            asm volatile("s_waitcnt lgkmcnt(0)" ::: "memory");
            const unsigned c0 = lane < ncand ? cand[lane] : 0u, c1 = lane + 64 < ncand ? cand[lane + 64] : 0u;
            unsigned tl = 0u;
            for (int bit = 17; bit >= 0; --bit) { const unsigned cc = tl | (1u << bit); const int n = __popcll(__ballot(c0 >= cc)) + __popcll(__ballot(c1 >= cc)); if (n >= kk) tl = cc; }
            t = (t15 << 17) | (tl - 1u);
        } else {
            int tt = (int)(t15 << 16);
            for (int bit = 15; bit >= 0; --bit) { const int cc = tt | (1 << bit); int n = 0;
#pragma unroll
                for (int i = 0; i < NTW; ++i) n += __popcll(__ballot((int)(u[i] >> 1) >= cc));
                if (n >= KSEL) tt = cc; }
            t = ((unsigned)tt << 1) | 1u; int n1 = 0;
#pragma unroll
            for (int i = 0; i < NTW; ++i) n1 += __popcll(__ballot(u[i] >= t));
            if (n1 < KSEL) t -= 1u;
        }
        int tot = 0;
#pragma unroll
        for (int i = 0; i < NTW; ++i) { const unsigned long long w = __ballot(u[i] >= t); tot += __popcll(w); if (i < NT && lane == 0) mrow[i] = w; }
        if (tot > KSEL) {
            int need = KSEL;
#pragma unroll
            for (int i = 0; i < NTW; ++i) need -= __popcll(__ballot(u[i] > t));
#pragma unroll
            for (int i = 0; i < NTW; ++i) {
                unsigned long long w = __ballot(u[i] > t); unsigned long long e = __ballot(u[i] == t);
                if (need > 0 && e) { const int pe = __popcll(e); if (pe <= need) { w |= e; need -= pe; } else { while (need > 0) { const unsigned long long low = e & (~e + 1ull); w |= low; e ^= low; --need; } } }
                if (i < NT && lane == 0) mrow[i] = w; } }
        if (NTe > NT && lane == 0) mrow[NT] = 0ull;
    }
}
__device__ __forceinline__ void select2(const float* scA, const float* scB, unsigned long long* mrowA, unsigned long long* mrowB, int NT, int NTe, int NP, int lane, unsigned* cand) {
    if (NP <= KSEL) {
        for (int i = 0; i < NTe; ++i) { const int lo = 64 * i; const unsigned long long w = (lo + 64 <= NP) ? ~0ull : (lo >= NP ? 0ull : ((1ull << (NP - lo)) - 1ull)); if (lane == 0) { mrowA[i] = w; mrowB[i] = w; } }
        return;
    }
    if (NT <= 9) select2_t<9>(scA, scB, mrowA, mrowB, NT, NTe, lane, cand);
    else if (NT <= 17) select2_t<17>(scA, scB, mrowA, mrowB, NT, NTe, lane, cand);
    else if (NT <= 25) select2_t<25>(scA, scB, mrowA, mrowB, NT, NTe, lane, cand);
    else select2_t<33>(scA, scB, mrowA, mrowB, NT, NTe, lane, cand);
}
__device__ __forceinline__ void dsa_item(const Args& a, int b, int j, char* smem, int dry = 0) {
    unsigned char* ws = a.ws; { size_t z_ = 0; asm volatile("" : "+s"(z_)); ws += z_; }
    int tid_ = threadIdx.x; asm volatile("" : "+v"(tid_));
    const int tid = tid_, lane = tid & 63, wid = __builtin_amdgcn_readfirstlane(tid >> 6), hi = lane >> 5;
    const int limit = 64 * (j + 1), NP = 16 + limit, NT = j + 2, NTe = (NT + 1) & ~1, row0 = b * 2048 + 64 * j;
    const bf16_t* iq = (const bf16_t*)(ws + OFF_IQ); const bf16_t* ikb = (const bf16_t*)(ws + OFF_IKB); const float* misc = (const float*)(ws + OFF_MISC);
    float* SC = (float*)(smem + SC_OFF); float* IWL = (float*)(smem + IWL_OFF); unsigned long long* MASK = (unsigned long long*)(smem + MASK_OFF);
    { const int q = tid >> 3, hh = tid & 7; IWL[tid] = misc[(size_t)(row0 + q) * 16 + 8 + hh] * 0.044194173824159216f; }
    bf16x8 af[4][4];
#define DSA_AF_LOAD(sb) do { const int rho = lane & 31, qq = 2 * ((rho >> 2) & 1) + (rho >> 4), hh = 4 * ((rho >> 3) & 1) + (rho & 3); \
        _Pragma("unroll") for (int mt = 0; mt < 4; ++mt) _Pragma("unroll") for (int ks = 0; ks < 4; ++ks) \
            af[mt][ks] = *(const bf16x8*)(iq + (size_t)(row0 + (sb) * 16 + 4 * mt + qq) * 512 + hh * 64 + 16 * ks + 8 * hi); } while (0)
    DSA_AF_LOAD(0);
    if ((DSASEL & 1) && !(dry & 1)) for (int sub = 0; sub < 4; ++sub) {
        for (int p = tid; p < 16 * 16; p += 512) SC[(p >> 4) * SC_PITCH + (p & 15)] = __builtin_inff();
        for (int p = tid; p < 16 * 48; p += 512) { const int q = p / 48, x = p - q * 48; SC[q * SC_PITCH + NP + x] = -__builtin_inff(); }
        __syncthreads();
        for (int rep_i = 0; rep_i < 1 + (DSA_REP & 1); ++rep_i) {
        const bf16_t* ikp = ikb + ((size_t)b * TP + 16 + (lane & 31)) * 64 + 8 * hi;
        bf16x8 bnx[4];
        { const int kt0 = wid < 2 * (j + 1) ? wid : 0;
#pragma unroll
          for (int ks = 0; ks < 4; ++ks) bnx[ks] = *(const bf16x8*)(ikp + (size_t)(32 * kt0) * 64 + 16 * ks); }
        for (int kt = wid; kt < 2 * (j + 1); kt += 8) {
            bf16x8 bfr[4];
#pragma unroll
            for (int ks = 0; ks < 4; ++ks) bfr[ks] = bnx[ks];
            { const int ktn = (kt + 8 < 2 * (j + 1)) ? kt + 8 : kt;
#pragma unroll
              for (int ks = 0; ks < 4; ++ks) bnx[ks] = *(const bf16x8*)(ikp + (size_t)(32 * ktn) * 64 + 16 * ks); }
#pragma unroll
            for (int mt = 0; mt < 4; ++mt) {
                f32x16 acc = {};
#pragma unroll
                for (int ks = 0; ks < 4; ++ks) acc = __builtin_amdgcn_mfma_f32_32x32x16_bf16(af[mt][ks], bfr[ks], acc, 0, 0, 0);
                const float* iw0 = IWL + (sub * 16 + 4 * mt + 2 * hi) * 8;
                float s0 = 0.f, s1 = 0.f;
#pragma unroll
                for (int rg = 0; rg < 8; ++rg) { s0 += fmaxf(acc[rg], 0.f) * iw0[rg]; s1 += fmaxf(acc[8 + rg], 0.f) * iw0[8 + rg]; }
                if (s0 == 0.f) s0 = 0.f; if (s1 == 0.f) s1 = 0.f;
                float* sp = SC + (4 * mt + 2 * hi) * SC_PITCH + 16 + 32 * kt + (lane & 31);
                sp[0] = s0; sp[SC_PITCH] = s1;
            }
        }
        }
        if (sub < 3) DSA_AF_LOAD(sub + 1);
        __syncthreads();
#pragma unroll 1
        for (int rep_s = 0; rep_s < 1 + ((DSA_REP >> 1) & 1); ++rep_s)
        { const int ql = 2 * wid; select2(SC + ql * SC_PITCH, SC + (ql + 1) * SC_PITCH, MASK + (sub * 16 + ql) * 34, MASK + (sub * 16 + ql + 1) * 34, NT, NTe, NP, lane, (unsigned*)(smem + END_OFF) + wid * 128); }
        __syncthreads();
    }
#pragma unroll 1
    for (int rep_a = 0; rep_a < 1 + ((DSA_REP >> 2) & 1); ++rep_a)
    if ((DSASEL & 2) && !(dry & 2)) attn_body((const bf16_t*)(ws + OFF_BQ) + (size_t)row0 * 512, (const bf16_t*)(ws + OFF_KB) + (size_t)b * TP * 128, (const bf16_t*)(ws + OFF_VB) + (size_t)b * TP * 128,
              (bf16_t*)(ws + OFF_OAB) + (size_t)row0 * 1024 + 512, NTe, smem + MASK_OFF, smem);
    __syncthreads();
}
__device__ __forceinline__ void dsa_meta_item(const Args& a) {
    unsigned char* ws = a.ws; { size_t z_ = 0; asm volatile("" : "+s"(z_)); ws += z_; }
    int tid_ = threadIdx.x; asm volatile("" : "+v"(tid_));
    if (tid_ >= 64) return;
    const int lane = tid_, q = lane >> 2, h = lane & 3;
    const bf16_t* qp = (const bf16_t*)(ws + M_BQ) + q * 512 + h * 128; const bf16_t* kb = (const bf16_t*)(ws + OFF_KB); const bf16_t* vb = (const bf16_t*)(ws + OFF_VB);
    float s[16]; float mx = -1e30f;
#pragma unroll
    for (int k = 0; k < 16; ++k) { float acc = 0.f; for (int d = 0; d < 128; ++d) acc += bf2f(qp[d]) * bf2f(kb[k * 128 + d]); s[k] = acc * SCALE; mx = fmaxf(mx, s[k]); }
    float l = 0.f;
#pragma unroll
    for (int k = 0; k < 16; ++k) { s[k] = __expf(s[k] - mx); l += s[k]; }
    const float rl = 1.f / l;
    bf16_t* op = (bf16_t*)(ws + M_OAB) + q * 1024 + 512 + h * 128;
    for (int d = 0; d < 128; ++d) { float acc = 0.f;
#pragma unroll
        for (int k = 0; k < 16; ++k) acc += s[k] * bf2f(vb[k * 128 + d]); op[d] = f2bf(acc * rl); }
}
}

__device__ __forceinline__ void p_mixers(const Args& a, int layer_rep, char* smem, int dry = 0) {
    const int layer = layer_rep & 1;
    unsigned* ctr = (unsigned*)(a.ws + OFF_CTL) + CW_QUEUE + 64 * layer_rep;
    int* slot = (int*)(smem + LDS_XB - 16);
    constexpr int NSCAN = NB * 4, NDSA = NB * 32, NITEM = NSCAN + NDSA + 1;
    for (;;) {
        __syncthreads();
        if (threadIdx.x == 0) *slot = (int)__hip_atomic_fetch_add(ctr, 1u, __ATOMIC_RELAXED, __HIP_MEMORY_SCOPE_AGENT);
        __syncthreads();
        const int it = *slot;
        if (it >= NITEM) break;
#ifndef MIXSEL
#define MIXSEL 7
#endif
        if (it == 0) { if ((MIXSEL & 4) && !dry) da::dsa_meta_item(a); }
        else if (it <= NSCAN) { const int si = it - 1; for (int rep_g = 0; rep_g < 1 + ((DSA_REP >> 3) & 1); ++rep_g) if ((MIXSEL & 1) && !(dry & 4)) gdn_scan_item(a, layer, si >> 2, si & 3, smem); }
        else { const int k = it - 1 - NSCAN, j = 31 - (k >> 5), b = k & 31; if (MIXSEL & 2) da::dsa_item(a, b, j, smem, dry); }
    }
}

__device__ __forceinline__ void p_halo(const Args& a, int layer) {
    unsigned char* ws = a.ws; { size_t z_ = 0; asm volatile("" : "+s"(z_)); ws += z_; }
    int tid_ = threadIdx.x; asm volatile("" : "+v"(tid_));
    const int lane = tid_ & 63, wid = tid_ >> 6, r = lane & 15, g = lane >> 4, gw = blockIdx.x * 8 + wid, nW = gridDim.x * 8;
    const bf16_t* hb = (const bf16_t*)(ws + OFF_HB); const bf16_t* WupT = (const bf16_t*)(ws + OFF_WUP) + (size_t)layer * NIN * DM;
    const u64_t* ssq = (const u64_t*)(ws + OFF_SSQ) + (size_t)(2 * layer + 1) * RR; float* hg = (float*)(ws + OFF_HG);
    for (int job = gw; job < 32 * 176; job += nW) {
        const int rt = job & 31, ct = job >> 5;
        const int rowA = ((r >> 1) == 0) ? 0 : 256 * (8 * rt + (r >> 1)) - 2 + (r & 1);
        const bf16_t* ap = hb + (size_t)rowA * DM + g * 8; const bf16_t* bp = WupT + (size_t)(256 * (ct >> 3) + 16 * (ct & 7) + r) * DM + g * 8;
        f32x4 acc = {0.f, 0.f, 0.f, 0.f};
#pragma unroll 8
        for (int k = 0; k < DM; k += 32) acc = mfma16(*(const bf16x8*)(ap + k), *(const bf16x8*)(bp + k), acc);
#pragma unroll
        for (int rr = 0; rr < 4; ++rr) { const int ri = 4 * g + rr;
            if ((ri >> 1) != 0) { const int pmD = 8 * rt + (ri >> 1), rowD = 256 * pmD - 2 + (ri & 1);
                hg[(size_t)(pmD * 2 + (ri & 1)) * DFF + 128 * (ct >> 3) + 16 * (ct & 7) + r] = acc[rr] * rstd_of(ssq, rowD); } }
    }
}
__device__ __forceinline__ void meta_act(const Args& a, int layer) {
    unsigned char* ws = a.ws; { size_t z_ = 0; asm volatile("" : "+s"(z_)); ws += z_; }
    int tid_ = threadIdx.x; asm volatile("" : "+v"(tid_));
    const float* cw = a.in[I_CONV_FFN] + (size_t)layer * 3 * DFF; const float* mgu = (const float*)(ws + M_GU); bf16_t* mact = (bf16_t*)(ws + M_ACT);
    for (int c = blockIdx.x * 512 + tid_; c < DFF; c += gridDim.x * 512) { const int gi = (c >> 7) * 256 + (c & 127); const float w0 = cw[c], w1 = cw[DFF + c], w2 = cw[2 * DFF + c]; float g0 = 0.f, g1 = 0.f;
        for (int t = 0; t < 16; ++t) { const float g2 = mgu[t * 5632 + gi], uu = mgu[t * 5632 + gi + 128]; mact[t * DFF + c] = f2bf(silu_f(w0 * g0 + w1 * g1 + w2 * g2) * uu); g0 = g1; g1 = g2; } }
}

constexpr int NPH = 1 + 8 * NLAYER;
#ifndef ONE_LAUNCH
#define ONE_LAUNCH 0
#endif
#ifndef STAGGER_US
#define STAGGER_US 0
#endif
__device__ __forceinline__ void stagger_delay(int us) {
    if (us > 0 && (blockIdx.x & 1)) { const unsigned long long t0 = __builtin_amdgcn_s_memrealtime(); while (__builtin_amdgcn_s_memrealtime() - t0 < (unsigned long long)us * 100ull) __builtin_amdgcn_s_sleep(8); }
}
__device__ __forceinline__ void meta_y_lds(const unsigned char* ws, char* img) {
    const float* P = (const float*)(ws + M_GU);
    for (int i = threadIdx.x; i < 16 * 1024; i += 512) { const int t = i >> 10, ch = i & 1023, n = 256 * (ch >> 7) + (ch & 127);
        *(bf16_t*)(img + t * MN_PITCH + ch * 2) = f2bf(P[t * 5632 + n] + P[t * 5632 + n + 128]); }
    __syncthreads();
}
template <int L> __device__ __forceinline__ void layer_phases(const Args& a, char* smem, const XcdBarrier& bar, const int lo, const int hi) {
    constexpr int l = L;
    unsigned char* ws0 = a.ws;
    PG8_LAS unsigned char* glds = (PG8_LAS unsigned char*)smem;
    const int G = gridDim.x, bx = blockIdx.x;
#define IN(k) (lo <= (k) && (k) < hi)
#define SEAM(k) do { if (IN(k) && IN((k) + 1)) xcd_barrier(bar); } while (0)
#define OPQ_WS() unsigned char* ws = ws0; { size_t z_ = 0; asm volatile("" : "+s"(z_)); ws += z_; }
#ifndef EN_MASK
#define EN_MASK 0xFFFF
#endif
#ifndef REP_MASK
#define REP_MASK 0
#endif
#define NREP(k) (1 + ((REP_MASK >> (k)) & 1))
    constexpr int pb = 1 + 8 * l;
    for (int rep = 0; rep < NREP(0); ++rep) if (IN(pb + 0)) { OPQ_WS();
        const bf16_t* WinT = (const bf16_t*)(ws + OFF_WIN) + (size_t)l * NIN * DM;
        meta_norm_lds((const float*)(ws + M_H), smem);
        small_gemm16<true>(smem, WinT, NIN, DM, MEpiIn{ws, a.in[I_B_GATE] + l * 2048}, smem + 40960);
        __syncthreads();
        pg8::Gemm g{(const bf16_t*)(ws + OFF_HB), WinT, RR, NIN, DM}; pg8::StaticOrder S; S.init(RR, NIN, G, bx);
        EpiIn E{(bf16_t*)(ws + OFF_QKV), (bf16_t*)(ws + OFF_HALO), (bf16_t*)(ws + OFF_Z), (bf16_t*)(ws + OFF_BQ), (bf16_t*)(ws + OFF_IQ), (bf16_t*)(ws + OFF_KB), (bf16_t*)(ws + OFF_VB),
                (bf16_t*)(ws + OFF_IKB), (float*)(ws + OFF_MISC), (bf16_t*)a.out, a.in[I_B_GATE] + l * 2048, (const u64_t*)(ws + OFF_SSQ) + (size_t)(2 * l) * RR};
        stagger_delay(STAGGER_US);
        pg8::gemm_phase<EpiIn, pg8::StaticOrder>(glds, g, S, E, nullptr);
#if defined(PROBE_DUP_IN)
        pg8::gemm_phase<EpiIn, pg8::StaticOrder>(glds, g, S, E, nullptr);
#endif
    }
    SEAM(pb + 0);
#if defined(PROBE_DRY_PREP)
    if (IN(pb + 1)) p_mixprep(a, l, smem, a.ph_hi == 12345, PROBE_DRY_PREP);
#endif
    if (IN(pb + 1)) p_mixprep(a, l, smem, true);
    SEAM(pb + 1);
#if defined(PROBE_DRYMIX)
    if (IN(pb + 2)) p_mixers(a, l + 2, smem, PROBE_DRYMIX);
#endif
    for (int rep = 0; rep < NREP(2); ++rep) if (IN(pb + 2)) p_mixers(a, l + 2 * rep, smem);
    SEAM(pb + 2);
    for (int rep = 0; rep < NREP(3); ++rep) if (IN(pb + 3)) { OPQ_WS();
        const bf16_t* WbrT = (const bf16_t*)(ws + OFF_WBR) + (size_t)l * 2048 * DM;
        small_gemm16<false>((const bf16_t*)(ws + M_OAB), WbrT, 2048, DM, MEpiBr{ws, DBG_NO_GDN ? 0.f : 1.f, DBG_NO_DSA ? 0.f : 1.f}, smem + 40960);
        pg8::Gemm g{(const bf16_t*)(ws + OFF_OAB), WbrT, RR, 2048, DM}; pg8::StaticOrder S; S.init(RR, 2048, G, bx);
        EpiBr E{(bf16_t*)(ws + OFF_Y), (const bf16_t*)a.out, DBG_NO_GDN ? 0.f : 1.f, DBG_NO_DSA ? 0.f : 1.f};
        pg8::gemm_phase<EpiBr, pg8::StaticOrder>(glds, g, S, E, nullptr);
    }
    SEAM(pb + 3);
    for (int rep = 0; rep < NREP(4); ++rep) if (IN(pb + 4)) { OPQ_WS();
        const bf16_t* WoutT = (const bf16_t*)(ws + OFF_WOUT) + (size_t)l * DM * DM;
        meta_y_lds(ws, smem);
        small_gemm16<true>(smem, WoutT, DM, DM, MEpiResid{(float*)(ws + M_H), (DBG_NO_MIX || rep) ? 0.f : 1.f}, smem + 40960);
        __syncthreads();
        pg8::Gemm g{(const bf16_t*)(ws + OFF_Y), WoutT, RR, DM, DM}; pg8::StaticOrder S; S.init(RR, DM, G, bx);
        EpiResidB E{(bf16_t*)(ws + OFF_HB), rep ? nullptr : (u64_t*)(ws + OFF_SSQ) + (size_t)(2 * l + 1) * RR, (DBG_NO_MIX || rep) ? 0.f : 1.f};
        pg8::gemm_phase<EpiResidB, pg8::StaticOrder>(glds, g, S, E, nullptr);
    }
    SEAM(pb + 4);
    if (IN(pb + 5)) { OPQ_WS();
        const bf16_t* WupT = (const bf16_t*)(ws + OFF_WUP) + (size_t)l * NIN * DM;
        meta_norm_lds((const float*)(ws + M_H), smem);
        small_gemm16<true>(smem, WupT, NIN, DM, MEpiUp{(float*)(ws + M_GU)}, smem + 40960);
        p_halo(a, l);
    }
    SEAM(pb + 5);
    for (int rep = 0; rep < NREP(6); ++rep) if (IN(pb + 6)) { OPQ_WS();
        const bf16_t* WupT = (const bf16_t*)(ws + OFF_WUP) + (size_t)l * NIN * DM;
        if constexpr (L + 1 < NLAYER) meta_act(a, l);
#if defined(PANEL_UP)
        pg8::Gemm g{(const bf16_t*)(ws + OFF_HB), WupT, RR, NIN, DM}; PanelOrder S; S.init(RR, NIN, G, bx);
#else
        pg8::Gemm g{(const bf16_t*)(ws + OFF_HB), WupT, RR, NIN, DM}; pg8::StaticOrder S; S.init(RR, NIN, G, bx);
#endif
        EpiUpConv E{(bf16_t*)(ws + OFF_ACT), (const u64_t*)(ws + OFF_SSQ) + (size_t)(2 * l + 1) * RR, a.in[I_CONV_FFN] + (size_t)l * 3 * DFF, (const float*)(ws + OFF_HG), (const float*)(ws + M_GU), smem + 131072, a.ph_hi};
#if defined(PANEL_UP)
        pg8::gemm_phase<EpiUpConv, PanelOrder>(glds, g, S, E, nullptr);
#else
        pg8::gemm_phase<EpiUpConv, pg8::StaticOrder>(glds, g, S, E, nullptr);
#endif
#if defined(PROBE_UPMODE)
        { EpiUpConvT<PROBE_UPMODE> E2{(bf16_t*)(ws + OFF_ACT), (const u64_t*)(ws + OFF_SSQ) + (size_t)(2 * l + 1) * RR, a.in[I_CONV_FFN] + (size_t)l * 3 * DFF, (const float*)(ws + OFF_HG), (const float*)(ws + M_GU), smem + 131072, a.ph_hi};
          pg8::gemm_phase<EpiUpConvT<PROBE_UPMODE>, pg8::StaticOrder>(glds, g, S, E2, nullptr); }
#endif
#if defined(PROBE_NULLM)
        { EpiNull EN; pg8::Gemm g2{(const bf16_t*)(ws + OFF_OAB), (const bf16_t*)(ws + OFF_WUP) + (size_t)(1 - l) * NIN * DM, PROBE_NULLM, NIN, DM}; pg8::StaticOrder S2; S2.init(PROBE_NULLM, NIN, G, bx);
          pg8::gemm_phase<EpiNull, pg8::StaticOrder>(glds, g2, S2, EN, nullptr); }
#endif
    }
    SEAM(pb + 6);
    for (int rep = 0; rep < NREP(7); ++rep) if (IN(pb + 7)) { OPQ_WS();
        const bf16_t* WdnT = (const bf16_t*)(ws + OFF_WDN) + (size_t)l * DM * DFF;
        if constexpr (L + 1 < NLAYER) small_gemm16<false>((const bf16_t*)(ws + M_ACT), WdnT, DM, DFF, MEpiResid{(float*)(ws + M_H), (DBG_NO_FFN || rep) ? 0.f : 1.f}, smem + 40960);
        pg8::Gemm g{(const bf16_t*)(ws + OFF_ACT), WdnT, RR, DM, DFF}; pg8::StaticOrder S; S.init(RR, DM, G, bx);
#if defined(PROBE_NULLDOWN)
        { EpiNull EN; pg8::gemm_phase<EpiNull, pg8::StaticOrder>(glds, g, S, EN, nullptr); }
#endif
        if constexpr (L + 1 < NLAYER) {
            EpiResidB E{(bf16_t*)(ws + OFF_HB), rep ? nullptr : (u64_t*)(ws + OFF_SSQ) + (size_t)(2 * l + 2) * RR, (DBG_NO_FFN || rep) ? 0.f : 1.f};
            pg8::gemm_phase<EpiResidB, pg8::StaticOrder>(glds, g, S, E, nullptr);
        } else {
            EpiFinal E{(const bf16_t*)(ws + OFF_HB), a.out, DBG_NO_FFN ? 0.f : 1.f};
            pg8::gemm_phase<EpiFinal, pg8::StaticOrder>(glds, g, S, E, nullptr);
        }
    }
    SEAM(pb + 7);
#undef IN
#undef SEAM
#undef OPQ_WS
}
__global__ void __launch_bounds__(512, 2) fwd(Args a) {
    extern __shared__ __attribute__((aligned(16))) char smem[];
    unsigned char* ws = a.ws;
    const int lo = a.ph_lo, hi = a.ph_hi;
    const bool fused = (hi - lo) > 1;
    if (threadIdx.x == 0) *(u32x4*)(smem + LDS_XB) = (u32x4){0u, 0u, 0u, 0u};
    __syncthreads();
    XcdBarrier bar; bar.bar = (unsigned*)(ws + OFF_CTL); bar.x = 0; bar.st = (volatile LAS unsigned*)(smem + LDS_XB);
    if (fused) bar = xcd_barrier_post((unsigned*)(ws + OFF_CTL), (volatile LAS unsigned*)(smem + LDS_XB));
    for (int rep = 0; rep < 1 + ((REP_MASK >> 15) & 1); ++rep) if ((EN_MASK & 1) && lo <= 0 && 0 < hi) p_prologue(a, smem);
    if (lo <= 0 && 1 < hi) xcd_barrier(bar);
    layer_phases<0>(a, smem, bar, lo, hi);
    layer_phases<1>(a, smem, bar, lo, hi);
}


extern "C" void kernel_launch(void* const* d_in, const int* in_sizes, int n_in, void* d_out, int out_size, void* d_ws, size_t ws_size, hipStream_t stream) {
    static int grid = 0;
    if (grid == 0) {
        if (n_in != 20 || in_sizes[0] != RR * DM || out_size != RR * DM || ws_size < WS_END) {
            fprintf(stderr, "kernel_launch: shape mismatch: n_in %d in0 %d out %d ws %zu (need %zu)\n", n_in, n_in > 0 ? in_sizes[0] : -1, out_size, ws_size, (size_t)WS_END); grid = -1; return; }
        int dev = 0, cus = 0, per_cu = 0;
        if (hipGetDevice(&dev) != hipSuccess || hipDeviceGetAttribute(&cus, hipDeviceAttributeMultiprocessorCount, dev) != hipSuccess) { fprintf(stderr, "kernel_launch: device query failed\n"); grid = -1; return; }
        if (hipFuncSetAttribute((const void*)fwd, hipFuncAttributeMaxDynamicSharedMemorySize, LDS_BYTES) != hipSuccess) { fprintf(stderr, "kernel_launch: hipFuncSetAttribute failed\n"); grid = -1; return; }
        if (hipOccupancyMaxActiveBlocksPerMultiprocessor(&per_cu, (const void*)fwd, 512, LDS_BYTES) != hipSuccess || per_cu < 1)
            fprintf(stderr, "kernel_launch: note: occupancy query reports %d workgroups per CU\n", per_cu);
        (void)hipGetLastError();
        grid = cus;
    }
    if (grid < 0) return;
    if (hipMemsetAsync((char*)d_ws + OFF_CTL, 0, SZ_CTL, stream) != hipSuccess) { fprintf(stderr, "kernel_launch: memset failed\n"); return; }
    Args a{};
    for (int i = 0; i < 20; ++i) a.in[i] = (const float*)d_in[i];
    a.out = (float*)d_out; a.ws = (unsigned char*)d_ws;
#if ONE_LAUNCH
    a.ph_lo = 0; a.ph_hi = NPH;
    hipLaunchKernelGGL(fwd, dim3(grid), dim3(512), LDS_BYTES, stream, a);
#else
    for (int p = 0; p < NPH; ++p) { a.ph_lo = p; a.ph_hi = p + 1; hipLaunchKernelGGL(fwd, dim3(grid), dim3(512), LDS_BYTES, stream, a); }
#endif
    const hipError_t le = hipPeekAtLastError();
    if (le != hipSuccess) fprintf(stderr, "kernel_launch: launch failed: %s\n", hipGetErrorName(le));
}
```

```cpp
#define ONE_LAUNCH 1
#include <hip/hip_runtime.h>
#include <cstdio>
#include <cstdint>

#define LAS __attribute__((address_space(3)))
typedef unsigned short bf16_t;
typedef short bf16x8 __attribute__((ext_vector_type(8)));
typedef short s16x4 __attribute__((ext_vector_type(4)));
typedef float f32x4 __attribute__((ext_vector_type(4)));
typedef float f32x16 __attribute__((ext_vector_type(16)));
typedef unsigned u32x4 __attribute__((ext_vector_type(4)));
typedef unsigned u32x2 __attribute__((ext_vector_type(2)));

constexpr int NB = 32, SQ = 2048, RR = NB * SQ, NMETA = 16, TP = 2176, DM = 1024, TPOS = 2064;
constexpr int NIN = 5632, DFF = 2816, NLAYER = 2;
constexpr float EPSF = 1e-6f;

constexpr size_t al256(size_t x) { return (x + 255) / 256 * 256; }
constexpr size_t OFF_CTL = 0, SZ_CTL = 65536;
constexpr size_t OFF_WIN = OFF_CTL + SZ_CTL, SZ_WIN = (size_t)NLAYER * NIN * DM * 2;
constexpr size_t OFF_WBR = OFF_WIN + SZ_WIN, SZ_WBR = (size_t)NLAYER * 2048 * DM * 2;
constexpr size_t OFF_WOUT = OFF_WBR + SZ_WBR, SZ_WOUT = (size_t)NLAYER * DM * DM * 2;
constexpr size_t OFF_WUP = OFF_WOUT + SZ_WOUT, SZ_WUP = (size_t)NLAYER * NIN * DM * 2;
constexpr size_t OFF_WDN = OFF_WUP + SZ_WUP, SZ_WDN = (size_t)NLAYER * DM * DFF * 2;
constexpr size_t OFF_COSA = OFF_WDN + SZ_WDN, SZ_ROPA = (size_t)TPOS * 64 * 4;
constexpr size_t OFF_SINA = OFF_COSA + SZ_ROPA;
constexpr size_t OFF_COSI = OFF_SINA + SZ_ROPA, SZ_ROPI = (size_t)TPOS * 32 * 4;
constexpr size_t OFF_SINI = OFF_COSI + SZ_ROPI;
constexpr size_t OFF_M = al256(OFF_SINI + SZ_ROPI);
constexpr size_t M_H = OFF_M;
constexpr size_t M_RAW = M_H + 16 * 1024 * 4;
constexpr size_t M_CHUNK = M_RAW + 16 * 1536 * 2;
constexpr size_t M_Z = M_CHUNK + 64 * 1536 * 2;
constexpr size_t M_BQ = M_Z + 16 * 512 * 2;
constexpr size_t M_IQ = M_BQ + 16 * 512 * 2;
constexpr size_t M_K = M_IQ + 16 * 512 * 2;
constexpr size_t M_V = M_K + 16 * 128 * 2;
constexpr size_t M_MISC = M_V + 16 * 128 * 2;
constexpr size_t M_GATES = M_MISC + 16 * 16 * 4;
constexpr size_t M_TQ = M_GATES + 16 * 2048 * 2;
constexpr size_t M_GC = M_TQ + 4 * 2 * 4096 * 2;
constexpr size_t M_BETA = M_GC + 64 * 4 * 4;
constexpr size_t M_OAB = M_BETA + 64 * 4 * 4;
constexpr size_t M_Y = M_OAB + 16 * 1024 * 2;
constexpr size_t M_GU = M_Y + 16 * 1024 * 2;
constexpr size_t M_ACT = M_GU + 16 * 5632 * 4;
constexpr size_t M_END = M_ACT + 16 * 2816 * 2;
constexpr size_t OFF_HB = al256(M_END), SZ_HB = (size_t)RR * DM * 2;
constexpr size_t OFF_SSQ = OFF_HB + SZ_HB, SZ_SSQ = (size_t)4 * RR * 8;
constexpr size_t OFF_QKV = OFF_SSQ + SZ_SSQ, SZ_QKV = (size_t)RR * 1536 * 2;
constexpr size_t OFF_HALO = OFF_QKV + SZ_QKV, SZ_HALO = (size_t)(RR / 64) * 3 * 1536 * 2;
constexpr size_t OFF_Z = OFF_HALO + SZ_HALO, SZ_512 = (size_t)RR * 512 * 2;
constexpr size_t OFF_BQ = OFF_Z + SZ_512;
constexpr size_t OFF_IQ = OFF_BQ + SZ_512;
constexpr size_t OFF_KB = OFF_IQ + SZ_512, SZ_KB = (size_t)NB * TP * 128 * 2;
constexpr size_t OFF_VB = OFF_KB + SZ_KB;
constexpr size_t OFF_IKB = OFF_VB + SZ_KB, SZ_IKB = (size_t)NB * TP * 64 * 2;
constexpr size_t OFF_MISC = OFF_IKB + SZ_IKB, SZ_MISC = (size_t)RR * 16 * 4;
constexpr size_t OFF_GC = OFF_MISC + SZ_MISC, SZ_GC = (size_t)RR * 4 * 4;
constexpr size_t OFF_BETA = OFF_GC + SZ_GC;
constexpr size_t OFF_TQ = OFF_BETA + SZ_GC, SZ_TQ = (size_t)NB * 32 * 4 * 2 * 4096 * 2;
constexpr size_t OFF_OAB = OFF_TQ + SZ_TQ, SZ_OAB = (size_t)RR * DM * 2;
constexpr size_t OFF_HG = OFF_OAB + SZ_OAB, SZ_HG = (size_t)256 * 2 * DFF * 4;
constexpr size_t WS_END = OFF_HG + SZ_HG;
constexpr size_t OFF_Y = OFF_QKV;
constexpr size_t OFF_ACT = OFF_QKV, SZ_FF = (size_t)RR * DFF * 2;
static_assert(OFF_ACT + SZ_FF <= OFF_OAB, "ffn alias region");
static_assert(WS_END <= (size_t)1073741824, "workspace budget");
constexpr int CW_QUEUE = 4096;

constexpr int LDS_BYTES = 163840, LDS_XB = LDS_BYTES - 16;

#define AS_GLOBAL(p) ((unsigned char*)(__attribute__((address_space(1))) unsigned char*)(p))
typedef __bf16 bf16x2_t __attribute__((ext_vector_type(2)));
__device__ __forceinline__ unsigned cvt_pk(float lo, float hi) { bf16x2_t v; v[0] = (__bf16)lo; v[1] = (__bf16)hi; return __builtin_bit_cast(unsigned, v); }
__device__ __forceinline__ bf16_t f2bf(float x) { return (bf16_t)(cvt_pk(x, 0.f) & 0xffffu); }
__device__ __forceinline__ float bf2f(bf16_t b) { return __uint_as_float(((unsigned)b) << 16); }
__device__ __forceinline__ float bflo(unsigned w) { return __uint_as_float(w << 16); }
__device__ __forceinline__ float bfhi(unsigned w) { return __uint_as_float(w & 0xffff0000u); }
template <int CTRL, int RM = 0xf> __device__ __forceinline__ float dpp_mov(float v) {
    return __builtin_bit_cast(float, __builtin_amdgcn_update_dpp(0, __builtin_bit_cast(int, v), CTRL, RM, 0xf, false)); }
__device__ __forceinline__ float row_sum16(float v) {
    v += dpp_mov<0xB1>(v); v += dpp_mov<0x4E>(v); v += dpp_mov<0x141>(v); v += dpp_mov<0x140>(v); return v; }
__device__ __forceinline__ float wave_sum_hi(float v) {
    v = row_sum16(v); v += dpp_mov<0x142, 0xa>(v); v += dpp_mov<0x143, 0xc>(v); return v; }
__device__ __forceinline__ float wave_sum(float v) { return __builtin_bit_cast(float, __builtin_amdgcn_readlane(__builtin_bit_cast(int, wave_sum_hi(v)), 63)); }
__device__ __forceinline__ float half_sum(float v) {
#pragma unroll
    for (int o = 16; o; o >>= 1) v += __shfl_xor(v, o);
    return v; }
typedef unsigned long long u64_t;
constexpr float SSQ_SCALE = 1048576.f, SSQ_INV = 1.f / 1048576.f;
__device__ __forceinline__ float rstd_of(const u64_t* ssq, int row) { return rsqrtf((float)ssq[row] * (SSQ_INV / DM) + EPSF); }
#ifndef FAST_SIG
#define FAST_SIG 1
#endif
#ifndef FAST_SILU
#define FAST_SILU 1
#endif
__device__ __forceinline__ float sigmoid_f(float x) { return FAST_SIG ? __builtin_amdgcn_rcpf(1.f + __expf(-x)) : 1.f / (1.f + __expf(-x)); }
__device__ __forceinline__ float sigmoid_slow(float x) { return 1.f / (1.f + __expf(-x)); }
__device__ __forceinline__ float sigmoid_fast(float x) { return __builtin_amdgcn_rcpf(1.f + __expf(-x)); }
__device__ __forceinline__ float silu_f(float x) { return FAST_SILU ? x * __builtin_amdgcn_rcpf(1.f + __expf(-x)) : x / (1.f + __expf(-x)); }
__device__ __forceinline__ float softplus_f(float x) { return fmaxf(x, 0.f) + log1pf(__expf(-fabsf(x))); }
__device__ __forceinline__ u32x4 pack8(f32x4 a, f32x4 b) { u32x4 w; w.x = cvt_pk(a[0], a[1]); w.y = cvt_pk(a[2], a[3]); w.z = cvt_pk(b[0], b[1]); w.w = cvt_pk(b[2], b[3]); return w; }
__device__ __forceinline__ bf16x8 as_bf8(u32x4 w) { return __builtin_bit_cast(bf16x8, w); }
__device__ __forceinline__ f32x4 mfma16(bf16x8 a, bf16x8 b, f32x4 c) { return __builtin_amdgcn_mfma_f32_16x16x32_bf16(a, b, c, 0, 0, 0); }

#define XB_TMO      128
#define XB_XCNT(j)  (256  + 64 * (j))
#define XB_XSUB(j)  (1280 + 64 * (j))
#define XB_XGEN(j)  (2304 + 64 * (j))
#define XB_TOP      3328
#define XB_TOPGEN   3392
#define XCD_BAR_WORDS 3456
#define XB_SPIN_CAP (1u << 18)
__device__ __forceinline__ unsigned xb_ld(unsigned* p)              { return __hip_atomic_load(p, __ATOMIC_RELAXED, __HIP_MEMORY_SCOPE_AGENT); }
__device__ __forceinline__ unsigned xb_add(unsigned* p, unsigned v) { return __hip_atomic_fetch_add(p, v, __ATOMIC_RELAXED, __HIP_MEMORY_SCOPE_AGENT); }
__device__ __forceinline__ unsigned xb_xcc_id() { return (unsigned)__builtin_amdgcn_s_getreg((3 << 11) | 20) & 0xFu; }
#define XB_SPIN(cond, bar) do { unsigned _sp = 0; while (cond) { __builtin_amdgcn_s_sleep(1); \
    if ((++_sp & 255u) == 0u) { if (xb_ld(&(bar)[XB_TMO])) break; if (_sp > XB_SPIN_CAP) { atomicAdd(&(bar)[XB_TMO], 1u); break; } } } } while (0)
struct XcdBarrier { unsigned* bar; unsigned x; volatile LAS unsigned* st; };
__device__ __forceinline__ XcdBarrier xcd_barrier_post(unsigned* bar, volatile LAS unsigned* st) {
    XcdBarrier b; b.bar = bar; b.x = xb_xcc_id(); b.st = st;
    if (threadIdx.x == 0) (void)xb_add(&bar[XB_XCNT(b.x)], 1u);
    return b;
}
__device__ __forceinline__ void xcd_barrier_complete(unsigned* bar, unsigned x, unsigned& nloc, unsigned& nx) {
    const unsigned G = gridDim.x * gridDim.y * gridDim.z;
    unsigned sum, cnt, mine, sp = 0u;
    for (;;) {
        sum = 0u; cnt = 0u; mine = 0u;
#pragma unroll
        for (unsigned j = 0; j < 16; ++j) { const unsigned c = xb_ld(&bar[XB_XCNT(j)]); sum += c; cnt += (c > 0u) ? 1u : 0u; mine = (j == x) ? c : mine; }
        if (sum == G) break;
        __builtin_amdgcn_s_sleep(1);
        if ((++sp & 255u) == 0u) { if (xb_ld(&bar[XB_TMO])) break; if (sp > XB_SPIN_CAP) { atomicAdd(&bar[XB_TMO], 1u); break; } }
    }
    nloc = mine > 0u ? mine : 1u; nx = cnt > 0u ? cnt : 1u;
}
__device__ __forceinline__ void xcd_barrier(const XcdBarrier& b) {
    asm volatile("s_waitcnt vmcnt(0)" ::: "memory");
    __syncthreads();
    if (threadIdx.x == 0) {
        unsigned* bar = b.bar;
        __builtin_amdgcn_s_waitcnt(0);
        unsigned nloc = b.st[0], nx = b.st[1];
        if (nloc == 0u) { xcd_barrier_complete(bar, b.x, nloc, nx); b.st[0] = nloc; b.st[1] = nx; }
        const unsigned old = xb_add(&bar[XB_XSUB(b.x)], 1u);
        const unsigned gen = old / nloc;
        if (old + 1u == (gen + 1u) * nloc) {
            __builtin_amdgcn_fence(__ATOMIC_RELEASE, "agent");
            asm volatile("s_waitcnt vmcnt(0)" ::: "memory");
            const unsigned og = xb_add(&bar[XB_TOP], 1u);
            const unsigned tg = og / nx;
            if (og + 1u == (tg + 1u) * nx) xb_add(&bar[XB_TOPGEN], 1u);
            else XB_SPIN(xb_ld(&bar[XB_TOPGEN]) == tg, bar);
            __builtin_amdgcn_fence(__ATOMIC_ACQUIRE, "agent");
            xb_add(&bar[XB_XGEN(b.x)], 1u);
            asm volatile("s_waitcnt vmcnt(0)" ::: "memory");
        } else {
            XB_SPIN(xb_ld(&bar[XB_XGEN(b.x)]) == gen, bar);
            __builtin_amdgcn_fence(__ATOMIC_ACQUIRE, "agent");
            asm volatile("s_waitcnt vmcnt(0)" ::: "memory");
        }
    }
    __syncthreads();
}

namespace pg8 {
#define PG8_LAS __attribute__((address_space(3)))
typedef unsigned short bf16_t;
typedef short bf16x8 __attribute__((ext_vector_type(8)));
typedef float f32x4 __attribute__((ext_vector_type(4)));
typedef unsigned u32x4 __attribute__((ext_vector_type(4)));
constexpr int BM = 256, BK = 64, HALF = 128, HTB = HALF * BK * 2  , STAGE_BYTES = 8 * HTB, NXCD = 8, WGM = 8;

__host__ __device__ __forceinline__ int lds_byte(int r, int c) { const int st = (r >> 4) * 2 + (c >> 5), rr = r & 15, cc = c & 31, ob = rr * 64 + cc * 2; return st * 1024 + (ob ^ (((ob >> 9) & 1) << 5)); }
__host__ __device__ __forceinline__ void stage_rc(int b, int& R, int& C) { const int st = b / 1024, sb = b % 1024, swz = sb ^ (((sb >> 9) & 1) << 5); R = (st >> 1) * 16 + swz / 64; C = (st & 1) * 32 + (swz % 64) / 2; }
__host__ __device__ __forceinline__ int perm32(int rho) { const int n = rho >> 4, i = rho & 15; return 8 * (i >> 2) + 4 * n + (i & 3); }

struct Unit { int pm, pn; };
struct Gemm { const bf16_t* A; const bf16_t* Bt; int M, N, K; };

struct StaticOrder {
    int nM, nN, nwg, G, c;
    __host__ __device__ void init(int M, int N, int G_, int c_) { nM = M / BM; nN = N / BM; nwg = nM * nN; G = G_; c = c_; }
    __host__ __device__ bool next(int i, Unit& u) const {
        const long L = (long)i * G + c; if (L >= nwg) return false;
        int wgid = (int)L; { const int q = nwg / NXCD, r = nwg % NXCD, xcd = wgid % NXCD, off = wgid / NXCD; wgid = (xcd < r ? xcd * (q + 1) : r * (q + 1) + (xcd - r) * q) + off; }
        const int nig = WGM * nN, gid = wgid / nig, fm = gid * WGM, gsz = (nM - fm) < WGM ? (nM - fm) : WGM;
        u.pm = fm + ((wgid % nig) % gsz); u.pn = (wgid % nig) / gsz; return true;
    }
    __device__ __forceinline__ void a_ready(const Unit&) const {}
    __device__ __forceinline__ void done(const Unit&) const {}
};
__device__ __forceinline__ unsigned cvt_pk_bf16(float lo, float hi) { unsigned r; asm volatile("v_cvt_pk_bf16_f32 %0, %1, %2" : "=v"(r) : "v"(lo), "v"(hi)); return r; }
typedef float f32x2 __attribute__((ext_vector_type(2)));
template <class Epi, class Sched, bool STAMP = false>
__device__ __forceinline__ void gemm_phase(PG8_LAS unsigned char* lds, const Gemm g, const Sched& S, const Epi& E, unsigned long long* stamps) {
    int tid_ = threadIdx.x; asm volatile("" : "+v"(tid_));
    const int tid = tid_, wid = __builtin_amdgcn_readfirstlane(tid >> 6), lane = tid & 63, wr = wid >> 2, wc = wid & 3, fr = lane & 15, fq = lane >> 4;
    const int K = g.K, nt = K / BK;
    int ts_lo = 0, ts_hi = 0, nts = 0; const unsigned long long rt_entry = STAMP ? (unsigned long long)wall_clock64() : 0ull;
#define PG8_STAMP() do { if (STAMP && wid == 0 && nts < 64) { const unsigned long long _c = (unsigned long long)clock64(); \
        ts_lo = (lane == nts) ? (int)(unsigned)_c : ts_lo; ts_hi = (lane == nts) ? (int)(unsigned)(_c >> 32) : ts_hi; ++nts; } } while (0)
    PG8_STAMP();
    unsigned voffA[2], voffB[2];
#pragma unroll
    for (int i = 0; i < 2; ++i) { int R, C; stage_rc(tid * 16 + i * 8192, R, C); const int Rb = Epi::PERM ? ((R & ~31) + perm32(R & 31)) : R;
        const int Ra = Epi::APERM ? (8 * (16 * (R >> 6) + (R & 15)) + ((R >> 4) & 3)) : R;
        voffA[i] = (unsigned)(Ra * K + C) * 2u; voffB[i] = (unsigned)(Rb * K + C) * 2u; }
    const size_t kstep = (size_t)(BK * 2);
    const size_t hstep = (size_t)HALF * K * 2;
    const size_t tstep = 2 * hstep;
    const size_t hstepA = Epi::APERM ? (size_t)4 * K * 2 : hstep;
    const unsigned ldsw = (unsigned)wid * 1024u;
    const int aoff = lds_byte(wr * 64 + fr, fq * 8), boff = lds_byte(wc * 32 + fr, fq * 8);
#define PG8_SA(b, h) (((b) * 2 + (h)) * HTB)
#define PG8_SB(b, h) ((4 + (b) * 2 + (h)) * HTB)
#define PG8_STAGE(bufoff, gbase, voff) do { _Pragma("unroll") for (int _i = 0; _i < 2; ++_i) \
        __builtin_amdgcn_global_load_lds((const unsigned*)((const char*)(gbase) + (voff)[_i]), (PG8_LAS unsigned*)(lds + (bufoff) + ldsw + _i * 8192), 16, 0, 0); } while (0)
#define PG8_LDA(dst, b, h) do { _Pragma("unroll") for (int m = 0; m < 4; ++m) _Pragma("unroll") for (int k = 0; k < 2; ++k) dst[m][k] = *(const PG8_LAS bf16x8*)(lds + PG8_SA(b, h) + aoff + m * 2048 + k * 1024); } while (0)
#define PG8_LDB(dst, b, h) do { _Pragma("unroll") for (int n = 0; n < 2; ++n) _Pragma("unroll") for (int k = 0; k < 2; ++k) dst[n][k] = *(const PG8_LAS bf16x8*)(lds + PG8_SB(b, h) + boff + n * 2048 + k * 1024); } while (0)
#define PG8_MMA(ai, bj, At, Bt) do { __builtin_amdgcn_s_setprio(1); _Pragma("unroll") for (int m = 0; m < 4; ++m) _Pragma("unroll") for (int n = 0; n < 2; ++n) _Pragma("unroll") for (int k = 0; k < 2; ++k) \
        acc[ai][bj][m][n] = __builtin_amdgcn_mfma_f32_16x16x32_bf16(Bt[n][k], At[m][k], acc[ai][bj][m][n], 0, 0, 0); __builtin_amdgcn_s_setprio(0); } while (0)
#define PG8_WAIT_V(n) asm volatile("s_waitcnt vmcnt(" #n ")" ::: "memory")
#define PG8_WAIT_L(n) asm volatile("s_waitcnt lgkmcnt(" #n ")" ::: "memory")
#define PG8_BAR __builtin_amdgcn_s_barrier()
#define PG8_SCHED __builtin_amdgcn_sched_barrier(0)
    Unit cur, nxt; int ui = 0;
    if (!S.next(0, cur)) return;
    f32x4 acc[2][2][4][2];
#pragma unroll
    for (int a = 0; a < 2; ++a)
#pragma unroll
        for (int b = 0; b < 2; ++b)
#pragma unroll
            for (int m = 0; m < 4; ++m)
#pragma unroll
                for (int n = 0; n < 2; ++n) acc[a][b][m][n] = (f32x4){0.f, 0.f, 0.f, 0.f};
    bf16x8 At[4][2], B0[2][2], B1[2][2];
    const char* cA = (const char*)g.A + (size_t)cur.pm * tstep; const char* cB = (const char*)g.Bt + (size_t)cur.pn * tstep;
    S.a_ready(cur);
    PG8_STAGE(PG8_SB(0, 0), cB, voffB); PG8_STAGE(PG8_SA(0, 0), cA, voffA); PG8_STAGE(PG8_SB(0, 1), cB + hstep, voffB); PG8_STAGE(PG8_SA(0, 1), cA + hstepA, voffA);
    if (wr == 1) PG8_BAR;
    PG8_WAIT_V(4); PG8_BAR;
    PG8_STAGE(PG8_SB(1, 0), cB + kstep, voffB); PG8_STAGE(PG8_SA(1, 0), cA + kstep, voffA); PG8_STAGE(PG8_SB(1, 1), cB + hstep + kstep, voffB);
    PG8_WAIT_V(6); PG8_BAR;
    PG8_STAMP();
    for (;;) {
        const bool has_next = S.next(ui + 1, nxt);
        const char* nA = has_next ? (const char*)g.A + (size_t)nxt.pm * tstep : cA; const char* nB = has_next ? (const char*)g.Bt + (size_t)nxt.pn * tstep : cB;
        for (int t = 0; t < nt; t += 2) {
            const bool last = (t == nt - 2);
            const bool bd_lo = !Epi::BD || (t * BK * 2 < K), bd_hi = !Epi::BD || !(t * BK * 2 < K);
            const char* a1 = cA + (size_t)(t + 1) * kstep;
            const char* a2 = last ? nA : cA + (size_t)(t + 2) * kstep; const char* b2 = last ? nB : cB + (size_t)(t + 2) * kstep;
            const char* a3 = a2 + kstep; const char* b3 = b2 + kstep;
            if (last && has_next) S.a_ready(nxt);
            PG8_LDB(B0, 0, 0); PG8_SCHED; PG8_LDA(At, 0, 0); PG8_STAGE(PG8_SA(1, 1), a1 + hstepA, voffA);
            PG8_WAIT_L(8); PG8_BAR; PG8_WAIT_L(0); if (bd_lo) PG8_MMA(0, 0, At, B0); PG8_BAR; PG8_SCHED;
            PG8_LDB(B1, 0, 1); PG8_STAGE(PG8_SB(0, 0), b2, voffB);
            PG8_BAR; PG8_WAIT_L(0); if (bd_hi) PG8_MMA(0, 1, At, B1); PG8_BAR;
            PG8_LDA(At, 0, 1); PG8_STAGE(PG8_SA(0, 0), a2, voffA);
            PG8_BAR; PG8_WAIT_L(0); if (bd_lo) PG8_MMA(1, 0, At, B0); PG8_BAR; PG8_SCHED;
            PG8_STAGE(PG8_SB(0, 1), b2 + hstep, voffB);
            PG8_WAIT_V(6); PG8_BAR; if (bd_hi) PG8_MMA(1, 1, At, B1); PG8_BAR;
            PG8_LDB(B0, 1, 0); PG8_SCHED; PG8_LDA(At, 1, 0); PG8_STAGE(PG8_SA(0, 1), a2 + hstepA, voffA);
            PG8_WAIT_L(8); PG8_BAR; PG8_WAIT_L(0); if (bd_lo) PG8_MMA(0, 0, At, B0); PG8_BAR; PG8_SCHED;
            PG8_LDB(B1, 1, 1); PG8_STAGE(PG8_SB(1, 0), b3, voffB);
            PG8_BAR; PG8_WAIT_L(0); if (bd_hi) PG8_MMA(0, 1, At, B1); PG8_BAR;
            PG8_LDA(At, 1, 1); PG8_STAGE(PG8_SA(1, 0), a3, voffA);
            PG8_BAR; PG8_WAIT_L(0); if (bd_lo) PG8_MMA(1, 0, At, B0); PG8_BAR; PG8_SCHED;
            PG8_STAGE(PG8_SB(1, 1), b3 + hstep, voffB);
            PG8_WAIT_V(6); PG8_BAR; if (bd_hi) PG8_MMA(1, 1, At, B1); PG8_BAR;
        }
        PG8_STAMP();
        if constexpr (!Epi::AFTER_DRAIN) { E(acc, cur, wr, wc, fr, fq); S.done(cur); }
        PG8_STAMP();
        if (!has_next) break;
#pragma unroll
        for (int a = 0; a < 2; ++a)
#pragma unroll
            for (int b = 0; b < 2; ++b)
#pragma unroll
                for (int m = 0; m < 4; ++m)
#pragma unroll
                    for (int n = 0; n < 2; ++n) acc[a][b][m][n] = (f32x4){0.f, 0.f, 0.f, 0.f};
        cur = nxt; cA = nA; cB = nB; ++ui;
    }
    PG8_WAIT_V(0);
    if (wr == 0) PG8_BAR;
    PG8_BAR;
    if constexpr (Epi::AFTER_DRAIN) { E.fused(acc, cur, wr, wc, fr, fq, lds, wid, lane); S.done(cur); }
    PG8_STAMP();
    if (STAMP && wid == 0) { stamps[lane] = lane < nts ? (((unsigned long long)(unsigned)ts_hi << 32) | (unsigned)ts_lo) : 0ull;
        if (lane == 62) stamps[62] = rt_entry; if (lane == 63) stamps[63] = (unsigned long long)wall_clock64(); }
#undef PG8_STAMP
#undef PG8_SA
#undef PG8_SB
#undef PG8_STAGE
#undef PG8_LDA
#undef PG8_LDB
#undef PG8_MMA
#undef PG8_WAIT_V
#undef PG8_WAIT_L
#undef PG8_BAR
#undef PG8_SCHED
}
}

struct Args { const float* in[20]; float* out; unsigned char* ws; int ph_lo, ph_hi; };
enum { I_X = 0, I_META, I_NORM_MIX, I_W_IN, I_CONV_A, I_A_LOG, I_DT_BIAS, I_A_OUT_NORM, I_Q_NORM, I_K_NORM, I_KIDX_NORM, I_W_BA, I_W_BB, I_W_GATE, I_B_GATE, I_W_OUT, I_NORM_FFN, I_W_UP, I_CONV_FFN, I_W_DOWN };

#ifndef DBG_NO_DSA
#define DBG_NO_DSA 0
#endif
#ifndef DBG_NO_GDN
#define DBG_NO_GDN 0
#endif
#ifndef DBG_NO_MIX
#define DBG_NO_MIX 0
#endif
#ifndef DBG_NO_FFN
#define DBG_NO_FFN 0
#endif

#ifndef SIG_EPI
#define SIG_EPI sigmoid_fast
#endif
#ifndef SIG_META
#define SIG_META sigmoid_fast
#endif
#ifndef SIG_BETA
#define SIG_BETA sigmoid_fast
#endif
#ifndef GATE_ROT
#define GATE_ROT 0
#endif
#define GATE_COL(row, col) (GATE_ROT ? (((col) + 128 * ((row) & 15)) & 2047) : (col))
#ifndef NT_STORE
#define NT_STORE 0
#endif
#define ST16(ptr, val) do { if (NT_STORE) __builtin_nontemporal_store((val), (u32x4*)(ptr)); else *(u32x4*)(ptr) = (val); } while (0)
struct PanelOrder : pg8::StaticOrder {
    __host__ __device__ bool next(int i, pg8::Unit& u) const { if (i >= nN || c >= nM) return false; u.pm = c; u.pn = i; return true; }
};
using pg8::Unit;
struct EpiIn {
    static constexpr bool PERM = true, AFTER_DRAIN = false, APERM = false, BD = false;
    bf16_t *qkv, *halo, *z, *bq, *iq, *kb, *vb, *ikb; float* misc; bf16_t* gates; const float* bgate; const u64_t* ssq;
    __device__ __forceinline__ void operator()(const f32x4 (&acc)[2][2][4][2], const Unit& u, int wr, int wc, int fr, int fq) const {
        const int pn = u.pn, row0 = u.pm * 256 + wr * 64 + fr, cl = wc * 32 + 8 * fq;
        float rs[2][4];
        { u64_t sv[2][4];
#pragma unroll
          for (int ai = 0; ai < 2; ++ai)
#pragma unroll
              for (int m = 0; m < 4; ++m) sv[ai][m] = ssq[row0 + ai * 128 + m * 16];
#pragma unroll
          for (int ai = 0; ai < 2; ++ai)
#pragma unroll
              for (int m = 0; m < 4; ++m) rs[ai][m] = rsqrtf((float)sv[ai][m] * (SSQ_INV / DM) + EPSF); }
        if (pn < 12) {
            bf16_t* base; int ld, cb;
            if (pn < 6) { base = qkv; ld = 1536; cb = pn * 256; } else if (pn < 8) { base = z; ld = 512; cb = (pn - 6) * 256; }
            else if (pn < 10) { base = bq; ld = 512; cb = (pn - 8) * 256; } else { base = iq; ld = 512; cb = (pn - 10) * 256; }
#pragma unroll
            for (int ai = 0; ai < 2; ++ai)
#pragma unroll
                for (int m = 0; m < 4; ++m) {
                    const int row = row0 + ai * 128 + m * 16; const float r = rs[ai][m];
                    bf16_t* p = base + (size_t)row * ld + cb + cl;
                    const u32x4 w0 = pack8(acc[ai][0][m][0] * r, acc[ai][0][m][1] * r), w1 = pack8(acc[ai][1][m][0] * r, acc[ai][1][m][1] * r);
                    ST16(p, w0); ST16(p + 128, w1);
                    if (pn < 6 && (row & 63) >= 61) {
                        bf16_t* hp = halo + ((size_t)(row >> 6) * 3 + ((row & 63) - 61)) * 1536 + cb + cl;
                        *(u32x4*)hp = w0; *(u32x4*)(hp + 128) = w1;
                    }
                }
        } else if (pn == 12) {
#pragma unroll
            for (int ai = 0; ai < 2; ++ai)
#pragma unroll
                for (int m = 0; m < 4; ++m) {
                    const int row = row0 + ai * 128 + m * 16; const float r = rs[ai][m];
                    const size_t prow = (size_t)(row >> 11) * TP + 16 + (row & 2047);
                    *(u32x4*)(kb + prow * 128 + cl) = pack8(acc[ai][0][m][0] * r, acc[ai][0][m][1] * r);
                    *(u32x4*)(vb + prow * 128 + cl) = pack8(acc[ai][1][m][0] * r, acc[ai][1][m][1] * r);
                }
        } else if (pn == 13) {
#pragma unroll
            for (int ai = 0; ai < 2; ++ai)
#pragma unroll
                for (int m = 0; m < 4; ++m) {
                    const int row = row0 + ai * 128 + m * 16; const float r = rs[ai][m];
                    if (cl < 64) { const size_t prow = (size_t)(row >> 11) * TP + 16 + (row & 2047); *(u32x4*)(ikb + prow * 64 + cl) = pack8(acc[ai][0][m][0] * r, acc[ai][0][m][1] * r); }
                    else if (cl < 80) { float* mp = misc + (size_t)row * 16 + (cl - 64); *(f32x4*)mp = acc[ai][0][m][0] * r; *(f32x4*)(mp + 4) = acc[ai][0][m][1] * r; }
                }
        } else {
            const int cb = (pn - 14) * 256 + cl;
            f32x4 bv[2][2];
#pragma unroll
            for (int bj = 0; bj < 2; ++bj) { bv[bj][0] = *(const f32x4*)(bgate + cb + bj * 128); bv[bj][1] = *(const f32x4*)(bgate + cb + bj * 128 + 4); }
#pragma unroll
            for (int ai = 0; ai < 2; ++ai)
#pragma unroll
                for (int m = 0; m < 4; ++m) {
                    const int row = row0 + ai * 128 + m * 16; const float r = rs[ai][m];
                    bf16_t* p = gates + (size_t)row * 2048;
#pragma unroll
                    for (int bj = 0; bj < 2; ++bj) {
                        f32x4 v0 = acc[ai][bj][m][0] * r + bv[bj][0], v1 = acc[ai][bj][m][1] * r + bv[bj][1];
#pragma unroll
                        for (int j = 0; j < 4; ++j) { v0[j] = SIG_EPI(v0[j]); v1[j] = SIG_EPI(v1[j]); }
                        ST16(p + GATE_COL(row, cb + bj * 128), pack8(v0, v1));
                    }
                }
        }
    }
};
struct EpiBr {
    static constexpr bool PERM = true, AFTER_DRAIN = false, APERM = false, BD = true;
    bf16_t* y; const bf16_t* gates; float sca, scb;
    __device__ __forceinline__ u32x4 comb(const f32x4 (&acc)[2][2][4][2], int ai, int m, u32x4 ga, u32x4 gb) const {
        f32x4 a0 = acc[ai][0][m][0] * sca, a1 = acc[ai][0][m][1] * sca, b0 = acc[ai][1][m][0] * scb, b1 = acc[ai][1][m][1] * scb, v0, v1;
        v0[0] = bflo(ga.x) * a0[0] + bflo(gb.x) * b0[0]; v0[1] = bfhi(ga.x) * a0[1] + bfhi(gb.x) * b0[1]; v0[2] = bflo(ga.y) * a0[2] + bflo(gb.y) * b0[2]; v0[3] = bfhi(ga.y) * a0[3] + bfhi(gb.y) * b0[3];
        v1[0] = bflo(ga.z) * a1[0] + bflo(gb.z) * b1[0]; v1[1] = bfhi(ga.z) * a1[1] + bfhi(gb.z) * b1[1]; v1[2] = bflo(ga.w) * a1[2] + bflo(gb.w) * b1[2]; v1[3] = bfhi(ga.w) * a1[3] + bfhi(gb.w) * b1[3];
        return pack8(v0, v1); }
    __device__ __forceinline__ void operator()(const f32x4 (&acc)[2][2][4][2], const Unit& u, int wr, int wc, int fr, int fq) const {
        const int row0 = u.pm * 256 + wr * 64 + fr, c0 = u.pn * 128 + wc * 32 + 8 * fq;
        u32x4 ga[4], gb[4], w0[4];
#pragma unroll
        for (int m = 0; m < 4; ++m) { const int rw = row0 + m * 16; const size_t go = (size_t)rw * 2048; ga[m] = *(const u32x4*)(gates + go + GATE_COL(rw, c0)); gb[m] = *(const u32x4*)(gates + go + GATE_COL(rw, 1024 + c0)); }
#pragma unroll
        for (int m = 0; m < 4; ++m) w0[m] = comb(acc, 0, m, ga[m], gb[m]);
#pragma unroll
        for (int m = 0; m < 4; ++m) { const int rw = row0 + 128 + m * 16; const size_t go = (size_t)rw * 2048; ga[m] = *(const u32x4*)(gates + go + GATE_COL(rw, c0)); gb[m] = *(const u32x4*)(gates + go + GATE_COL(rw, 1024 + c0)); }
#pragma unroll
        for (int m = 0; m < 4; ++m) *(u32x4*)(y + (size_t)(row0 + m * 16) * 1024 + c0) = w0[m];
#pragma unroll
        for (int m = 0; m < 4; ++m) *(u32x4*)(y + (size_t)(row0 + 128 + m * 16) * 1024 + c0) = comb(acc, 1, m, ga[m], gb[m]);
    }
};
struct EpiResidB {
    static constexpr bool PERM = true, AFTER_DRAIN = false, APERM = false, BD = false;
    bf16_t* hb; u64_t* ssq; float sc;
    __device__ __forceinline__ u32x4 upd(const f32x4 (&acc)[2][2][4][2], int ai, int bj, int m, u32x4 ov, float& part) const {
        f32x4 v0 = acc[ai][bj][m][0] * sc, v1 = acc[ai][bj][m][1] * sc;
        v0[0] += bflo(ov.x); v0[1] += bfhi(ov.x); v0[2] += bflo(ov.y); v0[3] += bfhi(ov.y); v1[0] += bflo(ov.z); v1[1] += bfhi(ov.z); v1[2] += bflo(ov.w); v1[3] += bfhi(ov.w);
        const u32x4 w = pack8(v0, v1);
        part += bflo(w.x) * bflo(w.x) + bfhi(w.x) * bfhi(w.x) + bflo(w.y) * bflo(w.y) + bfhi(w.y) * bfhi(w.y) + bflo(w.z) * bflo(w.z) + bfhi(w.z) * bfhi(w.z) + bflo(w.w) * bflo(w.w) + bfhi(w.w) * bfhi(w.w);
        return w; }
    __device__ __forceinline__ void operator()(const f32x4 (&acc)[2][2][4][2], const Unit& u, int wr, int wc, int fr, int fq) const {
        const int row0 = u.pm * 256 + wr * 64 + fr, c0 = u.pn * 256 + wc * 32 + 8 * fq;
        u32x4 o[4][2], w0[4][2]; float p0[4], p1[4];
#pragma unroll
        for (int m = 0; m < 4; ++m)
#pragma unroll
            for (int bj = 0; bj < 2; ++bj) o[m][bj] = *(const u32x4*)(hb + (size_t)(row0 + m * 16) * DM + c0 + bj * 128);
#pragma unroll
        for (int m = 0; m < 4; ++m) { p0[m] = 0.f; w0[m][0] = upd(acc, 0, 0, m, o[m][0], p0[m]); w0[m][1] = upd(acc, 0, 1, m, o[m][1], p0[m]); }
#pragma unroll
        for (int m = 0; m < 4; ++m)
#pragma unroll
            for (int bj = 0; bj < 2; ++bj) o[m][bj] = *(const u32x4*)(hb + (size_t)(row0 + 128 + m * 16) * DM + c0 + bj * 128);
#pragma unroll
        for (int m = 0; m < 4; ++m)
#pragma unroll
            for (int bj = 0; bj < 2; ++bj) *(u32x4*)(hb + (size_t)(row0 + m * 16) * DM + c0 + bj * 128) = w0[m][bj];
#pragma unroll
        for (int m = 0; m < 4; ++m) { p1[m] = 0.f;
#pragma unroll
            for (int bj = 0; bj < 2; ++bj) *(u32x4*)(hb + (size_t)(row0 + 128 + m * 16) * DM + c0 + bj * 128) = upd(acc, 1, bj, m, o[m][bj], p1[m]); }
#pragma unroll
        for (int m = 0; m < 4; ++m) {
            float a = p0[m], b = p1[m];
            a += __shfl_xor(a, 16); a += __shfl_xor(a, 32); b += __shfl_xor(b, 16); b += __shfl_xor(b, 32);
            if (ssq != nullptr && fq == 0) { atomicAdd(ssq + row0 + m * 16, (u64_t)(unsigned)(a * SSQ_SCALE + 0.5f)); atomicAdd(ssq + row0 + 128 + m * 16, (u64_t)(unsigned)(b * SSQ_SCALE + 0.5f)); }
        }
    }
};
struct EpiFinal {
    static constexpr bool PERM = true, AFTER_DRAIN = false, APERM = false, BD = false;
    const bf16_t* hb; float* out; float sc;
    __device__ __forceinline__ void operator()(const f32x4 (&acc)[2][2][4][2], const Unit& u, int wr, int wc, int fr, int fq) const {
        const int row0 = u.pm * 256 + wr * 64 + fr, c0 = u.pn * 256 + wc * 32 + 8 * fq;
        u32x4 o[2][4][2];
#pragma unroll
        for (int ai = 0; ai < 2; ++ai)
#pragma unroll
            for (int m = 0; m < 4; ++m)
#pragma unroll
                for (int bj = 0; bj < 2; ++bj) o[ai][m][bj] = *(const u32x4*)(hb + (size_t)(row0 + ai * 128 + m * 16) * DM + c0 + bj * 128);
#pragma unroll
        for (int ai = 0; ai < 2; ++ai)
#pragma unroll
            for (int m = 0; m < 4; ++m) {
                const size_t ro = (size_t)(row0 + ai * 128 + m * 16) * DM + c0;
#pragma unroll
                for (int bj = 0; bj < 2; ++bj) { const u32x4 ov = o[ai][m][bj]; f32x4 v0 = acc[ai][bj][m][0] * sc, v1 = acc[ai][bj][m][1] * sc;
                    v0[0] += bflo(ov.x); v0[1] += bfhi(ov.x); v0[2] += bflo(ov.y); v0[3] += bfhi(ov.y); v1[0] += bflo(ov.z); v1[1] += bfhi(ov.z); v1[2] += bflo(ov.w); v1[3] += bfhi(ov.w);
                    *(f32x4*)(out + ro + bj * 128) = v0; *(f32x4*)(out + ro + bj * 128 + 4) = v1; }
            }
    }
};
struct EpiNull {
    static constexpr bool PERM = true, AFTER_DRAIN = false, APERM = false, BD = false;
    __device__ __forceinline__ void operator()(const f32x4 (&acc)[2][2][4][2], const Unit& u, int wr, int wc, int fr, int fq) const {
#pragma unroll
        for (int ai = 0; ai < 2; ++ai)
#pragma unroll
            for (int bj = 0; bj < 2; ++bj)
#pragma unroll
                for (int m = 0; m < 4; ++m)
#pragma unroll
                    for (int n = 0; n < 2; ++n) asm volatile("" :: "v"(acc[ai][bj][m][n]));
    }
};
struct EpiUp {
    static constexpr bool PERM = true, AFTER_DRAIN = false, APERM = false, BD = false;
    bf16_t *gpre, *up; const u64_t* ssq;
    __device__ __forceinline__ void operator()(const f32x4 (&acc)[2][2][4][2], const Unit& u, int wr, int wc, int fr, int fq) const {
        const int row0 = u.pm * 256 + wr * 64 + fr, c0 = u.pn * 128 + wc * 32 + 8 * fq;
        u64_t sv[2][4];
#pragma unroll
        for (int ai = 0; ai < 2; ++ai)
#pragma unroll
            for (int m = 0; m < 4; ++m) sv[ai][m] = ssq[row0 + ai * 128 + m * 16];
#pragma unroll
        for (int ai = 0; ai < 2; ++ai)
#pragma unroll
            for (int m = 0; m < 4; ++m) {
                const int row = row0 + ai * 128 + m * 16; const float r = rsqrtf((float)sv[ai][m] * (SSQ_INV / DM) + EPSF);
                const size_t o = (size_t)row * DFF + c0;
                *(u32x4*)(gpre + o) = pack8(acc[ai][0][m][0] * r, acc[ai][0][m][1] * r);
                *(u32x4*)(up + o) = pack8(acc[ai][1][m][0] * r, acc[ai][1][m][1] * r);
            }
    }
};

template <int MODE> struct EpiUpConvT {
    static constexpr bool PERM = true, AFTER_DRAIN = false, APERM = true, BD = false;
    bf16_t* act; const u64_t* ssq; const float* cw; const float* hg; const float* mgu; char* xlds; int rt;
    __device__ __forceinline__ void operator()(const f32x4 (&acc)[2][2][4][2], const Unit& u, int wr, int wc, int fr, int fq) const {
        const int pm = u.pm, pn = u.pn, cl = wc * 32 + 8 * fq, ch0 = pn * 128 + cl, t0 = pm * 256 + 8 * (16 * wr + fr);
        u64_t sv[8];
#pragma unroll
        for (int j = 0; j < 8; ++j) sv[j] = (MODE == 2) ? (u64_t)(1000000 + j + rt) : ssq[t0 + j];
        float w0[8], w1[8], w2[8], b1[8], b2[8];
        { const f32x4 a0 = *(const f32x4*)(cw + ch0), a1 = *(const f32x4*)(cw + ch0 + 4), c0 = *(const f32x4*)(cw + DFF + ch0), c1 = *(const f32x4*)(cw + DFF + ch0 + 4),
                      e0 = *(const f32x4*)(cw + 2 * DFF + ch0), e1 = *(const f32x4*)(cw + 2 * DFF + ch0 + 4);
          const float* h2 = ((pm & 7) == 0) ? mgu + 14 * 5632 + pn * 256 + cl : hg + (size_t)(pm * 2) * DFF + ch0;
          const float* h1 = ((pm & 7) == 0) ? mgu + 15 * 5632 + pn * 256 + cl : hg + (size_t)(pm * 2 + 1) * DFF + ch0;
          const f32x4 p20 = *(const f32x4*)h2, p21 = *(const f32x4*)(h2 + 4), p10 = *(const f32x4*)h1, p11 = *(const f32x4*)(h1 + 4);
#pragma unroll
          for (int c = 0; c < 4; ++c) { w0[c] = a0[c]; w0[4 + c] = a1[c]; w1[c] = c0[c]; w1[4 + c] = c1[c]; w2[c] = e0[c]; w2[4 + c] = e1[c]; b2[c] = p20[c]; b2[4 + c] = p21[c]; b1[c] = p10[c]; b1[4 + c] = p11[c]; } }
        float rs[8];
#pragma unroll
        for (int j = 0; j < 8; ++j) rs[j] = rsqrtf((float)sv[j] * (SSQ_INV / DM) + EPSF);
        float g6[8], g7[8];
#pragma unroll
        for (int c = 0; c < 8; ++c) { g6[c] = acc[1][0][2][c >> 2][c & 3] * rs[6]; g7[c] = acc[1][0][3][c >> 2][c & 3] * rs[7]; }
        float* xw = (float*)(xlds + ((wc * 4 + fq) * 16) * 4);
        if (wr == 0 && fr == 15) { *(f32x4*)xw = (f32x4){g6[0], g6[1], g6[2], g6[3]}; *(f32x4*)(xw + 4) = (f32x4){g6[4], g6[5], g6[6], g6[7]};
                                   *(f32x4*)(xw + 8) = (f32x4){g7[0], g7[1], g7[2], g7[3]}; *(f32x4*)(xw + 12) = (f32x4){g7[4], g7[5], g7[6], g7[7]}; }
        asm volatile("s_waitcnt lgkmcnt(0)" ::: "memory");
        __builtin_amdgcn_s_barrier();
        asm volatile("" ::: "memory");
        if (wr == 1) { const f32x4 q0 = *(const f32x4*)xw, q1 = *(const f32x4*)(xw + 4), q2 = *(const f32x4*)(xw + 8), q3 = *(const f32x4*)(xw + 12);
#pragma unroll
            for (int c = 0; c < 4; ++c) { b2[c] = q0[c]; b2[4 + c] = q1[c]; b1[c] = q2[c]; b1[4 + c] = q3[c]; } }
        float gm1[8], gm2[8];
#pragma unroll
        for (int c = 0; c < 8; ++c) {
            gm1[c] = __int_as_float(__builtin_amdgcn_update_dpp(__float_as_int(b1[c]), __float_as_int(g7[c]), 0x111, 0xf, 0xf, false));
            gm2[c] = __int_as_float(__builtin_amdgcn_update_dpp(__float_as_int(b2[c]), __float_as_int(g6[c]), 0x111, 0xf, 0xf, false)); }
#pragma unroll
        for (int j = 0; j < 8; ++j) { const int ai = j >> 2, m = j & 3; float o[8];
#pragma unroll
            for (int c = 0; c < 8; ++c) { const float g = acc[ai][0][m][c >> 2][c & 3] * rs[j], up = acc[ai][1][m][c >> 2][c & 3] * rs[j];
                o[c] = silu_f(w0[c] * gm2[c] + w1[c] * gm1[c] + w2[c] * g) * up; gm2[c] = gm1[c]; gm1[c] = g; }
            u32x4 w; w.x = cvt_pk(o[0], o[1]); w.y = cvt_pk(o[2], o[3]); w.z = cvt_pk(o[4], o[5]); w.w = cvt_pk(o[6], o[7]);
            if (MODE != 1 || rt == 12345) ST16(act + (size_t)(t0 + j) * DFF + ch0, w); }
    }
};
typedef EpiUpConvT<0> EpiUpConv;

constexpr int MN_PITCH = 2064;
template <bool ALDS, class F> __device__ __forceinline__ void small_gemm16(const void* Ain, const bf16_t* Bt, int N, int K, const F& epi, char* red) {
    int tid_ = threadIdx.x; asm volatile("" : "+v"(tid_));
    const int lane = tid_ & 63, wid = tid_ >> 6, r = lane & 15, g = lane >> 4;
    const int kw = K >> 3, kb0 = wid * kw;
    for (int ct = blockIdx.x; ct < N / 16; ct += gridDim.x) {
        f32x4 acc = {0.f, 0.f, 0.f, 0.f};
        const bf16_t* bp = Bt + (size_t)(ct * 16 + r) * K + kb0 + g * 8;
        if (ALDS) { const char* ap = (const char*)Ain + r * MN_PITCH + (kb0 + g * 8) * 2;
#pragma unroll 4
            for (int k = 0; k < kw; k += 32) acc = mfma16(*(const bf16x8*)(ap + k * 2), *(const bf16x8*)(bp + k), acc);
        } else { const bf16_t* ap = (const bf16_t*)Ain + (size_t)r * K + kb0 + g * 8;
#pragma unroll 4
            for (int k = 0; k < kw; k += 32) acc = mfma16(*(const bf16x8*)(ap + k), *(const bf16x8*)(bp + k), acc); }
        *(f32x4*)(red + (wid * 64 + lane) * 16) = acc;
        __syncthreads();
        if (wid == 0) { f32x4 s = *(const f32x4*)(red + lane * 16);
#pragma unroll
            for (int w = 1; w < 8; ++w) s += *(const f32x4*)(red + (w * 64 + lane) * 16);
#pragma unroll
            for (int rr = 0; rr < 4; ++rr) epi(4 * g + rr, ct * 16 + r, s[rr]); }
        __syncthreads();
    }
}
__device__ __forceinline__ void meta_norm_lds(const float* hmeta, char* img) {
    int tid_ = threadIdx.x; asm volatile("" : "+v"(tid_));
    const int lane = tid_ & 63, wid = tid_ >> 6;
#pragma unroll
    for (int rr = 0; rr < 2; ++rr) { const int row = 2 * wid + rr; const float* src = hmeta + row * DM;
        f32x4 v[4]; float ss = 0.f;
#pragma unroll
        for (int i = 0; i < 4; ++i) { v[i] = ((const f32x4*)src)[lane + 64 * i]; ss += v[i][0] * v[i][0] + v[i][1] * v[i][1] + v[i][2] * v[i][2] + v[i][3] * v[i][3]; }
        ss = wave_sum(ss); const float rstd = rsqrtf(ss * (1.f / DM) + EPSF);
#pragma unroll
        for (int i = 0; i < 4; ++i) { u32x2 w; w.x = cvt_pk(v[i][0] * rstd, v[i][1] * rstd); w.y = cvt_pk(v[i][2] * rstd, v[i][3] * rstd); *(u32x2*)(img + row * MN_PITCH + (lane + 64 * i) * 8) = w; } }
    __syncthreads();
}
struct MEpiIn { unsigned char* ws; const float* bgate;
    __device__ __forceinline__ void operator()(int t, int n, float v) const {
        if (n < 1536) ((bf16_t*)(ws + M_RAW))[t * 1536 + n] = f2bf(v);
        else if (n < 2048) ((bf16_t*)(ws + M_Z))[t * 512 + n - 1536] = f2bf(v);
        else if (n < 2560) ((bf16_t*)(ws + M_BQ))[t * 512 + n - 2048] = f2bf(v);
        else if (n < 3072) ((bf16_t*)(ws + M_IQ))[t * 512 + n - 2560] = f2bf(v);
        else if (n < 3200) ((bf16_t*)(ws + M_K))[t * 128 + n - 3072] = f2bf(v);
        else if (n < 3328) ((bf16_t*)(ws + M_V))[t * 128 + n - 3200] = f2bf(v);
        else if (n < 3392) { }
        else if (n < 3408) ((float*)(ws + M_MISC))[t * 16 + n - 3392] = v;
        else if (n < 3584) { }
        else ((bf16_t*)(ws + M_GATES))[t * 2048 + n - 3584] = f2bf(SIG_META(v + bgate[n - 3584]));
    } };
struct MEpiBr { unsigned char* ws; float sca, scb;
    __device__ __forceinline__ void operator()(int t, int n, float v) const {
        const int ch = 128 * (n >> 8) + (n & 127), br = (n >> 7) & 1;
        const float g = bf2f(((const bf16_t*)(ws + M_GATES))[t * 2048 + br * 1024 + ch]);
        ((float*)(ws + M_GU))[t * 5632 + n] = g * v * (br ? scb : sca);
    } };
struct MEpiResid { float* h; float sc; __device__ __forceinline__ void operator()(int t, int n, float v) const { h[t * 1024 + n] += v * sc; } };
struct MEpiUp { float* gu; __device__ __forceinline__ void operator()(int t, int n, float v) const { gu[t * 5632 + n] = v; } };

struct MapId { __device__ __forceinline__ int operator()(int n) const { return n; } };
struct MapWin { __device__ __forceinline__ int operator()(int n) const {
    if (n < 2048) return n; if (n < 2560) return n - 2048 + 2056; if (n < 3072) return n - 2560 + 2824; if (n < 3200) return n - 3072 + 2568;
    if (n < 3328) return n - 3200 + 2696; if (n < 3392) return n - 3328 + 3336; if (n < 3400) return n - 3392 + 2048; if (n < 3408) return n; return -1; } };
struct MapWup { __device__ __forceinline__ int operator()(int n) const { const int t = n >> 8, w = n & 255; return w < 128 ? 128 * t + w : 2816 + 128 * t + (w - 128); } };
struct MapBrA { __device__ __forceinline__ int operator()(int n) const { return (n & 255) < 128 ? 128 * (n >> 8) + (n & 127) : -1; } };
struct MapBrB { __device__ __forceinline__ int operator()(int n) const { return (n & 255) >= 128 ? 128 * (n >> 8) + (n & 127) : -1; } };
template <class Map> __device__ __forceinline__ void tr_cvt(const float* __restrict__ src, int ldsrc, int K, bf16_t* __restrict__ dst, int ldd, int koff, int Nd, const Map& map, const float* gain, float* tile, int& g0) {
    const int G = gridDim.x, tid = threadIdx.x, nnt = Nd / 64, nt = nnt * (K / 128);
    int t = ((int)blockIdx.x - (g0 % G) + G) % G;
    for (; t < nt; t += G) {
        const int n0 = (t % nnt) * 64, k0 = (t / nnt) * 128;
        { const int nn = tid & 63, col = map(n0 + nn); float v[16];
#pragma unroll
          for (int i = 0; i < 16; ++i) { const int kk = (tid >> 6) + 8 * i; v[i] = col >= 0 ? src[(size_t)(k0 + kk) * ldsrc + col] : 0.f; }
#pragma unroll
          for (int i = 0; i < 16; ++i) { const int kk = (tid >> 6) + 8 * i; tile[kk * 65 + nn] = v[i]; } }
        __syncthreads();
#pragma unroll
        for (int hh = 0; hh < 2; ++hh) { const int nn = tid >> 3, part = (tid & 7) + 8 * hh; float v[8];
#pragma unroll
          for (int jj = 0; jj < 8; ++jj) { const int kk = part * 8 + jj; v[jj] = tile[kk * 65 + nn] * (gain ? gain[k0 + kk] : 1.f); }
          u32x4 w; w.x = cvt_pk(v[0], v[1]); w.y = cvt_pk(v[2], v[3]); w.z = cvt_pk(v[4], v[5]); w.w = cvt_pk(v[6], v[7]);
          *(u32x4*)(dst + (size_t)(n0 + nn) * ldd + koff + k0 + part * 8) = w; }
        __syncthreads();
    }
    g0 += nt;
}
__device__ __forceinline__ void p_prologue(const Args& a, char* smem) {
    unsigned char* ws = a.ws; { size_t z_ = 0; asm volatile("" : "+s"(z_)); ws += z_; } float* tile = (float*)smem; int g0 = 0;
    for (int l = 0; l < NLAYER; ++l) {
        const float* gmix = a.in[I_NORM_MIX] + l * DM; const float* gffn = a.in[I_NORM_FFN] + l * DM;
        tr_cvt(a.in[I_W_IN] + (size_t)l * DM * 3408, 3408, DM, (bf16_t*)(ws + OFF_WIN) + (size_t)l * NIN * DM, DM, 0, 3584, MapWin(), gmix, tile, g0);
        tr_cvt(a.in[I_W_GATE] + (size_t)l * DM * 2048, 2048, DM, (bf16_t*)(ws + OFF_WIN) + ((size_t)l * NIN + 3584) * DM, DM, 0, 2048, MapId(), gmix, tile, g0);
        tr_cvt(a.in[I_W_BA] + (size_t)l * 512 * DM, DM, 512, (bf16_t*)(ws + OFF_WBR) + (size_t)l * 2048 * DM, DM, 0, 2048, MapBrA(), nullptr, tile, g0);
        tr_cvt(a.in[I_W_BB] + (size_t)l * 512 * DM, DM, 512, (bf16_t*)(ws + OFF_WBR) + (size_t)l * 2048 * DM, DM, 512, 2048, MapBrB(), nullptr, tile, g0);
        tr_cvt(a.in[I_W_OUT] + (size_t)l * DM * DM, DM, DM, (bf16_t*)(ws + OFF_WOUT) + (size_t)l * DM * DM, DM, 0, DM, MapId(), nullptr, tile, g0);
        tr_cvt(a.in[I_W_UP] + (size_t)l * DM * 5632, 5632, DM, (bf16_t*)(ws + OFF_WUP) + (size_t)l * NIN * DM, DM, 0, NIN, MapWup(), gffn, tile, g0);
        tr_cvt(a.in[I_W_DOWN] + (size_t)l * DFF * DM, DM, DFF, (bf16_t*)(ws + OFF_WDN) + (size_t)l * DM * DFF, DFF, 0, DM, MapId(), nullptr, tile, g0);
    }
    const int gt = blockIdx.x * 512 + threadIdx.x, nT = gridDim.x * 512;
    { const int lane = threadIdx.x & 63, gw = blockIdx.x * 8 + (threadIdx.x >> 6), nW = gridDim.x * 8;
      bf16_t* hb = (bf16_t*)(ws + OFF_HB); u64_t* ssq = (u64_t*)(ws + OFF_SSQ);
      for (int row = 2 * gw; row < RR; row += 2 * nW) { const float* src = a.in[I_X] + (size_t)row * DM; float ss0 = 0.f, ss1 = 0.f; f32x4 v[8];
#pragma unroll
          for (int i = 0; i < 8; ++i) v[i] = ((const f32x4*)src)[lane + 64 * i];
#pragma unroll
          for (int i = 0; i < 8; ++i) { u32x2 w; w.x = cvt_pk(v[i][0], v[i][1]); w.y = cvt_pk(v[i][2], v[i][3]);
              const float q = bflo(w.x) * bflo(w.x) + bfhi(w.x) * bfhi(w.x) + bflo(w.y) * bflo(w.y) + bfhi(w.y) * bfhi(w.y); if (i < 4) ss0 += q; else ss1 += q;
              ((u32x2*)(hb + (size_t)row * DM))[lane + 64 * i] = w; }
          ss0 = wave_sum(ss0); ss1 = wave_sum(ss1); if (lane == 0) { ssq[row] = (u64_t)(ss0 * SSQ_SCALE + 0.5f); ssq[row + 1] = (u64_t)(ss1 * SSQ_SCALE + 0.5f); } }
      for (int i = gt; i < 3 * RR; i += nT) ssq[RR + i] = 0ull; }
    float* cosA = (float*)(ws + OFF_COSA); float* sinA = (float*)(ws + OFF_SINA); float* cosI = (float*)(ws + OFF_COSI); float* sinI = (float*)(ws + OFF_SINI);
    for (int i = gt; i < TPOS * 96; i += nT) {
        const int pos = i / 96, j = i % 96;
        if (j < 64) { const float inv = 1.0f / powf(10000.f, (float)(2 * j) / 128.f), ang = (float)pos * inv; cosA[pos * 64 + j] = cosf(ang); sinA[pos * 64 + j] = sinf(ang); }
        else { const int jj = j - 64; const float inv = 1.0f / powf(10000.f, (float)(2 * jj) / 64.f), ang = (float)pos * inv; cosI[pos * 32 + jj] = cosf(ang); sinI[pos * 32 + jj] = sinf(ang); }
    }
    for (int i = gt; i < 16 * 1024; i += nT) ((float*)(ws + M_H))[i] = a.in[I_META][i];
    for (int i = gt; i < NB * (TP - TPOS) * 16; i += nT) {
        const int b = i / ((TP - TPOS) * 16), r = i % ((TP - TPOS) * 16);
        const size_t o = ((size_t)b * TP + TPOS) * 128 + (size_t)r * 8;
        *(u32x4*)((bf16_t*)(ws + OFF_KB) + o) = (u32x4){0u, 0u, 0u, 0u}; *(u32x4*)((bf16_t*)(ws + OFF_VB) + o) = (u32x4){0u, 0u, 0u, 0u};
    }
}

template <int GL, bool NORM> __device__ __forceinline__ u32x4 rope8(u32x4 raw, int lig, const float* w, const float* cs, const float* sn) {
    float x[8] = {bflo(raw.x), bfhi(raw.x), bflo(raw.y), bfhi(raw.y), bflo(raw.z), bfhi(raw.z), bflo(raw.w), bfhi(raw.w)};
    if (NORM) { float ss = 0.f;
#pragma unroll
        for (int j = 0; j < 8; ++j) ss += x[j] * x[j];
        ss += dpp_mov<0xB1>(ss); ss += dpp_mov<0x4E>(ss); ss += dpp_mov<0x141>(ss); if (GL == 16) ss += dpp_mov<0x140>(ss);
        const float rstd = rsqrtf(ss * (1.f / (8 * GL)) + EPSF);
        const f32x4 w0 = *(const f32x4*)(w + 8 * lig), w1 = *(const f32x4*)(w + 8 * lig + 4);
#pragma unroll
        for (int j = 0; j < 4; ++j) { x[j] *= rstd * w0[j]; x[4 + j] *= rstd * w1[j]; } }
    const int ih = lig & (GL / 2 - 1); const bool second = lig >= GL / 2;
    const f32x4 c0 = *(const f32x4*)(cs + 8 * ih), c1 = *(const f32x4*)(cs + 8 * ih + 4), s0 = *(const f32x4*)(sn + 8 * ih), s1 = *(const f32x4*)(sn + 8 * ih + 4);
    float o[8];
#pragma unroll
    for (int j = 0; j < 8; ++j) { const float other = (GL == 16) ? dpp_mov<0x128>(x[j]) : dpp_mov<0x1B>(dpp_mov<0x141>(x[j])), cc = j < 4 ? c0[j] : c1[j - 4], ss_ = j < 4 ? s0[j] : s1[j - 4];
        o[j] = x[j] * cc + (second ? other * ss_ : -other * ss_); }
    u32x4 r; r.x = cvt_pk(o[0], o[1]); r.y = cvt_pk(o[2], o[3]); r.z = cvt_pk(o[4], o[5]); r.w = cvt_pk(o[6], o[7]); return r;
}
#ifndef SBAR
#define SBAR() __builtin_amdgcn_sched_barrier(0)
#endif
namespace mp {
constexpr int RAW_OFF = 0, QS_OFF = 51712, KS_OFF = 70144, MT_OFF = 88576, GC_OFF = 154112, BT_OFF = 155136, RED_OFF = 156160, CNT_OFF = 157184;
}
__device__ __forceinline__ void p_mixprep(const Args& a, int layer, char* smem, bool do_store, int skip = 0) {
    using namespace mp;
    unsigned char* ws = a.ws; { size_t z_ = 0; asm volatile("" : "+s"(z_)); ws += z_; }
    bf16_t* qkv = (bf16_t*)(ws + OFF_QKV); const bf16_t* halo = (const bf16_t*)(ws + OFF_HALO); const bf16_t* mraw = (const bf16_t*)(ws + M_RAW);
    bf16_t* mchunk = (bf16_t*)(ws + M_CHUNK); bf16_t* TQ = (bf16_t*)(ws + OFF_TQ); bf16_t* mTQ = (bf16_t*)(ws + M_TQ);
    const float* conv_a = a.in[I_CONV_A] + (size_t)layer * 4 * 1536;
    const float* a_log = a.in[I_A_LOG] + layer * 4; const float* dt_bias = a.in[I_DT_BIAS] + layer * 4;
    const float* qn = a.in[I_Q_NORM] + layer * 128; const float* kn = a.in[I_K_NORM] + layer * 128; const float* kin = a.in[I_KIDX_NORM] + layer * 64;
    const float* cosA = (const float*)(ws + OFF_COSA); const float* sinA = (const float*)(ws + OFF_SINA); const float* cosI = (const float*)(ws + OFF_COSI); const float* sinI = (const float*)(ws + OFF_SINI);
    float* GCs = (float*)(smem + GC_OFF); float* BTs = (float*)(smem + BT_OFF); float* RED = (float*)(smem + RED_OFF);
    bf16_t* QS = (bf16_t*)(smem + QS_OFF); bf16_t* KS = (bf16_t*)(smem + KS_OFF); bf16_t* RV = (bf16_t*)(smem + RAW_OFF + 2 * 67 * 256);
    for (int item = blockIdx.x; item < 1028; item += gridDim.x) {
        int tid_ = threadIdx.x; asm volatile("" : "+v"(tid_));
        const int tid = tid_, lane = tid & 63, wid = __builtin_amdgcn_readfirstlane(tid >> 6);
        const bool is_meta = item >= 1024; const int b = item >> 5, c = item & 31, row0 = b * 2048 + 64 * c;
        const int h_lo = is_meta ? item - 1024 : 0, h_hi = is_meta ? h_lo + 1 : 4;
        { float g = 0.f, be = 0.f; const int t = tid >> 2, h = tid & 3;
          if (tid < 256 && (!is_meta || t >= 48)) { const float* mpp = is_meta ? (const float*)(ws + M_MISC) + (t - 48) * 16 : (const float*)(ws + OFF_MISC) + (size_t)(row0 + t) * 16;
              g = -__expf(a_log[h]) * softplus_f(mpp[h] + dt_bias[h]); be = SIG_BETA(mpp[4 + h]); }
          float s = g;
#pragma unroll
          for (int o = 4; o < 64; o <<= 1) { const float v = __shfl_up(s, o); if (lane >= o) s += v; }
          if (tid < 256 && lane >= 60) RED[wid * 4 + (lane & 3)] = s;
          __syncthreads();
          if (tid < 256) { for (int w = 0; w < wid; ++w) s += RED[w * 4 + h]; GCs[tid] = s; BTs[tid] = be; } }
        __syncthreads();
        if (do_store && tid < 256 && item <= 1024) { float* gd = is_meta ? (float*)(ws + M_GC) : (float*)(ws + OFF_GC) + (size_t)row0 * 4; float* bd = is_meta ? (float*)(ws + M_BETA) : (float*)(ws + OFF_BETA) + (size_t)row0 * 4;
            gd[tid] = GCs[tid]; bd[tid] = BTs[tid]; }
        const bf16_t* zsrc = (const bf16_t*)(ws + OFF_KB) + (size_t)TPOS * 128;
#define MP_DMA(hh, plo, phi) do { int td_ = tid; asm volatile("" : "+v"(td_)); _Pragma("unroll 1") for (int it = 0; it < 7; ++it) { const int p = td_ + 512 * it; \
            if (p >= (plo) && p < (phi)) { const int tensor = p / (67 * 16), rem = p - tensor * (67 * 16), rr = rem >> 4, cc = (rem & 15) * 8, tt = rr - 3, col = tensor * 512 + (hh) * 128 + cc; \
                const bf16_t* sp = zsrc; \
                if (!is_meta) { if (tt >= 0) sp = qkv + (size_t)(row0 + tt) * 1536 + col; else if (c > 0) sp = halo + ((size_t)((row0 >> 6) - 1) * 3 + (tt + 3)) * 1536 + col; \
                    else sp = mraw + (size_t)(16 + tt) * 1536 + col; } \
                else if (tt >= 48) sp = mraw + (size_t)(tt - 48) * 1536 + col; \
                __builtin_amdgcn_global_load_lds((const unsigned*)sp, (LAS unsigned*)(smem + RAW_OFF + (wid * 64 + 512 * it) * 16), 16, 0, 0); } } } while (0)
        MP_DMA(h_lo, 0, 3 * 67 * 16);
        for (int h = h_lo; h < ((skip & 8) ? h_lo : h_hi); ++h) {
            const int co = lane & 15, t0 = 2 * (wid * 4 + (lane >> 4));
            f32x4 cw[3][4][2];
#pragma unroll
            for (int tensor = 0; tensor < 3; ++tensor)
#pragma unroll
                for (int k = 0; k < 4; ++k) { const float* wp = conv_a + k * 1536 + tensor * 512 + h * 128 + 8 * co; cw[tensor][k][0] = *(const f32x4*)wp; cw[tensor][k][1] = *(const f32x4*)(wp + 4); }
            asm volatile("s_waitcnt vmcnt(0)" ::: "memory");
            __syncthreads();
            u32x4 ov[2];
#pragma unroll
            for (int tensor = 0; tensor < 3; ++tensor) {
                const char* rp = smem + RAW_OFF + tensor * 67 * 256 + t0 * 256 + co * 16;
                float x[5][8];
#pragma unroll
                for (int r = 0; r < 5; ++r) { const u32x4 v = *(const u32x4*)(rp + r * 256);
                    x[r][0] = bflo(v.x); x[r][1] = bfhi(v.x); x[r][2] = bflo(v.y); x[r][3] = bfhi(v.y); x[r][4] = bflo(v.z); x[r][5] = bfhi(v.z); x[r][6] = bflo(v.w); x[r][7] = bfhi(v.w); }
#pragma unroll
                for (int i = 0; i < 2; ++i) { float y[8]; float ss = 0.f;
#pragma unroll
                    for (int j = 0; j < 8; ++j) { const float pre = cw[tensor][0][j >> 2][j & 3] * x[i][j] + cw[tensor][1][j >> 2][j & 3] * x[i + 1][j] + cw[tensor][2][j >> 2][j & 3] * x[i + 2][j] + cw[tensor][3][j >> 2][j & 3] * x[i + 3][j];
                        y[j] = (skip & 32) ? x[i + 3][j] : silu_f(pre); ss += y[j] * y[j]; }
                    if (tensor < 2) { if (!(skip & 1)) ss = row_sum16(ss);
                        const float rn = rsqrtf(ss + EPSF) * (tensor == 0 ? 0.08838834764831845f : 1.f);
#pragma unroll
                        for (int j = 0; j < 8; ++j) y[j] *= rn; }
                    u32x4 o; o.x = cvt_pk(y[0], y[1]); o.y = cvt_pk(y[2], y[3]); o.z = cvt_pk(y[4], y[5]); o.w = cvt_pk(y[6], y[7]);
                    if (tensor == 0) *(u32x4*)(QS + (t0 + i) * 144 + 8 * co) = o; else if (tensor == 1) *(u32x4*)(KS + (t0 + i) * 144 + 8 * co) = o; else ov[i] = o; }
            }
            __syncthreads();
            if (h + 1 < h_hi) MP_DMA(h + 1, 0, 2 * 67 * 16);
            *(u32x4*)(RV + (t0 + 3) * 128 + 8 * co) = ov[0]; *(u32x4*)(RV + (t0 + 4) * 128 + 8 * co) = ov[1];
            __syncthreads();
            if (!(skip & 128)) { bf16_t* dbase = is_meta ? mchunk : qkv + (size_t)row0 * 1536;
              for (int p = tid; p < 3072; p += 512) { const int tensor = p >> 10, t = (p & 1023) >> 4, cc = (p & 15) * 8;
                  const bf16_t* sp = tensor == 0 ? QS + t * 144 + cc : (tensor == 1 ? KS + t * 144 + cc : RV + (t + 3) * 128 + cc);
                  if (do_store) *(u32x4*)(dbase + (size_t)t * 1536 + tensor * 512 + h * 128 + cc) = *(const u32x4*)sp; } }
            if (!(skip & 256)) { const int r = lane & 15, g = lane >> 4, mt = wid >> 1;
              bf16_t* tqd = is_meta ? mTQ + h * 8192 : TQ + (size_t)((row0 >> 6) * 4 + h) * 8192;
              float* MT = (float*)(smem + MT_OFF) + h * 4096;
#pragma unroll
              for (int nti = 0; nti < 2; ++nti) { const int nt = 2 * (wid & 1) + nti;
                  f32x4 akk = {0.f, 0.f, 0.f, 0.f}, aqk = {0.f, 0.f, 0.f, 0.f};
#pragma unroll
                  for (int s = 0; s < 4; ++s) {
                      const bf16x8 fk = *(const bf16x8*)(KS + (16 * mt + r) * 144 + 32 * s + 8 * g);
                      const bf16x8 fq = *(const bf16x8*)(QS + (16 * mt + r) * 144 + 32 * s + 8 * g);
                      const bf16x8 fb = *(const bf16x8*)(KS + (16 * nt + r) * 144 + 32 * s + 8 * g);
                      akk = mfma16(fk, fb, akk); aqk = mfma16(fq, fb, aqk); }
                  const int j = 16 * nt + r; const float gcj = GCs[j * 4 + h];
#pragma unroll
                  for (int rr = 0; rr < 4; ++rr) { const int i = 16 * mt + 4 * g + rr; const float gci = GCs[i * 4 + h], bi = BTs[i * 4 + h];
                      const float dec = (i >= j) ? __expf(gci - gcj) : 0.f;
                      MT[i * 64 + j] = (i > j) ? bi * akk[rr] * dec : 0.f;
                      if (do_store) tqd[4096 + i * 64 + j] = f2bf((i >= j) ? aqk[rr] * dec : 0.f); } } }
            __syncthreads();
            if (h + 1 < h_hi) MP_DMA(h + 1, 2 * 67 * 16, 3 * 67 * 16);
        }
#undef MP_DMA
        if (!(skip & 2) && wid < 4 && wid >= h_lo && wid < h_hi) { const int hh = wid;
            float* MT = (float*)(smem + MT_OFF) + hh * 4096;
            float tr[64]; f32x4 mb[3][4];
#define SUB_LD(buf, r_, k_) do { _Pragma("unroll") for (int x = 0; x < 4; ++x) mb[buf][x] = *(const f32x4*)(MT + (4 * (r_) + x) * 64 + 4 * (k_)); } while (0)
#define SUB_NEXT(buf, r_, k_) do { if ((k_) < (r_)) SUB_LD(buf, r_, (k_) + 1); else if ((r_) < 15) SUB_LD(buf, (r_) + 1, 0); } while (0)
            SUB_LD(0, 0, 0); SUB_LD(1, 1, 0);
#pragma unroll
            for (int r = 0; r < 16; ++r) { const int i0 = 4 * r;
                float a0 = (lane == i0) ? 1.f : 0.f, a1 = (lane == i0 + 1) ? 1.f : 0.f, a2 = (lane == i0 + 2) ? 1.f : 0.f, a3 = (lane == i0 + 3) ? 1.f : 0.f;
#pragma unroll
                for (int k = 0; k <= r; ++k) { const int n = r * (r + 1) / 2 + k, cur = n % 3, nx = (n + 2) % 3;
                    { const int r1 = (k < r) ? r : r + 1, k1 = (k < r) ? k + 1 : 0; if (r1 < 16) SUB_NEXT(nx, r1, k1); }
                    SBAR();
                    if (k < r) { const f32x4 m0 = mb[cur][0], m1 = mb[cur][1], m2 = mb[cur][2], m3 = mb[cur][3]; const float t0 = tr[4 * k], t1 = tr[4 * k + 1], t2 = tr[4 * k + 2], t3 = tr[4 * k + 3];
                        a0 = fmaf(-m0[0], t0, a0); a1 = fmaf(-m1[0], t0, a1); a2 = fmaf(-m2[0], t0, a2); a3 = fmaf(-m3[0], t0, a3);
                        a0 = fmaf(-m0[1], t1, a0); a1 = fmaf(-m1[1], t1, a1); a2 = fmaf(-m2[1], t1, a2); a3 = fmaf(-m3[1], t1, a3);
                        a0 = fmaf(-m0[2], t2, a0); a1 = fmaf(-m1[2], t2, a1); a2 = fmaf(-m2[2], t2, a2); a3 = fmaf(-m3[2], t2, a3);
                        a0 = fmaf(-m0[3], t3, a0); a1 = fmaf(-m1[3], t3, a1); a2 = fmaf(-m2[3], t3, a2); a3 = fmaf(-m3[3], t3, a3); }
                    else { const f32x4 d1 = mb[cur][1], d2 = mb[cur][2], d3 = mb[cur][3];
                        a1 -= d1[0] * a0; a2 -= d2[0] * a0 + d2[1] * a1; a3 -= d3[0] * a0 + d3[1] * a1 + d3[2] * a2;
                        tr[i0] = a0; tr[i0 + 1] = a1; tr[i0 + 2] = a2; tr[i0 + 3] = a3; }
                    SBAR();
                }
            }
#undef SUB_LD
#undef SUB_NEXT
#pragma unroll
            for (int i = 0; i < 64; ++i) MT[i * 64 + lane] = tr[i];
            bf16_t* td = is_meta ? mTQ + hh * 8192 : TQ + (size_t)((row0 >> 6) * 4 + hh) * 8192;
            if (do_store) for (int it = 0; it < 8; ++it) { const int p = lane + 64 * it; const f32x4 v0 = *(const f32x4*)(MT + p * 8), v1 = *(const f32x4*)(MT + p * 8 + 4);
                *(u32x4*)(td + p * 8) = pack8(v0, v1); }
        }
#ifndef TOK_SPLIT
#define TOK_SPLIT 1
#endif
        const bool tokp = !(skip & 4) && item <= 1024 && (wid >= 4 || (TOK_SPLIT && !is_meta));
        if (tokp) {
            bf16_t* kb = (bf16_t*)(ws + OFF_KB); bf16_t* vb = (bf16_t*)(ws + OFF_VB); bf16_t* ikb = (bf16_t*)(ws + OFF_IKB);
            const int ntok = is_meta ? 4 : (TOK_SPLIT ? (wid >= 4 ? 12 : 4) : 16), tbase = is_meta ? (wid - 4) * 4 : (TOK_SPLIT ? (wid >= 4 ? (wid - 4) * 12 : 48 + wid * 4) : (wid - 4) * 16);
            const int uk = lane >> 4, ui = (lane >> 3) & 3;
            u32x4 rq[4], ri[4], rk, rik, nq[4], ni[4], nk, nik;
#define TP_LOAD(Q, I, K, IK, tb) do { _Pragma("unroll") for (int u = 0; u < 4; ++u) { const int tl = (tb) + u; const size_t row = (size_t)row0 + tl; \
                    const bf16_t* qp = is_meta ? (const bf16_t*)(ws + M_BQ) + tl * 512 : (const bf16_t*)(ws + OFF_BQ) + row * 512; \
                    const bf16_t* ip = is_meta ? (const bf16_t*)(ws + M_IQ) + tl * 512 : (const bf16_t*)(ws + OFF_IQ) + row * 512; \
                    Q[u] = *(const u32x4*)(qp + lane * 8); I[u] = *(const u32x4*)(ip + lane * 8); } \
                { const int tlk = (tb) + uk, tli = (tb) + ui; \
                  K = *(const u32x4*)(is_meta ? (const bf16_t*)(ws + M_K) + tlk * 128 + (lane & 15) * 8 : kb + ((size_t)b * TP + 16 + 64 * c + tlk) * 128 + (lane & 15) * 8); \
                  IK = *(const u32x4*)(is_meta ? (const bf16_t*)(ws + M_K) + tli * 128 : ikb + ((size_t)b * TP + 16 + 64 * c + tli) * 64 + (lane & 7) * 8); } } while (0)
            TP_LOAD(rq, ri, rk, rik, tbase);
            for (int t0 = 0; t0 < ntok; t0 += 4) {
                if (t0 + 4 < ntok) TP_LOAD(nq, ni, nk, nik, tbase + t0 + 4);
#pragma unroll
                for (int u = 0; u < 4; ++u) { const int tl = tbase + t0 + u; const size_t row = (size_t)row0 + tl; const int pos = is_meta ? tl : 16 + 64 * c + tl;
                    const u32x4 oq = rope8<16, true>(rq[u], lane & 15, qn, cosA + pos * 64, sinA + pos * 64);
                    const u32x4 oi = rope8<8, false>(ri[u], lane & 7, nullptr, cosI + pos * 32, sinI + pos * 32);
                    bf16_t* qp = is_meta ? (bf16_t*)(ws + M_BQ) + tl * 512 : (bf16_t*)(ws + OFF_BQ) + row * 512;
                    bf16_t* ip = is_meta ? (bf16_t*)(ws + M_IQ) + tl * 512 : (bf16_t*)(ws + OFF_IQ) + row * 512;
                    if (do_store) { *(u32x4*)(qp + lane * 8) = oq; *(u32x4*)(ip + lane * 8) = oi; } }
                { const int tlk = tbase + t0 + uk, tli = tbase + t0 + ui, posk = is_meta ? tlk : 16 + 64 * c + tlk, posi = is_meta ? tli : 16 + 64 * c + tli;
                  const u32x4 ok = rope8<16, true>(rk, lane & 15, kn, cosA + posk * 64, sinA + posk * 64);
                  if (!is_meta) { const u32x4 oik = rope8<8, true>(rik, lane & 7, kin, cosI + posi * 32, sinI + posi * 32);
                      if (do_store) { *(u32x4*)(kb + ((size_t)b * TP + posk) * 128 + (lane & 15) * 8) = ok; if (lane < 32) *(u32x4*)(ikb + ((size_t)b * TP + posi) * 64 + (lane & 7) * 8) = oik; } }
                  else if (do_store) {
                      const u32x4 vv = *(const u32x4*)((const bf16_t*)(ws + M_V) + tlk * 128 + (lane & 15) * 8);
                      for (int bb = 0; bb < NB; ++bb) { *(u32x4*)(kb + ((size_t)bb * TP + tlk) * 128 + (lane & 15) * 8) = ok; *(u32x4*)(vb + ((size_t)bb * TP + tlk) * 128 + (lane & 15) * 8) = vv; } } }
#pragma unroll
                for (int u = 0; u < 4; ++u) { rq[u] = nq[u]; ri[u] = ni[u]; }
                rk = nk; rik = nik;
            }
#undef TP_LOAD
        }
        __syncthreads();
    }
}

namespace gs { constexpr int KN_OFF = 0, KT_OFF = 17408, QN_OFF = 35840, VT_OFF = 53248, TT_OFF = 71680, QK_OFF = 80896, GC_OFF = 90112, BT_OFF = 90368, OT_OFF = 90624; }
__device__ __forceinline__ bf16x8 frag2(const char* base, int off) { return *(const bf16x8*)(base + off); }
__device__ __forceinline__ void gdn_scan_item(const Args& a, int layer, int b, int h, char* smem) {
    using namespace gs;
    unsigned char* ws = a.ws; { size_t z_ = 0; asm volatile("" : "+s"(z_)); ws += z_; }
    int tid_ = threadIdx.x; asm volatile("" : "+v"(tid_));
    const int tid = tid_, lane = tid & 63, wid = __builtin_amdgcn_readfirstlane(tid >> 6), r = lane & 15, g = lane >> 4, e0 = 16 * wid;
    const bf16_t* qkv = (const bf16_t*)(ws + OFF_QKV); const bf16_t* mchunk = (const bf16_t*)(ws + M_CHUNK);
    const bf16_t* TQ = (const bf16_t*)(ws + OFF_TQ); const bf16_t* mTQ = (const bf16_t*)(ws + M_TQ);
    const float* ng = a.in[I_A_OUT_NORM] + layer * 128;
    const float ng1 = ng[lane], ng2 = ng[lane + 64];
    f32x4 S[8];
#pragma unroll
    for (int i = 0; i < 8; ++i) S[i] = (f32x4){0.f, 0.f, 0.f, 0.f};
    u32x4 pk[2], pq[2], pv[2], pt, pqk; float psc = 0.f;
#define GS_LOAD(n) do { const int n_ = (n); \
        const bf16_t* qb_ = n_ == 0 ? mchunk : qkv + (size_t)(b * 2048 + 64 * (n_ - 1)) * 1536; \
        const bf16_t* tq_ = n_ == 0 ? mTQ + h * 8192 : TQ + (size_t)((b * 32 + n_ - 1) * 4 + h) * 8192; \
        const float* gc_ = n_ == 0 ? (const float*)(ws + M_GC) : (const float*)(ws + OFF_GC) + (size_t)(b * 2048 + 64 * (n_ - 1)) * 4; \
        const float* bt_ = n_ == 0 ? (const float*)(ws + M_BETA) : (const float*)(ws + OFF_BETA) + (size_t)(b * 2048 + 64 * (n_ - 1)) * 4; \
        _Pragma("unroll") for (int i_ = 0; i_ < 2; ++i_) { const int p_ = tid + 512 * i_, cr_ = p_ >> 4, d0_ = (p_ & 15) * 8; const bf16_t* rp_ = qb_ + (size_t)cr_ * 1536 + h * 128 + d0_; \
            pq[i_] = *(const u32x4*)rp_; pk[i_] = *(const u32x4*)(rp_ + 512); pv[i_] = *(const u32x4*)(rp_ + 1024); } \
        pt = *(const u32x4*)(tq_ + (tid >> 3) * 64 + (tid & 7) * 8); pqk = *(const u32x4*)(tq_ + 4096 + (tid >> 3) * 64 + (tid & 7) * 8); \
        if (tid < 64) psc = gc_[tid * 4 + h]; else if (tid < 128) psc = bt_[(tid - 64) * 4 + h]; } while (0)
    GS_LOAD(0);
    for (int n = 0; n < 33; ++n) {
#pragma unroll
        for (int i = 0; i < 2; ++i) { const int p = tid + 512 * i, cr = p >> 4, d0 = (p & 15) * 8;
            { const int u = (d0 >> 3) & 3, pa = (d0 & ~31) + 16 * (u & 1) + 4 * (u >> 1);
              *(u32x2*)(smem + KN_OFF + cr * 272 + pa * 2) = (u32x2){pk[i].x, pk[i].y}; *(u32x2*)(smem + KN_OFF + cr * 272 + (pa + 8) * 2) = (u32x2){pk[i].z, pk[i].w};
              *(u32x2*)(smem + QN_OFF + cr * 272 + pa * 2) = (u32x2){pq[i].x, pq[i].y}; *(u32x2*)(smem + QN_OFF + cr * 272 + (pa + 8) * 2) = (u32x2){pq[i].z, pq[i].w}; }
            const int cp = (cr & ~31) + 8 * ((cr >> 2) & 3) + 4 * ((cr >> 4) & 1) + (cr & 3);
            bf16_t* kt = (bf16_t*)(smem + KT_OFF) + d0 * 72 + cp; bf16_t* vt = (bf16_t*)(smem + VT_OFF) + d0 * 72 + cp;
            const unsigned kw[4] = {pk[i].x, pk[i].y, pk[i].z, pk[i].w}, vw[4] = {pv[i].x, pv[i].y, pv[i].z, pv[i].w};
#pragma unroll
            for (int jj = 0; jj < 4; ++jj) { kt[(2 * jj) * 72] = (bf16_t)(kw[jj] & 0xffffu); kt[(2 * jj + 1) * 72] = (bf16_t)(kw[jj] >> 16);
                vt[(2 * jj) * 72] = (bf16_t)(vw[jj] & 0xffffu); vt[(2 * jj + 1) * 72] = (bf16_t)(vw[jj] >> 16); } }
        { const int c0 = (tid & 7) * 8, u = (c0 >> 3) & 3, pa = (c0 & ~31) + 16 * (u & 1) + 4 * (u >> 1), ro = (tid >> 3) * 144;
          *(u32x2*)(smem + TT_OFF + ro + pa * 2) = (u32x2){pt.x, pt.y}; *(u32x2*)(smem + TT_OFF + ro + (pa + 8) * 2) = (u32x2){pt.z, pt.w};
          *(u32x2*)(smem + QK_OFF + ro + pa * 2) = (u32x2){pqk.x, pqk.y}; *(u32x2*)(smem + QK_OFF + ro + (pa + 8) * 2) = (u32x2){pqk.z, pqk.w}; }
        if (tid < 64) ((float*)(smem + GC_OFF))[tid] = psc; else if (tid < 128) ((float*)(smem + BT_OFF))[tid - 64] = psc;
        __syncthreads();
        if (n < 32) GS_LOAD(n + 1);
        bf16_t zz1[8], zz2[8];
#pragma unroll
        for (int i = 0; i < 8; ++i) { const int c = 8 * wid + i; const bf16_t* zp;
            if (n == 0) zp = (const bf16_t*)(ws + M_Z) + (c >= 48 ? c - 48 : 0) * 512 + h * 128;
            else zp = (const bf16_t*)(ws + OFF_Z) + ((size_t)b * 2048 + 64 * (n - 1) + c) * 512 + h * 128;
            zz1[i] = zp[lane]; zz2[i] = zp[lane + 64]; }
        const float* GC = (const float*)(smem + GC_OFF); const float* BT = (const float*)(smem + BT_OFF);
        bf16x8 Sb[4];
#pragma unroll
        for (int s = 0; s < 4; ++s) Sb[s] = as_bf8(pack8(S[2 * s], S[2 * s + 1]));
        f32x4 X[4], P[4];
#pragma unroll
        for (int mt = 0; mt < 4; ++mt) { X[mt] = (f32x4){0.f, 0.f, 0.f, 0.f}; P[mt] = (f32x4){0.f, 0.f, 0.f, 0.f};
#pragma unroll
            for (int s = 0; s < 4; ++s) { const int off = (16 * mt + r) * 272 + (32 * s + 8 * g) * 2;
                X[mt] = mfma16(frag2(smem + KN_OFF, off), Sb[s], X[mt]); P[mt] = mfma16(frag2(smem + QN_OFF, off), Sb[s], P[mt]); } }
        f32x4 Rr[4], eg[4], gcv[4];
#pragma unroll
        for (int mt = 0; mt < 4; ++mt) { const int c0 = 16 * mt + 4 * g; gcv[mt] = *(const f32x4*)(GC + c0); const f32x4 bt4 = *(const f32x4*)(BT + c0);
            const u32x2 vt = *(const u32x2*)(smem + VT_OFF + (e0 + r) * 144 + (32 * (mt >> 1) + 8 * g + 4 * (mt & 1)) * 2);
            const float vv[4] = {bflo(vt.x), bfhi(vt.x), bflo(vt.y), bfhi(vt.y)};
#pragma unroll
            for (int rr = 0; rr < 4; ++rr) { eg[mt][rr] = __expf(gcv[mt][rr]); Rr[mt][rr] = bt4[rr] * (vv[rr] - eg[mt][rr] * X[mt][rr]); } }
        bf16x8 Rb[2] = {as_bf8(pack8(Rr[0], Rr[1])), as_bf8(pack8(Rr[2], Rr[3]))};
        f32x4 Vn[4];
#pragma unroll
        for (int mt = 0; mt < 4; ++mt) { Vn[mt] = (f32x4){0.f, 0.f, 0.f, 0.f};
#pragma unroll
            for (int s = 0; s < 2; ++s) Vn[mt] = mfma16(frag2(smem + TT_OFF, (16 * mt + r) * 144 + (32 * s + 8 * g) * 2), Rb[s], Vn[mt]); }
        bf16x8 Vnb[2] = {as_bf8(pack8(Vn[0], Vn[1])), as_bf8(pack8(Vn[2], Vn[3]))};
        const float glast = GC[63];
        f32x4 O[4], Vp[4];
#pragma unroll
        for (int mt = 0; mt < 4; ++mt) {
#pragma unroll
            for (int rr = 0; rr < 4; ++rr) { O[mt][rr] = P[mt][rr] * eg[mt][rr]; Vp[mt][rr] = Vn[mt][rr] * __expf(glast - gcv[mt][rr]); }
#pragma unroll
            for (int s = 0; s < 2; ++s) O[mt] = mfma16(frag2(smem + QK_OFF, (16 * mt + r) * 144 + (32 * s + 8 * g) * 2), Vnb[s], O[mt]); }
        bf16x8 Vpb[2] = {as_bf8(pack8(Vp[0], Vp[1])), as_bf8(pack8(Vp[2], Vp[3]))};
        const float egl = __expf(glast);
#pragma unroll
        for (int dt = 0; dt < 8; ++dt) { S[dt] = S[dt] * egl;
#pragma unroll
            for (int s = 0; s < 2; ++s) S[dt] = mfma16(frag2(smem + KT_OFF, (16 * dt + r) * 144 + (32 * s + 8 * g) * 2), Vpb[s], S[dt]); }
        float* OT = (float*)(smem + OT_OFF);
#pragma unroll
        for (int mt = 0; mt < 4; ++mt)
#pragma unroll
            for (int rr = 0; rr < 4; ++rr) OT[(16 * mt + 4 * g + rr) * 132 + e0 + r] = O[mt][rr];
        __syncthreads();
#pragma unroll
        for (int i = 0; i < 8; ++i) { const int c = 8 * wid + i;
            const float o1 = OT[c * 132 + lane], o2 = OT[c * 132 + lane + 64];
            const float ss = wave_sum(o1 * o1 + o2 * o2), rstd = rsqrtf(ss * (1.f / 128.f) + EPSF);
            bf16_t* op; bool wrt;
            if (n == 0) { wrt = (b == 0 && c >= 48); op = (bf16_t*)(ws + M_OAB) + (c - 48) * 1024 + h * 128; }
            else { const size_t row = (size_t)b * 2048 + 64 * (n - 1) + c; op = (bf16_t*)(ws + OFF_OAB) + row * 1024 + h * 128; wrt = true; }
            if (wrt) { op[lane] = f2bf(o1 * rstd * ng1 * silu_f(bf2f(zz1[i]))); op[lane + 64] = f2bf(o2 * rstd * ng2 * silu_f(bf2f(zz2[i]))); } }
    }
#undef GS_LOAD
    __syncthreads();
}

#ifndef DSASEL
#define DSASEL 3
#endif
#ifndef DSA_REP
#define DSA_REP 0
#endif
namespace da {
constexpr int SC_PITCH = 2112, SC_OFF = 0, MASK_OFF = 16 * SC_PITCH * 4, IWL_OFF = MASK_OFF + 64 * 34 * 8, END_OFF = IWL_OFF + 64 * 8 * 4;
constexpr int KSEL = 272;
static_assert(END_OFF + 8 * 128 * 4 <= LDS_XB - 16, "dsa lds");
constexpr float SCALE = 0.088388347648318440f, THR = 8.f;
constexpr int SHM_V = 64 * 128 * 2, SHM_K = 64 * 128 * 2;
#define KSWZ(row, colB) ((row) * 256 + ((colB) ^ (((row) & 7) << 4)))
#define SBAR() __builtin_amdgcn_sched_barrier(0)
__device__ __forceinline__ int crow(int r, int hi) { return (r & 3) + 8 * (r >> 2) + 4 * hi; }
__device__ __forceinline__ void partialSM(f32x16& p0, f32x16& p1, float& m_reg, float& mn, float& alpha) {
  constexpr float C = SCALE * 1.4426950408889634f;
  float pmax = p0[0]; for (int r = 1; r < 16; ++r) pmax = fmaxf(pmax, p0[r]); for (int r = 0; r < 16; ++r) pmax = fmaxf(pmax, p1[r]);
  { auto rr = __builtin_amdgcn_permlane32_swap(__float_as_uint(pmax), __float_as_uint(pmax), false, false);
    pmax = fmaxf(__uint_as_float(rr[0]), __uint_as_float(rr[1])); }
  if (__builtin_expect(__all(pmax - m_reg <= THR / SCALE), 1)) { mn = m_reg; alpha = 1.f; }
  else { mn = fmaxf(m_reg, pmax); alpha = __builtin_amdgcn_exp2f((m_reg - mn) * C); m_reg = mn; }
  float mnC = -mn * C;
  for (int r = 0; r < 16; ++r) p0[r] = fmaf(p0[r], C, mnC); for (int r = 0; r < 16; ++r) p1[r] = fmaf(p1[r], C, mnC);
  for (int r = 0; r < 16; ++r) p0[r] = __builtin_amdgcn_exp2f(p0[r]);
}
__device__ __forceinline__ void finishSM(f32x16& p0, f32x16& p1, float alpha, float& l_reg, bf16x8& pa0, bf16x8& pa1, bf16x8& pa2, bf16x8& pa3) {
  for (int r = 0; r < 16; ++r) p1[r] = __builtin_amdgcn_exp2f(p1[r]);
  float ps = 0; for (int r = 0; r < 16; ++r) ps += p0[r]; for (int r = 0; r < 16; ++r) ps += p1[r];
  { auto rr = __builtin_amdgcn_permlane32_swap(__float_as_uint(ps), __float_as_uint(ps), false, false);
    ps = __uint_as_float(rr[0]) + __uint_as_float(rr[1]); }
  l_reg = l_reg * alpha + ps;
#define PK4(P, BASE, OUT) do { unsigned a0 = cvt_pk(P[BASE + 0], P[BASE + 1]), a1 = cvt_pk(P[BASE + 2], P[BASE + 3]);   \
    unsigned b0 = cvt_pk(P[BASE + 4], P[BASE + 5]), b1 = cvt_pk(P[BASE + 6], P[BASE + 7]);                              \
    auto r0 = __builtin_amdgcn_permlane32_swap(a0, b0, false, false); auto r1 = __builtin_amdgcn_permlane32_swap(a1, b1, false, false); \
    u32x4 w = {r0[0], r1[0], r0[1], r1[1]}; OUT = as_bf8(w); } while (0)
  PK4(p0, 0, pa0); PK4(p0, 8, pa1); PK4(p1, 0, pa2); PK4(p1, 8, pa3);
#undef PK4
}
__device__ __forceinline__ void qkt(f32x16& p0, f32x16& p1, const char* Ks, const bf16x8* qr, int r32, int hi) {
  p0 = f32x16{}; p1 = f32x16{};
  for (int d0 = 0; d0 < 8; ++d0) { int cb = (d0 * 16 + hi * 8) * 2;
    bf16x8 b0 = *reinterpret_cast<const bf16x8*>(Ks + KSWZ(r32, cb));
    bf16x8 b1 = *reinterpret_cast<const bf16x8*>(Ks + KSWZ(32 + r32, cb));
    p0 = __builtin_amdgcn_mfma_f32_32x32x16_bf16(b0, qr[d0], p0, 0, 0, 0);
    p1 = __builtin_amdgcn_mfma_f32_32x32x16_bf16(b1, qr[d0], p1, 0, 0, 0); }
}
__device__ __forceinline__ void maskp(f32x16& p0, f32x16& p1, const char* mrow, int tile, int hi) {
  const u32x2 mw = *(const u32x2*)(mrow + tile * 8); const unsigned w0 = mw.x >> (4 * hi), w1 = mw.y >> (4 * hi);
#pragma unroll
  for (int r = 0; r < 16; ++r) { const int bit = (r & 3) + 8 * (r >> 2);
    p0[r] = ((w0 >> bit) & 1u) ? p0[r] : -1e30f; p1[r] = ((w1 >> bit) & 1u) ? p1[r] : -1e30f; }
}
__device__ __forceinline__ int v_st(int k, int c) { const int kk = (k & ~0xC) | ((k & 4) << 1) | ((k & 8) >> 1); return ((kk >> 3) * 4 + (c >> 5)) * 512 + ((kk & 7) * 32 + (c & 31)) * 2; }
__device__ __forceinline__ int v_rd_base(int lane) { return ((lane & 3) << 3) | (((lane >> 2) & 3) << 6) | (((lane >> 4) & 1) << 5) | (((lane >> 5) & 1) << 8); }
constexpr int v_rd_off(int d0, int ks, int half) { return d0 * 512 + ks * 4096 + half * 2048; }
template <int OFF> __device__ __forceinline__ s16x4 tr_read(int vb) {
  s16x4 r; asm volatile("ds_read_b64_tr_b16 %0, %1 offset:%2" : "=&v"(r) : "v"(vb), "i"(OFF) : "memory"); return r;
}
template <int D0> __device__ __forceinline__ void pv_one(f32x16& od, int vb, bf16x8 pa0, bf16x8 pa1, bf16x8 pa2, bf16x8 pa3) {
  const s16x4 l0 = tr_read<v_rd_off(D0, 0, 0)>(vb), h0 = tr_read<v_rd_off(D0, 0, 1)>(vb), l1 = tr_read<v_rd_off(D0, 1, 0)>(vb), h1 = tr_read<v_rd_off(D0, 1, 1)>(vb);
  const s16x4 l2 = tr_read<v_rd_off(D0, 2, 0)>(vb), h2 = tr_read<v_rd_off(D0, 2, 1)>(vb), l3 = tr_read<v_rd_off(D0, 3, 0)>(vb), h3 = tr_read<v_rd_off(D0, 3, 1)>(vb);
  asm volatile("s_waitcnt lgkmcnt(0)" ::: "memory"); SBAR();
#define PK(L, H) (bf16x8){L[0], L[1], L[2], L[3], H[0], H[1], H[2], H[3]}
  od = __builtin_amdgcn_mfma_f32_32x32x16_bf16(pa0, PK(l0, h0), od, 0, 0, 0);
  od = __builtin_amdgcn_mfma_f32_32x32x16_bf16(pa1, PK(l1, h1), od, 0, 0, 0);
  od = __builtin_amdgcn_mfma_f32_32x32x16_bf16(pa2, PK(l2, h2), od, 0, 0, 0);
  od = __builtin_amdgcn_mfma_f32_32x32x16_bf16(pa3, PK(l3, h3), od, 0, 0, 0);
#undef PK
}
__device__ __forceinline__ void pv_d0(f32x16* o, int vb, bf16x8 pa0, bf16x8 pa1, bf16x8 pa2, bf16x8 pa3) {
  pv_one<0>(o[0], vb, pa0, pa1, pa2, pa3); pv_one<1>(o[1], vb, pa0, pa1, pa2, pa3); pv_one<2>(o[2], vb, pa0, pa1, pa2, pa3); pv_one<3>(o[3], vb, pa0, pa1, pa2, pa3);
}
__device__ __forceinline__ void attn_body(const bf16_t* Qb, const bf16_t* Kh, const bf16_t* Vh, bf16_t* Ob, int NT, const char* maskbase, char* lds) {
  int tid_ = threadIdx.x; asm volatile("" : "+v"(tid_));
  const int tid = tid_, wid = tid >> 6, lane = tid & 63, r32 = lane & 31, hi = lane >> 5;
  char* V_lds = lds; char* K_lds = lds + 2 * SHM_V;
  float* wsf = (float*)(lds + 2 * SHM_V + 2 * SHM_K) + wid * 64; float* li_l = wsf; float* al_l = wsf + 32;
  float m_reg = -1e30f, l_reg = 0; f32x16 o[4] = {}; bf16x8 qr[8];
  const int head = wid >> 1, qloc0 = (wid & 1) * 32;
  const char* mrow = maskbase + (qloc0 + r32) * (34 * 8);
  const bf16_t* Qw = Qb + (size_t)(qloc0 + r32) * 512 + head * 128 + hi * 8;
#pragma unroll
  for (int d0 = 0; d0 < 8; ++d0) qr[d0] = *(const bf16x8*)(Qw + d0 * 16);
  const int sr = tid >> 4, sc = (tid & 15) * 8;
  const int vb0 = (int)(uintptr_t)V_lds + v_rd_base(lane);
  struct { bf16x8 vs0, vs1, ks0, ks1; } sr_[2];
#define SLOAD(i, k0) do { sr_[i].vs0 = *(const bf16x8*)(&Vh[(long)((k0) + sr) * 128 + sc]); sr_[i].vs1 = *(const bf16x8*)(&Vh[(long)((k0) + 32 + sr) * 128 + sc]); \
    sr_[i].ks0 = *(const bf16x8*)(&Kh[(long)((k0) + sr) * 128 + sc]); sr_[i].ks1 = *(const bf16x8*)(&Kh[(long)((k0) + 32 + sr) * 128 + sc]); } while (0)
#define SWRITE(b, i) do { int t_ = tid; asm volatile("" : "+v"(t_)); const int sr_w = t_ >> 4, sc_w = (t_ & 15) * 8;     \
    *(bf16x8*)(V_lds + (b) * SHM_V + v_st(sr_w, sc_w)) = sr_[i].vs0;          \
    *(bf16x8*)(V_lds + (b) * SHM_V + v_st(32 + sr_w, sc_w)) = sr_[i].vs1; int kc = sc_w * 2;               \
    *(bf16x8*)(K_lds + (b) * SHM_K + KSWZ(sr_w, kc)) = sr_[i].ks0;                       \
    *(bf16x8*)(K_lds + (b) * SHM_K + KSWZ(32 + sr_w, kc)) = sr_[i].ks1; } while (0)
#define SWAIT() asm volatile("s_waitcnt vmcnt(4)" ::: "memory")
#define RESC(a) do { if (__any((a) < 1.f)) { if (hi == 0) al_l[r32] = (a); asm volatile("s_waitcnt lgkmcnt(0)" ::: "memory"); \
    for (int d = 0; d < 4; ++d) for (int r = 0; r < 16; ++r) o[d][r] *= al_l[crow(r, hi)]; } } while (0)
  f32x16 pA0, pA1, pB0, pB1; float mnA, mnB, alA, alB; bf16x8 pa0, pa1, pa2, pa3;
  constexpr int SE = 0, SO = 1;
  SLOAD(SE, 0); asm volatile("s_waitcnt vmcnt(0)" ::: "memory"); SWRITE(0, SE); __syncthreads();
  qkt(pA0, pA1, K_lds, qr, r32, hi); maskp(pA0, pA1, mrow, 0, hi); partialSM(pA0, pA1, m_reg, mnA, alA);
  SLOAD(SO, 64); if (2 < NT) SLOAD(SE, 2 * 64);
  SWAIT(); SWRITE(1, SO); __syncthreads();
  for (int j = 1; j + 1 < NT; j += 2) {
    SBAR(); qkt(pB0, pB1, K_lds + SHM_K, qr, r32, hi); maskp(pB0, pB1, mrow, j, hi);
    finishSM(pA0, pA1, alA, l_reg, pa0, pa1, pa2, pa3); SBAR();
    SLOAD(SO, (j + 2) * 64); SBAR();
    pv_d0(o, vb0, pa0, pa1, pa2, pa3); partialSM(pB0, pB1, m_reg, mnB, alB);
    __syncthreads(); SWAIT(); SWRITE(0, SE);
    RESC(alB); __syncthreads();
    SBAR(); qkt(pA0, pA1, K_lds, qr, r32, hi); maskp(pA0, pA1, mrow, j + 1, hi);
    finishSM(pB0, pB1, alB, l_reg, pa0, pa1, pa2, pa3); SBAR();
    if (j + 3 < NT) SLOAD(SE, (j + 3) * 64); SBAR();
    pv_d0(o, vb0 + SHM_V, pa0, pa1, pa2, pa3); partialSM(pA0, pA1, m_reg, mnA, alA);
    __syncthreads(); SWAIT(); SWRITE(1, SO);
    RESC(alA); __syncthreads();
  }
  SBAR(); qkt(pB0, pB1, K_lds + SHM_K, qr, r32, hi); maskp(pB0, pB1, mrow, NT - 1, hi);
  finishSM(pA0, pA1, alA, l_reg, pa0, pa1, pa2, pa3); SBAR();
  pv_d0(o, vb0, pa0, pa1, pa2, pa3); partialSM(pB0, pB1, m_reg, mnB, alB);
  __syncthreads(); RESC(alB);
  finishSM(pB0, pB1, alB, l_reg, pa0, pa1, pa2, pa3); SBAR();
  pv_d0(o, vb0 + SHM_V, pa0, pa1, pa2, pa3);
  if (hi == 0) li_l[r32] = l_reg; asm volatile("s_waitcnt lgkmcnt(0)" ::: "memory");
  float rli[16];
#pragma unroll
  for (int r = 0; r < 16; ++r) rli[r] = __builtin_amdgcn_rcpf(li_l[crow(r, hi)]);
#pragma unroll
  for (int r = 0; r < 16; ++r) { bf16_t* orow = Ob + (size_t)(qloc0 + crow(r, hi)) * 1024 + head * 128 + r32;
#pragma unroll
    for (int d0 = 0; d0 < 4; ++d0) orow[d0 * 32] = f2bf(o[d0][r] * rli[r]); }
  asm volatile("s_waitcnt vmcnt(0)" ::: "memory");
#undef SLOAD
#undef SWRITE
#undef SWAIT
#undef RESC
}
__device__ __forceinline__ int wave_total(int x) {
    x += __builtin_amdgcn_update_dpp(0, x, 0x128, 0xf, 0xf, false);
    x += __builtin_amdgcn_update_dpp(0, x, 0x124, 0xf, 0xf, false);
    x += __builtin_amdgcn_update_dpp(0, x, 0x122, 0xf, 0xf, false);
    x += __builtin_amdgcn_update_dpp(0, x, 0x121, 0xf, 0xf, false);
    return __builtin_amdgcn_readlane(x, 0) + __builtin_amdgcn_readlane(x, 16) + __builtin_amdgcn_readlane(x, 32) + __builtin_amdgcn_readlane(x, 48);
}
__device__ __forceinline__ unsigned ordkey(float x) { const unsigned b = __float_as_uint(x); return (b & 0x80000000u) ? ~b : (b | 0x80000000u); }
typedef unsigned short us2_t __attribute__((ext_vector_type(2)));
template <int NTW> __device__ __forceinline__ void select2_t(const float* scA, const float* scB, unsigned long long* mrowA, unsigned long long* mrowB, int NT, int NTe, int lane, unsigned* cand) {
    constexpr int NP2 = (NTW + 1) / 2;
    unsigned ua[NTW], ub[NTW];
#pragma unroll
    for (int i = 0; i < NTW; ++i) { ua[i] = (i < NT) ? ordkey(scA[64 * i + lane]) : 0u; ub[i] = (i < NT) ? ordkey(scB[64 * i + lane]) : 0u; }
    unsigned pa[NP2], pb[NP2];
#pragma unroll
    for (int p = 0; p < NP2; ++p) { const unsigned a0 = ua[2 * p] >> 17, a1 = (2 * p + 1 < NTW) ? (ua[2 * p + 1 < NTW ? 2 * p + 1 : 0] >> 17) : 0u, b0 = ub[2 * p] >> 17, b1 = (2 * p + 1 < NTW) ? (ub[2 * p + 1 < NTW ? 2 * p + 1 : 0] >> 17) : 0u;
        pa[p] = (a0 | 0x8000u) | ((a1 | 0x8000u) << 16); pb[p] = (b0 | 0x8000u) | ((b1 | 0x8000u) << 16); }
    unsigned ta = 0u, tb = 0u; int gea = 64 * NTW, geb = 64 * NTW;
#pragma unroll 1
    for (int bit = 14; bit >= 0; --bit) { const unsigned ca = ta | (1u << bit), cb = tb | (1u << bit); const unsigned ca2 = ca | (ca << 16), cb2 = cb | (cb << 16);
        unsigned sa = 0u, sb = 0u; int na = 0, nb = 0;
#pragma unroll
        for (int p = 0; p < NP2; ++p) {
            const unsigned da = __builtin_bit_cast(unsigned, __builtin_bit_cast(us2_t, pa[p]) - __builtin_bit_cast(us2_t, ca2)), db = __builtin_bit_cast(unsigned, __builtin_bit_cast(us2_t, pb[p]) - __builtin_bit_cast(us2_t, cb2));
            sa = (sa >> 1) | (da & 0x80008000u); sb = (sb >> 1) | (db & 0x80008000u);
            if ((p & 15) == 15) { na += __popc(sa); nb += __popc(sb); sa = 0u; sb = 0u; } }
        na = wave_total(na + __popc(sa)); nb = wave_total(nb + __popc(sb));
        if (na >= KSEL) { ta = ca; gea = na; } if (nb >= KSEL) { tb = cb; geb = nb; } }
#pragma unroll 1
    for (int q = 0; q < 2; ++q) {
        unsigned long long* mrow = q ? mrowB : mrowA; const unsigned t15 = q ? tb : ta;
        unsigned u[NTW];
#pragma unroll
        for (int i = 0; i < NTW; ++i) u[i] = q ? ub[i] : ua[i];
        int ncand = 0;
#pragma unroll
        for (int i = 0; i < NTW; ++i) { const unsigned long long mc = __ballot((u[i] >> 17) == t15);
            if (mc) { const int idx = ncand + (int)__builtin_amdgcn_mbcnt_hi((unsigned)(mc >> 32), __builtin_amdgcn_mbcnt_lo((unsigned)mc, 0u));
                if (((u[i] >> 17) == t15) && idx < 128) cand[idx] = (u[i] & 0x1FFFFu) + 1u; }
            ncand += __popcll(mc); }
        const int ngt = (q ? geb : gea) - ncand;
        const int kk = KSEL - ngt;
        unsigned t;
#ifndef CAND_CAP
#define CAND_CAP 128
#endif
        if (ncand <= CAND_CAP) {
            asm volatile("s_waitcnt lgkmcnt(0)" ::: "memory");
            const unsigned c0 = lane < ncand ? cand[lane] : 0u, c1 = lane + 64 < ncand ? cand[lane + 64] : 0u;
            unsigned tl = 0u;
            for (int bit = 17; bit >= 0; --bit) { const unsigned cc = tl | (1u << bit); const int n = __popcll(__ballot(c0 >= cc)) + __popcll(__ballot(c1 >= cc)); if (n >= kk) tl = cc; }
            t = (t15 << 17) | (tl - 1u);
        } else {
            int tt = (int)(t15 << 16);
            for (int bit = 15; bit >= 0; --bit) { const int cc = tt | (1 << bit); int n = 0;
#pragma unroll
                for (int i = 0; i < NTW; ++i) n += __popcll(__ballot((int)(u[i] >> 1) >= cc));
                if (n >= KSEL) tt = cc; }
            t = ((unsigned)tt << 1) | 1u; int n1 = 0;
#pragma unroll
            for (int i = 0; i < NTW; ++i) n1 += __popcll(__ballot(u[i] >= t));
            if (n1 < KSEL) t -= 1u;
        }
        int tot = 0;
#pragma unroll
        for (int i = 0; i < NTW; ++i) { const unsigned long long w = __ballot(u[i] >= t); tot += __popcll(w); if (i < NT && lane == 0) mrow[i] = w; }
        if (tot > KSEL) {
            int need = KSEL;
#pragma unroll
            for (int i = 0; i < NTW; ++i) need -= __popcll(__ballot(u[i] > t));
#pragma unroll
            for (int i = 0; i < NTW; ++i) {
                unsigned long long w = __ballot(u[i] > t); unsigned long long e = __ballot(u[i] == t);
                if (need > 0 && e) { const int pe = __popcll(e); if (pe <= need) { w |= e; need -= pe; } else { while (need > 0) { const unsigned long long low = e & (~e + 1ull); w |= low; e ^= low; --need; } } }
                if (i < NT && lane == 0) mrow[i] = w; } }
        if (NTe > NT && lane == 0) mrow[NT] = 0ull;
    }
}
__device__ __forceinline__ void select2(const float* scA, const float* scB, unsigned long long* mrowA, unsigned long long* mrowB, int NT, int NTe, int NP, int lane, unsigned* cand) {
    if (NP <= KSEL) {
        for (int i = 0; i < NTe; ++i) { const int lo = 64 * i; const unsigned long long w = (lo + 64 <= NP) ? ~0ull : (lo >= NP ? 0ull : ((1ull << (NP - lo)) - 1ull)); if (lane == 0) { mrowA[i] = w; mrowB[i] = w; } }
        return;
    }
    if (NT <= 9) select2_t<9>(scA, scB, mrowA, mrowB, NT, NTe, lane, cand);
    else if (NT <= 17) select2_t<17>(scA, scB, mrowA, mrowB, NT, NTe, lane, cand);
    else if (NT <= 25) select2_t<25>(scA, scB, mrowA, mrowB, NT, NTe, lane, cand);
    else select2_t<33>(scA, scB, mrowA, mrowB, NT, NTe, lane, cand);
}
__device__ __forceinline__ void dsa_item(const Args& a, int b, int j, char* smem, int dry = 0) {
    unsigned char* ws = a.ws; { size_t z_ = 0; asm volatile("" : "+s"(z_)); ws += z_; }
    int tid_ = threadIdx.x; asm volatile("" : "+v"(tid_));
    const int tid = tid_, lane = tid & 63, wid = __builtin_amdgcn_readfirstlane(tid >> 6), hi = lane >> 5;
    const int limit = 64 * (j + 1), NP = 16 + limit, NT = j + 2, NTe = (NT + 1) & ~1, row0 = b * 2048 + 64 * j;
    const bf16_t* iq = (const bf16_t*)(ws + OFF_IQ); const bf16_t* ikb = (const bf16_t*)(ws + OFF_IKB); const float* misc = (const float*)(ws + OFF_MISC);
    float* SC = (float*)(smem + SC_OFF); float* IWL = (float*)(smem + IWL_OFF); unsigned long long* MASK = (unsigned long long*)(smem + MASK_OFF);
    { const int q = tid >> 3, hh = tid & 7; IWL[tid] = misc[(size_t)(row0 + q) * 16 + 8 + hh] * 0.044194173824159216f; }
    bf16x8 af[4][4];
#define DSA_AF_LOAD(sb) do { const int rho = lane & 31, qq = 2 * ((rho >> 2) & 1) + (rho >> 4), hh = 4 * ((rho >> 3) & 1) + (rho & 3); \
        _Pragma("unroll") for (int mt = 0; mt < 4; ++mt) _Pragma("unroll") for (int ks = 0; ks < 4; ++ks) \
            af[mt][ks] = *(const bf16x8*)(iq + (size_t)(row0 + (sb) * 16 + 4 * mt + qq) * 512 + hh * 64 + 16 * ks + 8 * hi); } while (0)
    DSA_AF_LOAD(0);
    if ((DSASEL & 1) && !(dry & 1)) for (int sub = 0; sub < 4; ++sub) {
        for (int p = tid; p < 16 * 16; p += 512) SC[(p >> 4) * SC_PITCH + (p & 15)] = __builtin_inff();
        for (int p = tid; p < 16 * 48; p += 512) { const int q = p / 48, x = p - q * 48; SC[q * SC_PITCH + NP + x] = -__builtin_inff(); }
        __syncthreads();
        for (int rep_i = 0; rep_i < 1 + (DSA_REP & 1); ++rep_i) {
        const bf16_t* ikp = ikb + ((size_t)b * TP + 16 + (lane & 31)) * 64 + 8 * hi;
        bf16x8 bnx[4];
        { const int kt0 = wid < 2 * (j + 1) ? wid : 0;
#pragma unroll
          for (int ks = 0; ks < 4; ++ks) bnx[ks] = *(const bf16x8*)(ikp + (size_t)(32 * kt0) * 64 + 16 * ks); }
        for (int kt = wid; kt < 2 * (j + 1); kt += 8) {
            bf16x8 bfr[4];
#pragma unroll
            for (int ks = 0; ks < 4; ++ks) bfr[ks] = bnx[ks];
            { const int ktn = (kt + 8 < 2 * (j + 1)) ? kt + 8 : kt;
#pragma unroll
              for (int ks = 0; ks < 4; ++ks) bnx[ks] = *(const bf16x8*)(ikp + (size_t)(32 * ktn) * 64 + 16 * ks); }
#pragma unroll
            for (int mt = 0; mt < 4; ++mt) {
                f32x16 acc = {};
#pragma unroll
                for (int ks = 0; ks < 4; ++ks) acc = __builtin_amdgcn_mfma_f32_32x32x16_bf16(af[mt][ks], bfr[ks], acc, 0, 0, 0);
                const float* iw0 = IWL + (sub * 16 + 4 * mt + 2 * hi) * 8;
                float s0 = 0.f, s1 = 0.f;
#pragma unroll
                for (int rg = 0; rg < 8; ++rg) { s0 += fmaxf(acc[rg], 0.f) * iw0[rg]; s1 += fmaxf(acc[8 + rg], 0.f) * iw0[8 + rg]; }
                if (s0 == 0.f) s0 = 0.f; if (s1 == 0.f) s1 = 0.f;
                float* sp = SC + (4 * mt + 2 * hi) * SC_PITCH + 16 + 32 * kt + (lane & 31);
                sp[0] = s0; sp[SC_PITCH] = s1;
            }
        }
        }
        if (sub < 3) DSA_AF_LOAD(sub + 1);
        __syncthreads();
#pragma unroll 1
        for (int rep_s = 0; rep_s < 1 + ((DSA_REP >> 1) & 1); ++rep_s)
        { const int ql = 2 * wid; select2(SC + ql * SC_PITCH, SC + (ql + 1) * SC_PITCH, MASK + (sub * 16 + ql) * 34, MASK + (sub * 16 + ql + 1) * 34, NT, NTe, NP, lane, (unsigned*)(smem + END_OFF) + wid * 128); }
        __syncthreads();
    }
#pragma unroll 1
    for (int rep_a = 0; rep_a < 1 + ((DSA_REP >> 2) & 1); ++rep_a)
    if ((DSASEL & 2) && !(dry & 2)) attn_body((const bf16_t*)(ws + OFF_BQ) + (size_t)row0 * 512, (const bf16_t*)(ws + OFF_KB) + (size_t)b * TP * 128, (const bf16_t*)(ws + OFF_VB) + (size_t)b * TP * 128,
              (bf16_t*)(ws + OFF_OAB) + (size_t)row0 * 1024 + 512, NTe, smem + MASK_OFF, smem);
    __syncthreads();
}
__device__ __forceinline__ void dsa_meta_item(const Args& a) {
    unsigned char* ws = a.ws; { size_t z_ = 0; asm volatile("" : "+s"(z_)); ws += z_; }
    int tid_ = threadIdx.x; asm volatile("" : "+v"(tid_));
    if (tid_ >= 64) return;
    const int lane = tid_, q = lane >> 2, h = lane & 3;
    const bf16_t* qp = (const bf16_t*)(ws + M_BQ) + q * 512 + h * 128; const bf16_t* kb = (const bf16_t*)(ws + OFF_KB); const bf16_t* vb = (const bf16_t*)(ws + OFF_VB);
    float s[16]; float mx = -1e30f;
#pragma unroll
    for (int k = 0; k < 16; ++k) { float acc = 0.f; for (int d = 0; d < 128; ++d) acc += bf2f(qp[d]) * bf2f(kb[k * 128 + d]); s[k] = acc * SCALE; mx = fmaxf(mx, s[k]); }
    float l = 0.f;
#pragma unroll
    for (int k = 0; k < 16; ++k) { s[k] = __expf(s[k] - mx); l += s[k]; }
    const float rl = 1.f / l;
    bf16_t* op = (bf16_t*)(ws + M_OAB) + q * 1024 + 512 + h * 128;
    for (int d = 0; d < 128; ++d) { float acc = 0.f;
#pragma unroll
        for (int k = 0; k < 16; ++k) acc += s[k] * bf2f(vb[k * 128 + d]); op[d] = f2bf(acc * rl); }
}
}

__device__ __forceinline__ void p_mixers(const Args& a, int layer_rep, char* smem, int dry = 0) {
    const int layer = layer_rep & 1;
    unsigned* ctr = (unsigned*)(a.ws + OFF_CTL) + CW_QUEUE + 64 * layer_rep;
    int* slot = (int*)(smem + LDS_XB - 16);
    constexpr int NSCAN = NB * 4, NDSA = NB * 32, NITEM = NSCAN + NDSA + 1;
    for (;;) {
        __syncthreads();
        if (threadIdx.x == 0) *slot = (int)__hip_atomic_fetch_add(ctr, 1u, __ATOMIC_RELAXED, __HIP_MEMORY_SCOPE_AGENT);
        __syncthreads();
        const int it = *slot;
        if (it >= NITEM) break;
#ifndef MIXSEL
#define MIXSEL 7
#endif
        if (it == 0) { if ((MIXSEL & 4) && !dry) da::dsa_meta_item(a); }
        else if (it <= NSCAN) { const int si = it - 1; for (int rep_g = 0; rep_g < 1 + ((DSA_REP >> 3) & 1); ++rep_g) if ((MIXSEL & 1) && !(dry & 4)) gdn_scan_item(a, layer, si >> 2, si & 3, smem); }
        else { const int k = it - 1 - NSCAN, j = 31 - (k >> 5), b = k & 31; if (MIXSEL & 2) da::dsa_item(a, b, j, smem, dry); }
    }
}

__device__ __forceinline__ void p_halo(const Args& a, int layer) {
    unsigned char* ws = a.ws; { size_t z_ = 0; asm volatile("" : "+s"(z_)); ws += z_; }
    int tid_ = threadIdx.x; asm volatile("" : "+v"(tid_));
    const int lane = tid_ & 63, wid = tid_ >> 6, r = lane & 15, g = lane >> 4, gw = blockIdx.x * 8 + wid, nW = gridDim.x * 8;
    const bf16_t* hb = (const bf16_t*)(ws + OFF_HB); const bf16_t* WupT = (const bf16_t*)(ws + OFF_WUP) + (size_t)layer * NIN * DM;
    const u64_t* ssq = (const u64_t*)(ws + OFF_SSQ) + (size_t)(2 * layer + 1) * RR; float* hg = (float*)(ws + OFF_HG);
    for (int job = gw; job < 32 * 176; job += nW) {
        const int rt = job & 31, ct = job >> 5;
        const int rowA = ((r >> 1) == 0) ? 0 : 256 * (8 * rt + (r >> 1)) - 2 + (r & 1);
        const bf16_t* ap = hb + (size_t)rowA * DM + g * 8; const bf16_t* bp = WupT + (size_t)(256 * (ct >> 3) + 16 * (ct & 7) + r) * DM + g * 8;
        f32x4 acc = {0.f, 0.f, 0.f, 0.f};
#pragma unroll 8
        for (int k = 0; k < DM; k += 32) acc = mfma16(*(const bf16x8*)(ap + k), *(const bf16x8*)(bp + k), acc);
#pragma unroll
        for (int rr = 0; rr < 4; ++rr) { const int ri = 4 * g + rr;
            if ((ri >> 1) != 0) { const int pmD = 8 * rt + (ri >> 1), rowD = 256 * pmD - 2 + (ri & 1);
                hg[(size_t)(pmD * 2 + (ri & 1)) * DFF + 128 * (ct >> 3) + 16 * (ct & 7) + r] = acc[rr] * rstd_of(ssq, rowD); } }
    }
}
__device__ __forceinline__ void meta_act(const Args& a, int layer) {
    unsigned char* ws = a.ws; { size_t z_ = 0; asm volatile("" : "+s"(z_)); ws += z_; }
    int tid_ = threadIdx.x; asm volatile("" : "+v"(tid_));
    const float* cw = a.in[I_CONV_FFN] + (size_t)layer * 3 * DFF; const float* mgu = (const float*)(ws + M_GU); bf16_t* mact = (bf16_t*)(ws + M_ACT);
    for (int c = blockIdx.x * 512 + tid_; c < DFF; c += gridDim.x * 512) { const int gi = (c >> 7) * 256 + (c & 127); const float w0 = cw[c], w1 = cw[DFF + c], w2 = cw[2 * DFF + c]; float g0 = 0.f, g1 = 0.f;
        for (int t = 0; t < 16; ++t) { const float g2 = mgu[t * 5632 + gi], uu = mgu[t * 5632 + gi + 128]; mact[t * DFF + c] = f2bf(silu_f(w0 * g0 + w1 * g1 + w2 * g2) * uu); g0 = g1; g1 = g2; } }
}

constexpr int NPH = 1 + 8 * NLAYER;
#ifndef ONE_LAUNCH
#define ONE_LAUNCH 0
#endif
#ifndef STAGGER_US
#define STAGGER_US 0
#endif
__device__ __forceinline__ void stagger_delay(int us) {
    if (us > 0 && (blockIdx.x & 1)) { const unsigned long long t0 = __builtin_amdgcn_s_memrealtime(); while (__builtin_amdgcn_s_memrealtime() - t0 < (unsigned long long)us * 100ull) __builtin_amdgcn_s_sleep(8); }
}
__device__ __forceinline__ void meta_y_lds(const unsigned char* ws, char* img) {
    const float* P = (const float*)(ws + M_GU);
    for (int i = threadIdx.x; i < 16 * 1024; i += 512) { const int t = i >> 10, ch = i & 1023, n = 256 * (ch >> 7) + (ch & 127);
        *(bf16_t*)(img + t * MN_PITCH + ch * 2) = f2bf(P[t * 5632 + n] + P[t * 5632 + n + 128]); }
    __syncthreads();
}
template <int L> __device__ __forceinline__ void layer_phases(const Args& a, char* smem, const XcdBarrier& bar, const int lo, const int hi) {
    constexpr int l = L;
    unsigned char* ws0 = a.ws;
    PG8_LAS unsigned char* glds = (PG8_LAS unsigned char*)smem;
    const int G = gridDim.x, bx = blockIdx.x;
#define IN(k) (lo <= (k) && (k) < hi)
#define SEAM(k) do { if (IN(k) && IN((k) + 1)) xcd_barrier(bar); } while (0)
#define OPQ_WS() unsigned char* ws = ws0; { size_t z_ = 0; asm volatile("" : "+s"(z_)); ws += z_; }
#ifndef EN_MASK
#define EN_MASK 0xFFFF
#endif
#ifndef REP_MASK
#define REP_MASK 0
#endif
#define NREP(k) (1 + ((REP_MASK >> (k)) & 1))
    constexpr int pb = 1 + 8 * l;
    for (int rep = 0; rep < NREP(0); ++rep) if (IN(pb + 0)) { OPQ_WS();
        const bf16_t* WinT = (const bf16_t*)(ws + OFF_WIN) + (size_t)l * NIN * DM;
        meta_norm_lds((const float*)(ws + M_H), smem);
        small_gemm16<true>(smem, WinT, NIN, DM, MEpiIn{ws, a.in[I_B_GATE] + l * 2048}, smem + 40960);
        __syncthreads();
        pg8::Gemm g{(const bf16_t*)(ws + OFF_HB), WinT, RR, NIN, DM}; pg8::StaticOrder S; S.init(RR, NIN, G, bx);
        EpiIn E{(bf16_t*)(ws + OFF_QKV), (bf16_t*)(ws + OFF_HALO), (bf16_t*)(ws + OFF_Z), (bf16_t*)(ws + OFF_BQ), (bf16_t*)(ws + OFF_IQ), (bf16_t*)(ws + OFF_KB), (bf16_t*)(ws + OFF_VB),
                (bf16_t*)(ws + OFF_IKB), (float*)(ws + OFF_MISC), (bf16_t*)a.out, a.in[I_B_GATE] + l * 2048, (const u64_t*)(ws + OFF_SSQ) + (size_t)(2 * l) * RR};
        stagger_delay(STAGGER_US);
        pg8::gemm_phase<EpiIn, pg8::StaticOrder>(glds, g, S, E, nullptr);
#if defined(PROBE_DUP_IN)
        pg8::gemm_phase<EpiIn, pg8::StaticOrder>(glds, g, S, E, nullptr);
#endif
    }
    SEAM(pb + 0);
#if defined(PROBE_DRY_PREP)
    if (IN(pb + 1)) p_mixprep(a, l, smem, a.ph_hi == 12345, PROBE_DRY_PREP);
#endif
    if (IN(pb + 1)) p_mixprep(a, l, smem, true);
    SEAM(pb + 1);
#if defined(PROBE_DRYMIX)
    if (IN(pb + 2)) p_mixers(a, l + 2, smem, PROBE_DRYMIX);
#endif
    for (int rep = 0; rep < NREP(2); ++rep) if (IN(pb + 2)) p_mixers(a, l + 2 * rep, smem);
    SEAM(pb + 2);
    for (int rep = 0; rep < NREP(3); ++rep) if (IN(pb + 3)) { OPQ_WS();
        const bf16_t* WbrT = (const bf16_t*)(ws + OFF_WBR) + (size_t)l * 2048 * DM;
        small_gemm16<false>((const bf16_t*)(ws + M_OAB), WbrT, 2048, DM, MEpiBr{ws, DBG_NO_GDN ? 0.f : 1.f, DBG_NO_DSA ? 0.f : 1.f}, smem + 40960);
        pg8::Gemm g{(const bf16_t*)(ws + OFF_OAB), WbrT, RR, 2048, DM}; pg8::StaticOrder S; S.init(RR, 2048, G, bx);
        EpiBr E{(bf16_t*)(ws + OFF_Y), (const bf16_t*)a.out, DBG_NO_GDN ? 0.f : 1.f, DBG_NO_DSA ? 0.f : 1.f};
        pg8::gemm_phase<EpiBr, pg8::StaticOrder>(glds, g, S, E, nullptr);
    }
    SEAM(pb + 3);
    for (int rep = 0; rep < NREP(4); ++rep) if (IN(pb + 4)) { OPQ_WS();
        const bf16_t* WoutT = (const bf16_t*)(ws + OFF_WOUT) + (size_t)l * DM * DM;
        meta_y_lds(ws, smem);
        small_gemm16<true>(smem, WoutT, DM, DM, MEpiResid{(float*)(ws + M_H), (DBG_NO_MIX || rep) ? 0.f : 1.f}, smem + 40960);
        __syncthreads();
        pg8::Gemm g{(const bf16_t*)(ws + OFF_Y), WoutT, RR, DM, DM}; pg8::StaticOrder S; S.init(RR, DM, G, bx);
        EpiResidB E{(bf16_t*)(ws + OFF_HB), rep ? nullptr : (u64_t*)(ws + OFF_SSQ) + (size_t)(2 * l + 1) * RR, (DBG_NO_MIX || rep) ? 0.f : 1.f};
        pg8::gemm_phase<EpiResidB, pg8::StaticOrder>(glds, g, S, E, nullptr);
    }
    SEAM(pb + 4);
    if (IN(pb + 5)) { OPQ_WS();
        const bf16_t* WupT = (const bf16_t*)(ws + OFF_WUP) + (size_t)l * NIN * DM;
        meta_norm_lds((const float*)(ws + M_H), smem);
        small_gemm16<true>(smem, WupT, NIN, DM, MEpiUp{(float*)(ws + M_GU)}, smem + 40960);
        p_halo(a, l);
    }
    SEAM(pb + 5);
    for (int rep = 0; rep < NREP(6); ++rep) if (IN(pb + 6)) { OPQ_WS();
        const bf16_t* WupT = (const bf16_t*)(ws + OFF_WUP) + (size_t)l * NIN * DM;
        if constexpr (L + 1 < NLAYER) meta_act(a, l);
#if defined(PANEL_UP)
        pg8::Gemm g{(const bf16_t*)(ws + OFF_HB), WupT, RR, NIN, DM}; PanelOrder S; S.init(RR, NIN, G, bx);
#else
        pg8::Gemm g{(const bf16_t*)(ws + OFF_HB), WupT, RR, NIN, DM}; pg8::StaticOrder S; S.init(RR, NIN, G, bx);
#endif
        EpiUpConv E{(bf16_t*)(ws + OFF_ACT), (const u64_t*)(ws + OFF_SSQ) + (size_t)(2 * l + 1) * RR, a.in[I_CONV_FFN] + (size_t)l * 3 * DFF, (const float*)(ws + OFF_HG), (const float*)(ws + M_GU), smem + 131072, a.ph_hi};
#if defined(PANEL_UP)
        pg8::gemm_phase<EpiUpConv, PanelOrder>(glds, g, S, E, nullptr);
#else
        pg8::gemm_phase<EpiUpConv, pg8::StaticOrder>(glds, g, S, E, nullptr);
#endif
#if defined(PROBE_UPMODE)
        { EpiUpConvT<PROBE_UPMODE> E2{(bf16_t*)(ws + OFF_ACT), (const u64_t*)(ws + OFF_SSQ) + (size_t)(2 * l + 1) * RR, a.in[I_CONV_FFN] + (size_t)l * 3 * DFF, (const float*)(ws + OFF_HG), (const float*)(ws + M_GU), smem + 131072, a.ph_hi};
          pg8::gemm_phase<EpiUpConvT<PROBE_UPMODE>, pg8::StaticOrder>(glds, g, S, E2, nullptr); }
#endif
#if defined(PROBE_NULLM)
        { EpiNull EN; pg8::Gemm g2{(const bf16_t*)(ws + OFF_OAB), (const bf16_t*)(ws + OFF_WUP) + (size_t)(1 - l) * NIN * DM, PROBE_NULLM, NIN, DM}; pg8::StaticOrder S2; S2.init(PROBE_NULLM, NIN, G, bx);
          pg8::gemm_phase<EpiNull, pg8::StaticOrder>(glds, g2, S2, EN, nullptr); }
#endif
    }
    SEAM(pb + 6);
    for (int rep = 0; rep < NREP(7); ++rep) if (IN(pb + 7)) { OPQ_WS();
        const bf16_t* WdnT = (const bf16_t*)(ws + OFF_WDN) + (size_t)l * DM * DFF;
        if constexpr (L + 1 < NLAYER) small_gemm16<false>((const bf16_t*)(ws + M_ACT), WdnT, DM, DFF, MEpiResid{(float*)(ws + M_H), (DBG_NO_FFN || rep) ? 0.f : 1.f}, smem + 40960);
        pg8::Gemm g{(const bf16_t*)(ws + OFF_ACT), WdnT, RR, DM, DFF}; pg8::StaticOrder S; S.init(RR, DM, G, bx);
#if defined(PROBE_NULLDOWN)
        { EpiNull EN; pg8::gemm_phase<EpiNull, pg8::StaticOrder>(glds, g, S, EN, nullptr); }
#endif
        if constexpr (L + 1 < NLAYER) {
            EpiResidB E{(bf16_t*)(ws + OFF_HB), rep ? nullptr : (u64_t*)(ws + OFF_SSQ) + (size_t)(2 * l + 2) * RR, (DBG_NO_FFN || rep) ? 0.f : 1.f};
            pg8::gemm_phase<EpiResidB, pg8::StaticOrder>(glds, g, S, E, nullptr);
        } else {
            EpiFinal E{(const bf16_t*)(ws + OFF_HB), a.out, DBG_NO_FFN ? 0.f : 1.f};
            pg8::gemm_phase<EpiFinal, pg8::StaticOrder>(glds, g, S, E, nullptr);
        }
    }
    SEAM(pb + 7);
#undef IN
#undef SEAM
#undef OPQ_WS
}
__global__ void __launch_bounds__(512, 2) fwd(Args a) {
    extern __shared__ __attribute__((aligned(16))) char smem[];
    unsigned char* ws = a.ws;
    const int lo = a.ph_lo, hi = a.ph_hi;
    const bool fused = (hi - lo) > 1;
    if (threadIdx.x == 0) *(u32x4*)(smem + LDS_XB) = (u32x4){0u, 0u, 0u, 0u};
    __syncthreads();
    XcdBarrier bar; bar.bar = (unsigned*)(ws + OFF_CTL); bar.x = 0; bar.st = (volatile LAS unsigned*)(smem + LDS_XB);
    if (fused) bar = xcd_barrier_post((unsigned*)(ws + OFF_CTL), (volatile LAS unsigned*)(smem + LDS_XB));
    for (int rep = 0; rep < 1 + ((REP_MASK >> 15) & 1); ++rep) if ((EN_MASK & 1) && lo <= 0 && 0 < hi) p_prologue(a, smem);
    if (lo <= 0 && 1 < hi) xcd_barrier(bar);
    layer_phases<0>(a, smem, bar, lo, hi);
    layer_phases<1>(a, smem, bar, lo, hi);
}


extern "C" void kernel_launch(void* const* d_in, const int* in_sizes, int n_in, void* d_out, int out_size, void* d_ws, size_t ws_size, hipStream_t stream) {
    static int grid = 0;
    if (grid == 0) {
        if (n_in != 20 || in_sizes[0] != RR * DM || out_size != RR * DM || ws_size < WS_END) {
            fprintf(stderr, "kernel_launch: shape mismatch: n_in %d in0 %d out %d ws %zu (need %zu)\n", n_in, n_in > 0 ? in_sizes[0] : -1, out_size, ws_size, (size_t)WS_END); grid = -1; return; }
        int dev = 0, cus = 0, per_cu = 0;
        if (hipGetDevice(&dev) != hipSuccess || hipDeviceGetAttribute(&cus, hipDeviceAttributeMultiprocessorCount, dev) != hipSuccess) { fprintf(stderr, "kernel_launch: device query failed\n"); grid = -1; return; }
        if (hipFuncSetAttribute((const void*)fwd, hipFuncAttributeMaxDynamicSharedMemorySize, LDS_BYTES) != hipSuccess) { fprintf(stderr, "kernel_launch: hipFuncSetAttribute failed\n"); grid = -1; return; }
        if (hipOccupancyMaxActiveBlocksPerMultiprocessor(&per_cu, (const void*)fwd, 512, LDS_BYTES) != hipSuccess || per_cu < 1)
            fprintf(stderr, "kernel_launch: note: occupancy query reports %d workgroups per CU\n", per_cu);
        (void)hipGetLastError();
        grid = cus;
    }
    if (grid < 0) return;
    if (hipMemsetAsync((char*)d_ws + OFF_CTL, 0, SZ_CTL, stream) != hipSuccess) { fprintf(stderr, "kernel_launch: memset failed\n"); return; }
    Args a{};
    for (int i = 0; i < 20; ++i) a.in[i] = (const float*)d_in[i];
    a.out = (float*)d_out; a.ws = (unsigned char*)d_ws;
#if ONE_LAUNCH
    a.ph_lo = 0; a.ph_hi = NPH;
    hipLaunchKernelGGL(fwd, dim3(grid), dim3(512), LDS_BYTES, stream, a);
#else
    for (int p = 0; p < NPH; ++p) { a.ph_lo = p; a.ph_hi = p + 1; hipLaunchKernelGGL(fwd, dim3(grid), dim3(512), LDS_BYTES, stream, a); }
#endif
    const hipError_t le = hipPeekAtLastError();
    if (le != hipSuccess) fprintf(stderr, "kernel_launch: launch failed: %s\n", hipGetErrorName(le));
}
```
